# Optimizing an MI355X kernel written in HIP

```python
import math
import jax
import jax.numpy as jnp
from jax import lax
import numpy as np

D_MODEL = 4096
BATCH = 4
SEQ = 4096
DEPTH = 2
DEC_BATCH = 16
DEC_SEQ = 16
PAST_LEN = 2048

CHUNK = 64
MIX_WIDTH = D_MODEL
DN_WIDTH = MIX_WIDTH // 2
DN_HEAD_DIM = 128
DN_HEADS = DN_WIDTH // DN_HEAD_DIM
CONV_W = 4
DN_CONV_DIM = 3 * DN_WIDTH
ATT_WIDTH = MIX_WIDTH - DN_WIDTH
ATT_HEAD_DIM = 64
ATT_Q_HEADS = ATT_WIDTH // ATT_HEAD_DIM
ATT_KV_HEADS = ATT_Q_HEADS // 8
ATT_GROUP = ATT_Q_HEADS // ATT_KV_HEADS
ATT_KV_WIDTH = ATT_KV_HEADS * ATT_HEAD_DIM
WINDOW = 128
ROPE_THETA = 10000.0
NORM_EPS = 1e-6
IN_SIZES = (DN_CONV_DIM, DN_WIDTH, DN_HEADS, DN_HEADS, ATT_WIDTH, ATT_KV_WIDTH, ATT_KV_WIDTH, ATT_WIDTH)
IN_DIM = sum(IN_SIZES)

kernel_name = 'hybrid_gdn_swa_sink_stream_step'


def rms_norm(x, gain):
    xf = x.astype(jnp.float32)
    y = xf * lax.rsqrt(jnp.mean(xf * xf, axis=-1, keepdims=True) + NORM_EPS)
    return (y * gain.astype(jnp.float32)).astype(x.dtype)


def l2_norm(x):
    xf = x.astype(jnp.float32)
    return xf * lax.rsqrt(jnp.sum(xf * xf, axis=-1, keepdims=True) + NORM_EPS)


def rope(x, pos):
    half = x.shape[-1] // 2
    inv = ROPE_THETA ** (-jnp.arange(half, dtype=jnp.float32) / half)
    ang = pos.astype(jnp.float32)[:, None] * inv[None, :]
    cos = jnp.cos(ang)[None, :, None, :]
    sin = jnp.sin(ang)[None, :, None, :]
    x1 = x[..., :half].astype(jnp.float32)
    x2 = x[..., half:].astype(jnp.float32)
    return jnp.concatenate([x1 * cos - x2 * sin, x2 * cos + x1 * sin], axis=-1).astype(x.dtype)


def split_cols(p):
    points = []
    acc = 0
    for s in IN_SIZES[:-1]:
        acc += s
        points.append(acc)
    return jnp.split(p, points, axis=-1)


def causal_short_conv(x, buf, w):
    t = x.shape[1]
    xp = jnp.concatenate([buf.astype(x.dtype), x], axis=1)
    y = xp[:, 0:t] * w[0]
    for j in range(1, CONV_W):
        y = y + xp[:, j:j + t] * w[j]
    return jax.nn.silu(y), xp[:, -(CONV_W - 1):]


def gated_delta_rule(q, k, v, g, beta, s0):
    n, t, h, dk = q.shape
    dv = v.shape[-1]
    cs = min(CHUNK, t)
    nc = t // cs

    def blk(a):
        return a.reshape(n, nc, cs, *a.shape[2:])

    q, k, v, g, beta = blk(q) * dk ** -0.5, blk(k), blk(v), blk(g), blk(beta)
    gc = jnp.cumsum(g, axis=2)
    idx = jnp.arange(cs)
    causal = (idx[:, None] >= idx[None, :])[None, None, :, :, None]
    strict = (idx[:, None] > idx[None, :])[None, None, :, :, None]
    diff = gc[:, :, :, None, :] - gc[:, :, None, :, :]
    gamma = jnp.exp(jnp.where(causal, diff, -jnp.inf))
    kk = jnp.einsum('ncihd,ncjhd->ncijh', k, k)
    a_mat = jnp.where(strict, beta[:, :, :, None, :] * kk * gamma, 0.0).transpose(0, 1, 4, 2, 3)
    rhs_u = (beta[..., None] * v).transpose(0, 1, 3, 2, 4)
    rhs_w = (beta[..., None] * jnp.exp(gc)[..., None] * k).transpose(0, 1, 3, 2, 4)
    sol = lax.linalg.triangular_solve(a_mat, jnp.concatenate([rhs_u, rhs_w], axis=-1),
                                      left_side=True, lower=True, unit_diagonal=True)
    u, w = sol[..., :dv], sol[..., dv:]
    qk = jnp.einsum('ncihd,ncjhd->nchij', q, k) * gamma.transpose(0, 1, 4, 2, 3)
    qdec = (q * jnp.exp(gc)[..., None]).transpose(0, 1, 3, 2, 4)
    kdec = (k * jnp.exp(gc[:, :, -1:, :] - gc)[..., None]).transpose(0, 1, 3, 2, 4)
    blk_decay = jnp.exp(gc[:, :, -1, :])
    xs = tuple(a.swapaxes(0, 1) for a in (u, w, qk, qdec, kdec, blk_decay))

    def step(s, inp):
        u_c, w_c, qk_c, qdec_c, kdec_c, dec_c = inp
        v_new = u_c - jnp.einsum('nhid,nhde->nhie', w_c, s)
        o = jnp.einsum('nhid,nhde->nhie', qdec_c, s) + jnp.einsum('nhij,nhje->nhie', qk_c, v_new)
        s = s * dec_c[..., None, None] + jnp.einsum('nhjd,nhje->nhde', kdec_c, v_new)
        return s, o

    s_final, o = lax.scan(step, s0, xs)
    o = o.transpose(1, 0, 3, 2, 4).reshape(n, t, h, dv)
    return o, s_final


def deltanet_branch(qkv_pre, z, b, a, conv_buf, s0, conv_w, a_log, dt_bias, norm_g):
    n, t, _ = qkv_pre.shape
    qkv, new_buf = causal_short_conv(qkv_pre, conv_buf, conv_w)
    q, k, v = jnp.split(qkv, 3, axis=-1)
    q = l2_norm(q.reshape(n, t, DN_HEADS, DN_HEAD_DIM))
    k = l2_norm(k.reshape(n, t, DN_HEADS, DN_HEAD_DIM))
    v = v.reshape(n, t, DN_HEADS, DN_HEAD_DIM).astype(jnp.float32)
    beta = jax.nn.sigmoid(b.astype(jnp.float32))
    g = -jnp.exp(a_log.astype(jnp.float32)) * jax.nn.softplus(a.astype(jnp.float32) + dt_bias.astype(jnp.float32))
    o, s_new = gated_delta_rule(q, k, v, g, beta, s0.astype(jnp.float32))
    zg = jax.nn.silu(z.reshape(n, t, DN_HEADS, DN_HEAD_DIM).astype(jnp.float32))
    o = rms_norm(o, norm_g) * zg
    return o.reshape(n, t, DN_WIDTH).astype(qkv_pre.dtype), new_buf, s_new


def sink_attention(q, k, v, sinks, mask):
    s = jnp.einsum('...tkgd,...skd->...kgts', q, k).astype(jnp.float32) * ATT_HEAD_DIM ** -0.5
    if mask is not None:
        s = jnp.where(mask, s, -jnp.inf)
    sink = sinks.astype(jnp.float32).reshape(ATT_KV_HEADS, ATT_GROUP)[:, :, None, None]
    m = jnp.maximum(jnp.max(s, axis=-1, keepdims=True), sink)
    p = jnp.exp(s - m)
    p = (p / (jnp.sum(p, axis=-1, keepdims=True) + jnp.exp(sink - m))).astype(v.dtype)
    return jnp.einsum('...kgts,...skd->...tkgd', p, v)


def to_band(x, nc, nb):
    n = x.shape[0]
    xp = jnp.pad(x, ((0, 0), (nb * CHUNK, 0), (0, 0), (0, 0)))
    xp = xp.reshape(n, nc + nb, CHUNK, *x.shape[2:])
    return jnp.concatenate([xp[:, j:j + nc] for j in range(nb + 1)], axis=2)


def swa_branch(q, k, v, z, pos, sinks, cache_k, cache_v):
    n, t, _ = q.shape
    q = rope(q.reshape(n, t, ATT_Q_HEADS, ATT_HEAD_DIM), pos)
    k = rope(k.reshape(n, t, ATT_KV_HEADS, ATT_HEAD_DIM), pos)
    v = v.reshape(n, t, ATT_KV_HEADS, ATT_HEAD_DIM)
    if cache_k is None:
        nc = t // CHUNK
        nb = WINDOW // CHUNK
        band = (nb + 1) * CHUNK
        qb = q.reshape(n, nc, CHUNK, ATT_KV_HEADS, ATT_GROUP, ATT_HEAD_DIM)
        kpos = (jnp.arange(nc)[:, None] - nb) * CHUNK + jnp.arange(band)[None, :]
        mask = (kpos >= 0)[None, :, None, None, None, :]
        o = sink_attention(qb, to_band(k, nc, nb), to_band(v, nc, nb), sinks, mask)
        k_all, v_all = k, v
        rows = WINDOW
    else:
        k_all = jnp.concatenate([cache_k.astype(k.dtype), k], axis=1)
        v_all = jnp.concatenate([cache_v.astype(v.dtype), v], axis=1)
        qg = q.reshape(n, t, ATT_KV_HEADS, ATT_GROUP, ATT_HEAD_DIM)
        o = sink_attention(qg, k_all, v_all, sinks, None)
        rows = cache_k.shape[1]
    o = o.reshape(n, t, ATT_WIDTH) * jax.nn.silu(z)
    return o, k_all[:, -rows:], v_all[:, -rows:]


def layer(x, c, pos, conv_buf, dn_state, win_k, win_v,
          w_ada, b_ada, g_pre, g_post, w_in, conv_w, a_log, dt_bias, dn_norm, sinks, w_out):
    shift, scale, gate = jnp.split(jax.nn.silu(c) @ w_ada + b_ada, 3, axis=-1)
    h = rms_norm(x, g_pre) * (1.0 + scale[:, None, :]) + shift[:, None, :]
    qkv_pre, z_dn, b_dn, a_dn, q_at, k_at, v_at, z_at = split_cols(h @ w_in)
    o_dn, conv_new, s_new = deltanet_branch(qkv_pre, z_dn, b_dn, a_dn, conv_buf, dn_state,
                                            conv_w, a_log, dt_bias, dn_norm)
    o_at, k_new, v_new = swa_branch(q_at, k_at, v_at, z_at, pos, sinks, win_k, win_v)
    y = jnp.concatenate([o_dn, o_at], axis=-1) @ w_out
    x = x + gate[:, None, :] * rms_norm(y, g_post)
    return x, conv_new, s_new.astype(x.dtype), k_new, v_new


def setup_inputs(seed: int = 0) -> dict:
    key = jax.random.key(seed)
    ks = jax.random.split(key, 22)
    f32 = jnp.float32

    def nrm(k, shape, s):
        return jax.random.normal(k, shape, f32) * s

    win_rows = min(WINDOW, PAST_LEN)
    dt = jnp.exp(jax.random.uniform(ks[15], (DEPTH, DN_HEADS), f32, math.log(1e-3), math.log(1e-1)))
    return {
        'x_prompt': nrm(ks[0], (BATCH, SEQ, D_MODEL), 1.0),
        'x_sample': nrm(ks[1], (DEC_BATCH, DEC_SEQ, D_MODEL), 1.0),
        'state_conv': nrm(ks[2], (DEPTH, DEC_BATCH, CONV_W - 1, DN_CONV_DIM), 1.0),
        'state_dn': nrm(ks[3], (DEPTH, DEC_BATCH, DN_HEADS, DN_HEAD_DIM, DN_HEAD_DIM), 0.05),
        'cache_k': nrm(ks[4], (DEPTH, DEC_BATCH, win_rows, ATT_KV_HEADS, ATT_HEAD_DIM), 1.0),
        'cache_v': nrm(ks[5], (DEPTH, DEC_BATCH, win_rows, ATT_KV_HEADS, ATT_HEAD_DIM), 1.0),
        'c_prompt': nrm(ks[6], (BATCH, D_MODEL), 1.0),
        'c_sample': nrm(ks[7], (DEC_BATCH, D_MODEL), 1.0),
        'w_ada': nrm(ks[8], (DEPTH, D_MODEL, 3 * D_MODEL), 0.5 * D_MODEL ** -0.5),
        'b_ada': nrm(ks[9], (DEPTH, 3 * D_MODEL), 0.02),
        'g_pre': 1.0 + nrm(ks[10], (DEPTH, D_MODEL), 0.05),
        'g_post': 1.0 + nrm(ks[11], (DEPTH, D_MODEL), 0.05),
        'w_in': nrm(ks[12], (DEPTH, D_MODEL, IN_DIM), D_MODEL ** -0.5),
        'conv_w': nrm(ks[13], (DEPTH, CONV_W, DN_CONV_DIM), CONV_W ** -0.5),
        'a_log': jnp.log(jax.random.uniform(ks[14], (DEPTH, DN_HEADS), f32, 1.0, 16.0)),
        'dt_bias': dt + jnp.log(-jnp.expm1(-dt)),
        'dn_norm': 1.0 + nrm(ks[16], (DEPTH, DN_HEAD_DIM), 0.05),
        'sinks': nrm(ks[17], (DEPTH, ATT_Q_HEADS), 0.5),
        'w_out': nrm(ks[18], (DEPTH, MIX_WIDTH, D_MODEL), MIX_WIDTH ** -0.5),
    }


def reference(x_prompt, x_sample, state_conv, state_dn, cache_k, cache_v, c_prompt, c_sample,
              w_ada, b_ada, g_pre, g_post, w_in, conv_w, a_log, dt_bias, dn_norm, sinks, w_out):
    bp, tp, _ = x_prompt.shape
    pos_p = jnp.arange(tp)
    pos_s = PAST_LEN + jnp.arange(x_sample.shape[1])
    zero_conv = jnp.zeros((bp, CONV_W - 1, DN_CONV_DIM), x_prompt.dtype)
    zero_state = jnp.zeros((bp, DN_HEADS, DN_HEAD_DIM, DN_HEAD_DIM), jnp.float32)
    xp, xs = x_prompt, x_sample
    conv_p, dn_p, k_p, v_p = [], [], [], []
    conv_s, dn_s, k_s, v_s = [], [], [], []
    for l in range(DEPTH):
        lw = (w_ada[l], b_ada[l], g_pre[l], g_post[l], w_in[l], conv_w[l],
              a_log[l], dt_bias[l], dn_norm[l], sinks[l], w_out[l])
        xp, cb, sb, kb, vb = layer(xp, c_prompt, pos_p, zero_conv, zero_state, None, None, *lw)
        conv_p.append(cb); dn_p.append(sb); k_p.append(kb); v_p.append(vb)
        xs, cb, sb, kb, vb = layer(xs, c_sample, pos_s, state_conv[l], state_dn[l],
                                   cache_k[l], cache_v[l], *lw)
        conv_s.append(cb); dn_s.append(sb); k_s.append(kb); v_s.append(vb)
    return (xp, xs,
            jnp.stack(conv_p), jnp.stack(dn_p), jnp.stack(k_p), jnp.stack(v_p),
            jnp.stack(conv_s), jnp.stack(dn_s), jnp.stack(k_s), jnp.stack(v_s))
```

```cpp
#include <hip/hip_runtime.h>
#include <cstdio>
#include <cstdint>
#define MK_PER_PHASE 0
__device__ __forceinline__ int tid_opaque() { int t = threadIdx.x; asm volatile("" : "+v"(t)); return t; }
namespace pg8 {
#define PG8_LAS __attribute__((address_space(3)))
typedef unsigned short bf16_t;
typedef short bf16x8 __attribute__((ext_vector_type(8)));
typedef float f32x4 __attribute__((ext_vector_type(4)));
typedef unsigned u32x4 __attribute__((ext_vector_type(4)));
constexpr int BM = 256, BK = 64, HALF = 128, HTB = HALF * BK * 2  , STAGE_BYTES = 8 * HTB, NXCD = 8, WGM = 8;

__host__ __device__ __forceinline__ int lds_byte(int r, int c) { const int st = (r >> 4) * 2 + (c >> 5), rr = r & 15, cc = c & 31, ob = rr * 64 + cc * 2; return st * 1024 + (ob ^ (((ob >> 9) & 1) << 5)); }
__host__ __device__ __forceinline__ void stage_rc(int b, int& R, int& C) { const int st = b / 1024, sb = b % 1024, swz = sb ^ (((sb >> 9) & 1) << 5); R = (st >> 1) * 16 + swz / 64; C = (st & 1) * 32 + (swz % 64) / 2; }
__host__ __device__ __forceinline__ int perm32(int rho) { const int n = rho >> 4, i = rho & 15; return 8 * (i >> 2) + 4 * n + (i & 3); }

struct Unit { int pm, pn; };
struct Gemm { const bf16_t* A; const bf16_t* Bt; int M, N, K; };

struct StaticOrder {
    int nM, nN, nwg, G, c;
    __host__ __device__ void init(int M, int N, int G_, int c_) { nM = M / BM; nN = N / BM; nwg = nM * nN; G = G_; c = c_; }
    __host__ __device__ bool next(int i, Unit& u) const {
        const long L = (long)i * G + c; if (L >= nwg) return false;
        int wgid = (int)L; { const int q = nwg / NXCD, r = nwg % NXCD, xcd = wgid % NXCD, off = wgid / NXCD; wgid = (xcd < r ? xcd * (q + 1) : r * (q + 1) + (xcd - r) * q) + off; }
        const int nig = WGM * nN, gid = wgid / nig, fm = gid * WGM, gsz = (nM - fm) < WGM ? (nM - fm) : WGM;
        u.pm = fm + ((wgid % nig) % gsz); u.pn = (wgid % nig) / gsz; return true;
    }
    __device__ __forceinline__ void a_ready(const Unit&) const {}
    __device__ __forceinline__ void done(const Unit&) const {}
};

typedef __bf16 hwbf16x2_t __attribute__((ext_vector_type(2))); typedef float f32x2_t __attribute__((ext_vector_type(2)));
__device__ __forceinline__ unsigned cvt_pk_bf16(float lo, float hi) { const f32x2_t v = {lo, hi}; return __builtin_bit_cast(unsigned, __builtin_convertvector(v, hwbf16x2_t)); }
struct EpiP {
    static constexpr bool PERM = true, AFTER_DRAIN = false;
    bf16_t* O; int ldc;
    __device__ __forceinline__ void operator()(const f32x4 (&acc)[2][2][4][2], const Unit& u, int wr, int wc, int fr, int fq) const {
        const int row0 = u.pm * BM + wr * 64 + fr, col0 = u.pn * BM + wc * 32 + 8 * fq;
#pragma unroll
        for (int ai = 0; ai < 2; ++ai)
#pragma unroll
            for (int m = 0; m < 4; ++m) { bf16_t* rowp = O + (size_t)(row0 + ai * HALF + m * 16) * ldc + col0;
#pragma unroll
                for (int bj = 0; bj < 2; ++bj) { const f32x4 v0 = acc[ai][bj][m][0], v1 = acc[ai][bj][m][1];
                    u32x4 w; w.x = cvt_pk_bf16(v0[0], v0[1]); w.y = cvt_pk_bf16(v0[2], v0[3]); w.z = cvt_pk_bf16(v1[0], v1[1]); w.w = cvt_pk_bf16(v1[2], v1[3]);
                    *(u32x4*)(rowp + bj * HALF) = w; } }
    }
};
struct EpiY {
    static constexpr bool PERM = true, AFTER_DRAIN = false;
    bf16_t* O; int ldc; float* part;
    __device__ __forceinline__ void operator()(const f32x4 (&acc)[2][2][4][2], const Unit& u, int wr, int wc, int fr, int fq) const {
        const int row0 = u.pm * BM + wr * 64 + fr, col0 = u.pn * BM + wc * 32 + 8 * fq;
#pragma unroll
        for (int ai = 0; ai < 2; ++ai)
#pragma unroll
            for (int m = 0; m < 4; ++m) { const int row = row0 + ai * HALF + m * 16; bf16_t* rowp = O + (size_t)row * ldc + col0; float s = 0.f;
#pragma unroll
                for (int bj = 0; bj < 2; ++bj) { const f32x4 v0 = acc[ai][bj][m][0], v1 = acc[ai][bj][m][1];
                    s += (v0[0] * v0[0] + v0[1] * v0[1]) + (v0[2] * v0[2] + v0[3] * v0[3]) + (v1[0] * v1[0] + v1[1] * v1[1]) + (v1[2] * v1[2] + v1[3] * v1[3]);
                    u32x4 w; w.x = cvt_pk_bf16(v0[0], v0[1]); w.y = cvt_pk_bf16(v0[2], v0[3]); w.z = cvt_pk_bf16(v1[0], v1[1]); w.w = cvt_pk_bf16(v1[2], v1[3]);
                    *(u32x4*)(rowp + bj * HALF) = w; }
                s += __shfl_xor(s, 16); s += __shfl_xor(s, 32);
                if (fq == 0) part[(size_t)row * 64 + u.pn * 4 + wc] = s; }
    }
};

template <class Epi, class Sched, bool ALIGN_EPI = false, bool SP2 = false>
__device__ __forceinline__ void gemm_phase(PG8_LAS unsigned char* lds, const Gemm g, const Sched& S, const Epi& E) {
    const int tid = tid_opaque(), wid = __builtin_amdgcn_readfirstlane(tid >> 6), lane = tid & 63, wr = wid >> 2, wc = wid & 3, fr = lane & 15, fq = lane >> 4;
    const int K = g.K, nt = K / BK;
    unsigned voffA[2], voffB[2];
#pragma unroll
    for (int i = 0; i < 2; ++i) { int R, C; stage_rc(tid * 16 + i * 8192, R, C); const int Rb = Epi::PERM ? ((R & ~31) + perm32(R & 31)) : R;
        voffA[i] = (unsigned)(R * K + C) * 2u; voffB[i] = (unsigned)(Rb * K + C) * 2u; }
    const size_t kstep = (size_t)(BK * 2);
    const size_t hstep = (size_t)HALF * K * 2;
    const size_t tstep = 2 * hstep;
    const unsigned ldsw = (unsigned)wid * 1024u;
    const int aoff = lds_byte(wr * 64 + fr, fq * 8), boff = lds_byte(wc * 32 + fr, fq * 8);
#define PG8_SA(b, h) (((b) * 2 + (h)) * HTB)
#define PG8_SB(b, h) ((4 + (b) * 2 + (h)) * HTB)
#define PG8_STAGE(bufoff, gbase, voff) do { _Pragma("unroll") for (int _i = 0; _i < 2; ++_i) \
        __builtin_amdgcn_global_load_lds((const unsigned*)((const char*)(gbase) + (voff)[_i]), (PG8_LAS unsigned*)(lds + (bufoff) + ldsw + _i * 8192), 16, 0, 0); } while (0)
#define PG8_LDA(dst, b, h) do { _Pragma("unroll") for (int m = 0; m < 4; ++m) _Pragma("unroll") for (int k = 0; k < 2; ++k) dst[m][k] = *(const PG8_LAS bf16x8*)(lds + PG8_SA(b, h) + aoff + m * 2048 + k * 1024); } while (0)
#define PG8_LDB(dst, b, h) do { _Pragma("unroll") for (int n = 0; n < 2; ++n) _Pragma("unroll") for (int k = 0; k < 2; ++k) dst[n][k] = *(const PG8_LAS bf16x8*)(lds + PG8_SB(b, h) + boff + n * 2048 + k * 1024); } while (0)
#define PG8_MMA(ai, bj, At, Bt) do { __builtin_amdgcn_s_setprio(1); _Pragma("unroll") for (int m = 0; m < 4; ++m) _Pragma("unroll") for (int n = 0; n < 2; ++n) _Pragma("unroll") for (int k = 0; k < 2; ++k) \
        acc[ai][bj][m][n] = __builtin_amdgcn_mfma_f32_16x16x32_bf16(Bt[n][k], At[m][k], acc[ai][bj][m][n], 0, 0, 0); __builtin_amdgcn_s_setprio(0); } while (0)
#define PG8_WAIT_V(n) asm volatile("s_waitcnt vmcnt(" #n ")" ::: "memory")
#define PG8_WAIT_L(n) asm volatile("s_waitcnt lgkmcnt(" #n ")" ::: "memory")
#define PG8_BAR __builtin_amdgcn_s_barrier()
#define PG8_SCHED __builtin_amdgcn_sched_barrier(0)
    Unit cur, nxt; int ui = 0;
    if (!S.next(0, cur)) return;
    f32x4 acc[2][2][4][2];
#pragma unroll
    for (int a = 0; a < 2; ++a)
#pragma unroll
        for (int b = 0; b < 2; ++b)
#pragma unroll
            for (int m = 0; m < 4; ++m)
#pragma unroll
                for (int n = 0; n < 2; ++n) acc[a][b][m][n] = (f32x4){0.f, 0.f, 0.f, 0.f};
    bf16x8 At[4][2], B0[2][2], B1[2][2];
    const char* cA = (const char*)g.A + (size_t)cur.pm * tstep; const char* cB = (const char*)g.Bt + (size_t)cur.pn * tstep;
    S.a_ready(cur);
    if constexpr (SP2) {
        PG8_STAGE(PG8_SB(0, 0), cB, voffB); PG8_STAGE(PG8_SB(0, 1), cB + hstep, voffB); PG8_STAGE(PG8_SA(0, 0), cA, voffA); PG8_STAGE(PG8_SA(0, 1), cA + hstep, voffA);
        if (wr == 1) PG8_BAR;
        PG8_WAIT_V(2); PG8_BAR;
        PG8_STAGE(PG8_SB(1, 0), cB + kstep, voffB); PG8_STAGE(PG8_SA(1, 0), cA + kstep, voffA); PG8_STAGE(PG8_SB(1, 1), cB + hstep + kstep, voffB);
        PG8_WAIT_V(6); PG8_BAR;
    } else {
        PG8_STAGE(PG8_SB(0, 0), cB, voffB); PG8_STAGE(PG8_SA(0, 0), cA, voffA); PG8_STAGE(PG8_SB(0, 1), cB + hstep, voffB); PG8_STAGE(PG8_SA(0, 1), cA + hstep, voffA);
        if (wr == 1) PG8_BAR;
        PG8_WAIT_V(4); PG8_BAR;
        PG8_STAGE(PG8_SB(1, 0), cB + kstep, voffB); PG8_STAGE(PG8_SA(1, 0), cA + kstep, voffA); PG8_STAGE(PG8_SB(1, 1), cB + hstep + kstep, voffB);
        PG8_WAIT_V(6); PG8_BAR;
    }
    for (;;) {
        const bool has_next = S.next(ui + 1, nxt);
        const char* nA = has_next ? (const char*)g.A + (size_t)nxt.pm * tstep : cA; const char* nB = has_next ? (const char*)g.Bt + (size_t)nxt.pn * tstep : cB;
        for (int t = 0; t < nt; t += 2) {
            const bool last = (t == nt - 2);
            const char* a1 = cA + (size_t)(t + 1) * kstep;
            const char* a2 = last ? nA : cA + (size_t)(t + 2) * kstep; const char* b2 = last ? nB : cB + (size_t)(t + 2) * kstep;
            const char* a3 = a2 + kstep; const char* b3 = b2 + kstep;
            if (last && has_next) S.a_ready(nxt);
            if constexpr (SP2) {
            PG8_LDB(B0, 0, 0); PG8_LDB(B1, 0, 1); PG8_SCHED; PG8_LDA(At, 0, 0); PG8_STAGE(PG8_SA(1, 1), a1 + hstep, voffA);
            PG8_WAIT_V(8); PG8_WAIT_L(0); PG8_BAR; PG8_MMA(0, 0, At, B0); PG8_MMA(0, 1, At, B1); PG8_BAR; PG8_SCHED;
            PG8_LDA(At, 0, 1); PG8_STAGE(PG8_SB(0, 0), b2, voffB); PG8_STAGE(PG8_SB(0, 1), b2 + hstep, voffB); PG8_STAGE(PG8_SA(0, 0), a2, voffA);
            PG8_WAIT_V(8); PG8_WAIT_L(0); PG8_BAR; PG8_MMA(1, 0, At, B0); PG8_MMA(1, 1, At, B1); PG8_BAR; PG8_SCHED;
            PG8_LDB(B0, 1, 0); PG8_LDB(B1, 1, 1); PG8_SCHED; PG8_LDA(At, 1, 0); PG8_STAGE(PG8_SA(0, 1), a2 + hstep, voffA);
            PG8_WAIT_V(8); PG8_WAIT_L(0); PG8_BAR; PG8_MMA(0, 0, At, B0); PG8_MMA(0, 1, At, B1); PG8_BAR; PG8_SCHED;
            PG8_LDA(At, 1, 1); PG8_STAGE(PG8_SB(1, 0), b3, voffB); PG8_STAGE(PG8_SB(1, 1), b3 + hstep, voffB); PG8_STAGE(PG8_SA(1, 0), a3, voffA);
            PG8_WAIT_V(8); PG8_WAIT_L(0); PG8_BAR; PG8_MMA(1, 0, At, B0); PG8_MMA(1, 1, At, B1); PG8_BAR; PG8_SCHED;
            } else {
            PG8_LDB(B0, 0, 0); PG8_SCHED; PG8_LDA(At, 0, 0); PG8_STAGE(PG8_SA(1, 1), a1 + hstep, voffA);
            PG8_WAIT_L(8); PG8_BAR; PG8_WAIT_L(0); PG8_MMA(0, 0, At, B0); PG8_BAR; PG8_SCHED;
            PG8_LDB(B1, 0, 1); PG8_STAGE(PG8_SB(0, 0), b2, voffB);
            PG8_BAR; PG8_WAIT_L(0); PG8_MMA(0, 1, At, B1); PG8_BAR;
            PG8_LDA(At, 0, 1); PG8_STAGE(PG8_SA(0, 0), a2, voffA);
            PG8_BAR; PG8_WAIT_L(0); PG8_MMA(1, 0, At, B0); PG8_BAR; PG8_SCHED;
            PG8_STAGE(PG8_SB(0, 1), b2 + hstep, voffB);
            PG8_WAIT_V(6); PG8_BAR; PG8_MMA(1, 1, At, B1); PG8_BAR;
            PG8_LDB(B0, 1, 0); PG8_SCHED; PG8_LDA(At, 1, 0); PG8_STAGE(PG8_SA(0, 1), a2 + hstep, voffA);
            PG8_WAIT_L(8); PG8_BAR; PG8_WAIT_L(0); PG8_MMA(0, 0, At, B0); PG8_BAR; PG8_SCHED;
            PG8_LDB(B1, 1, 1); PG8_STAGE(PG8_SB(1, 0), b3, voffB);
            PG8_BAR; PG8_WAIT_L(0); PG8_MMA(0, 1, At, B1); PG8_BAR;
            PG8_LDA(At, 1, 1); PG8_STAGE(PG8_SA(1, 0), a3, voffA);
            PG8_BAR; PG8_WAIT_L(0); PG8_MMA(1, 0, At, B0); PG8_BAR; PG8_SCHED;
            PG8_STAGE(PG8_SB(1, 1), b3 + hstep, voffB);
            PG8_WAIT_V(6); PG8_BAR; PG8_MMA(1, 1, At, B1); PG8_BAR;
            }
        }
        if constexpr (ALIGN_EPI) { if (wr == 0) PG8_BAR; }
        if constexpr (!Epi::AFTER_DRAIN) { E(acc, cur, wr, wc, fr, fq); S.done(cur); }
        if (!has_next) break;
#pragma unroll
        for (int a = 0; a < 2; ++a)
#pragma unroll
            for (int b = 0; b < 2; ++b)
#pragma unroll
                for (int m = 0; m < 4; ++m)
#pragma unroll
                    for (int n = 0; n < 2; ++n) acc[a][b][m][n] = (f32x4){0.f, 0.f, 0.f, 0.f};
        cur = nxt; cA = nA; cB = nB; ++ui;
        if constexpr (ALIGN_EPI) { if (wr == 1) PG8_BAR; }
    }
    PG8_WAIT_V(0);
    if constexpr (!ALIGN_EPI) { if (wr == 0) PG8_BAR; }
    PG8_BAR;
    if constexpr (Epi::AFTER_DRAIN) { E.fused(acc, cur, wr, wc, fr, fq, lds, wid, lane); S.done(cur); }
#undef PG8_SA
#undef PG8_SB
#undef PG8_STAGE
#undef PG8_LDA
#undef PG8_LDB
#undef PG8_MMA
#undef PG8_WAIT_V
#undef PG8_WAIT_L
#undef PG8_BAR
#undef PG8_SCHED
}
}

#define GAS __attribute__((address_space(1)))
#define LAS __attribute__((address_space(3)))
typedef unsigned short bf16;
typedef short bf16x8 __attribute__((ext_vector_type(8)));
typedef short bf16x4 __attribute__((ext_vector_type(4)));
typedef float f32x4 __attribute__((ext_vector_type(4)));
typedef float f32x2 __attribute__((ext_vector_type(2)));
typedef unsigned u32x4 __attribute__((ext_vector_type(4)));
typedef unsigned u32x2 __attribute__((ext_vector_type(2)));

constexpr int D = 4096, NB = 4, T = 4096, NSB = 16, TS = 16, PAST = 2048;
constexpr int MP = NB * T, MS = NSB * TS, M = MP + MS;
constexpr int NP = 13056, IN_DIM = 12832;
constexpr int C_Q = 0, C_K = 2048, C_V = 4096, C_ZDN = 6144, C_AQ = 8192, C_AK = 10240, C_AV = 10496, C_AZ = 10752, C_B = 12800, C_A = 12816;
constexpr float EPS = 1e-6f;
constexpr size_t O_YP = 0, O_YS = O_YP + (size_t)MP * D, O_CONVP = O_YS + (size_t)MS * D, O_DNP = O_CONVP + 2 * 4 * 3 * 6144, O_KP = O_DNP + 2 * 4 * 16 * 128 * 128,
                 O_VP = O_KP + 2 * 4 * 128 * 256, O_CONVS = O_VP + 2 * 4 * 128 * 256, O_DNS = O_CONVS + 2 * 16 * 3 * 6144, O_KS = O_DNS + (size_t)2 * 16 * 16 * 128 * 128,
                 O_VS = O_KS + 2 * 16 * 128 * 256, O_END = O_VS + 2 * 16 * 128 * 256;
static_assert(O_END == 82001920, "output size");
constexpr size_t MiB = 1u << 20;
constexpr size_t WS_CTL = 0, CTL_ZERO_BYTES = 1 * MiB;
constexpr size_t WS_MOD = 1 * MiB;
constexpr size_t WS_ROPE = 3 * MiB;
constexpr size_t WS_DEC = 4 * MiB;
constexpr size_t WS_YSQ = 5 * MiB;
constexpr size_t WS_BIN = 10 * MiB;
constexpr size_t BIN_BYTES = (size_t)NP * 4096 * 2;
constexpr size_t WS_BOUT = 214 * MiB;
constexpr size_t BOUT_BYTES = (size_t)4096 * 4096 * 2;
constexpr size_t WS_HO = 278 * MiB;
constexpr size_t WS_P = 408 * MiB;
constexpr size_t WS_REC = 823 * MiB;
constexpr int REC_W = 0, REC_QD = 16384, REC_KD = 32768, REC_QK = 49152, REC_U = 57344, REC_G = 73728, REC_BYTES = 90112, REC_STAGE = 57344;
constexpr int NREC = 4096 + 256;
constexpr size_t WS_END = WS_REC + (size_t)NREC * REC_BYTES;
static_assert(WS_BIN + 2 * BIN_BYTES <= WS_BOUT && WS_HO + (size_t)M * D * 2 <= WS_P && WS_P + (size_t)M * NP * 2 <= WS_REC, "ws map");
constexpr int CW_BAR = 4096;
constexpr int LDS_BYTES = 147456;
constexpr int MISC_OFF = 147456 - 256;

#define RLX_AGENT __ATOMIC_RELAXED, __HIP_MEMORY_SCOPE_AGENT
#define LDS_WAIT() asm volatile("s_waitcnt lgkmcnt(0)" ::: "memory")
#define VM_WAIT() asm volatile("s_waitcnt vmcnt(0)" ::: "memory")
typedef __bf16 hwbf16x2 __attribute__((ext_vector_type(2)));
__device__ __forceinline__ unsigned cvtpk(float lo, float hi) { const f32x2 v = {lo, hi}; return __builtin_bit_cast(unsigned, __builtin_convertvector(v, hwbf16x2)); }
__device__ __forceinline__ float bflo(unsigned w) { return __uint_as_float(w << 16); }
__device__ __forceinline__ float bfhi(unsigned w) { return __uint_as_float(w & 0xffff0000u); }
__device__ __forceinline__ float bf1(bf16 h) { return __uint_as_float(((unsigned)h) << 16); }
__device__ __forceinline__ float silu_f(float x) { return x * __builtin_amdgcn_rcpf(1.0f + __expf(-x)); }
__device__ __forceinline__ float sigmoid_f(float x) { return __builtin_amdgcn_rcpf(1.0f + __expf(-x)); }
__device__ __forceinline__ float wave_sum(float v) {
#pragma unroll
    for (int o = 1; o < 64; o <<= 1) v += __shfl_xor(v, o);
    return v;
}
__device__ __forceinline__ float wave_max(float v) {
#pragma unroll
    for (int o = 1; o < 64; o <<= 1) v = fmaxf(v, __shfl_xor(v, o));
    return v;
}
__device__ __forceinline__ void unpack8(const u32x4 w, float (&f)[8]) {
    f[0] = bflo(w.x); f[1] = bfhi(w.x); f[2] = bflo(w.y); f[3] = bfhi(w.y); f[4] = bflo(w.z); f[5] = bfhi(w.z); f[6] = bflo(w.w); f[7] = bfhi(w.w);
}
__device__ __forceinline__ u32x4 pack8(const float (&f)[8]) { u32x4 w; w.x = cvtpk(f[0], f[1]); w.y = cvtpk(f[2], f[3]); w.z = cvtpk(f[4], f[5]); w.w = cvtpk(f[6], f[7]); return w; }
__device__ __forceinline__ bf16x8 as_bf16x8(const u32x4 w) { return __builtin_bit_cast(bf16x8, w); }
__device__ __forceinline__ bf16x4 as_bf16x4(const u32x2 w) { return __builtin_bit_cast(bf16x4, w); }

#define XB_TMO      128
#define XB_XCNT(j)  (256  + 64 * (j))
#define XB_XSUB(j)  (1280 + 64 * (j))
#define XB_XGEN(j)  (2304 + 64 * (j))
#define XB_TOP      3328
#define XB_TOPGEN   3392
#define XCD_BAR_WORDS 3456
#define XB_SPIN_CAP (1u << 18)

__device__ __forceinline__ unsigned xb_ld(unsigned* p)              { return __hip_atomic_load(p, __ATOMIC_RELAXED, __HIP_MEMORY_SCOPE_AGENT); }
__device__ __forceinline__ unsigned xb_add(unsigned* p, unsigned v) { return __hip_atomic_fetch_add(p, v, __ATOMIC_RELAXED, __HIP_MEMORY_SCOPE_AGENT); }
__device__ __forceinline__ unsigned xb_xcc_id() { return (unsigned)__builtin_amdgcn_s_getreg((3 << 11) | 20) & 0xFu; }
#define XB_SPIN(cond, bar) do { unsigned _sp = 0; while (cond) { __builtin_amdgcn_s_sleep(1); \
    if ((++_sp & 255u) == 0u) { if (xb_ld(&(bar)[XB_TMO])) break; if (_sp > XB_SPIN_CAP) { atomicAdd(&(bar)[XB_TMO], 1u); break; } } } } while (0)

struct XcdBarrier {
    unsigned* bar; unsigned x;
    volatile LAS unsigned* st;
};

__device__ __forceinline__ XcdBarrier xcd_barrier_post(unsigned* bar, volatile LAS unsigned* st) {
    XcdBarrier b; b.bar = bar; b.x = xb_xcc_id(); b.st = st;
    if (threadIdx.x == 0) (void)xb_add(&bar[XB_XCNT(b.x)], 1u);
    return b;
}
__device__ __forceinline__ void xcd_barrier_complete(unsigned* bar, unsigned x, unsigned& nloc, unsigned& nx) {
    const unsigned G = gridDim.x * gridDim.y * gridDim.z;
    unsigned sum, cnt, mine, sp = 0u;
    for (;;) {
        sum = 0u; cnt = 0u; mine = 0u;
#pragma unroll
        for (unsigned j = 0; j < 16; ++j) { const unsigned c = xb_ld(&bar[XB_XCNT(j)]); sum += c; cnt += (c > 0u) ? 1u : 0u; mine = (j == x) ? c : mine; }
        if (sum == G) break;
        __builtin_amdgcn_s_sleep(1);
        if ((++sp & 255u) == 0u) { if (xb_ld(&bar[XB_TMO])) break; if (sp > XB_SPIN_CAP) { atomicAdd(&bar[XB_TMO], 1u); break; } }
    }
    nloc = mine > 0u ? mine : 1u; nx = cnt > 0u ? cnt : 1u;
}

__device__ __forceinline__ void xcd_barrier(const XcdBarrier& b) {
    asm volatile("s_waitcnt vmcnt(0)" ::: "memory");
    __syncthreads();
    if (threadIdx.x == 0) {
        unsigned* bar = b.bar;
        __builtin_amdgcn_s_waitcnt(0);
        unsigned nloc = b.st[0], nx = b.st[1];
        if (nloc == 0u) { xcd_barrier_complete(bar, b.x, nloc, nx); b.st[0] = nloc; b.st[1] = nx; }
        const unsigned old = xb_add(&bar[XB_XSUB(b.x)], 1u);
        const unsigned gen = old / nloc;
        if (old + 1u == (gen + 1u) * nloc) {
            __builtin_amdgcn_fence(__ATOMIC_RELEASE, "agent");
            asm volatile("s_waitcnt vmcnt(0)" ::: "memory");
            const unsigned og = xb_add(&bar[XB_TOP], 1u);
            const unsigned tg = og / nx;
            if (og + 1u == (tg + 1u) * nx) xb_add(&bar[XB_TOPGEN], 1u);
            else XB_SPIN(xb_ld(&bar[XB_TOPGEN]) == tg, bar);
            __builtin_amdgcn_fence(__ATOMIC_ACQUIRE, "agent");
            xb_add(&bar[XB_XGEN(b.x)], 1u);
            asm volatile("s_waitcnt vmcnt(0)" ::: "memory");
        } else {
            XB_SPIN(xb_ld(&bar[XB_XGEN(b.x)]) == gen, bar);
            __builtin_amdgcn_fence(__ATOMIC_ACQUIRE, "agent");
            asm volatile("s_waitcnt vmcnt(0)" ::: "memory");
        }
    }
    __syncthreads();
}

struct Args { const float* in[19]; float* out; unsigned char* ws; int ph_lo, ph_hi; };

__device__ __forceinline__ void p0_transpose_item(const float* W, int K, int N, bf16* WT, int dst_row0, LAS float* scr, int k0, int n0, int lane) {
#pragma unroll 8
    for (int i = 0; i < 32; ++i) { const int kk = 2 * i + (lane >> 5); scr[kk * 33 + (lane & 31)] = W[(size_t)(k0 + kk) * N + n0 + (lane & 31)]; }
    LDS_WAIT(); asm volatile("" ::: "memory");
    const int c = lane & 7;
#pragma unroll
    for (int j = 0; j < 4; ++j) { const int n = (lane >> 3) + 8 * j; const LAS float* s = scr + (8 * c) * 33 + n;
        u32x4 o; o.x = cvtpk(s[0 * 33], s[1 * 33]); o.y = cvtpk(s[2 * 33], s[3 * 33]); o.z = cvtpk(s[4 * 33], s[5 * 33]); o.w = cvtpk(s[6 * 33], s[7 * 33]);
        *(u32x4*)(WT + (size_t)(dst_row0 + n) * K + k0 + 8 * c) = o; }
    LDS_WAIT(); asm volatile("" ::: "memory");
}
__device__ __forceinline__ void phase_prologue(const Args& a, LAS unsigned char* lds, int G) {
    const int tid = tid_opaque(), lane = tid & 63, wave = tid >> 6;
    {
        const float* cp = a.in[6]; const float* cs = a.in[7]; const float* w_ada = a.in[8]; const float* b_ada = a.in[9];
        float* mod = (float*)(a.ws + WS_MOD);
        LAS float* sc = (LAS float*)lds;
        LAS float* red = (LAS float*)(lds + 40960);
        const int cgp = tid & 7, ksl = tid >> 3;
        for (int it = blockIdx.x; it < 768; it += G) {
            const int l = it / 384, col0 = (it % 384) * 32;
            f32x4 acc[20];
#pragma unroll
            for (int j = 0; j < 20; ++j) acc[j] = (f32x4){0.f, 0.f, 0.f, 0.f};
            for (int kt = 0; kt < 8; ++kt) {
                __syncthreads();
#pragma unroll
                for (int j = 0; j < 20; ++j) { const float cv = (j < 4) ? cp[j * 4096 + kt * 512 + tid] : cs[(j - 4) * 4096 + kt * 512 + tid]; sc[tid * 20 + j] = silu_f(cv); }
                __syncthreads();
                const float* wp = w_ada + ((size_t)l * 4096 + kt * 512 + ksl * 8) * 12288 + col0 + cgp * 4;
                f32x4 w[8];
#pragma unroll
                for (int kk = 0; kk < 8; ++kk) w[kk] = *(const f32x4*)(wp + (size_t)kk * 12288);
#pragma unroll
                for (int kk = 0; kk < 8; ++kk) {
                    const LAS f32x4* s4 = (const LAS f32x4*)(sc + (ksl * 8 + kk) * 20);
#pragma unroll
                    for (int j4 = 0; j4 < 5; ++j4) { const f32x4 s = s4[j4];
#pragma unroll
                        for (int jj = 0; jj < 4; ++jj) acc[j4 * 4 + jj] += s[jj] * w[kk]; }
                }
            }
#pragma unroll
            for (int j = 0; j < 20; ++j)
#pragma unroll
                for (int c = 0; c < 4; ++c) { float v = acc[j][c]; v += __shfl_xor(v, 8); v += __shfl_xor(v, 16); v += __shfl_xor(v, 32); acc[j][c] = v; }
            __syncthreads();
            if (lane < 8) {
#pragma unroll
                for (int j = 0; j < 20; ++j) *(LAS f32x4*)(red + (wave * 20 + j) * 32 + lane * 4) = acc[j];
            }
            __syncthreads();
            for (int o = tid; o < 640; o += 512) { const int j = o >> 5, c = o & 31; float s = 0.f;
#pragma unroll
                for (int w8 = 0; w8 < 8; ++w8) s += red[(w8 * 20 + j) * 32 + c];
                mod[((size_t)l * 20 + j) * 12288 + col0 + c] = s + b_ada[(size_t)l * 12288 + col0 + c]; }
        }
        __syncthreads();
    }
    {
        LAS float* scr = (LAS float*)(lds + wave * 8448);
        const int gw = blockIdx.x * 8 + wave, NGW = G * 8;
        constexpr int I_IN = 64 * 401, I_OUT = 64 * 128, I_L = I_IN + I_OUT;
        for (int it = gw; it < 2 * I_L; it += NGW) {
            const int l = it / I_L; int r = it % I_L;
            if (r < I_IN) { const int kb = r / 401, nb = r % 401, n0 = nb * 32; const int dst = (n0 < 8192) ? n0 : ((n0 < 8224) ? (C_B + (n0 - 8192)) : (n0 - 32));
                p0_transpose_item(a.in[12] + (size_t)l * 4096 * IN_DIM, 4096, IN_DIM, (bf16*)(a.ws + WS_BIN + l * BIN_BYTES), dst, scr, kb * 64, n0, lane); }
            else { r -= I_IN; const int kb = r / 128, nb = r % 128;
                p0_transpose_item(a.in[18] + (size_t)l * 4096 * 4096, 4096, 4096, (bf16*)(a.ws + WS_BOUT + l * BOUT_BYTES), nb * 32, scr, kb * 64, nb * 32, lane); }
        }
        const int gt = blockIdx.x * 512 + tid, NT = G * 512;
        constexpr int ZU = (NP - IN_DIM) * 4096 * 2 / 16;
        for (int u = gt; u < 2 * ZU; u += NT) { const int l = u / ZU, r = u % ZU;
            *(u32x4*)(a.ws + WS_BIN + l * BIN_BYTES + (size_t)IN_DIM * 4096 * 2 + (size_t)r * 16) = (u32x4){0u, 0u, 0u, 0u}; }
        f32x2* rt = (f32x2*)(a.ws + WS_ROPE);
        for (int idx = gt; idx < 4096 * 32; idx += NT) { const int pos = idx >> 5, i = idx & 31;
            const double inv = exp2(-(double)i * (13.287712379549449 / 32.0)); const double ang = (double)pos * inv;
            rt[idx] = (f32x2){(float)cos(ang), (float)sin(ang)}; }
    }
}

__device__ __forceinline__ void phase_h0(const Args& a, int G) {
    const int tid = tid_opaque(), lane = tid & 63, wave = tid >> 6;
    const int gw = blockIdx.x * 8 + wave, NGW = G * 8;
    const float* mod = (const float*)(a.ws + WS_MOD); const float* g_pre = a.in[10];
    bf16* H = (bf16*)(a.ws + WS_HO);
    for (int row = gw; row < M; row += NGW) {
        const float* xr = (row < MP) ? a.in[0] + (size_t)row * D : a.in[1] + (size_t)(row - MP) * D;
        const int j = (row < MP) ? (row >> 12) : (4 + ((row - MP) >> 4));
        const float* mr = mod + (size_t)j * 12288;
        f32x4 v[16]; float s = 0.f;
#pragma unroll
        for (int q = 0; q < 16; ++q) { v[q] = *(const f32x4*)(xr + 4 * lane + 256 * q); s += (v[q][0] * v[q][0] + v[q][1] * v[q][1]) + (v[q][2] * v[q][2] + v[q][3] * v[q][3]); }
        const float rstd = rsqrtf(wave_sum(s) * (1.f / D) + EPS);
#pragma unroll
        for (int q = 0; q < 16; ++q) { const int c = 4 * lane + 256 * q; const f32x4 g = *(const f32x4*)(g_pre + c), sh = *(const f32x4*)(mr + c), sc = *(const f32x4*)(mr + 4096 + c);
            const f32x4 hv = v[q] * rstd * g * (sc + 1.0f) + sh; u32x2 w; w.x = cvtpk(hv[0], hv[1]); w.y = cvtpk(hv[2], hv[3]);
            *(u32x2*)(H + (size_t)row * D + c) = w; }
    }
}
__device__ __forceinline__ void phase_resid(const Args& a, int l, int G) {
    const int tid = tid_opaque(), lane = tid & 63, wave = tid >> 6;
    const int gw = blockIdx.x * 8 + wave, NGW = G * 8;
    const float* mod = (const float*)(a.ws + WS_MOD); const float* g_pre = a.in[10]; const float* g_post = a.in[11] + (size_t)l * D;
    const bf16* Y = (const bf16*)(a.ws + WS_P); const float* ysq = (const float*)(a.ws + WS_YSQ);
    bf16* H = (bf16*)(a.ws + WS_HO);
    for (int row = gw; row < M; row += NGW) {
        float* orow = (row < MP) ? a.out + O_YP + (size_t)row * D : a.out + O_YS + (size_t)(row - MP) * D;
        const float* xr = (l == 0) ? ((row < MP) ? a.in[0] + (size_t)row * D : a.in[1] + (size_t)(row - MP) * D) : orow;
        const int j = (row < MP) ? (row >> 12) : (4 + ((row - MP) >> 4));
        const float* mr = mod + ((size_t)l * 20 + j) * 12288;
        const float rstd_y = rsqrtf(wave_sum(ysq[(size_t)row * 64 + lane]) * (1.f / D) + EPS);
        f32x4 v[16]; float s = 0.f;
#pragma unroll
        for (int q = 0; q < 16; ++q) { const int c = 4 * lane + 256 * q; const f32x4 x = *(const f32x4*)(xr + c); const u32x2 yw = *(const u32x2*)(Y + (size_t)row * D + c);
            const f32x4 y = (f32x4){bflo(yw.x), bfhi(yw.x), bflo(yw.y), bfhi(yw.y)}; const f32x4 gt = *(const f32x4*)(mr + 8192 + c), gp = *(const f32x4*)(g_post + c);
            v[q] = x + gt * (y * rstd_y * gp); s += (v[q][0] * v[q][0] + v[q][1] * v[q][1]) + (v[q][2] * v[q][2] + v[q][3] * v[q][3]);
            *(f32x4*)(orow + c) = v[q]; }
        if (l == 0) {
            const float rstd = rsqrtf(wave_sum(s) * (1.f / D) + EPS); const float* m1 = mod + ((size_t)20 + j) * 12288;
#pragma unroll
            for (int q = 0; q < 16; ++q) { const int c = 4 * lane + 256 * q; const f32x4 g = *(const f32x4*)(g_pre + D + c), sh = *(const f32x4*)(m1 + c), sc = *(const f32x4*)(m1 + 4096 + c);
                const f32x4 hv = v[q] * rstd * g * (sc + 1.0f) + sh; u32x2 w; w.x = cvtpk(hv[0], hv[1]); w.y = cvtpk(hv[2], hv[3]);
                *(u32x2*)(H + (size_t)row * D + c) = w; }
        }
    }
}


constexpr int L_KH = 0, L_QH = 18432, L_RT = 36864, L_XT = 77824, L_AI = 118784, L_DG = 129024, L_DI = 133120, L_GT = 135168;
constexpr int S128 = 144, S64 = 80;

__device__ __forceinline__ void phase_c1(const Args& a, int l, LAS unsigned char* lds, int G) {
    int tid, lane, wave, fr, fq;
#define RELANE() do { tid = tid_opaque(); lane = tid & 63; wave = __builtin_amdgcn_readfirstlane(tid >> 6); fr = lane & 15; fq = lane >> 4; } while (0)
    RELANE();
    const bf16* P = (const bf16*)(a.ws + WS_P);
    float* decbuf = (float*)(a.ws + WS_DEC);
    const float* conv_w = a.in[13] + (size_t)l * 4 * 6144;
    LAS bf16* KH = (LAS bf16*)(lds + L_KH); LAS bf16* QH = (LAS bf16*)(lds + L_QH); LAS bf16* RT = (LAS bf16*)(lds + L_RT); LAS bf16* XT = (LAS bf16*)(lds + L_XT);
    LAS bf16* AI = (LAS bf16*)(lds + L_AI); LAS float* DG = (LAS float*)(lds + L_DG); LAS bf16* DI = (LAS bf16*)(lds + L_DI);
    LAS float* g_beta = (LAS float*)(lds + L_GT); LAS float* g_gc = g_beta + 64; LAS float* g_egc = g_beta + 128; LAS float* g_misc = g_beta + 192;

    for (int item = blockIdx.x; item < NREC; item += G) {
        const bool sample = item >= 4096;
        int n, c, h, ntok; size_t rowbase;
        if (!sample) { h = item & 15; c = (item >> 4) & 63; n = item >> 10; rowbase = (size_t)n * 4096 + c * 64; ntok = 64; }
        else { const int s = item - 4096; h = s & 15; n = s >> 4; c = 0; rowbase = (size_t)MP + n * 16; ntok = 16; }
        unsigned char* rec = a.ws + WS_REC + (size_t)item * REC_BYTES;
        const bool last = sample || (c == 63);
        __syncthreads();
        RELANE();
        float val[8][8];
        float ssq[8];
        int g = 3, cgl, seg;
        if (tid < 384) {
            cgl = tid & 15; g = (tid >> 4) % 3; seg = tid / 48;
            const int ch0 = g * 2048 + h * 128 + cgl * 8;
            const int t0 = seg * 8;
            float w[4][8];
#pragma unroll
            for (int j = 0; j < 4; ++j) { const f32x4 w0 = *(const f32x4*)(conv_w + (size_t)j * 6144 + ch0), w1 = *(const f32x4*)(conv_w + (size_t)j * 6144 + ch0 + 4);
                w[j][0] = w0[0]; w[j][1] = w0[1]; w[j][2] = w0[2]; w[j][3] = w0[3]; w[j][4] = w1[0]; w[j][5] = w1[1]; w[j][6] = w1[2]; w[j][7] = w1[3]; }
            u32x4 raw[11];
#pragma unroll
            for (int i = 0; i < 11; ++i) { const int tt = t0 - 3 + i; raw[i] = (u32x4){0u, 0u, 0u, 0u};
                if (tt < ntok && (tt >= 0 || (!sample && c > 0))) raw[i] = *(const u32x4*)(P + (rowbase + tt) * NP + ch0); }
            float win[4][8];
#pragma unroll
            for (int i = 0; i < 3; ++i) unpack8(raw[i], win[i]);
            if (sample && seg == 0) {
                const float* sc = a.in[2] + (((size_t)l * 16 + n) * 3) * 6144 + ch0;
#pragma unroll
                for (int i = 0; i < 3; ++i) { const f32x4 s0 = *(const f32x4*)(sc + (size_t)i * 6144), s1 = *(const f32x4*)(sc + (size_t)i * 6144 + 4);
                    win[i][0] = s0[0]; win[i][1] = s0[1]; win[i][2] = s0[2]; win[i][3] = s0[3]; win[i][4] = s1[0]; win[i][5] = s1[1]; win[i][6] = s1[2]; win[i][7] = s1[3]; }
            }
#pragma unroll
            for (int tok = 0; tok < 8; ++tok) {
                unpack8(raw[3 + tok], win[3]);
                const bool tv = (t0 + tok) < ntok;
                float s = 0.f;
#pragma unroll
                for (int i = 0; i < 8; ++i) { const float y = w[0][i] * win[0][i] + w[1][i] * win[1][i] + w[2][i] * win[2][i] + w[3][i] * win[3][i]; const float v = tv ? silu_f(y) : 0.f; val[tok][i] = v; s += v * v; }
                ssq[tok] = s;
                if (last && tok >= 5 && seg == (sample ? 1 : 7)) {
                    float* co = sample ? a.out + O_CONVS + (((size_t)l * 16 + n) * 3 + (tok - 5)) * 6144 + ch0 : a.out + O_CONVP + (((size_t)l * 4 + n) * 3 + (tok - 5)) * 6144 + ch0;
                    *(f32x4*)co = (f32x4){win[3][0], win[3][1], win[3][2], win[3][3]}; *(f32x4*)(co + 4) = (f32x4){win[3][4], win[3][5], win[3][6], win[3][7]};
                }
#pragma unroll
                for (int i = 0; i < 8; ++i) { win[0][i] = win[1][i]; win[1][i] = win[2][i]; win[2][i] = win[3][i]; }
            }
#pragma unroll
            for (int tok = 0; tok < 8; ++tok) { float s = ssq[tok]; s += __shfl_xor(s, 1); s += __shfl_xor(s, 2); s += __shfl_xor(s, 4); s += __shfl_xor(s, 8); ssq[tok] = s; }
        } else {
            const int tz = tid - 384; cgl = tz & 15; seg = tz >> 4;
            const int t0 = seg * 8, e0 = cgl * 8;
            const float* dn = a.in[16] + (size_t)l * 128 + e0;
            float dnw[8];
            { const f32x4 d0 = *(const f32x4*)dn, d1 = *(const f32x4*)(dn + 4); dnw[0] = d0[0]; dnw[1] = d0[1]; dnw[2] = d0[2]; dnw[3] = d0[3]; dnw[4] = d1[0]; dnw[5] = d1[1]; dnw[6] = d1[2]; dnw[7] = d1[3]; }
#pragma unroll
            for (int tok = 0; tok < 8; ++tok) { float z[8];
                u32x4 rw = (u32x4){0u, 0u, 0u, 0u}; if (t0 + tok < ntok) rw = *(const u32x4*)(P + (rowbase + t0 + tok) * NP + C_ZDN + h * 128 + e0);
                unpack8(rw, z);
#pragma unroll
                for (int i = 0; i < 8; ++i) val[tok][i] = silu_f(z[i]) * dnw[i]; }
            if (wave == 6) {
                float beta = 0.f, gg = 0.f;
                if (lane < ntok) { const float b = bf1(P[(rowbase + lane) * NP + C_B + h]), av = bf1(P[(rowbase + lane) * NP + C_A + h]);
                    beta = sigmoid_f(b); const float xx = av + a.in[15][l * 16 + h]; const float sp = fmaxf(xx, 0.f) + log1pf(__expf(-fabsf(xx)));
                    gg = -__expf(a.in[14][l * 16 + h]) * sp; }
                float gc = gg;
#pragma unroll
                for (int o = 1; o < 64; o <<= 1) { const float t = __shfl_up(gc, o); if (lane >= o) gc += t; }
                g_beta[lane] = beta; g_gc[lane] = gc; g_egc[lane] = __expf(gc);
                const float gcl = __shfl(gc, 63);
                if (lane == 0) { g_misc[0] = gcl; decbuf[item] = __expf(gcl); }
            }
        }
        __syncthreads();
        {
            { const int t1 = tid_opaque(); cgl = (t1 < 384) ? (t1 & 15) : ((t1 - 384) & 15); seg = (t1 < 384) ? (t1 / 48) : ((t1 - 384) >> 4); }
            const int t0 = seg * 8;
            float bt[8], gcv[8], eg[8];
            { const f32x4 b0 = *(const LAS f32x4*)(g_beta + t0), b1 = *(const LAS f32x4*)(g_beta + t0 + 4), c0 = *(const LAS f32x4*)(g_gc + t0), c1 = *(const LAS f32x4*)(g_gc + t0 + 4),
                  e0 = *(const LAS f32x4*)(g_egc + t0), e1 = *(const LAS f32x4*)(g_egc + t0 + 4);
#pragma unroll
              for (int i = 0; i < 4; ++i) { bt[i] = b0[i]; bt[4 + i] = b1[i]; gcv[i] = c0[i]; gcv[4 + i] = c1[i]; eg[i] = e0[i]; eg[4 + i] = e1[i]; } }
            const float gcl = g_misc[0];
            const int qs0 = ((cgl * 8) & 15) >> 2, half0 = ((cgl * 8) >> 4) & 1, ks0 = (cgl * 8) >> 5;
            const int tq0 = (t0 & 15) >> 2, thalf = (t0 >> 4) & 1, tks = t0 >> 5;
            if (g == 0) {
#pragma unroll
                for (int tok = 0; tok < 8; ++tok) { const int t = t0 + tok; const float r = rsqrtf(ssq[tok] + EPS) * 0.08838834764831845f; float qv[8];
#pragma unroll
                    for (int i = 0; i < 8; ++i) qv[i] = val[tok][i] * r;
                    *(LAS u32x4*)(QH + t * S128 + cgl * 8) = pack8(qv);
                    const float e = eg[tok];
                    unsigned char* fp = rec + REC_QD + (size_t)((((t >> 4) * 4 + ks0) * 64 + (t & 15) + 16 * qs0) * 16 + 8 * half0);
                    u32x2 w0, w1; w0.x = cvtpk(qv[0] * e, qv[1] * e); w0.y = cvtpk(qv[2] * e, qv[3] * e); w1.x = cvtpk(qv[4] * e, qv[5] * e); w1.y = cvtpk(qv[6] * e, qv[7] * e);
                    *(u32x2*)fp = w0; *(u32x2*)(fp + 256) = w1; }
            } else if (g == 1) {
                float kv[8][8];
#pragma unroll
                for (int tok = 0; tok < 8; ++tok) { const float r = rsqrtf(ssq[tok] + EPS);
#pragma unroll
                    for (int i = 0; i < 8; ++i) kv[tok][i] = val[tok][i] * r;
                    *(LAS u32x4*)(KH + (t0 + tok) * S128 + cgl * 8) = pack8(kv[tok]); }
#pragma unroll
                for (int i = 0; i < 8; ++i) { const int d = cgl * 8 + i; float rr[8], kd[8];
#pragma unroll
                    for (int tok = 0; tok < 8; ++tok) { rr[tok] = kv[tok][i] * bt[tok] * eg[tok]; kd[tok] = kv[tok][i] * __expf(gcl - gcv[tok]); }
                    *(LAS u32x4*)(RT + (128 + d) * S64 + t0) = pack8(rr);
                    unsigned char* fp = rec + REC_KD + (size_t)((((d >> 4) * 2 + tks) * 64 + (d & 15) + 16 * tq0) * 16 + 8 * thalf);
                    u32x2 w0, w1; w0.x = cvtpk(kd[0], kd[1]); w0.y = cvtpk(kd[2], kd[3]); w1.x = cvtpk(kd[4], kd[5]); w1.y = cvtpk(kd[6], kd[7]);
                    *(u32x2*)fp = w0; *(u32x2*)(fp + 256) = w1; }
            } else if (g == 2) {
#pragma unroll
                for (int i = 0; i < 8; ++i) { const int e = cgl * 8 + i; float rr[8];
#pragma unroll
                    for (int tok = 0; tok < 8; ++tok) rr[tok] = val[tok][i] * bt[tok];
                    *(LAS u32x4*)(RT + e * S64 + t0) = pack8(rr); }
            } else {
#pragma unroll
                for (int i = 0; i < 8; ++i) { const int e = cgl * 8 + i;
                    unsigned char* fp = rec + REC_G + (size_t)((((e >> 4) * 4 + (t0 >> 4)) * 64 + (e & 15) + 16 * tq0) * 8);
                    u32x2 w0, w1; w0.x = cvtpk(val[0][i], val[1][i]); w0.y = cvtpk(val[2][i], val[3][i]); w1.x = cvtpk(val[4][i], val[5][i]); w1.y = cvtpk(val[6][i], val[7][i]);
                    *(u32x2*)fp = w0; *(u32x2*)(fp + 128) = w1; }
            }
        }
        __syncthreads();
#if defined(DBG_C1_STOP) && DBG_C1_STOP <= 1
        continue;
#endif
        RELANE();
#pragma unroll
        for (int k2 = 0; k2 < 2; ++k2) {
            const int tile = wave * 2 + k2, ti = tile >> 2, tj = tile & 3;
            f32x4 acq = (f32x4){0.f, 0.f, 0.f, 0.f}, ack = (f32x4){0.f, 0.f, 0.f, 0.f};
#pragma unroll
            for (int ks = 0; ks < 4; ++ks) {
                const bf16x8 kj = *(const LAS bf16x8*)(KH + (16 * tj + fr) * S128 + 32 * ks + 8 * fq);
                const bf16x8 qi = *(const LAS bf16x8*)(QH + (16 * ti + fr) * S128 + 32 * ks + 8 * fq);
                acq = __builtin_amdgcn_mfma_f32_16x16x32_bf16(kj, qi, acq, 0, 0, 0);
                if (ti >= tj) { const bf16x8 ki = *(const LAS bf16x8*)(KH + (16 * ti + fr) * S128 + 32 * ks + 8 * fq);
                    ack = __builtin_amdgcn_mfma_f32_16x16x32_bf16(ki, kj, ack, 0, 0, 0); }
            }
            {
                const int i = 16 * ti + fr; const float gi = g_gc[i]; const f32x4 gj = *(const LAS f32x4*)(g_gc + 16 * tj + 4 * fq); float o[4];
#pragma unroll
                for (int r = 0; r < 4; ++r) { const int j = 16 * tj + 4 * fq + r; o[r] = (i >= j) ? acq[r] * __expf(fminf(gi - gj[r], 0.f)) : 0.f; }
                u32x2 w; w.x = cvtpk(o[0], o[1]); w.y = cvtpk(o[2], o[3]);
                *(u32x2*)(rec + REC_QK + (size_t)(((ti * 2 + (tj >> 1)) * 64 + lane) * 16 + 8 * (tj & 1))) = w;
            }
            if (ti >= tj) {
                const int j = 16 * tj + fr; const float gj = g_gc[j]; const f32x4 gi = *(const LAS f32x4*)(g_gc + 16 * ti + 4 * fq), bi = *(const LAS f32x4*)(g_beta + 16 * ti + 4 * fq);
#pragma unroll
                for (int r = 0; r < 4; ++r) { const int i = 16 * ti + 4 * fq + r; const float v = (i > j) ? bi[r] * ack[r] * __expf(fminf(gi[r] - gj, 0.f)) : 0.f;
                    AI[i * S64 + j] = (bf16)(cvtpk(v, 0.f) & 0xffffu);
                    if (ti == tj) DG[(ti * 16 + (i & 15)) * 16 + fr] = v; }
            }
        }
        __syncthreads();
#if defined(DBG_C1_STOP) && DBG_C1_STOP <= 2
        continue;
#endif
        RELANE();
        if (wave == 0) {
            const int b = fq, cc = fr; float x[16];
#pragma unroll
            for (int r = 0; r < 16; ++r) { float s = (r == cc) ? 1.f : 0.f;
                const LAS float* drow = DG + (b * 16 + r) * 16;
#pragma unroll
                for (int j = 0; j < r; ++j) s -= drow[j] * x[j];
                x[r] = s; DI[(b * 16 + r) * 16 + cc] = (bf16)(cvtpk(s, 0.f) & 0xffffu); }
        }
        __syncthreads();
#if defined(DBG_C1_STOP) && DBG_C1_STOP <= 3
        continue;
#endif
#pragma unroll
        for (int b = 0; b < 4; ++b) {
            RELANE();
#pragma unroll
            for (int k2 = 0; k2 < 2; ++k2) {
                const int nt = wave * 2 + k2;
                f32x4 y = (f32x4){0.f, 0.f, 0.f, 0.f};
#pragma unroll
                for (int ks = 0; ks < (b + 1) / 2; ++ks) {
                    const bool ok = (32 * ks + 8 * fq) < 16 * b;
                    u32x4 av = *(const LAS u32x4*)(AI + (16 * b + fr) * S64 + 32 * ks + 8 * fq), xv = *(const LAS u32x4*)(XT + (16 * nt + fr) * S64 + 32 * ks + 8 * fq);
                    if (!ok) { av = (u32x4){0u, 0u, 0u, 0u}; xv = (u32x4){0u, 0u, 0u, 0u}; }
                    y = __builtin_amdgcn_mfma_f32_16x16x32_bf16(as_bf16x8(av), as_bf16x8(xv), y, 0, 0, 0);
                }
                const u32x2 rv = *(const LAS u32x2*)(RT + (16 * nt + fr) * S64 + 16 * b + 4 * fq);
                const float z0 = bflo(rv.x) - y[0], z1 = bfhi(rv.x) - y[1], z2 = bflo(rv.y) - y[2], z3 = bfhi(rv.y) - y[3];
                u32x2 zb; zb.x = cvtpk(z0, z1); zb.y = cvtpk(z2, z3);
                const u32x2 dv = *(const LAS u32x2*)(DI + (b * 16 + fr) * 16 + 4 * fq);
                const f32x4 xo = __builtin_amdgcn_mfma_f32_16x16x16bf16_1k(as_bf16x4(dv), as_bf16x4(zb), (f32x4){0.f, 0.f, 0.f, 0.f}, 0, 0, 0);
                u32x2 xw; xw.x = cvtpk(xo[0], xo[1]); xw.y = cvtpk(xo[2], xo[3]);
                *(LAS u32x2*)(XT + (16 * nt + fr) * S64 + 16 * b + 4 * fq) = xw;
                if (nt < 8) *(u32x2*)(rec + REC_U + (size_t)(((nt * 4 + b) * 64 + lane) * 8)) = xw;
            }
            __syncthreads();
        }
#if defined(DBG_C1_STOP) && DBG_C1_STOP <= 4
        continue;
#endif
        RELANE();
#pragma unroll
        for (int k2 = 0; k2 < 2; ++k2) {
            const int u = tid + 512 * k2, frag = u >> 6, tt = frag >> 2, ks = frag & 3;
            float wv[8];
#pragma unroll
            for (int j = 0; j < 8; ++j) wv[j] = bf1(XT[(128 + 32 * ks + 16 * (j >> 2) + 4 * fq + (j & 3)) * S64 + 16 * tt + fr]);
            *(u32x4*)(rec + REC_W + (size_t)((frag * 64 + lane) * 16)) = pack8(wv);
        }
    }
#undef RELANE
}


constexpr int L_SS = 2 * REC_STAGE, L_RS = L_SS + 2048;
__device__ __forceinline__ void scan_seq(const Args& a, int l, LAS unsigned char* lds, int seq) {
    const int tid = tid_opaque(), lane = tid & 63, wave = __builtin_amdgcn_readfirstlane(tid >> 6);
    const int fr = lane & 15, fq = lane >> 4;
    const bool sample = seq >= 64;
    const int s2 = sample ? seq - 64 : seq, n = s2 >> 4, h = s2 & 15;
    const int nsteps = sample ? 1 : 64, ntok = sample ? 16 : 64;
    const int rec0 = sample ? 4096 + s2 : (n * 64) * 16 + h;
    const size_t rowbase0 = sample ? (size_t)MP + n * 16 : (size_t)n * 4096;
    const unsigned char* recs = a.ws + WS_REC;
    const float* decbuf = (const float*)(a.ws + WS_DEC);
    bf16* Ob = (bf16*)(a.ws + WS_HO);
    LAS float* ss = (LAS float*)(lds + L_SS); LAS float* rs = (LAS float*)(lds + L_RS);
    f32x4 st[8];
    if (sample) { const float* s0 = a.in[3] + (((size_t)l * 16 + n) * 16 + h) * 16384;
#pragma unroll
        for (int t = 0; t < 8; ++t)
#pragma unroll
            for (int j = 0; j < 4; ++j) st[t][j] = s0[(16 * t + 4 * fq + j) * 128 + 16 * wave + fr];
    } else {
#pragma unroll
        for (int t = 0; t < 8; ++t) st[t] = (f32x4){0.f, 0.f, 0.f, 0.f};
    }
    __syncthreads();
    {   const unsigned char* src = recs + (size_t)rec0 * REC_BYTES;
#pragma unroll
        for (int k = 0; k < 7; ++k) { const int p = wave * 7 + k;
            __builtin_amdgcn_global_load_lds((const unsigned*)(src + p * 1024 + lane * 16), (LAS unsigned*)(lds + p * 1024), 16, 0, 0); } }
    for (int c = 0; c < nsteps; ++c) {
        const LAS unsigned char* buf = lds + (c & 1) * REC_STAGE;
        const unsigned char* rec = recs + (size_t)(rec0 + 16 * c) * REC_BYTES;
        VM_WAIT(); __syncthreads();
        if (c + 1 < nsteps) { const unsigned char* src = rec + 16 * REC_BYTES; LAS unsigned char* dst = lds + ((c + 1) & 1) * REC_STAGE;
#pragma unroll
            for (int k = 0; k < 7; ++k) { const int p = wave * 7 + k;
                __builtin_amdgcn_global_load_lds((const unsigned*)(src + p * 1024 + lane * 16), (LAS unsigned*)(dst + p * 1024), 16, 0, 0); } }
        u32x2 uw[4], gw[4];
#pragma unroll
        for (int t = 0; t < 4; ++t) { uw[t] = *(const u32x2*)(rec + REC_U + ((wave * 4 + t) * 64 + lane) * 8); gw[t] = *(const u32x2*)(rec + REC_G + ((wave * 4 + t) * 64 + lane) * 8); }
        const float dec = decbuf[rec0 + 16 * c];
        bf16x8 Bs[4];
#pragma unroll
        for (int ks = 0; ks < 4; ++ks) { u32x4 w; w.x = cvtpk(st[2 * ks][0], st[2 * ks][1]); w.y = cvtpk(st[2 * ks][2], st[2 * ks][3]); w.z = cvtpk(st[2 * ks + 1][0], st[2 * ks + 1][1]); w.w = cvtpk(st[2 * ks + 1][2], st[2 * ks + 1][3]); Bs[ks] = as_bf16x8(w); }
        f32x4 ws4[4], oacc[4];
#pragma unroll
        for (int t = 0; t < 4; ++t) { ws4[t] = (f32x4){0.f, 0.f, 0.f, 0.f}; oacc[t] = (f32x4){0.f, 0.f, 0.f, 0.f}; }
#pragma unroll
        for (int t = 0; t < 4; ++t)
#pragma unroll
            for (int ks = 0; ks < 4; ++ks) { const bf16x8 af = *(const LAS bf16x8*)(buf + REC_W + ((t * 4 + ks) * 64 + lane) * 16); ws4[t] = __builtin_amdgcn_mfma_f32_16x16x32_bf16(af, Bs[ks], ws4[t], 0, 0, 0); }
#pragma unroll
        for (int t = 0; t < 4; ++t)
#pragma unroll
            for (int ks = 0; ks < 4; ++ks) { const bf16x8 af = *(const LAS bf16x8*)(buf + REC_QD + ((t * 4 + ks) * 64 + lane) * 16); oacc[t] = __builtin_amdgcn_mfma_f32_16x16x32_bf16(af, Bs[ks], oacc[t], 0, 0, 0); }
        bf16x8 Bv[2];
        {   f32x4 vn[4];
#pragma unroll
            for (int t = 0; t < 4; ++t) vn[t] = (f32x4){bflo(uw[t].x), bfhi(uw[t].x), bflo(uw[t].y), bfhi(uw[t].y)} - ws4[t];
#pragma unroll
            for (int k2 = 0; k2 < 2; ++k2) { u32x4 w; w.x = cvtpk(vn[2 * k2][0], vn[2 * k2][1]); w.y = cvtpk(vn[2 * k2][2], vn[2 * k2][3]); w.z = cvtpk(vn[2 * k2 + 1][0], vn[2 * k2 + 1][1]); w.w = cvtpk(vn[2 * k2 + 1][2], vn[2 * k2 + 1][3]); Bv[k2] = as_bf16x8(w); } }
#pragma unroll
        for (int t = 0; t < 4; ++t)
#pragma unroll
            for (int k2 = 0; k2 < 2; ++k2) { const bf16x8 af = *(const LAS bf16x8*)(buf + REC_QK + ((t * 2 + k2) * 64 + lane) * 16); oacc[t] = __builtin_amdgcn_mfma_f32_16x16x32_bf16(af, Bv[k2], oacc[t], 0, 0, 0); }
#pragma unroll
        for (int t = 0; t < 8; ++t) { st[t] = st[t] * dec;
#pragma unroll
            for (int k2 = 0; k2 < 2; ++k2) { const bf16x8 af = *(const LAS bf16x8*)(buf + REC_KD + ((t * 2 + k2) * 64 + lane) * 16); st[t] = __builtin_amdgcn_mfma_f32_16x16x32_bf16(af, Bv[k2], st[t], 0, 0, 0); } }
#pragma unroll
        for (int t = 0; t < 4; ++t) { f32x4 q = oacc[t] * oacc[t];
#pragma unroll
            for (int j = 0; j < 4; ++j) { float v = q[j]; v += __shfl_xor(v, 1); v += __shfl_xor(v, 2); v += __shfl_xor(v, 4); v += __shfl_xor(v, 8); q[j] = v; }
            if (fr == 0) *(LAS f32x4*)(ss + wave * 64 + 16 * t + 4 * fq) = q; }
        __syncthreads();
        if (tid < 64) { float tsum = 0.f;
#pragma unroll
            for (int w8 = 0; w8 < 8; ++w8) tsum += ss[w8 * 64 + tid];
            rs[tid] = rsqrtf(tsum * (1.f / 128.f) + EPS); }
        __syncthreads();
#pragma unroll
        for (int t = 0; t < 4; ++t) { const f32x4 r4 = *(const LAS f32x4*)(rs + 16 * t + 4 * fq); const f32x4 gv = (f32x4){bflo(gw[t].x), bfhi(gw[t].x), bflo(gw[t].y), bfhi(gw[t].y)};
#pragma unroll
            for (int j = 0; j < 4; ++j) { const int tok = 16 * t + 4 * fq + j;
                if (tok < ntok) Ob[(rowbase0 + (size_t)c * 64 + tok) * D + h * 128 + 16 * wave + fr] = (bf16)(cvtpk(oacc[t][j] * r4[j] * gv[j], 0.f) & 0xffffu); } }
    }
    {   float* so = sample ? a.out + O_DNS + (((size_t)l * 16 + n) * 16 + h) * 16384 : a.out + O_DNP + (((size_t)l * 4 + n) * 16 + h) * 16384;
#pragma unroll
        for (int t = 0; t < 8; ++t)
#pragma unroll
            for (int j = 0; j < 4; ++j) so[(16 * t + 4 * fq + j) * 128 + 16 * wave + fr] = st[t][j]; }
}

constexpr int L_KI = 0, L_VT = 30720, SKI = 80, SVT = 200;
__device__ __forceinline__ void attn_prompt_item(const Args& a, int l, LAS unsigned char* lds, int it) {
    const int tid = tid_opaque(), lane = tid & 63, wave = __builtin_amdgcn_readfirstlane(tid >> 6);
    const int fr = lane & 15, fq = lane >> 4;
    const int kv = it & 3, c = (it >> 2) & 63, n = it >> 8;
    const bf16* P = (const bf16*)(a.ws + WS_P); const f32x2* rope = (const f32x2*)(a.ws + WS_ROPE);
    bf16* Ob = (bf16*)(a.ws + WS_HO);
    LAS bf16* KI = (LAS bf16*)(lds + L_KI); LAS bf16* VT = (LAS bf16*)(lds + L_VT);
    const int kt0 = (c >= 2) ? 0 : (8 - 4 * c);
    __syncthreads();
#pragma unroll
    for (int k2 = 0; k2 < 2; ++k2) { const int u = tid + 512 * k2; if (u < 768) { const int key = u >> 2, dg = u & 3, tok = (c - 2) * 64 + key;
        if (tok >= 0) { const bf16* kp = P + ((size_t)n * 4096 + tok) * NP + C_AK + kv * 64 + dg * 8; float x1[8], x2[8], o1[8], o2[8];
            unpack8(*(const u32x4*)kp, x1); unpack8(*(const u32x4*)(kp + 32), x2);
#pragma unroll
            for (int j = 0; j < 8; ++j) { const f32x2 cs = rope[tok * 32 + dg * 8 + j]; o1[j] = x1[j] * cs.x - x2[j] * cs.y; o2[j] = x2[j] * cs.x + x1[j] * cs.y; }
            *(LAS u32x4*)(KI + key * SKI + dg * 8) = pack8(o1); *(LAS u32x4*)(KI + key * SKI + 32 + dg * 8) = pack8(o2);
            if (c == 63 && key >= 64) { float* ko = a.out + O_KP + ((((size_t)l * 4 + n) * 128 + (key - 64)) * 4 + kv) * 64 + dg * 8;
                *(f32x4*)ko = (f32x4){o1[0], o1[1], o1[2], o1[3]}; *(f32x4*)(ko + 4) = (f32x4){o1[4], o1[5], o1[6], o1[7]};
                *(f32x4*)(ko + 32) = (f32x4){o2[0], o2[1], o2[2], o2[3]}; *(f32x4*)(ko + 36) = (f32x4){o2[4], o2[5], o2[6], o2[7]}; } } } }
#pragma unroll
    for (int k3 = 0; k3 < 3; ++k3) { const int u = tid + 512 * k3, key = u >> 3, dg = u & 7, tok = (c - 2) * 64 + key;
        if (tok >= 0) { const u32x4 vw = *(const u32x4*)(P + ((size_t)n * 4096 + tok) * NP + C_AV + kv * 64 + dg * 8);
            const unsigned ww[4] = {vw.x, vw.y, vw.z, vw.w};
#pragma unroll
            for (int j = 0; j < 8; ++j) VT[(dg * 8 + j) * SVT + key] = (bf16)((j & 1) ? (ww[j >> 1] >> 16) : (ww[j >> 1] & 0xffffu));
            if (c == 63 && key >= 64) { float vf[8]; unpack8(vw, vf); float* vo = a.out + O_VP + ((((size_t)l * 4 + n) * 128 + (key - 64)) * 4 + kv) * 64 + dg * 8;
                *(f32x4*)vo = (f32x4){vf[0], vf[1], vf[2], vf[3]}; *(f32x4*)(vo + 4) = (f32x4){vf[4], vf[5], vf[6], vf[7]}; } } }
    __syncthreads();
    const int hq = kv * 8 + wave;
    const float sink = a.in[17][l * 32 + hq];
    for (int qt = 0; qt < 4; ++qt) {
        const int tq = c * 64 + 16 * qt + fr; const size_t row = (size_t)n * 4096 + tq;
        bf16x8 Qf[2];
        {   const bf16* qp = P + row * NP + C_AQ + hq * 64 + 8 * fq; float x1[8], x2[8], o1[8], o2[8];
            unpack8(*(const u32x4*)qp, x1); unpack8(*(const u32x4*)(qp + 32), x2);
#pragma unroll
            for (int j = 0; j < 8; ++j) { const f32x2 cs = rope[tq * 32 + 8 * fq + j]; o1[j] = (x1[j] * cs.x - x2[j] * cs.y) * 0.125f; o2[j] = (x2[j] * cs.x + x1[j] * cs.y) * 0.125f; }
            Qf[0] = as_bf16x8(pack8(o1)); Qf[1] = as_bf16x8(pack8(o2)); }
        f32x4 s[12]; float m = sink;
#pragma unroll
        for (int kt = 0; kt < 12; ++kt) { s[kt] = (f32x4){0.f, 0.f, 0.f, 0.f};
            if (kt >= kt0) {
#pragma unroll
                for (int ks = 0; ks < 2; ++ks) { const bf16x8 kf = *(const LAS bf16x8*)(KI + (16 * kt + fr) * SKI + 32 * ks + 8 * fq); s[kt] = __builtin_amdgcn_mfma_f32_16x16x32_bf16(kf, Qf[ks], s[kt], 0, 0, 0); }
                m = fmaxf(m, fmaxf(fmaxf(s[kt][0], s[kt][1]), fmaxf(s[kt][2], s[kt][3]))); } }
        m = fmaxf(m, __shfl_xor(m, 16)); m = fmaxf(m, __shfl_xor(m, 32));
        float sum = 0.f; f32x4 oc[4];
#pragma unroll
        for (int dt = 0; dt < 4; ++dt) oc[dt] = (f32x4){0.f, 0.f, 0.f, 0.f};
#pragma unroll
        for (int kt = 0; kt < 12; ++kt) { if (kt >= kt0) {
            const float p0 = __expf(s[kt][0] - m), p1 = __expf(s[kt][1] - m), p2 = __expf(s[kt][2] - m), p3 = __expf(s[kt][3] - m); sum += (p0 + p1) + (p2 + p3);
            u32x2 pw; pw.x = cvtpk(p0, p1); pw.y = cvtpk(p2, p3);
#pragma unroll
            for (int dt = 0; dt < 4; ++dt) { const u32x2 vf = *(const LAS u32x2*)(VT + (16 * dt + fr) * SVT + 16 * kt + 4 * fq);
                oc[dt] = __builtin_amdgcn_mfma_f32_16x16x16bf16_1k(as_bf16x4(vf), as_bf16x4(pw), oc[dt], 0, 0, 0); } } }
        sum += __shfl_xor(sum, 16); sum += __shfl_xor(sum, 32);
        const float inv = 1.0f / (sum + __expf(sink - m));
#pragma unroll
        for (int dt = 0; dt < 4; ++dt) { const int d0 = 16 * dt + 4 * fq; const u32x2 zw = *(const u32x2*)(P + row * NP + C_AZ + hq * 64 + d0);
            const float o0 = oc[dt][0] * inv * silu_f(bflo(zw.x)), o1 = oc[dt][1] * inv * silu_f(bfhi(zw.x)), o2 = oc[dt][2] * inv * silu_f(bflo(zw.y)), o3 = oc[dt][3] * inv * silu_f(bfhi(zw.y));
            u32x2 ow; ow.x = cvtpk(o0, o1); ow.y = cvtpk(o2, o3);
            *(u32x2*)(Ob + row * D + 2048 + hq * 64 + d0) = ow; }
    }
}

constexpr int L_KF = 0, L_VF = 37440, L_QS = 74304;
__device__ __forceinline__ void attn_sample_item(const Args& a, int l, LAS unsigned char* lds, int it) {
    const int tid = tid_opaque(), lane = tid & 63, wave = __builtin_amdgcn_readfirstlane(tid >> 6);
    const int n = it >> 2, kv = it & 3;
    const bf16* P = (const bf16*)(a.ws + WS_P); const f32x2* rope = (const f32x2*)(a.ws + WS_ROPE);
    bf16* Ob = (bf16*)(a.ws + WS_HO);
    LAS float* Kf = (LAS float*)(lds + L_KF); LAS float* Vf = (LAS float*)(lds + L_VF);
    LAS float* qs = (LAS float*)(lds + L_QS) + wave * 208; LAS float* ps = qs + 64;
    const float* ck = a.in[4] + ((size_t)l * 16 + n) * 128 * 256 + kv * 64; const float* cv = a.in[5] + ((size_t)l * 16 + n) * 128 * 256 + kv * 64;
    __syncthreads();
    for (int i = 0; i < 16; ++i) { const int idx = tid + 512 * i, key = idx >> 6, d = idx & 63; Kf[key * 65 + d] = ck[(size_t)key * 256 + d]; Vf[key * 64 + d] = cv[(size_t)key * 256 + d]; }
    {   const int t = tid >> 5, d = tid & 31; const bf16* kp = P + ((size_t)MP + n * 16 + t) * NP + C_AK + kv * 64;
        const float x1 = bf1(kp[d]), x2 = bf1(kp[d + 32]); const f32x2 cs = rope[(PAST + t) * 32 + d];
        Kf[(128 + t) * 65 + d] = x1 * cs.x - x2 * cs.y; Kf[(128 + t) * 65 + d + 32] = x2 * cs.x + x1 * cs.y; }
    for (int i = 0; i < 2; ++i) { const int idx = tid + 512 * i, t = idx >> 6, d = idx & 63; Vf[(128 + t) * 64 + d] = bf1(P[((size_t)MP + n * 16 + t) * NP + C_AV + kv * 64 + d]); }
    __syncthreads();
    for (int i = 0; i < 16; ++i) { const int idx = tid + 512 * i, r = idx >> 6, d = idx & 63; const size_t o = ((((size_t)l * 16 + n) * 128 + r) * 4 + kv) * 64 + d;
        a.out[O_KS + o] = Kf[(16 + r) * 65 + d]; a.out[O_VS + o] = Vf[(16 + r) * 64 + d]; }
    const int hq = kv * 8 + wave; const float sink = a.in[17][l * 32 + hq];
    for (int t = 0; t < 16; ++t) {
        const size_t row = (size_t)MP + n * 16 + t;
        if (lane < 32) { const bf16* qp = P + row * NP + C_AQ + hq * 64; const float x1 = bf1(qp[lane]), x2 = bf1(qp[lane + 32]); const f32x2 cs = rope[(PAST + t) * 32 + lane];
            qs[lane] = (x1 * cs.x - x2 * cs.y) * 0.125f; qs[lane + 32] = (x2 * cs.x + x1 * cs.y) * 0.125f; }
        LDS_WAIT(); asm volatile("" ::: "memory");
        float sc[3];
#pragma unroll
        for (int k = 0; k < 3; ++k) { const int key = lane + 64 * k; float s = 0.f;
            if (key < 144) { for (int d = 0; d < 64; ++d) s += qs[d] * Kf[key * 65 + d]; } else s = -INFINITY;
            sc[k] = s; }
        const float m = fmaxf(sink, wave_max(fmaxf(fmaxf(sc[0], sc[1]), sc[2])));
        float psum = 0.f;
#pragma unroll
        for (int k = 0; k < 3; ++k) { const int key = lane + 64 * k; const float p = (key < 144) ? __expf(sc[k] - m) : 0.f; psum += p; if (key < 144) ps[key] = p; }
        const float inv = 1.0f / (wave_sum(psum) + __expf(sink - m));
        LDS_WAIT(); asm volatile("" ::: "memory");
        float o = 0.f;
        for (int key = 0; key < 144; ++key) o += ps[key] * Vf[key * 64 + lane];
        const float z = bf1(P[row * NP + C_AZ + hq * 64 + lane]);
        Ob[row * D + 2048 + hq * 64 + lane] = (bf16)(cvtpk(o * inv * silu_f(z), 0.f) & 0xffffu);
        LDS_WAIT(); asm volatile("" ::: "memory");
    }
}

__device__ __forceinline__ void phase_c2(const Args& a, int l, LAS unsigned char* lds, int G) {
    const int b = blockIdx.x;
    for (int k = 0;; ++k) {
        int seq = -1, att = -1, sat = -1;
        if (b < 64) { if (k > 0) break; seq = b; }
        else { const int it = (b - 64) + k * (G - 64); if (it >= 1344) break; if (it < 1024) att = it; else if (it < 1280) seq = 64 + (it - 1024); else sat = it - 1280; }
        if (seq >= 0) scan_seq(a, l, lds, seq);
        else if (att >= 0) attn_prompt_item(a, l, lds, att);
        else attn_sample_item(a, l, lds, sat);
    }
}


constexpr int N_PHASES = 12;
__global__ void __launch_bounds__(512, 2) fwd(Args args) {
    extern __shared__ __attribute__((aligned(16))) unsigned char lds_raw[];
    LAS unsigned char* lds = (LAS unsigned char*)lds_raw;
    const int G = gridDim.x;
    const Args* kp = (const Args*)__builtin_amdgcn_kernarg_segment_ptr();
#define ARGS(name) const Args* name##_p = kp; asm volatile("" : "+s"(name##_p)); const Args name = *name##_p
    const int lo = kp->ph_lo, hi = kp->ph_hi;
    volatile LAS unsigned* MISC = (volatile LAS unsigned*)(lds + MISC_OFF);
    for (int u = threadIdx.x; u < 64; u += 512) MISC[u] = 0u;
    __syncthreads();
    unsigned* barw = (unsigned*)(kp->ws + WS_CTL) + CW_BAR;
    XcdBarrier bar; bar.bar = barw; bar.x = 0; bar.st = nullptr;
    const bool multi = (hi - lo) > 1;
    if (multi) bar = xcd_barrier_post(barw, MISC + 8);
#define IN(k) (lo <= (k) && (k) < hi)
#define SEAM(k) do { if (IN(k) && IN((k) + 1)) xcd_barrier(bar); } while (0)
    if (IN(0)) { ARGS(a0); phase_prologue(a0, lds, G); }
    SEAM(0);
    if (IN(1)) { ARGS(a1); phase_h0(a1, G); }
    SEAM(1);
    for (int l = 0; l < 2; ++l) {
        const int pb = 2 + 5 * l;
        if (IN(pb + 0)) {
            ARGS(args);
            pg8::Gemm g{(const pg8::bf16_t*)(args.ws + WS_HO), (const pg8::bf16_t*)(args.ws + WS_BIN + l * BIN_BYTES), M, NP, D};
            pg8::StaticOrder S; S.init(M, NP, G, (int)blockIdx.x);
            pg8::EpiP E{(pg8::bf16_t*)(args.ws + WS_P), NP};
            pg8::gemm_phase<pg8::EpiP, pg8::StaticOrder, true, true>(lds, g, S, E);
        }
        SEAM(pb + 0);
        if (IN(pb + 1)) { ARGS(a2); phase_c1(a2, l, lds, G); }
        SEAM(pb + 1);
        if (IN(pb + 2)) { ARGS(a3); phase_c2(a3, l, lds, G); }
        SEAM(pb + 2);
        if (IN(pb + 3)) {
            ARGS(args);
            pg8::Gemm g{(const pg8::bf16_t*)(args.ws + WS_HO), (const pg8::bf16_t*)(args.ws + WS_BOUT + l * BOUT_BYTES), M, D, D};
            pg8::StaticOrder S; S.init(M, D, G, (int)blockIdx.x);
            pg8::EpiY E{(pg8::bf16_t*)(args.ws + WS_P), D, (float*)(args.ws + WS_YSQ)};
            pg8::gemm_phase<pg8::EpiY, pg8::StaticOrder, true, true>(lds, g, S, E);
        }
        SEAM(pb + 3);
        if (IN(pb + 4)) { ARGS(a4); phase_resid(a4, l, G); }
        SEAM(pb + 4);
    }
#undef IN
#undef SEAM
#undef ARGS
}


#ifdef DBG_STOP_AFTER
__global__ void dbg_dump(const unsigned char* ws, float* out) {
    const size_t regs[9][2] = {{WS_MOD, 1966080}, {WS_ROPE, 1048576}, {WS_DEC, 17408}, {WS_YSQ, (size_t)M * 64 * 4}, {WS_BIN, 2 * BIN_BYTES}, {WS_BOUT, 2 * BOUT_BYTES}, {WS_HO, (size_t)M * D * 2}, {WS_P, (size_t)M * NP * 2}, {WS_REC, (size_t)NREC * REC_BYTES}};
    size_t obase = 0;
    for (int r = 0; r < 9; ++r) { const size_t nchunk = regs[r][1] / 128; const unsigned short* p = (const unsigned short*)(ws + regs[r][0]);
        for (size_t i = (size_t)blockIdx.x * blockDim.x + threadIdx.x; i < nchunk; i += (size_t)gridDim.x * blockDim.x) { unsigned s = 0; for (int k = 0; k < 64; ++k) s += p[i * 64 + k]; out[obase + i] = (float)s; }
        obase += nchunk; }
}
#endif
#ifndef MK_PER_PHASE
#define MK_PER_PHASE 1
#endif
extern "C" void kernel_launch(void* const* d_in, const int* in_sizes, int n_in, void* d_out, int out_size, void* d_ws, size_t ws_size, hipStream_t stream) {
    static int grid = 0;
    if (grid == 0) {
        if (n_in != 19 || out_size != (int)O_END || ws_size < WS_END) { fprintf(stderr, "kernel_launch: unexpected shapes (n_in %d out %d ws %zu need %zu)\n", n_in, out_size, ws_size, (size_t)WS_END); grid = -1; return; }
        int dev = 0, cus = 0;
        if (hipGetDevice(&dev) != hipSuccess || hipDeviceGetAttribute(&cus, hipDeviceAttributeMultiprocessorCount, dev) != hipSuccess) { grid = -1; return; }
        if (hipFuncSetAttribute((const void*)fwd, hipFuncAttributeMaxDynamicSharedMemorySize, LDS_BYTES) != hipSuccess) { fprintf(stderr, "kernel_launch: hipFuncSetAttribute failed\n"); grid = -1; return; }
        int per_cu = 0;
        if (hipOccupancyMaxActiveBlocksPerMultiprocessor(&per_cu, (const void*)fwd, 512, LDS_BYTES) != hipSuccess || per_cu < 1) fprintf(stderr, "kernel_launch: occupancy query says %d\n", per_cu);
        (void)hipGetLastError();
        grid = cus;
        if (grid < 128) { fprintf(stderr, "kernel_launch: needs >= 128 CUs\n"); grid = -1; return; }
    }
    if (grid < 0) return;
    (void)in_sizes;
    if (hipMemsetAsync((char*)d_ws + WS_CTL, 0, CTL_ZERO_BYTES, stream) != hipSuccess) return;
    Args a{};
    for (int i = 0; i < 19; ++i) a.in[i] = (const float*)d_in[i];
    a.out = (float*)d_out; a.ws = (unsigned char*)d_ws;
#ifdef DBG_STOP_AFTER
    for (int p = 0; p <= DBG_STOP_AFTER; ++p) { a.ph_lo = p; a.ph_hi = p + 1; hipLaunchKernelGGL(fwd, dim3(grid), dim3(512), LDS_BYTES, stream, a); }
    hipLaunchKernelGGL(dbg_dump, dim3(2048), dim3(256), 0, stream, (const unsigned char*)d_ws, (float*)d_out);
#elif MK_PER_PHASE
    for (int p = 0; p < N_PHASES; ++p) { a.ph_lo = p; a.ph_hi = p + 1; hipLaunchKernelGGL(fwd, dim3(grid), dim3(512), LDS_BYTES, stream, a); }
#else
    a.ph_lo = 0; a.ph_hi = N_PHASES;
    hipLaunchKernelGGL(fwd, dim3(grid), dim3(512), LDS_BYTES, stream, a);
#endif
}
```

```cpp
#include <hip/hip_runtime.h>
#include <cstdio>
#include <cstdint>
#define MK_PER_PHASE 0
__device__ __forceinline__ int tid_opaque() { int t = threadIdx.x; asm volatile("" : "+v"(t)); return t; }
namespace pg8 {
#define PG8_LAS __attribute__((address_space(3)))
typedef unsigned short bf16_t;
typedef short bf16x8 __attribute__((ext_vector_type(8)));
typedef float f32x4 __attribute__((ext_vector_type(4)));
typedef unsigned u32x4 __attribute__((ext_vector_type(4)));
constexpr int BM = 256, BK = 64, HALF = 128, HTB = HALF * BK * 2  , STAGE_BYTES = 8 * HTB, NXCD = 8, WGM = 8;

__host__ __device__ __forceinline__ int lds_byte(int r, int c) { const int st = (r >> 4) * 2 + (c >> 5), rr = r & 15, cc = c & 31, ob = rr * 64 + cc * 2; return st * 1024 + (ob ^ (((ob >> 9) & 1) << 5)); }
__host__ __device__ __forceinline__ void stage_rc(int b, int& R, int& C) { const int st = b / 1024, sb = b % 1024, swz = sb ^ (((sb >> 9) & 1) << 5); R = (st >> 1) * 16 + swz / 64; C = (st & 1) * 32 + (swz % 64) / 2; }
__host__ __device__ __forceinline__ int perm32(int rho) { const int n = rho >> 4, i = rho & 15; return 8 * (i >> 2) + 4 * n + (i & 3); }

struct Unit { int pm, pn; };
struct Gemm { const bf16_t* A; const bf16_t* Bt; int M, N, K; };

struct StaticOrder {
    int nM, nN, nwg, G, c;
    __host__ __device__ void init(int M, int N, int G_, int c_) { nM = M / BM; nN = N / BM; nwg = nM * nN; G = G_; c = c_; }
    __host__ __device__ bool next(int i, Unit& u) const {
        const long L = (long)i * G + c; if (L >= nwg) return false;
        int wgid = (int)L; { const int q = nwg / NXCD, r = nwg % NXCD, xcd = wgid % NXCD, off = wgid / NXCD; wgid = (xcd < r ? xcd * (q + 1) : r * (q + 1) + (xcd - r) * q) + off; }
        const int nig = WGM * nN, gid = wgid / nig, fm = gid * WGM, gsz = (nM - fm) < WGM ? (nM - fm) : WGM;
        u.pm = fm + ((wgid % nig) % gsz); u.pn = (wgid % nig) / gsz; return true;
    }
    __device__ __forceinline__ void a_ready(const Unit&) const {}
    __device__ __forceinline__ void done(const Unit&) const {}
};

typedef __bf16 hwbf16x2_t __attribute__((ext_vector_type(2))); typedef float f32x2_t __attribute__((ext_vector_type(2)));
__device__ __forceinline__ unsigned cvt_pk_bf16(float lo, float hi) { const f32x2_t v = {lo, hi}; return __builtin_bit_cast(unsigned, __builtin_convertvector(v, hwbf16x2_t)); }
struct EpiP {
    static constexpr bool PERM = true, AFTER_DRAIN = false;
    bf16_t* O; int ldc;
    __device__ __forceinline__ void operator()(const f32x4 (&acc)[2][2][4][2], const Unit& u, int wr, int wc, int fr, int fq) const {
        const int row0 = u.pm * BM + wr * 64 + fr, col0 = u.pn * BM + wc * 32 + 8 * fq;
#pragma unroll
        for (int ai = 0; ai < 2; ++ai)
#pragma unroll
            for (int m = 0; m < 4; ++m) { bf16_t* rowp = O + (size_t)(row0 + ai * HALF + m * 16) * ldc + col0;
#pragma unroll
                for (int bj = 0; bj < 2; ++bj) { const f32x4 v0 = acc[ai][bj][m][0], v1 = acc[ai][bj][m][1];
                    u32x4 w; w.x = cvt_pk_bf16(v0[0], v0[1]); w.y = cvt_pk_bf16(v0[2], v0[3]); w.z = cvt_pk_bf16(v1[0], v1[1]); w.w = cvt_pk_bf16(v1[2], v1[3]);
                    *(u32x4*)(rowp + bj * HALF) = w; } }
    }
};
struct EpiY {
    static constexpr bool PERM = true, AFTER_DRAIN = false;
    bf16_t* O; int ldc; float* part;
    __device__ __forceinline__ void operator()(const f32x4 (&acc)[2][2][4][2], const Unit& u, int wr, int wc, int fr, int fq) const {
        const int row0 = u.pm * BM + wr * 64 + fr, col0 = u.pn * BM + wc * 32 + 8 * fq;
#pragma unroll
        for (int ai = 0; ai < 2; ++ai)
#pragma unroll
            for (int m = 0; m < 4; ++m) { const int row = row0 + ai * HALF + m * 16; bf16_t* rowp = O + (size_t)row * ldc + col0; float s = 0.f;
#pragma unroll
                for (int bj = 0; bj < 2; ++bj) { const f32x4 v0 = acc[ai][bj][m][0], v1 = acc[ai][bj][m][1];
                    s += (v0[0] * v0[0] + v0[1] * v0[1]) + (v0[2] * v0[2] + v0[3] * v0[3]) + (v1[0] * v1[0] + v1[1] * v1[1]) + (v1[2] * v1[2] + v1[3] * v1[3]);
                    u32x4 w; w.x = cvt_pk_bf16(v0[0], v0[1]); w.y = cvt_pk_bf16(v0[2], v0[3]); w.z = cvt_pk_bf16(v1[0], v1[1]); w.w = cvt_pk_bf16(v1[2], v1[3]);
                    *(u32x4*)(rowp + bj * HALF) = w; }
                s += __shfl_xor(s, 16); s += __shfl_xor(s, 32);
                if (fq == 0) part[(size_t)row * 64 + u.pn * 4 + wc] = s; }
    }
};

template <class Epi, class Sched, bool ALIGN_EPI = false, bool SP2 = false>
__device__ __forceinline__ void gemm_phase(PG8_LAS unsigned char* lds, const Gemm g, const Sched& S, const Epi& E) {
    const int tid = tid_opaque(), wid = __builtin_amdgcn_readfirstlane(tid >> 6), lane = tid & 63, wr = wid >> 2, wc = wid & 3, fr = lane & 15, fq = lane >> 4;
    const int K = g.K, nt = K / BK;
    unsigned voffA[2], voffB[2];
#pragma unroll
    for (int i = 0; i < 2; ++i) { int R, C; stage_rc(tid * 16 + i * 8192, R, C); const int Rb = Epi::PERM ? ((R & ~31) + perm32(R & 31)) : R;
        voffA[i] = (unsigned)(R * K + C) * 2u; voffB[i] = (unsigned)(Rb * K + C) * 2u; }
    const size_t kstep = (size_t)(BK * 2);
    const size_t hstep = (size_t)HALF * K * 2;
    const size_t tstep = 2 * hstep;
    const unsigned ldsw = (unsigned)wid * 1024u;
    const int aoff = lds_byte(wr * 64 + fr, fq * 8), boff = lds_byte(wc * 32 + fr, fq * 8);
#define PG8_SA(b, h) (((b) * 2 + (h)) * HTB)
#define PG8_SB(b, h) ((4 + (b) * 2 + (h)) * HTB)
#define PG8_STAGE(bufoff, gbase, voff) do { _Pragma("unroll") for (int _i = 0; _i < 2; ++_i) \
        __builtin_amdgcn_global_load_lds((const unsigned*)((const char*)(gbase) + (voff)[_i]), (PG8_LAS unsigned*)(lds + (bufoff) + ldsw + _i * 8192), 16, 0, 0); } while (0)
#define PG8_LDA(dst, b, h) do { _Pragma("unroll") for (int m = 0; m < 4; ++m) _Pragma("unroll") for (int k = 0; k < 2; ++k) dst[m][k] = *(const PG8_LAS bf16x8*)(lds + PG8_SA(b, h) + aoff + m * 2048 + k * 1024); } while (0)
#define PG8_LDB(dst, b, h) do { _Pragma("unroll") for (int n = 0; n < 2; ++n) _Pragma("unroll") for (int k = 0; k < 2; ++k) dst[n][k] = *(const PG8_LAS bf16x8*)(lds + PG8_SB(b, h) + boff + n * 2048 + k * 1024); } while (0)
#define PG8_MMA(ai, bj, At, Bt) do { __builtin_amdgcn_s_setprio(1); _Pragma("unroll") for (int m = 0; m < 4; ++m) _Pragma("unroll") for (int n = 0; n < 2; ++n) _Pragma("unroll") for (int k = 0; k < 2; ++k) \
        acc[ai][bj][m][n] = __builtin_amdgcn_mfma_f32_16x16x32_bf16(Bt[n][k], At[m][k], acc[ai][bj][m][n], 0, 0, 0); __builtin_amdgcn_s_setprio(0); } while (0)
#define PG8_WAIT_V(n) asm volatile("s_waitcnt vmcnt(" #n ")" ::: "memory")
#define PG8_WAIT_L(n) asm volatile("s_waitcnt lgkmcnt(" #n ")" ::: "memory")
#define PG8_BAR __builtin_amdgcn_s_barrier()
#define PG8_SCHED __builtin_amdgcn_sched_barrier(0)
    Unit cur, nxt; int ui = 0;
    if (!S.next(0, cur)) return;
    f32x4 acc[2][2][4][2];
#pragma unroll
    for (int a = 0; a < 2; ++a)
#pragma unroll
        for (int b = 0; b < 2; ++b)
#pragma unroll
            for (int m = 0; m < 4; ++m)
#pragma unroll
                for (int n = 0; n < 2; ++n) acc[a][b][m][n] = (f32x4){0.f, 0.f, 0.f, 0.f};
    bf16x8 At[4][2], B0[2][2], B1[2][2];
    const char* cA = (const char*)g.A + (size_t)cur.pm * tstep; const char* cB = (const char*)g.Bt + (size_t)cur.pn * tstep;
    S.a_ready(cur);
    if constexpr (SP2) {
        PG8_STAGE(PG8_SB(0, 0), cB, voffB); PG8_STAGE(PG8_SB(0, 1), cB + hstep, voffB); PG8_STAGE(PG8_SA(0, 0), cA, voffA); PG8_STAGE(PG8_SA(0, 1), cA + hstep, voffA);
        if (wr == 1) PG8_BAR;
        PG8_WAIT_V(2); PG8_BAR;
        PG8_STAGE(PG8_SB(1, 0), cB + kstep, voffB); PG8_STAGE(PG8_SA(1, 0), cA + kstep, voffA); PG8_STAGE(PG8_SB(1, 1), cB + hstep + kstep, voffB);
        PG8_WAIT_V(6); PG8_BAR;
    } else {
        PG8_STAGE(PG8_SB(0, 0), cB, voffB); PG8_STAGE(PG8_SA(0, 0), cA, voffA); PG8_STAGE(PG8_SB(0, 1), cB + hstep, voffB); PG8_STAGE(PG8_SA(0, 1), cA + hstep, voffA);
        if (wr == 1) PG8_BAR;
        PG8_WAIT_V(4); PG8_BAR;
        PG8_STAGE(PG8_SB(1, 0), cB + kstep, voffB); PG8_STAGE(PG8_SA(1, 0), cA + kstep, voffA); PG8_STAGE(PG8_SB(1, 1), cB + hstep + kstep, voffB);
        PG8_WAIT_V(6); PG8_BAR;
    }
    for (;;) {
        const bool has_next = S.next(ui + 1, nxt);
        const char* nA = has_next ? (const char*)g.A + (size_t)nxt.pm * tstep : cA; const char* nB = has_next ? (const char*)g.Bt + (size_t)nxt.pn * tstep : cB;
        for (int t = 0; t < nt; t += 2) {
            const bool last = (t == nt - 2);
            const char* a1 = cA + (size_t)(t + 1) * kstep;
            const char* a2 = last ? nA : cA + (size_t)(t + 2) * kstep; const char* b2 = last ? nB : cB + (size_t)(t + 2) * kstep;
            const char* a3 = a2 + kstep; const char* b3 = b2 + kstep;
            if (last && has_next) S.a_ready(nxt);
            if constexpr (SP2) {
            PG8_LDB(B0, 0, 0); PG8_LDB(B1, 0, 1); PG8_SCHED; PG8_LDA(At, 0, 0); PG8_STAGE(PG8_SA(1, 1), a1 + hstep, voffA);
            PG8_WAIT_V(8); PG8_WAIT_L(0); PG8_BAR; PG8_MMA(0, 0, At, B0); PG8_MMA(0, 1, At, B1); PG8_BAR; PG8_SCHED;
            PG8_LDA(At, 0, 1); PG8_STAGE(PG8_SB(0, 0), b2, voffB); PG8_STAGE(PG8_SB(0, 1), b2 + hstep, voffB); PG8_STAGE(PG8_SA(0, 0), a2, voffA);
            PG8_WAIT_V(8); PG8_WAIT_L(0); PG8_BAR; PG8_MMA(1, 0, At, B0); PG8_MMA(1, 1, At, B1); PG8_BAR; PG8_SCHED;
            PG8_LDB(B0, 1, 0); PG8_LDB(B1, 1, 1); PG8_SCHED; PG8_LDA(At, 1, 0); PG8_STAGE(PG8_SA(0, 1), a2 + hstep, voffA);
            PG8_WAIT_V(8); PG8_WAIT_L(0); PG8_BAR; PG8_MMA(0, 0, At, B0); PG8_MMA(0, 1, At, B1); PG8_BAR; PG8_SCHED;
            PG8_LDA(At, 1, 1); PG8_STAGE(PG8_SB(1, 0), b3, voffB); PG8_STAGE(PG8_SB(1, 1), b3 + hstep, voffB); PG8_STAGE(PG8_SA(1, 0), a3, voffA);
            PG8_WAIT_V(8); PG8_WAIT_L(0); PG8_BAR; PG8_MMA(1, 0, At, B0); PG8_MMA(1, 1, At, B1); PG8_BAR; PG8_SCHED;
            } else {
            PG8_LDB(B0, 0, 0); PG8_SCHED; PG8_LDA(At, 0, 0); PG8_STAGE(PG8_SA(1, 1), a1 + hstep, voffA);
            PG8_WAIT_L(8); PG8_BAR; PG8_WAIT_L(0); PG8_MMA(0, 0, At, B0); PG8_BAR; PG8_SCHED;
            PG8_LDB(B1, 0, 1); PG8_STAGE(PG8_SB(0, 0), b2, voffB);
            PG8_BAR; PG8_WAIT_L(0); PG8_MMA(0, 1, At, B1); PG8_BAR;
            PG8_LDA(At, 0, 1); PG8_STAGE(PG8_SA(0, 0), a2, voffA);
            PG8_BAR; PG8_WAIT_L(0); PG8_MMA(1, 0, At, B0); PG8_BAR; PG8_SCHED;
            PG8_STAGE(PG8_SB(0, 1), b2 + hstep, voffB);
            PG8_WAIT_V(6); PG8_BAR; PG8_MMA(1, 1, At, B1); PG8_BAR;
            PG8_LDB(B0, 1, 0); PG8_SCHED; PG8_LDA(At, 1, 0); PG8_STAGE(PG8_SA(0, 1), a2 + hstep, voffA);
            PG8_WAIT_L(8); PG8_BAR; PG8_WAIT_L(0); PG8_MMA(0, 0, At, B0); PG8_BAR; PG8_SCHED;
            PG8_LDB(B1, 1, 1); PG8_STAGE(PG8_SB(1, 0), b3, voffB);
            PG8_BAR; PG8_WAIT_L(0); PG8_MMA(0, 1, At, B1); PG8_BAR;
            PG8_LDA(At, 1, 1); PG8_STAGE(PG8_SA(1, 0), a3, voffA);
            PG8_BAR; PG8_WAIT_L(0); PG8_MMA(1, 0, At, B0); PG8_BAR; PG8_SCHED;
            PG8_STAGE(PG8_SB(1, 1), b3 + hstep, voffB);
            PG8_WAIT_V(6); PG8_BAR; PG8_MMA(1, 1, At, B1); PG8_BAR;
            }
        }
        if constexpr (ALIGN_EPI) { if (wr == 0) PG8_BAR; }
        if constexpr (!Epi::AFTER_DRAIN) { E(acc, cur, wr, wc, fr, fq); S.done(cur); }
        if (!has_next) break;
#pragma unroll
        for (int a = 0; a < 2; ++a)
#pragma unroll
            for (int b = 0; b < 2; ++b)
#pragma unroll
                for (int m = 0; m < 4; ++m)
#pragma unroll
                    for (int n = 0; n < 2; ++n) acc[a][b][m][n] = (f32x4){0.f, 0.f, 0.f, 0.f};
        cur = nxt; cA = nA; cB = nB; ++ui;
        if constexpr (ALIGN_EPI) { if (wr == 1) PG8_BAR; }
    }
    PG8_WAIT_V(0);
    if constexpr (!ALIGN_EPI) { if (wr == 0) PG8_BAR; }
    PG8_BAR;
    if constexpr (Epi::AFTER_DRAIN) { E.fused(acc, cur, wr, wc, fr, fq, lds, wid, lane); S.done(cur); }
#undef PG8_SA
#undef PG8_SB
#undef PG8_STAGE
#undef PG8_LDA
#undef PG8_LDB
#undef PG8_MMA
#undef PG8_WAIT_V
#undef PG8_WAIT_L
#undef PG8_BAR
#undef PG8_SCHED
}
}

#define GAS __attribute__((address_space(1)))
#define LAS __attribute__((address_space(3)))
typedef unsigned short bf16;
typedef short bf16x8 __attribute__((ext_vector_type(8)));
typedef short bf16x4 __attribute__((ext_vector_type(4)));
typedef float f32x4 __attribute__((ext_vector_type(4)));
typedef float f32x2 __attribute__((ext_vector_type(2)));
typedef unsigned u32x4 __attribute__((ext_vector_type(4)));
typedef unsigned u32x2 __attribute__((ext_vector_type(2)));

constexpr int D = 4096, NB = 4, T = 4096, NSB = 16, TS = 16, PAST = 2048;
constexpr int MP = NB * T, MS = NSB * TS, M = MP + MS;
constexpr int NP = 13056, IN_DIM = 12832;
constexpr int C_Q = 0, C_K = 2048, C_V = 4096, C_ZDN = 6144, C_AQ = 8192, C_AK = 10240, C_AV = 10496, C_AZ = 10752, C_B = 12800, C_A = 12816;
constexpr float EPS = 1e-6f;
constexpr size_t O_YP = 0, O_YS = O_YP + (size_t)MP * D, O_CONVP = O_YS + (size_t)MS * D, O_DNP = O_CONVP + 2 * 4 * 3 * 6144, O_KP = O_DNP + 2 * 4 * 16 * 128 * 128,
                 O_VP = O_KP + 2 * 4 * 128 * 256, O_CONVS = O_VP + 2 * 4 * 128 * 256, O_DNS = O_CONVS + 2 * 16 * 3 * 6144, O_KS = O_DNS + (size_t)2 * 16 * 16 * 128 * 128,
                 O_VS = O_KS + 2 * 16 * 128 * 256, O_END = O_VS + 2 * 16 * 128 * 256;
static_assert(O_END == 82001920, "output size");
constexpr size_t MiB = 1u << 20;
constexpr size_t WS_CTL = 0, CTL_ZERO_BYTES = 1 * MiB;
constexpr size_t WS_MOD = 1 * MiB;
constexpr size_t WS_ROPE = 3 * MiB;
constexpr size_t WS_DEC = 4 * MiB;
constexpr size_t WS_YSQ = 5 * MiB;
constexpr size_t WS_BIN = 10 * MiB;
constexpr size_t BIN_BYTES = (size_t)NP * 4096 * 2;
constexpr size_t WS_BOUT = 214 * MiB;
constexpr size_t BOUT_BYTES = (size_t)4096 * 4096 * 2;
constexpr size_t WS_HO = 278 * MiB;
constexpr size_t WS_P = 408 * MiB;
constexpr size_t WS_REC = 823 * MiB;
constexpr int REC_W = 0, REC_QD = 16384, REC_KD = 32768, REC_QK = 49152, REC_U = 57344, REC_G = 73728, REC_BYTES = 90112, REC_STAGE = 57344;
constexpr int NREC = 4096 + 256;
constexpr size_t WS_END = WS_REC + (size_t)NREC * REC_BYTES;
static_assert(WS_BIN + 2 * BIN_BYTES <= WS_BOUT && WS_HO + (size_t)M * D * 2 <= WS_P && WS_P + (size_t)M * NP * 2 <= WS_REC, "ws map");
constexpr int CW_BAR = 4096;
constexpr int LDS_BYTES = 147456;
constexpr int MISC_OFF = 147456 - 256;

#define RLX_AGENT __ATOMIC_RELAXED, __HIP_MEMORY_SCOPE_AGENT
#define LDS_WAIT() asm volatile("s_waitcnt lgkmcnt(0)" ::: "memory")
#define VM_WAIT() asm volatile("s_waitcnt vmcnt(0)" ::: "memory")
typedef __bf16 hwbf16x2 __attribute__((ext_vector_type(2)));
__device__ __forceinline__ unsigned cvtpk(float lo, float hi) { const f32x2 v = {lo, hi}; return __builtin_bit_cast(unsigned, __builtin_convertvector(v, hwbf16x2)); }
__device__ __forceinline__ float bflo(unsigned w) { return __uint_as_float(w << 16); }
__device__ __forceinline__ float bfhi(unsigned w) { return __uint_as_float(w & 0xffff0000u); }
__device__ __forceinline__ float bf1(bf16 h) { return __uint_as_float(((unsigned)h) << 16); }
__device__ __forceinline__ float silu_f(float x) { return x * __builtin_amdgcn_rcpf(1.0f + __expf(-x)); }
__device__ __forceinline__ float sigmoid_f(float x) { return __builtin_amdgcn_rcpf(1.0f + __expf(-x)); }
__device__ __forceinline__ float wave_sum(float v) {
#pragma unroll
    for (int o = 1; o < 64; o <<= 1) v += __shfl_xor(v, o);
    return v;
}
__device__ __forceinline__ float wave_max(float v) {
#pragma unroll
    for (int o = 1; o < 64; o <<= 1) v = fmaxf(v, __shfl_xor(v, o));
    return v;
}
__device__ __forceinline__ void unpack8(const u32x4 w, float (&f)[8]) {
    f[0] = bflo(w.x); f[1] = bfhi(w.x); f[2] = bflo(w.y); f[3] = bfhi(w.y); f[4] = bflo(w.z); f[5] = bfhi(w.z); f[6] = bflo(w.w); f[7] = bfhi(w.w);
}
__device__ __forceinline__ u32x4 pack8(const float (&f)[8]) { u32x4 w; w.x = cvtpk(f[0], f[1]); w.y = cvtpk(f[2], f[3]); w.z = cvtpk(f[4], f[5]); w.w = cvtpk(f[6], f[7]); return w; }
__device__ __forceinline__ bf16x8 as_bf16x8(const u32x4 w) { return __builtin_bit_cast(bf16x8, w); }
__device__ __forceinline__ bf16x4 as_bf16x4(const u32x2 w) { return __builtin_bit_cast(bf16x4, w); }

#define XB_TMO      128
#define XB_XCNT(j)  (256  + 64 * (j))
#define XB_XSUB(j)  (1280 + 64 * (j))
#define XB_XGEN(j)  (2304 + 64 * (j))
#define XB_TOP      3328
#define XB_TOPGEN   3392
#define XCD_BAR_WORDS 3456
#define XB_SPIN_CAP (1u << 18)

__device__ __forceinline__ unsigned xb_ld(unsigned* p)              { return __hip_atomic_load(p, __ATOMIC_RELAXED, __HIP_MEMORY_SCOPE_AGENT); }
__device__ __forceinline__ unsigned xb_add(unsigned* p, unsigned v) { return __hip_atomic_fetch_add(p, v, __ATOMIC_RELAXED, __HIP_MEMORY_SCOPE_AGENT); }
__device__ __forceinline__ unsigned xb_xcc_id() { return (unsigned)__builtin_amdgcn_s_getreg((3 << 11) | 20) & 0xFu; }
#define XB_SPIN(cond, bar) do { unsigned _sp = 0; while (cond) { __builtin_amdgcn_s_sleep(1); \
    if ((++_sp & 255u) == 0u) { if (xb_ld(&(bar)[XB_TMO])) break; if (_sp > XB_SPIN_CAP) { atomicAdd(&(bar)[XB_TMO], 1u); break; } } } } while (0)

struct XcdBarrier {
    unsigned* bar; unsigned x;
    volatile LAS unsigned* st;
};

__device__ __forceinline__ XcdBarrier xcd_barrier_post(unsigned* bar, volatile LAS unsigned* st) {
    XcdBarrier b; b.bar = bar; b.x = xb_xcc_id(); b.st = st;
    if (threadIdx.x == 0) (void)xb_add(&bar[XB_XCNT(b.x)], 1u);
    return b;
}
__device__ __forceinline__ void xcd_barrier_complete(unsigned* bar, unsigned x, unsigned& nloc, unsigned& nx) {
    const unsigned G = gridDim.x * gridDim.y * gridDim.z;
    unsigned sum, cnt, mine, sp = 0u;
    for (;;) {
        sum = 0u; cnt = 0u; mine = 0u;
#pragma unroll
        for (unsigned j = 0; j < 16; ++j) { const unsigned c = xb_ld(&bar[XB_XCNT(j)]); sum += c; cnt += (c > 0u) ? 1u : 0u; mine = (j == x) ? c : mine; }
        if (sum == G) break;
        __builtin_amdgcn_s_sleep(1);
        if ((++sp & 255u) == 0u) { if (xb_ld(&bar[XB_TMO])) break; if (sp > XB_SPIN_CAP) { atomicAdd(&bar[XB_TMO], 1u); break; } }
    }
    nloc = mine > 0u ? mine : 1u; nx = cnt > 0u ? cnt : 1u;
}

__device__ __forceinline__ void xcd_barrier(const XcdBarrier& b) {
    asm volatile("s_waitcnt vmcnt(0)" ::: "memory");
    __syncthreads();
    if (threadIdx.x == 0) {
        unsigned* bar = b.bar;
        __builtin_amdgcn_s_waitcnt(0);
        unsigned nloc = b.st[0], nx = b.st[1];
        if (nloc == 0u) { xcd_barrier_complete(bar, b.x, nloc, nx); b.st[0] = nloc; b.st[1] = nx; }
        const unsigned old = xb_add(&bar[XB_XSUB(b.x)], 1u);
        const unsigned gen = old / nloc;
        if (old + 1u == (gen + 1u) * nloc) {
            __builtin_amdgcn_fence(__ATOMIC_RELEASE, "agent");
            asm volatile("s_waitcnt vmcnt(0)" ::: "memory");
            const unsigned og = xb_add(&bar[XB_TOP], 1u);
            const unsigned tg = og / nx;
            if (og + 1u == (tg + 1u) * nx) xb_add(&bar[XB_TOPGEN], 1u);
            else XB_SPIN(xb_ld(&bar[XB_TOPGEN]) == tg, bar);
            __builtin_amdgcn_fence(__ATOMIC_ACQUIRE, "agent");
            xb_add(&bar[XB_XGEN(b.x)], 1u);
            asm volatile("s_waitcnt vmcnt(0)" ::: "memory");
        } else {
            XB_SPIN(xb_ld(&bar[XB_XGEN(b.x)]) == gen, bar);
            __builtin_amdgcn_fence(__ATOMIC_ACQUIRE, "agent");
            asm volatile("s_waitcnt vmcnt(0)" ::: "memory");
        }
    }
    __syncthreads();
}

struct Args { const float* in[19]; float* out; unsigned char* ws; int ph_lo, ph_hi; };

__device__ __forceinline__ void p0_transpose_item(const float* W, int K, int N, bf16* WT, int dst_row0, LAS float* scr, int k0, int n0, int lane) {
#pragma unroll 8
    for (int i = 0; i < 32; ++i) { const int kk = 2 * i + (lane >> 5); scr[kk * 33 + (lane & 31)] = W[(size_t)(k0 + kk) * N + n0 + (lane & 31)]; }
    LDS_WAIT(); asm volatile("" ::: "memory");
    const int c = lane & 7;
#pragma unroll
    for (int j = 0; j < 4; ++j) { const int n = (lane >> 3) + 8 * j; const LAS float* s = scr + (8 * c) * 33 + n;
        u32x4 o; o.x = cvtpk(s[0 * 33], s[1 * 33]); o.y = cvtpk(s[2 * 33], s[3 * 33]); o.z = cvtpk(s[4 * 33], s[5 * 33]); o.w = cvtpk(s[6 * 33], s[7 * 33]);
        *(u32x4*)(WT + (size_t)(dst_row0 + n) * K + k0 + 8 * c) = o; }
    LDS_WAIT(); asm volatile("" ::: "memory");
}
__device__ __forceinline__ void phase_prologue(const Args& a, LAS unsigned char* lds, int G) {
    const int tid = tid_opaque(), lane = tid & 63, wave = tid >> 6;
    {
        const float* cp = a.in[6]; const float* cs = a.in[7]; const float* w_ada = a.in[8]; const float* b_ada = a.in[9];
        float* mod = (float*)(a.ws + WS_MOD);
        LAS float* sc = (LAS float*)lds;
        LAS float* red = (LAS float*)(lds + 40960);
        const int cgp = tid & 7, ksl = tid >> 3;
        for (int it = blockIdx.x; it < 768; it += G) {
            const int l = it / 384, col0 = (it % 384) * 32;
            f32x4 acc[20];
#pragma unroll
            for (int j = 0; j < 20; ++j) acc[j] = (f32x4){0.f, 0.f, 0.f, 0.f};
            for (int kt = 0; kt < 8; ++kt) {
                __syncthreads();
#pragma unroll
                for (int j = 0; j < 20; ++j) { const float cv = (j < 4) ? cp[j * 4096 + kt * 512 + tid] : cs[(j - 4) * 4096 + kt * 512 + tid]; sc[tid * 20 + j] = silu_f(cv); }
                __syncthreads();
                const float* wp = w_ada + ((size_t)l * 4096 + kt * 512 + ksl * 8) * 12288 + col0 + cgp * 4;
                f32x4 w[8];
#pragma unroll
                for (int kk = 0; kk < 8; ++kk) w[kk] = *(const f32x4*)(wp + (size_t)kk * 12288);
#pragma unroll
                for (int kk = 0; kk < 8; ++kk) {
                    const LAS f32x4* s4 = (const LAS f32x4*)(sc + (ksl * 8 + kk) * 20);
#pragma unroll
                    for (int j4 = 0; j4 < 5; ++j4) { const f32x4 s = s4[j4];
#pragma unroll
                        for (int jj = 0; jj < 4; ++jj) acc[j4 * 4 + jj] += s[jj] * w[kk]; }
                }
            }
#pragma unroll
            for (int j = 0; j < 20; ++j)
#pragma unroll
                for (int c = 0; c < 4; ++c) { float v = acc[j][c]; v += __shfl_xor(v, 8); v += __shfl_xor(v, 16); v += __shfl_xor(v, 32); acc[j][c] = v; }
            __syncthreads();
            if (lane < 8) {
#pragma unroll
                for (int j = 0; j < 20; ++j) *(LAS f32x4*)(red + (wave * 20 + j) * 32 + lane * 4) = acc[j];
            }
            __syncthreads();
            for (int o = tid; o < 640; o += 512) { const int j = o >> 5, c = o & 31; float s = 0.f;
#pragma unroll
                for (int w8 = 0; w8 < 8; ++w8) s += red[(w8 * 20 + j) * 32 + c];
                mod[((size_t)l * 20 + j) * 12288 + col0 + c] = s + b_ada[(size_t)l * 12288 + col0 + c]; }
        }
        __syncthreads();
    }
    {
        LAS float* scr = (LAS float*)(lds + wave * 8448);
        const int gw = blockIdx.x * 8 + wave, NGW = G * 8;
        constexpr int I_IN = 64 * 401, I_OUT = 64 * 128, I_L = I_IN + I_OUT;
        for (int it = gw; it < 2 * I_L; it += NGW) {
            const int l = it / I_L; int r = it % I_L;
            if (r < I_IN) { const int kb = r / 401, nb = r % 401, n0 = nb * 32; const int dst = (n0 < 8192) ? n0 : ((n0 < 8224) ? (C_B + (n0 - 8192)) : (n0 - 32));
                p0_transpose_item(a.in[12] + (size_t)l * 4096 * IN_DIM, 4096, IN_DIM, (bf16*)(a.ws + WS_BIN + l * BIN_BYTES), dst, scr, kb * 64, n0, lane); }
            else { r -= I_IN; const int kb = r / 128, nb = r % 128;
                p0_transpose_item(a.in[18] + (size_t)l * 4096 * 4096, 4096, 4096, (bf16*)(a.ws + WS_BOUT + l * BOUT_BYTES), nb * 32, scr, kb * 64, nb * 32, lane); }
        }
        const int gt = blockIdx.x * 512 + tid, NT = G * 512;
        constexpr int ZU = (NP - IN_DIM) * 4096 * 2 / 16;
        for (int u = gt; u < 2 * ZU; u += NT) { const int l = u / ZU, r = u % ZU;
            *(u32x4*)(a.ws + WS_BIN + l * BIN_BYTES + (size_t)IN_DIM * 4096 * 2 + (size_t)r * 16) = (u32x4){0u, 0u, 0u, 0u}; }
        f32x2* rt = (f32x2*)(a.ws + WS_ROPE);
        for (int idx = gt; idx < 4096 * 32; idx += NT) { const int pos = idx >> 5, i = idx & 31;
            const double inv = exp2(-(double)i * (13.287712379549449 / 32.0)); const double ang = (double)pos * inv;
            rt[idx] = (f32x2){(float)cos(ang), (float)sin(ang)}; }
    }
}

__device__ __forceinline__ void phase_h0(const Args& a, int G) {
    const int tid = tid_opaque(), lane = tid & 63, wave = tid >> 6;
    const int gw = blockIdx.x * 8 + wave, NGW = G * 8;
    const float* mod = (const float*)(a.ws + WS_MOD); const float* g_pre = a.in[10];
    bf16* H = (bf16*)(a.ws + WS_HO);
    for (int row = gw; row < M; row += NGW) {
        const float* xr = (row < MP) ? a.in[0] + (size_t)row * D : a.in[1] + (size_t)(row - MP) * D;
        const int j = (row < MP) ? (row >> 12) : (4 + ((row - MP) >> 4));
        const float* mr = mod + (size_t)j * 12288;
        f32x4 v[16]; float s = 0.f;
#pragma unroll
        for (int q = 0; q < 16; ++q) { v[q] = *(const f32x4*)(xr + 4 * lane + 256 * q); s += (v[q][0] * v[q][0] + v[q][1] * v[q][1]) + (v[q][2] * v[q][2] + v[q][3] * v[q][3]); }
        const float rstd = rsqrtf(wave_sum(s) * (1.f / D) + EPS);
#pragma unroll
        for (int q = 0; q < 16; ++q) { const int c = 4 * lane + 256 * q; const f32x4 g = *(const f32x4*)(g_pre + c), sh = *(const f32x4*)(mr + c), sc = *(const f32x4*)(mr + 4096 + c);
            const f32x4 hv = v[q] * rstd * g * (sc + 1.0f) + sh; u32x2 w; w.x = cvtpk(hv[0], hv[1]); w.y = cvtpk(hv[2], hv[3]);
            *(u32x2*)(H + (size_t)row * D + c) = w; }
    }
}
__device__ __forceinline__ void phase_resid(const Args& a, int l, int G) {
    const int tid = tid_opaque(), lane = tid & 63, wave = tid >> 6;
    const int gw = blockIdx.x * 8 + wave, NGW = G * 8;
    const float* mod = (const float*)(a.ws + WS_MOD); const float* g_pre = a.in[10]; const float* g_post = a.in[11] + (size_t)l * D;
    const bf16* Y = (const bf16*)(a.ws + WS_P); const float* ysq = (const float*)(a.ws + WS_YSQ);
    bf16* H = (bf16*)(a.ws + WS_HO);
    for (int row = gw; row < M; row += NGW) {
        float* orow = (row < MP) ? a.out + O_YP + (size_t)row * D : a.out + O_YS + (size_t)(row - MP) * D;
        const float* xr = (l == 0) ? ((row < MP) ? a.in[0] + (size_t)row * D : a.in[1] + (size_t)(row - MP) * D) : orow;
        const int j = (row < MP) ? (row >> 12) : (4 + ((row - MP) >> 4));
        const float* mr = mod + ((size_t)l * 20 + j) * 12288;
        const float rstd_y = rsqrtf(wave_sum(ysq[(size_t)row * 64 + lane]) * (1.f / D) + EPS);
        f32x4 v[16]; float s = 0.f;
#pragma unroll
        for (int q = 0; q < 16; ++q) { const int c = 4 * lane + 256 * q; const f32x4 x = *(const f32x4*)(xr + c); const u32x2 yw = *(const u32x2*)(Y + (size_t)row * D + c);
            const f32x4 y = (f32x4){bflo(yw.x), bfhi(yw.x), bflo(yw.y), bfhi(yw.y)}; const f32x4 gt = *(const f32x4*)(mr + 8192 + c), gp = *(const f32x4*)(g_post + c);
            v[q] = x + gt * (y * rstd_y * gp); s += (v[q][0] * v[q][0] + v[q][1] * v[q][1]) + (v[q][2] * v[q][2] + v[q][3] * v[q][3]);
            *(f32x4*)(orow + c) = v[q]; }
        if (l == 0) {
            const float rstd = rsqrtf(wave_sum(s) * (1.f / D) + EPS); const float* m1 = mod + ((size_t)20 + j) * 12288;
#pragma unroll
            for (int q = 0; q < 16; ++q) { const int c = 4 * lane + 256 * q; const f32x4 g = *(const f32x4*)(g_pre + D + c), sh = *(const f32x4*)(m1 + c), sc = *(const f32x4*)(m1 + 4096 + c);
                const f32x4 hv = v[q] * rstd * g * (sc + 1.0f) + sh; u32x2 w; w.x = cvtpk(hv[0], hv[1]); w.y = cvtpk(hv[2], hv[3]);
                *(u32x2*)(H + (size_t)row * D + c) = w; }
        }
    }
}


constexpr int L_KH = 0, L_QH = 18432, L_RT = 36864, L_XT = 77824, L_AI = 118784, L_DG = 129024, L_DI = 133120, L_GT = 135168;
constexpr int S128 = 144, S64 = 80;

__device__ __forceinline__ void phase_c1(const Args& a, int l, LAS unsigned char* lds, int G) {
    int tid, lane, wave, fr, fq;
#define RELANE() do { tid = tid_opaque(); lane = tid & 63; wave = __builtin_amdgcn_readfirstlane(tid >> 6); fr = lane & 15; fq = lane >> 4; } while (0)
    RELANE();
    const bf16* P = (const bf16*)(a.ws + WS_P);
    float* decbuf = (float*)(a.ws + WS_DEC);
    const float* conv_w = a.in[13] + (size_t)l * 4 * 6144;
    LAS bf16* KH = (LAS bf16*)(lds + L_KH); LAS bf16* QH = (LAS bf16*)(lds + L_QH); LAS bf16* RT = (LAS bf16*)(lds + L_RT); LAS bf16* XT = (LAS bf16*)(lds + L_XT);
    LAS bf16* AI = (LAS bf16*)(lds + L_AI); LAS float* DG = (LAS float*)(lds + L_DG); LAS bf16* DI = (LAS bf16*)(lds + L_DI);
    LAS float* g_beta = (LAS float*)(lds + L_GT); LAS float* g_gc = g_beta + 64; LAS float* g_egc = g_beta + 128; LAS float* g_misc = g_beta + 192;

    for (int item = blockIdx.x; item < NREC; item += G) {
        const bool sample = item >= 4096;
        int n, c, h, ntok; size_t rowbase;
        if (!sample) { h = item & 15; c = (item >> 4) & 63; n = item >> 10; rowbase = (size_t)n * 4096 + c * 64; ntok = 64; }
        else { const int s = item - 4096; h = s & 15; n = s >> 4; c = 0; rowbase = (size_t)MP + n * 16; ntok = 16; }
        unsigned char* rec = a.ws + WS_REC + (size_t)item * REC_BYTES;
        const bool last = sample || (c == 63);
        __syncthreads();
        RELANE();
        float val[8][8];
        float ssq[8];
        int g = 3, cgl, seg;
        if (tid < 384) {
            cgl = tid & 15; g = (tid >> 4) % 3; seg = tid / 48;
            const int ch0 = g * 2048 + h * 128 + cgl * 8;
            const int t0 = seg * 8;
            float w[4][8];
#pragma unroll
            for (int j = 0; j < 4; ++j) { const f32x4 w0 = *(const f32x4*)(conv_w + (size_t)j * 6144 + ch0), w1 = *(const f32x4*)(conv_w + (size_t)j * 6144 + ch0 + 4);
                w[j][0] = w0[0]; w[j][1] = w0[1]; w[j][2] = w0[2]; w[j][3] = w0[3]; w[j][4] = w1[0]; w[j][5] = w1[1]; w[j][6] = w1[2]; w[j][7] = w1[3]; }
            u32x4 raw[11];
#pragma unroll
            for (int i = 0; i < 11; ++i) { const int tt = t0 - 3 + i; raw[i] = (u32x4){0u, 0u, 0u, 0u};
                if (tt < ntok && (tt >= 0 || (!sample && c > 0))) raw[i] = *(const u32x4*)(P + (rowbase + tt) * NP + ch0); }
            float win[4][8];
#pragma unroll
            for (int i = 0; i < 3; ++i) unpack8(raw[i], win[i]);
            if (sample && seg == 0) {
                const float* sc = a.in[2] + (((size_t)l * 16 + n) * 3) * 6144 + ch0;
#pragma unroll
                for (int i = 0; i < 3; ++i) { const f32x4 s0 = *(const f32x4*)(sc + (size_t)i * 6144), s1 = *(const f32x4*)(sc + (size_t)i * 6144 + 4);
                    win[i][0] = s0[0]; win[i][1] = s0[1]; win[i][2] = s0[2]; win[i][3] = s0[3]; win[i][4] = s1[0]; win[i][5] = s1[1]; win[i][6] = s1[2]; win[i][7] = s1[3]; }
            }
#pragma unroll
            for (int tok = 0; tok < 8; ++tok) {
                unpack8(raw[3 + tok], win[3]);
                const bool tv = (t0 + tok) < ntok;
                float s = 0.f;
#pragma unroll
                for (int i = 0; i < 8; ++i) { const float y = w[0][i] * win[0][i] + w[1][i] * win[1][i] + w[2][i] * win[2][i] + w[3][i] * win[3][i]; const float v = tv ? silu_f(y) : 0.f; val[tok][i] = v; s += v * v; }
                ssq[tok] = s;
                if (last && tok >= 5 && seg == (sample ? 1 : 7)) {
                    float* co = sample ? a.out + O_CONVS + (((size_t)l * 16 + n) * 3 + (tok - 5)) * 6144 + ch0 : a.out + O_CONVP + (((size_t)l * 4 + n) * 3 + (tok - 5)) * 6144 + ch0;
                    *(f32x4*)co = (f32x4){win[3][0], win[3][1], win[3][2], win[3][3]}; *(f32x4*)(co + 4) = (f32x4){win[3][4], win[3][5], win[3][6], win[3][7]};
                }
#pragma unroll
                for (int i = 0; i < 8; ++i) { win[0][i] = win[1][i]; win[1][i] = win[2][i]; win[2][i] = win[3][i]; }
            }
#pragma unroll
            for (int tok = 0; tok < 8; ++tok) { float s = ssq[tok]; s += __shfl_xor(s, 1); s += __shfl_xor(s, 2); s += __shfl_xor(s, 4); s += __shfl_xor(s, 8); ssq[tok] = s; }
        } else {
            const int tz = tid - 384; cgl = tz & 15; seg = tz >> 4;
            const int t0 = seg * 8, e0 = cgl * 8;
            const float* dn = a.in[16] + (size_t)l * 128 + e0;
            float dnw[8];
            { const f32x4 d0 = *(const f32x4*)dn, d1 = *(const f32x4*)(dn + 4); dnw[0] = d0[0]; dnw[1] = d0[1]; dnw[2] = d0[2]; dnw[3] = d0[3]; dnw[4] = d1[0]; dnw[5] = d1[1]; dnw[6] = d1[2]; dnw[7] = d1[3]; }
#pragma unroll
            for (int tok = 0; tok < 8; ++tok) { float z[8];
                u32x4 rw = (u32x4){0u, 0u, 0u, 0u}; if (t0 + tok < ntok) rw = *(const u32x4*)(P + (rowbase + t0 + tok) * NP + C_ZDN + h * 128 + e0);
                unpack8(rw, z);
#pragma unroll
                for (int i = 0; i < 8; ++i) val[tok][i] = silu_f(z[i]) * dnw[i]; }
            if (wave == 6) {
                float beta = 0.f, gg = 0.f;
                if (lane < ntok) { const float b = bf1(P[(rowbase + lane) * NP + C_B + h]), av = bf1(P[(rowbase + lane) * NP + C_A + h]);
                    beta = sigmoid_f(b); const float xx = av + a.in[15][l * 16 + h]; const float sp = fmaxf(xx, 0.f) + log1pf(__expf(-fabsf(xx)));
                    gg = -__expf(a.in[14][l * 16 + h]) * sp; }
                float gc = gg;
#pragma unroll
                for (int o = 1; o < 64; o <<= 1) { const float t = __shfl_up(gc, o); if (lane >= o) gc += t; }
                g_beta[lane] = beta; g_gc[lane] = gc; g_egc[lane] = __expf(gc);
                const float gcl = __shfl(gc, 63);
                if (lane == 0) { g_misc[0] = gcl; decbuf[item] = __expf(gcl); }
            }
        }
        __syncthreads();
        {
            { const int t1 = tid_opaque(); cgl = (t1 < 384) ? (t1 & 15) : ((t1 - 384) & 15); seg = (t1 < 384) ? (t1 / 48) : ((t1 - 384) >> 4); }
            const int t0 = seg * 8;
            float bt[8], gcv[8], eg[8];
            { const f32x4 b0 = *(const LAS f32x4*)(g_beta + t0), b1 = *(const LAS f32x4*)(g_beta + t0 + 4), c0 = *(const LAS f32x4*)(g_gc + t0), c1 = *(const LAS f32x4*)(g_gc + t0 + 4),
                  e0 = *(const LAS f32x4*)(g_egc + t0), e1 = *(const LAS f32x4*)(g_egc + t0 + 4);
#pragma unroll
              for (int i = 0; i < 4; ++i) { bt[i] = b0[i]; bt[4 + i] = b1[i]; gcv[i] = c0[i]; gcv[4 + i] = c1[i]; eg[i] = e0[i]; eg[4 + i] = e1[i]; } }
            const float gcl = g_misc[0];
            const int qs0 = ((cgl * 8) & 15) >> 2, half0 = ((cgl * 8) >> 4) & 1, ks0 = (cgl * 8) >> 5;
            const int tq0 = (t0 & 15) >> 2, thalf = (t0 >> 4) & 1, tks = t0 >> 5;
            if (g == 0) {
#pragma unroll
                for (int tok = 0; tok < 8; ++tok) { const int t = t0 + tok; const float r = rsqrtf(ssq[tok] + EPS) * 0.08838834764831845f; float qv[8];
#pragma unroll
                    for (int i = 0; i < 8; ++i) qv[i] = val[tok][i] * r;
                    *(LAS u32x4*)(QH + t * S128 + cgl * 8) = pack8(qv);
                    const float e = eg[tok];
                    unsigned char* fp = rec + REC_QD + (size_t)((((t >> 4) * 4 + ks0) * 64 + (t & 15) + 16 * qs0) * 16 + 8 * half0);
                    u32x2 w0, w1; w0.x = cvtpk(qv[0] * e, qv[1] * e); w0.y = cvtpk(qv[2] * e, qv[3] * e); w1.x = cvtpk(qv[4] * e, qv[5] * e); w1.y = cvtpk(qv[6] * e, qv[7] * e);
                    *(u32x2*)fp = w0; *(u32x2*)(fp + 256) = w1; }
            } else if (g == 1) {
                float kv[8][8];
#pragma unroll
                for (int tok = 0; tok < 8; ++tok) { const float r = rsqrtf(ssq[tok] + EPS);
#pragma unroll
                    for (int i = 0; i < 8; ++i) kv[tok][i] = val[tok][i] * r;
                    *(LAS u32x4*)(KH + (t0 + tok) * S128 + cgl * 8) = pack8(kv[tok]); }
#pragma unroll
                for (int i = 0; i < 8; ++i) { const int d = cgl * 8 + i; float rr[8], kd[8];
#pragma unroll
                    for (int tok = 0; tok < 8; ++tok) { rr[tok] = kv[tok][i] * bt[tok] * eg[tok]; kd[tok] = kv[tok][i] * __expf(gcl - gcv[tok]); }
                    *(LAS u32x4*)(RT + (128 + d) * S64 + t0) = pack8(rr);
                    unsigned char* fp = rec + REC_KD + (size_t)((((d >> 4) * 2 + tks) * 64 + (d & 15) + 16 * tq0) * 16 + 8 * thalf);
                    u32x2 w0, w1; w0.x = cvtpk(kd[0], kd[1]); w0.y = cvtpk(kd[2], kd[3]); w1.x = cvtpk(kd[4], kd[5]); w1.y = cvtpk(kd[6], kd[7]);
                    *(u32x2*)fp = w0; *(u32x2*)(fp + 256) = w1; }
            } else if (g == 2) {
#pragma unroll
                for (int i = 0; i < 8; ++i) { const int e = cgl * 8 + i; float rr[8];
#pragma unroll
                    for (int tok = 0; tok < 8; ++tok) rr[tok] = val[tok][i] * bt[tok];
                    *(LAS u32x4*)(RT + e * S64 + t0) = pack8(rr); }
            } else {
#pragma unroll
                for (int i = 0; i < 8; ++i) { const int e = cgl * 8 + i;
                    unsigned char* fp = rec + REC_G + (size_t)((((e >> 4) * 4 + (t0 >> 4)) * 64 + (e & 15) + 16 * tq0) * 8);
                    u32x2 w0, w1; w0.x = cvtpk(val[0][i], val[1][i]); w0.y = cvtpk(val[2][i], val[3][i]); w1.x = cvtpk(val[4][i], val[5][i]); w1.y = cvtpk(val[6][i], val[7][i]);
                    *(u32x2*)fp = w0; *(u32x2*)(fp + 128) = w1; }
            }
        }
        __syncthreads();
#if defined(DBG_C1_STOP) && DBG_C1_STOP <= 1
        continue;
#endif
        RELANE();
#pragma unroll
        for (int k2 = 0; k2 < 2; ++k2) {
            const int tile = wave * 2 + k2, ti = tile >> 2, tj = tile & 3;
            f32x4 acq = (f32x4){0.f, 0.f, 0.f, 0.f}, ack = (f32x4){0.f, 0.f, 0.f, 0.f};
#pragma unroll
            for (int ks = 0; ks < 4; ++ks) {
                const bf16x8 kj = *(const LAS bf16x8*)(KH + (16 * tj + fr) * S128 + 32 * ks + 8 * fq);
                const bf16x8 qi = *(const LAS bf16x8*)(QH + (16 * ti + fr) * S128 + 32 * ks + 8 * fq);
                acq = __builtin_amdgcn_mfma_f32_16x16x32_bf16(kj, qi, acq, 0, 0, 0);
                if (ti >= tj) { const bf16x8 ki = *(const LAS bf16x8*)(KH + (16 * ti + fr) * S128 + 32 * ks + 8 * fq);
                    ack = __builtin_amdgcn_mfma_f32_16x16x32_bf16(ki, kj, ack, 0, 0, 0); }
            }
            {
                const int i = 16 * ti + fr; const float gi = g_gc[i]; const f32x4 gj = *(const LAS f32x4*)(g_gc + 16 * tj + 4 * fq); float o[4];
#pragma unroll
                for (int r = 0; r < 4; ++r) { const int j = 16 * tj + 4 * fq + r; o[r] = (i >= j) ? acq[r] * __expf(fminf(gi - gj[r], 0.f)) : 0.f; }
                u32x2 w; w.x = cvtpk(o[0], o[1]); w.y = cvtpk(o[2], o[3]);
                *(u32x2*)(rec + REC_QK + (size_t)(((ti * 2 + (tj >> 1)) * 64 + lane) * 16 + 8 * (tj & 1))) = w;
            }
            if (ti >= tj) {
                const int j = 16 * tj + fr; const float gj = g_gc[j]; const f32x4 gi = *(const LAS f32x4*)(g_gc + 16 * ti + 4 * fq), bi = *(const LAS f32x4*)(g_beta + 16 * ti + 4 * fq);
#pragma unroll
                for (int r = 0; r < 4; ++r) { const int i = 16 * ti + 4 * fq + r; const float v = (i > j) ? bi[r] * ack[r] * __expf(fminf(gi[r] - gj, 0.f)) : 0.f;
                    AI[i * S64 + j] = (bf16)(cvtpk(v, 0.f) & 0xffffu);
                    if (ti == tj) DG[(ti * 16 + (i & 15)) * 16 + fr] = v; }
            }
        }
        __syncthreads();
#if defined(DBG_C1_STOP) && DBG_C1_STOP <= 2
        continue;
#endif
        RELANE();
        if (wave == 0) {
            const int b = fq, cc = fr; float x[16];
#pragma unroll
            for (int r = 0; r < 16; ++r) { float s = (r == cc) ? 1.f : 0.f;
                const LAS float* drow = DG + (b * 16 + r) * 16;
#pragma unroll
                for (int j = 0; j < r; ++j) s -= drow[j] * x[j];
                x[r] = s; DI[(b * 16 + r) * 16 + cc] = (bf16)(cvtpk(s, 0.f) & 0xffffu); }
        }
        __syncthreads();
#if defined(DBG_C1_STOP) && DBG_C1_STOP <= 3
        continue;
#endif
#pragma unroll
        for (int b = 0; b < 4; ++b) {
            RELANE();
#pragma unroll
            for (int k2 = 0; k2 < 2; ++k2) {
                const int nt = wave * 2 + k2;
                f32x4 y = (f32x4){0.f, 0.f, 0.f, 0.f};
#pragma unroll
                for (int ks = 0; ks < (b + 1) / 2; ++ks) {
                    const bool ok = (32 * ks + 8 * fq) < 16 * b;
                    u32x4 av = *(const LAS u32x4*)(AI + (16 * b + fr) * S64 + 32 * ks + 8 * fq), xv = *(const LAS u32x4*)(XT + (16 * nt + fr) * S64 + 32 * ks + 8 * fq);
                    if (!ok) { av = (u32x4){0u, 0u, 0u, 0u}; xv = (u32x4){0u, 0u, 0u, 0u}; }
                    y = __builtin_amdgcn_mfma_f32_16x16x32_bf16(as_bf16x8(av), as_bf16x8(xv), y, 0, 0, 0);
                }
                const u32x2 rv = *(const LAS u32x2*)(RT + (16 * nt + fr) * S64 + 16 * b + 4 * fq);
                const float z0 = bflo(rv.x) - y[0], z1 = bfhi(rv.x) - y[1], z2 = bflo(rv.y) - y[2], z3 = bfhi(rv.y) - y[3];
                u32x2 zb; zb.x = cvtpk(z0, z1); zb.y = cvtpk(z2, z3);
                const u32x2 dv = *(const LAS u32x2*)(DI + (b * 16 + fr) * 16 + 4 * fq);
                const f32x4 xo = __builtin_amdgcn_mfma_f32_16x16x16bf16_1k(as_bf16x4(dv), as_bf16x4(zb), (f32x4){0.f, 0.f, 0.f, 0.f}, 0, 0, 0);
                u32x2 xw; xw.x = cvtpk(xo[0], xo[1]); xw.y = cvtpk(xo[2], xo[3]);
                *(LAS u32x2*)(XT + (16 * nt + fr) * S64 + 16 * b + 4 * fq) = xw;
                if (nt < 8) *(u32x2*)(rec + REC_U + (size_t)(((nt * 4 + b) * 64 + lane) * 8)) = xw;
            }
            __syncthreads();
        }
#if defined(DBG_C1_STOP) && DBG_C1_STOP <= 4
        continue;
#endif
        RELANE();
#pragma unroll
        for (int k2 = 0; k2 < 2; ++k2) {
            const int u = tid + 512 * k2, frag = u >> 6, tt = frag >> 2, ks = frag & 3;
            float wv[8];
#pragma unroll
            for (int j = 0; j < 8; ++j) wv[j] = bf1(XT[(128 + 32 * ks + 16 * (j >> 2) + 4 * fq + (j & 3)) * S64 + 16 * tt + fr]);
            *(u32x4*)(rec + REC_W + (size_t)((frag * 64 + lane) * 16)) = pack8(wv);
        }
    }
#undef RELANE
}


constexpr int L_SS = 2 * REC_STAGE, L_RS = L_SS + 2048, L_OB = L_RS + 256, OBS = 136;
__device__ __forceinline__ void scan_seq(const Args& a, int l, LAS unsigned char* lds, int seq) {
    const int tid = tid_opaque(), lane = tid & 63, wave = __builtin_amdgcn_readfirstlane(tid >> 6);
    const int fr = lane & 15, fq = lane >> 4;
    const bool sample = seq >= 64;
    const int s2 = sample ? seq - 64 : seq, n = s2 >> 4, h = s2 & 15;
    const int nsteps = sample ? 1 : 64, ntok = sample ? 16 : 64;
    const int rec0 = sample ? 4096 + s2 : (n * 64) * 16 + h;
    const size_t rowbase0 = sample ? (size_t)MP + n * 16 : (size_t)n * 4096;
    const unsigned char* recs = a.ws + WS_REC;
    const float* decbuf = (const float*)(a.ws + WS_DEC);
    bf16* Ob = (bf16*)(a.ws + WS_HO);
    LAS float* ss = (LAS float*)(lds + L_SS); LAS float* rs = (LAS float*)(lds + L_RS); LAS bf16* ob = (LAS bf16*)(lds + L_OB);
    f32x4 st[8];
    if (sample) { const float* s0 = a.in[3] + (((size_t)l * 16 + n) * 16 + h) * 16384;
#pragma unroll
        for (int t = 0; t < 8; ++t)
#pragma unroll
            for (int j = 0; j < 4; ++j) st[t][j] = s0[(16 * t + 4 * fq + j) * 128 + 16 * wave + fr];
    } else {
#pragma unroll
        for (int t = 0; t < 8; ++t) st[t] = (f32x4){0.f, 0.f, 0.f, 0.f};
    }
    __syncthreads();
    {   const unsigned char* src = recs + (size_t)rec0 * REC_BYTES;
#pragma unroll
        for (int k = 0; k < 7; ++k) { const int p = wave * 7 + k;
            __builtin_amdgcn_global_load_lds((const unsigned*)(src + p * 1024 + lane * 16), (LAS unsigned*)(lds + p * 1024), 16, 0, 0); } }
    u32x2 u_cur[4], g_cur[4], u_nxt[4], g_nxt[4], g_prev[4]; float dec_cur, dec_nxt = 0.f; f32x4 o_prev[4];
    {   const unsigned char* rec = recs + (size_t)rec0 * REC_BYTES;
#pragma unroll
        for (int t = 0; t < 4; ++t) { u_cur[t] = *(const u32x2*)(rec + REC_U + ((wave * 4 + t) * 64 + lane) * 8); g_cur[t] = *(const u32x2*)(rec + REC_G + ((wave * 4 + t) * 64 + lane) * 8);
            u_nxt[t] = u_cur[t]; g_nxt[t] = g_cur[t]; g_prev[t] = g_cur[t]; o_prev[t] = (f32x4){0.f, 0.f, 0.f, 0.f}; }
        dec_cur = decbuf[rec0]; }
#define SCAN_STORE(cc) do {   \
        _Pragma("unroll") for (int t = 0; t < 4; ++t) { const f32x4 r4 = *(const LAS f32x4*)(rs + 16 * t + 4 * fq); \
            const f32x4 gv = (f32x4){bflo(g_prev[t].x), bfhi(g_prev[t].x), bflo(g_prev[t].y), bfhi(g_prev[t].y)}; \
            _Pragma("unroll") for (int j = 0; j < 4; ++j) ob[(16 * t + 4 * fq + j) * OBS + 16 * wave + fr] = (bf16)(cvtpk(o_prev[t][j] * r4[j] * gv[j], 0.f) & 0xffffu); } } while (0)
#define SCAN_FLUSH(cc) do {   \
        const int tok_ = tid >> 3, pc_ = tid & 7; \
        if (tok_ < ntok) { bf16* op_ = Ob + (rowbase0 + (size_t)(cc) * 64 + tok_) * D + h * 128 + pc_ * 8; \
            *(u32x4*)op_ = *(const LAS u32x4*)(ob + tok_ * OBS + pc_ * 8); *(u32x4*)(op_ + 64) = *(const LAS u32x4*)(ob + tok_ * OBS + 64 + pc_ * 8); } } while (0)
#define SCAN_RS() do { if (tid < 64) { float tsum = 0.f; \
            _Pragma("unroll") for (int w8 = 0; w8 < 8; ++w8) tsum += ss[w8 * 64 + tid]; \
            rs[tid] = rsqrtf(tsum * (1.f / 128.f) + EPS); } } while (0)
    for (int c = 0; c < nsteps; ++c) {
        const LAS unsigned char* buf = lds + (c & 1) * REC_STAGE;
        const unsigned char* rec = recs + (size_t)(rec0 + 16 * c) * REC_BYTES;
        VM_WAIT(); __syncthreads();
        if (c + 1 < nsteps) { const unsigned char* src = rec + 16 * REC_BYTES; LAS unsigned char* dst = lds + ((c + 1) & 1) * REC_STAGE;
#pragma unroll
            for (int k = 0; k < 7; ++k) { const int p = wave * 7 + k;
                __builtin_amdgcn_global_load_lds((const unsigned*)(src + p * 1024 + lane * 16), (LAS unsigned*)(dst + p * 1024), 16, 0, 0); }
#pragma unroll
            for (int t = 0; t < 4; ++t) { u_nxt[t] = *(const u32x2*)(src + REC_U + ((wave * 4 + t) * 64 + lane) * 8); g_nxt[t] = *(const u32x2*)(src + REC_G + ((wave * 4 + t) * 64 + lane) * 8); }
            dec_nxt = decbuf[rec0 + 16 * (c + 1)]; }
        if (c > 0) SCAN_RS();
        if (c > 1) SCAN_FLUSH(c - 2);
        bf16x8 Bs[4];
#pragma unroll
        for (int ks = 0; ks < 4; ++ks) { u32x4 w; w.x = cvtpk(st[2 * ks][0], st[2 * ks][1]); w.y = cvtpk(st[2 * ks][2], st[2 * ks][3]); w.z = cvtpk(st[2 * ks + 1][0], st[2 * ks + 1][1]); w.w = cvtpk(st[2 * ks + 1][2], st[2 * ks + 1][3]); Bs[ks] = as_bf16x8(w); }
        f32x4 ws4[4], oacc[4];
#pragma unroll
        for (int t = 0; t < 4; ++t) { ws4[t] = (f32x4){0.f, 0.f, 0.f, 0.f}; oacc[t] = (f32x4){0.f, 0.f, 0.f, 0.f}; }
#pragma unroll
        for (int t = 0; t < 4; ++t)
#pragma unroll
            for (int ks = 0; ks < 4; ++ks) { const bf16x8 af = *(const LAS bf16x8*)(buf + REC_W + ((t * 4 + ks) * 64 + lane) * 16); ws4[t] = __builtin_amdgcn_mfma_f32_16x16x32_bf16(af, Bs[ks], ws4[t], 0, 0, 0); }
#pragma unroll
        for (int t = 0; t < 4; ++t)
#pragma unroll
            for (int ks = 0; ks < 4; ++ks) { const bf16x8 af = *(const LAS bf16x8*)(buf + REC_QD + ((t * 4 + ks) * 64 + lane) * 16); oacc[t] = __builtin_amdgcn_mfma_f32_16x16x32_bf16(af, Bs[ks], oacc[t], 0, 0, 0); }
        bf16x8 Bv[2];
        {   f32x4 vn[4];
#pragma unroll
            for (int t = 0; t < 4; ++t) vn[t] = (f32x4){bflo(u_cur[t].x), bfhi(u_cur[t].x), bflo(u_cur[t].y), bfhi(u_cur[t].y)} - ws4[t];
#pragma unroll
            for (int k2 = 0; k2 < 2; ++k2) { u32x4 w; w.x = cvtpk(vn[2 * k2][0], vn[2 * k2][1]); w.y = cvtpk(vn[2 * k2][2], vn[2 * k2][3]); w.z = cvtpk(vn[2 * k2 + 1][0], vn[2 * k2 + 1][1]); w.w = cvtpk(vn[2 * k2 + 1][2], vn[2 * k2 + 1][3]); Bv[k2] = as_bf16x8(w); } }
#pragma unroll
        for (int t = 0; t < 4; ++t)
#pragma unroll
            for (int k2 = 0; k2 < 2; ++k2) { const bf16x8 af = *(const LAS bf16x8*)(buf + REC_QK + ((t * 2 + k2) * 64 + lane) * 16); oacc[t] = __builtin_amdgcn_mfma_f32_16x16x32_bf16(af, Bv[k2], oacc[t], 0, 0, 0); }
#pragma unroll
        for (int t = 0; t < 8; ++t) { st[t] = st[t] * dec_cur;
#pragma unroll
            for (int k2 = 0; k2 < 2; ++k2) { const bf16x8 af = *(const LAS bf16x8*)(buf + REC_KD + ((t * 2 + k2) * 64 + lane) * 16); st[t] = __builtin_amdgcn_mfma_f32_16x16x32_bf16(af, Bv[k2], st[t], 0, 0, 0); } }
        __syncthreads();
        if (c > 0) SCAN_STORE(c - 1);
#pragma unroll
        for (int t = 0; t < 4; ++t) { f32x4 q = oacc[t] * oacc[t];
#pragma unroll
            for (int j = 0; j < 4; ++j) { float v = q[j]; v += __shfl_xor(v, 1); v += __shfl_xor(v, 2); v += __shfl_xor(v, 4); v += __shfl_xor(v, 8); q[j] = v; }
            if (fr == 0) *(LAS f32x4*)(ss + wave * 64 + 16 * t + 4 * fq) = q; }
#pragma unroll
        for (int t = 0; t < 4; ++t) { o_prev[t] = oacc[t]; g_prev[t] = g_cur[t]; u_cur[t] = u_nxt[t]; g_cur[t] = g_nxt[t]; }
        dec_cur = dec_nxt;
    }
    __syncthreads();
    SCAN_RS();
    if (nsteps > 1) SCAN_FLUSH(nsteps - 2);
    __syncthreads();
    SCAN_STORE(nsteps - 1);
    __syncthreads();
    SCAN_FLUSH(nsteps - 1);
#undef SCAN_FLUSH
#undef SCAN_STORE
#undef SCAN_RS
    {   float* so = sample ? a.out + O_DNS + (((size_t)l * 16 + n) * 16 + h) * 16384 : a.out + O_DNP + (((size_t)l * 4 + n) * 16 + h) * 16384;
#pragma unroll
        for (int t = 0; t < 8; ++t)
#pragma unroll
            for (int j = 0; j < 4; ++j) so[(16 * t + 4 * fq + j) * 128 + 16 * wave + fr] = st[t][j]; }
}

constexpr int L_KI = 0, L_VT = 30720, SKI = 80, SVT = 200;
__device__ __forceinline__ void attn_prompt_item(const Args& a, int l, LAS unsigned char* lds, int it) {
    const int tid = tid_opaque(), lane = tid & 63, wave = __builtin_amdgcn_readfirstlane(tid >> 6);
    const int fr = lane & 15, fq = lane >> 4;
    const int kv = it & 3, c = (it >> 2) & 63, n = it >> 8;
    const bf16* P = (const bf16*)(a.ws + WS_P); const f32x2* rope = (const f32x2*)(a.ws + WS_ROPE);
    bf16* Ob = (bf16*)(a.ws + WS_HO);
    LAS bf16* KI = (LAS bf16*)(lds + L_KI); LAS bf16* VT = (LAS bf16*)(lds + L_VT);
    const int kt0 = (c >= 2) ? 0 : (8 - 4 * c);
    __syncthreads();
#pragma unroll
    for (int k2 = 0; k2 < 2; ++k2) { const int u = tid + 512 * k2; if (u < 768) { const int key = u >> 2, dg = u & 3, tok = (c - 2) * 64 + key;
        if (tok >= 0) { const bf16* kp = P + ((size_t)n * 4096 + tok) * NP + C_AK + kv * 64 + dg * 8; float x1[8], x2[8], o1[8], o2[8];
            unpack8(*(const u32x4*)kp, x1); unpack8(*(const u32x4*)(kp + 32), x2);
#pragma unroll
            for (int j = 0; j < 8; ++j) { const f32x2 cs = rope[tok * 32 + dg * 8 + j]; o1[j] = x1[j] * cs.x - x2[j] * cs.y; o2[j] = x2[j] * cs.x + x1[j] * cs.y; }
            *(LAS u32x4*)(KI + key * SKI + dg * 8) = pack8(o1); *(LAS u32x4*)(KI + key * SKI + 32 + dg * 8) = pack8(o2);
            if (c == 63 && key >= 64) { float* ko = a.out + O_KP + ((((size_t)l * 4 + n) * 128 + (key - 64)) * 4 + kv) * 64 + dg * 8;
                *(f32x4*)ko = (f32x4){o1[0], o1[1], o1[2], o1[3]}; *(f32x4*)(ko + 4) = (f32x4){o1[4], o1[5], o1[6], o1[7]};
                *(f32x4*)(ko + 32) = (f32x4){o2[0], o2[1], o2[2], o2[3]}; *(f32x4*)(ko + 36) = (f32x4){o2[4], o2[5], o2[6], o2[7]}; } } } }
#pragma unroll
    for (int k3 = 0; k3 < 3; ++k3) { const int u = tid + 512 * k3, key = u >> 3, dg = u & 7, tok = (c - 2) * 64 + key;
        if (tok >= 0) { const u32x4 vw = *(const u32x4*)(P + ((size_t)n * 4096 + tok) * NP + C_AV + kv * 64 + dg * 8);
            const unsigned ww[4] = {vw.x, vw.y, vw.z, vw.w};
#pragma unroll
            for (int j = 0; j < 8; ++j) VT[(dg * 8 + j) * SVT + key] = (bf16)((j & 1) ? (ww[j >> 1] >> 16) : (ww[j >> 1] & 0xffffu));
            if (c == 63 && key >= 64) { float vf[8]; unpack8(vw, vf); float* vo = a.out + O_VP + ((((size_t)l * 4 + n) * 128 + (key - 64)) * 4 + kv) * 64 + dg * 8;
                *(f32x4*)vo = (f32x4){vf[0], vf[1], vf[2], vf[3]}; *(f32x4*)(vo + 4) = (f32x4){vf[4], vf[5], vf[6], vf[7]}; } } }
    __syncthreads();
    const int hq = kv * 8 + wave;
    const float sink = a.in[17][l * 32 + hq];
    for (int qt = 0; qt < 4; ++qt) {
        const int tq = c * 64 + 16 * qt + fr; const size_t row = (size_t)n * 4096 + tq;
        bf16x8 Qf[2];
        {   const bf16* qp = P + row * NP + C_AQ + hq * 64 + 8 * fq; float x1[8], x2[8], o1[8], o2[8];
            unpack8(*(const u32x4*)qp, x1); unpack8(*(const u32x4*)(qp + 32), x2);
#pragma unroll
            for (int j = 0; j < 8; ++j) { const f32x2 cs = rope[tq * 32 + 8 * fq + j]; o1[j] = (x1[j] * cs.x - x2[j] * cs.y) * 0.125f; o2[j] = (x2[j] * cs.x + x1[j] * cs.y) * 0.125f; }
            Qf[0] = as_bf16x8(pack8(o1)); Qf[1] = as_bf16x8(pack8(o2)); }
        f32x4 s[12]; float m = sink;
#pragma unroll
        for (int kt = 0; kt < 12; ++kt) { s[kt] = (f32x4){0.f, 0.f, 0.f, 0.f};
            if (kt >= kt0) {
#pragma unroll
                for (int ks = 0; ks < 2; ++ks) { const bf16x8 kf = *(const LAS bf16x8*)(KI + (16 * kt + fr) * SKI + 32 * ks + 8 * fq); s[kt] = __builtin_amdgcn_mfma_f32_16x16x32_bf16(kf, Qf[ks], s[kt], 0, 0, 0); }
                m = fmaxf(m, fmaxf(fmaxf(s[kt][0], s[kt][1]), fmaxf(s[kt][2], s[kt][3]))); } }
        m = fmaxf(m, __shfl_xor(m, 16)); m = fmaxf(m, __shfl_xor(m, 32));
        float sum = 0.f; f32x4 oc[4];
#pragma unroll
        for (int dt = 0; dt < 4; ++dt) oc[dt] = (f32x4){0.f, 0.f, 0.f, 0.f};
#pragma unroll
        for (int kt = 0; kt < 12; ++kt) { if (kt >= kt0) {
            const float p0 = __expf(s[kt][0] - m), p1 = __expf(s[kt][1] - m), p2 = __expf(s[kt][2] - m), p3 = __expf(s[kt][3] - m); sum += (p0 + p1) + (p2 + p3);
            u32x2 pw; pw.x = cvtpk(p0, p1); pw.y = cvtpk(p2, p3);
#pragma unroll
            for (int dt = 0; dt < 4; ++dt) { const u32x2 vf = *(const LAS u32x2*)(VT + (16 * dt + fr) * SVT + 16 * kt + 4 * fq);
                oc[dt] = __builtin_amdgcn_mfma_f32_16x16x16bf16_1k(as_bf16x4(vf), as_bf16x4(pw), oc[dt], 0, 0, 0); } } }
        sum += __shfl_xor(sum, 16); sum += __shfl_xor(sum, 32);
        const float inv = 1.0f / (sum + __expf(sink - m));
#pragma unroll
        for (int dt = 0; dt < 4; ++dt) { const int d0 = 16 * dt + 4 * fq; const u32x2 zw = *(const u32x2*)(P + row * NP + C_AZ + hq * 64 + d0);
            const float o0 = oc[dt][0] * inv * silu_f(bflo(zw.x)), o1 = oc[dt][1] * inv * silu_f(bfhi(zw.x)), o2 = oc[dt][2] * inv * silu_f(bflo(zw.y)), o3 = oc[dt][3] * inv * silu_f(bfhi(zw.y));
            u32x2 ow; ow.x = cvtpk(o0, o1); ow.y = cvtpk(o2, o3);
            *(u32x2*)(Ob + row * D + 2048 + hq * 64 + d0) = ow; }
    }
}

constexpr int L_KF = 0, L_VF = 37440, L_QS = 74304;
__device__ __forceinline__ void attn_sample_item(const Args& a, int l, LAS unsigned char* lds, int it) {
    const int tid = tid_opaque(), lane = tid & 63, wave = __builtin_amdgcn_readfirstlane(tid >> 6);
    const int n = it >> 2, kv = it & 3;
    const bf16* P = (const bf16*)(a.ws + WS_P); const f32x2* rope = (const f32x2*)(a.ws + WS_ROPE);
    bf16* Ob = (bf16*)(a.ws + WS_HO);
    LAS float* Kf = (LAS float*)(lds + L_KF); LAS float* Vf = (LAS float*)(lds + L_VF);
    LAS float* qs = (LAS float*)(lds + L_QS) + wave * 208; LAS float* ps = qs + 64;
    const float* ck = a.in[4] + ((size_t)l * 16 + n) * 128 * 256 + kv * 64; const float* cv = a.in[5] + ((size_t)l * 16 + n) * 128 * 256 + kv * 64;
    __syncthreads();
    for (int i = 0; i < 16; ++i) { const int idx = tid + 512 * i, key = idx >> 6, d = idx & 63; Kf[key * 65 + d] = ck[(size_t)key * 256 + d]; Vf[key * 64 + d] = cv[(size_t)key * 256 + d]; }
    {   const int t = tid >> 5, d = tid & 31; const bf16* kp = P + ((size_t)MP + n * 16 + t) * NP + C_AK + kv * 64;
        const float x1 = bf1(kp[d]), x2 = bf1(kp[d + 32]); const f32x2 cs = rope[(PAST + t) * 32 + d];
        Kf[(128 + t) * 65 + d] = x1 * cs.x - x2 * cs.y; Kf[(128 + t) * 65 + d + 32] = x2 * cs.x + x1 * cs.y; }
    for (int i = 0; i < 2; ++i) { const int idx = tid + 512 * i, t = idx >> 6, d = idx & 63; Vf[(128 + t) * 64 + d] = bf1(P[((size_t)MP + n * 16 + t) * NP + C_AV + kv * 64 + d]); }
    __syncthreads();
    for (int i = 0; i < 16; ++i) { const int idx = tid + 512 * i, r = idx >> 6, d = idx & 63; const size_t o = ((((size_t)l * 16 + n) * 128 + r) * 4 + kv) * 64 + d;
        a.out[O_KS + o] = Kf[(16 + r) * 65 + d]; a.out[O_VS + o] = Vf[(16 + r) * 64 + d]; }
    const int hq = kv * 8 + wave; const float sink = a.in[17][l * 32 + hq];
    for (int t = 0; t < 16; ++t) {
        const size_t row = (size_t)MP + n * 16 + t;
        if (lane < 32) { const bf16* qp = P + row * NP + C_AQ + hq * 64; const float x1 = bf1(qp[lane]), x2 = bf1(qp[lane + 32]); const f32x2 cs = rope[(PAST + t) * 32 + lane];
            qs[lane] = (x1 * cs.x - x2 * cs.y) * 0.125f; qs[lane + 32] = (x2 * cs.x + x1 * cs.y) * 0.125f; }
        LDS_WAIT(); asm volatile("" ::: "memory");
        float sc[3];
#pragma unroll
        for (int k = 0; k < 3; ++k) { const int key = lane + 64 * k; float s = 0.f;
            if (key < 144) { for (int d = 0; d < 64; ++d) s += qs[d] * Kf[key * 65 + d]; } else s = -INFINITY;
            sc[k] = s; }
        const float m = fmaxf(sink, wave_max(fmaxf(fmaxf(sc[0], sc[1]), sc[2])));
        float psum = 0.f;
#pragma unroll
        for (int k = 0; k < 3; ++k) { const int key = lane + 64 * k; const float p = (key < 144) ? __expf(sc[k] - m) : 0.f; psum += p; if (key < 144) ps[key] = p; }
        const float inv = 1.0f / (wave_sum(psum) + __expf(sink - m));
        LDS_WAIT(); asm volatile("" ::: "memory");
        float o = 0.f;
        for (int key = 0; key < 144; ++key) o += ps[key] * Vf[key * 64 + lane];
        const float z = bf1(P[row * NP + C_AZ + hq * 64 + lane]);
        Ob[row * D + 2048 + hq * 64 + lane] = (bf16)(cvtpk(o * inv * silu_f(z), 0.f) & 0xffffu);
        LDS_WAIT(); asm volatile("" ::: "memory");
    }
}

__device__ __forceinline__ void phase_c2(const Args& a, int l, LAS unsigned char* lds, int G) {
    const int b = blockIdx.x;
    for (int k = 0;; ++k) {
        int seq = -1, att = -1, sat = -1;
        if (b < 64) { if (k > 0) break; seq = b; }
        else { const int it = (b - 64) + k * (G - 64); if (it >= 1344) break; if (it < 1024) att = it; else if (it < 1280) seq = 64 + (it - 1024); else sat = it - 1280; }
#ifndef DBG_REPEAT
#define DBG_REPEAT 0
#endif
        if (seq >= 0) { for (int r_ = 0; r_ < ((((DBG_REPEAT) >> 7) & 1) && seq < 64 ? 2 : 1); ++r_) scan_seq(a, l, lds, seq); }
        else if (att >= 0) { for (int r_ = 0; r_ < ((((DBG_REPEAT) >> 8) & 1) ? 2 : 1); ++r_) attn_prompt_item(a, l, lds, att); }
        else attn_sample_item(a, l, lds, sat);
    }
}


constexpr int N_PHASES = 12;
__device__ __forceinline__ Args load_args(const __attribute__((address_space(4))) Args* p) {
    Args a;
#pragma unroll
    for (int i = 0; i < 19; ++i) a.in[i] = (const float*)(const GAS float*)p->in[i];
    a.out = (float*)(GAS float*)p->out; a.ws = (unsigned char*)(GAS unsigned char*)p->ws; a.ph_lo = p->ph_lo; a.ph_hi = p->ph_hi; return a;
}
__global__ void __launch_bounds__(512, 2) fwd(Args args) {
    extern __shared__ __attribute__((aligned(16))) unsigned char lds_raw[];
    LAS unsigned char* lds = (LAS unsigned char*)lds_raw;
    const int G = gridDim.x;
    typedef const __attribute__((address_space(4))) Args* KArgs;
    const KArgs kp = (KArgs)__builtin_amdgcn_kernarg_segment_ptr();
#define ARGS(name) KArgs name##_p = kp; asm volatile("" : "+s"(name##_p)); const Args name = load_args(name##_p)
    const int lo = kp->ph_lo, hi = kp->ph_hi;
    volatile LAS unsigned* MISC = (volatile LAS unsigned*)(lds + MISC_OFF);
    for (int u = threadIdx.x; u < 64; u += 512) MISC[u] = 0u;
    __syncthreads();
    unsigned* barw = (unsigned*)(GAS unsigned*)((GAS unsigned char*)kp->ws + WS_CTL) + CW_BAR;
    XcdBarrier bar; bar.bar = barw; bar.x = 0; bar.st = nullptr;
    const bool multi = (hi - lo) > 1;
    if (multi) bar = xcd_barrier_post(barw, MISC + 8);
#define IN(k) (lo <= (k) && (k) < hi)
#ifndef DBG_REPEAT
#define DBG_REPEAT 0
#endif
#define REP(bit) for (int rep_ = 0; rep_ < (((DBG_REPEAT) >> (bit)) & 1) + 1; ++rep_)
#define SEAM(k) do { if (IN(k) && IN((k) + 1)) xcd_barrier(bar); } while (0)
    if (IN(0)) REP(0) { ARGS(a0); phase_prologue(a0, lds, G); }
    SEAM(0);
    if (IN(1)) REP(1) { ARGS(a1); phase_h0(a1, G); }
    SEAM(1);
    for (int l = 0; l < 2; ++l) {
        const int pb = 2 + 5 * l;
        if (IN(pb + 0)) REP(2) {
            ARGS(args);
            pg8::Gemm g{(const pg8::bf16_t*)(args.ws + WS_HO), (const pg8::bf16_t*)(args.ws + WS_BIN + l * BIN_BYTES), M, NP, D};
            pg8::StaticOrder S; S.init(M, NP, G, (int)blockIdx.x);
            pg8::EpiP E{(pg8::bf16_t*)(args.ws + WS_P), NP};
            pg8::gemm_phase<pg8::EpiP, pg8::StaticOrder, true, true>(lds, g, S, E);
        }
        SEAM(pb + 0);
        if (IN(pb + 1)) REP(3) { ARGS(a2); phase_c1(a2, l, lds, G); }
        SEAM(pb + 1);
        if (IN(pb + 2)) REP(4) { ARGS(a3); phase_c2(a3, l, lds, G); }
        SEAM(pb + 2);
        if (IN(pb + 3)) REP(5) {
            ARGS(args);
            pg8::Gemm g{(const pg8::bf16_t*)(args.ws + WS_HO), (const pg8::bf16_t*)(args.ws + WS_BOUT + l * BOUT_BYTES), M, D, D};
            pg8::StaticOrder S; S.init(M, D, G, (int)blockIdx.x);
            pg8::EpiY E{(pg8::bf16_t*)(args.ws + WS_P), D, (float*)(args.ws + WS_YSQ)};
            pg8::gemm_phase<pg8::EpiY, pg8::StaticOrder, true, true>(lds, g, S, E);
        }
        SEAM(pb + 3);
        if (IN(pb + 4)) for (int rep_ = 0; rep_ < ((((DBG_REPEAT) >> 6) & 1) && l == 0 ? 2 : 1); ++rep_) { ARGS(a4); phase_resid(a4, l, G); }
        SEAM(pb + 4);
    }
#undef IN
#undef SEAM
#undef ARGS
}


#ifdef DBG_STOP_AFTER
__global__ void dbg_dump(const unsigned char* ws, float* out) {
    const size_t regs[9][2] = {{WS_MOD, 1966080}, {WS_ROPE, 1048576}, {WS_DEC, 17408}, {WS_YSQ, (size_t)M * 64 * 4}, {WS_BIN, 2 * BIN_BYTES}, {WS_BOUT, 2 * BOUT_BYTES}, {WS_HO, (size_t)M * D * 2}, {WS_P, (size_t)M * NP * 2}, {WS_REC, (size_t)NREC * REC_BYTES}};
    size_t obase = 0;
    for (int r = 0; r < 9; ++r) { const size_t nchunk = regs[r][1] / 128; const unsigned short* p = (const unsigned short*)(ws + regs[r][0]);
        for (size_t i = (size_t)blockIdx.x * blockDim.x + threadIdx.x; i < nchunk; i += (size_t)gridDim.x * blockDim.x) { unsigned s = 0; for (int k = 0; k < 64; ++k) s += p[i * 64 + k]; out[obase + i] = (float)s; }
        obase += nchunk; }
}
#endif
#ifndef MK_PER_PHASE
#define MK_PER_PHASE 1
#endif
extern "C" void kernel_launch(void* const* d_in, const int* in_sizes, int n_in, void* d_out, int out_size, void* d_ws, size_t ws_size, hipStream_t stream) {
    static int grid = 0;
    if (grid == 0) {
        if (n_in != 19 || out_size != (int)O_END || ws_size < WS_END) { fprintf(stderr, "kernel_launch: unexpected shapes (n_in %d out %d ws %zu need %zu)\n", n_in, out_size, ws_size, (size_t)WS_END); grid = -1; return; }
        int dev = 0, cus = 0;
        if (hipGetDevice(&dev) != hipSuccess || hipDeviceGetAttribute(&cus, hipDeviceAttributeMultiprocessorCount, dev) != hipSuccess) { grid = -1; return; }
        if (hipFuncSetAttribute((const void*)fwd, hipFuncAttributeMaxDynamicSharedMemorySize, LDS_BYTES) != hipSuccess) { fprintf(stderr, "kernel_launch: hipFuncSetAttribute failed\n"); grid = -1; return; }
        int per_cu = 0;
        if (hipOccupancyMaxActiveBlocksPerMultiprocessor(&per_cu, (const void*)fwd, 512, LDS_BYTES) != hipSuccess || per_cu < 1) fprintf(stderr, "kernel_launch: occupancy query says %d\n", per_cu);
        (void)hipGetLastError();
        grid = cus;
        if (grid < 128) { fprintf(stderr, "kernel_launch: needs >= 128 CUs\n"); grid = -1; return; }
    }
    if (grid < 0) return;
    (void)in_sizes;
    if (hipMemsetAsync((char*)d_ws + WS_CTL, 0, CTL_ZERO_BYTES, stream) != hipSuccess) return;
    Args a{};
    for (int i = 0; i < 19; ++i) a.in[i] = (const float*)d_in[i];
    a.out = (float*)d_out; a.ws = (unsigned char*)d_ws;
#ifdef DBG_STOP_AFTER
    for (int p = 0; p <= DBG_STOP_AFTER; ++p) { a.ph_lo = p; a.ph_hi = p + 1; hipLaunchKernelGGL(fwd, dim3(grid), dim3(512), LDS_BYTES, stream, a); }
    hipLaunchKernelGGL(dbg_dump, dim3(2048), dim3(256), 0, stream, (const unsigned char*)d_ws, (float*)d_out);
#elif MK_PER_PHASE
    for (int p = 0; p < N_PHASES; ++p) { a.ph_lo = p; a.ph_hi = p + 1; hipLaunchKernelGGL(fwd, dim3(grid), dim3(512), LDS_BYTES, stream, a); }
#else
    a.ph_lo = 0; a.ph_hi = N_PHASES;
    hipLaunchKernelGGL(fwd, dim3(grid), dim3(512), LDS_BYTES, stream, a);
#endif
}
```

```cpp
#include <hip/hip_runtime.h>
#include <cstdio>
#include <cstdint>
#define MK_PER_PHASE 0
__device__ __forceinline__ int tid_opaque() { int t = threadIdx.x; asm volatile("" : "+v"(t)); return t; }
namespace pg8 {
#define PG8_LAS __attribute__((address_space(3)))
typedef unsigned short bf16_t;
typedef short bf16x8 __attribute__((ext_vector_type(8)));
typedef float f32x4 __attribute__((ext_vector_type(4)));
typedef unsigned u32x4 __attribute__((ext_vector_type(4)));
constexpr int BM = 256, BK = 64, HALF = 128, HTB = HALF * BK * 2  , STAGE_BYTES = 8 * HTB, NXCD = 8, WGM = 8;

__host__ __device__ __forceinline__ int lds_byte(int r, int c) { const int st = (r >> 4) * 2 + (c >> 5), rr = r & 15, cc = c & 31, ob = rr * 64 + cc * 2; return st * 1024 + (ob ^ (((ob >> 9) & 1) << 5)); }
__host__ __device__ __forceinline__ void stage_rc(int b, int& R, int& C) { const int st = b / 1024, sb = b % 1024, swz = sb ^ (((sb >> 9) & 1) << 5); R = (st >> 1) * 16 + swz / 64; C = (st & 1) * 32 + (swz % 64) / 2; }
__host__ __device__ __forceinline__ int perm32(int rho) { const int n = rho >> 4, i = rho & 15; return 8 * (i >> 2) + 4 * n + (i & 3); }

struct Unit { int pm, pn; };
struct Gemm { const bf16_t* A; const bf16_t* Bt; int M, N, K; };

struct StaticOrder {
    int nM, nN, nwg, G, c;
    __host__ __device__ void init(int M, int N, int G_, int c_) { nM = M / BM; nN = N / BM; nwg = nM * nN; G = G_; c = c_; }
    __host__ __device__ bool next(int i, Unit& u) const {
        const long L = (long)i * G + c; if (L >= nwg) return false;
        int wgid = (int)L; { const int q = nwg / NXCD, r = nwg % NXCD, xcd = wgid % NXCD, off = wgid / NXCD; wgid = (xcd < r ? xcd * (q + 1) : r * (q + 1) + (xcd - r) * q) + off; }
        const int nig = WGM * nN, gid = wgid / nig, fm = gid * WGM, gsz = (nM - fm) < WGM ? (nM - fm) : WGM;
        u.pm = fm + ((wgid % nig) % gsz); u.pn = (wgid % nig) / gsz; return true;
    }
    __device__ __forceinline__ void a_ready(const Unit&) const {}
    __device__ __forceinline__ void done(const Unit&) const {}
};

typedef __bf16 hwbf16x2_t __attribute__((ext_vector_type(2))); typedef float f32x2_t __attribute__((ext_vector_type(2)));
__device__ __forceinline__ unsigned cvt_pk_bf16(float lo, float hi) { const f32x2_t v = {lo, hi}; return __builtin_bit_cast(unsigned, __builtin_convertvector(v, hwbf16x2_t)); }
struct EpiP {
    static constexpr bool PERM = true, AFTER_DRAIN = false;
    bf16_t* O; int ldc; const float* dn; int gate_lo, gate_hi;
    __device__ __forceinline__ void operator()(const f32x4 (&acc)[2][2][4][2], const Unit& u, int wr, int wc, int fr, int fq) const {
        const int row0 = u.pm * BM + wr * 64 + fr, col0 = u.pn * BM + wc * 32 + 8 * fq;
        if (u.pn >= gate_lo && u.pn < gate_hi) {
            f32x4 dv[2][2];
#pragma unroll
            for (int bj = 0; bj < 2; ++bj) { const int e0 = (wc * 32 + 8 * fq) & 127; dv[bj][0] = *(const f32x4*)(dn + e0); dv[bj][1] = *(const f32x4*)(dn + e0 + 4); }
#pragma unroll
            for (int ai = 0; ai < 2; ++ai)
#pragma unroll
                for (int m = 0; m < 4; ++m) { bf16_t* rowp = O + (size_t)(row0 + ai * HALF + m * 16) * ldc + col0;
#pragma unroll
                    for (int bj = 0; bj < 2; ++bj) { f32x4 v[2] = {acc[ai][bj][m][0], acc[ai][bj][m][1]};
#pragma unroll
                        for (int n = 0; n < 2; ++n) { const f32x4 t = v[n] * -1.4426950408889634f; f32x4 s;
#pragma unroll
                            for (int j = 0; j < 4; ++j) s[j] = __builtin_amdgcn_rcpf(1.0f + __builtin_amdgcn_exp2f(t[j]));
                            v[n] = v[n] * s * dv[bj][n]; }
                        u32x4 w; w.x = cvt_pk_bf16(v[0][0], v[0][1]); w.y = cvt_pk_bf16(v[0][2], v[0][3]); w.z = cvt_pk_bf16(v[1][0], v[1][1]); w.w = cvt_pk_bf16(v[1][2], v[1][3]);
                        *(u32x4*)(rowp + bj * HALF) = w; } }
            return;
        }
#pragma unroll
        for (int ai = 0; ai < 2; ++ai)
#pragma unroll
            for (int m = 0; m < 4; ++m) { bf16_t* rowp = O + (size_t)(row0 + ai * HALF + m * 16) * ldc + col0;
#pragma unroll
                for (int bj = 0; bj < 2; ++bj) { const f32x4 v0 = acc[ai][bj][m][0], v1 = acc[ai][bj][m][1];
                    u32x4 w; w.x = cvt_pk_bf16(v0[0], v0[1]); w.y = cvt_pk_bf16(v0[2], v0[3]); w.z = cvt_pk_bf16(v1[0], v1[1]); w.w = cvt_pk_bf16(v1[2], v1[3]);
                    *(u32x4*)(rowp + bj * HALF) = w; } }
    }
};
struct EpiY {
    static constexpr bool PERM = true, AFTER_DRAIN = false;
    bf16_t* O; int ldc; float* part;
    __device__ __forceinline__ void operator()(const f32x4 (&acc)[2][2][4][2], const Unit& u, int wr, int wc, int fr, int fq) const {
        const int row0 = u.pm * BM + wr * 64 + fr, col0 = u.pn * BM + wc * 32 + 8 * fq;
#pragma unroll
        for (int ai = 0; ai < 2; ++ai)
#pragma unroll
            for (int m = 0; m < 4; ++m) { const int row = row0 + ai * HALF + m * 16; bf16_t* rowp = O + (size_t)row * ldc + col0; float s = 0.f;
#pragma unroll
                for (int bj = 0; bj < 2; ++bj) { const f32x4 v0 = acc[ai][bj][m][0], v1 = acc[ai][bj][m][1];
                    s += (v0[0] * v0[0] + v0[1] * v0[1]) + (v0[2] * v0[2] + v0[3] * v0[3]) + (v1[0] * v1[0] + v1[1] * v1[1]) + (v1[2] * v1[2] + v1[3] * v1[3]);
                    u32x4 w; w.x = cvt_pk_bf16(v0[0], v0[1]); w.y = cvt_pk_bf16(v0[2], v0[3]); w.z = cvt_pk_bf16(v1[0], v1[1]); w.w = cvt_pk_bf16(v1[2], v1[3]);
                    *(u32x4*)(rowp + bj * HALF) = w; }
                s += __shfl_xor(s, 16); s += __shfl_xor(s, 32);
                if (fq == 0) part[(size_t)row * 64 + u.pn * 4 + wc] = s; }
    }
};

template <class Epi, class Sched, bool ALIGN_EPI = false, bool SP2 = false>
__device__ __forceinline__ void gemm_phase(PG8_LAS unsigned char* lds, const Gemm g, const Sched& S, const Epi& E) {
    const int tid = tid_opaque(), wid = __builtin_amdgcn_readfirstlane(tid >> 6), lane = tid & 63, wr = wid >> 2, wc = wid & 3, fr = lane & 15, fq = lane >> 4;
    const int K = g.K, nt = K / BK;
    unsigned voffA[2], voffB[2];
#pragma unroll
    for (int i = 0; i < 2; ++i) { int R, C; stage_rc(tid * 16 + i * 8192, R, C); const int Rb = Epi::PERM ? ((R & ~31) + perm32(R & 31)) : R;
        voffA[i] = (unsigned)(R * K + C) * 2u; voffB[i] = (unsigned)(Rb * K + C) * 2u; }
    const size_t kstep = (size_t)(BK * 2);
    const size_t hstep = (size_t)HALF * K * 2;
    const size_t tstep = 2 * hstep;
    const unsigned ldsw = (unsigned)wid * 1024u;
    const int aoff = lds_byte(wr * 64 + fr, fq * 8), boff = lds_byte(wc * 32 + fr, fq * 8);
#define PG8_SA(b, h) (((b) * 2 + (h)) * HTB)
#define PG8_SB(b, h) ((4 + (b) * 2 + (h)) * HTB)
#define PG8_STAGE(bufoff, gbase, voff) do { _Pragma("unroll") for (int _i = 0; _i < 2; ++_i) \
        __builtin_amdgcn_global_load_lds((const unsigned*)((const char*)(gbase) + (voff)[_i]), (PG8_LAS unsigned*)(lds + (bufoff) + ldsw + _i * 8192), 16, 0, 0); } while (0)
#define PG8_LDA(dst, b, h) do { _Pragma("unroll") for (int m = 0; m < 4; ++m) _Pragma("unroll") for (int k = 0; k < 2; ++k) dst[m][k] = *(const PG8_LAS bf16x8*)(lds + PG8_SA(b, h) + aoff + m * 2048 + k * 1024); } while (0)
#define PG8_LDB(dst, b, h) do { _Pragma("unroll") for (int n = 0; n < 2; ++n) _Pragma("unroll") for (int k = 0; k < 2; ++k) dst[n][k] = *(const PG8_LAS bf16x8*)(lds + PG8_SB(b, h) + boff + n * 2048 + k * 1024); } while (0)
#define PG8_MMA(ai, bj, At, Bt) do { __builtin_amdgcn_s_setprio(1); _Pragma("unroll") for (int m = 0; m < 4; ++m) _Pragma("unroll") for (int n = 0; n < 2; ++n) _Pragma("unroll") for (int k = 0; k < 2; ++k) \
        acc[ai][bj][m][n] = __builtin_amdgcn_mfma_f32_16x16x32_bf16(Bt[n][k], At[m][k], acc[ai][bj][m][n], 0, 0, 0); __builtin_amdgcn_s_setprio(0); } while (0)
#define PG8_WAIT_V(n) asm volatile("s_waitcnt vmcnt(" #n ")" ::: "memory")
#define PG8_WAIT_L(n) asm volatile("s_waitcnt lgkmcnt(" #n ")" ::: "memory")
#define PG8_BAR __builtin_amdgcn_s_barrier()
#define PG8_SCHED __builtin_amdgcn_sched_barrier(0)
    Unit cur, nxt; int ui = 0;
    if (!S.next(0, cur)) return;
    f32x4 acc[2][2][4][2];
#pragma unroll
    for (int a = 0; a < 2; ++a)
#pragma unroll
        for (int b = 0; b < 2; ++b)
#pragma unroll
            for (int m = 0; m < 4; ++m)
#pragma unroll
                for (int n = 0; n < 2; ++n) acc[a][b][m][n] = (f32x4){0.f, 0.f, 0.f, 0.f};
    bf16x8 At[4][2], B0[2][2], B1[2][2];
    const char* cA = (const char*)g.A + (size_t)cur.pm * tstep; const char* cB = (const char*)g.Bt + (size_t)cur.pn * tstep;
    S.a_ready(cur);
    if constexpr (SP2) {
        PG8_STAGE(PG8_SB(0, 0), cB, voffB); PG8_STAGE(PG8_SB(0, 1), cB + hstep, voffB); PG8_STAGE(PG8_SA(0, 0), cA, voffA); PG8_STAGE(PG8_SA(0, 1), cA + hstep, voffA);
        if (wr == 1) PG8_BAR;
        PG8_WAIT_V(2); PG8_BAR;
        PG8_STAGE(PG8_SB(1, 0), cB + kstep, voffB); PG8_STAGE(PG8_SA(1, 0), cA + kstep, voffA); PG8_STAGE(PG8_SB(1, 1), cB + hstep + kstep, voffB);
        PG8_WAIT_V(6); PG8_BAR;
    } else {
        PG8_STAGE(PG8_SB(0, 0), cB, voffB); PG8_STAGE(PG8_SA(0, 0), cA, voffA); PG8_STAGE(PG8_SB(0, 1), cB + hstep, voffB); PG8_STAGE(PG8_SA(0, 1), cA + hstep, voffA);
        if (wr == 1) PG8_BAR;
        PG8_WAIT_V(4); PG8_BAR;
        PG8_STAGE(PG8_SB(1, 0), cB + kstep, voffB); PG8_STAGE(PG8_SA(1, 0), cA + kstep, voffA); PG8_STAGE(PG8_SB(1, 1), cB + hstep + kstep, voffB);
        PG8_WAIT_V(6); PG8_BAR;
    }
    for (;;) {
        const bool has_next = S.next(ui + 1, nxt);
        const char* nA = has_next ? (const char*)g.A + (size_t)nxt.pm * tstep : cA; const char* nB = has_next ? (const char*)g.Bt + (size_t)nxt.pn * tstep : cB;
        for (int t = 0; t < nt; t += 2) {
            const bool last = (t == nt - 2);
            const char* a1 = cA + (size_t)(t + 1) * kstep;
            const char* a2 = last ? nA : cA + (size_t)(t + 2) * kstep; const char* b2 = last ? nB : cB + (size_t)(t + 2) * kstep;
            const char* a3 = a2 + kstep; const char* b3 = b2 + kstep;
            if (last && has_next) S.a_ready(nxt);
            if constexpr (SP2) {
            PG8_LDB(B0, 0, 0); PG8_LDB(B1, 0, 1); PG8_SCHED; PG8_LDA(At, 0, 0); PG8_STAGE(PG8_SA(1, 1), a1 + hstep, voffA);
            PG8_WAIT_V(8); PG8_WAIT_L(0); PG8_BAR; PG8_MMA(0, 0, At, B0); PG8_MMA(0, 1, At, B1); PG8_BAR; PG8_SCHED;
            PG8_LDA(At, 0, 1); PG8_STAGE(PG8_SB(0, 0), b2, voffB); PG8_STAGE(PG8_SB(0, 1), b2 + hstep, voffB); PG8_STAGE(PG8_SA(0, 0), a2, voffA);
            PG8_WAIT_V(8); PG8_WAIT_L(0); PG8_BAR; PG8_MMA(1, 0, At, B0); PG8_MMA(1, 1, At, B1); PG8_BAR; PG8_SCHED;
            PG8_LDB(B0, 1, 0); PG8_LDB(B1, 1, 1); PG8_SCHED; PG8_LDA(At, 1, 0); PG8_STAGE(PG8_SA(0, 1), a2 + hstep, voffA);
            PG8_WAIT_V(8); PG8_WAIT_L(0); PG8_BAR; PG8_MMA(0, 0, At, B0); PG8_MMA(0, 1, At, B1); PG8_BAR; PG8_SCHED;
            PG8_LDA(At, 1, 1); PG8_STAGE(PG8_SB(1, 0), b3, voffB); PG8_STAGE(PG8_SB(1, 1), b3 + hstep, voffB); PG8_STAGE(PG8_SA(1, 0), a3, voffA);
            PG8_WAIT_V(8); PG8_WAIT_L(0); PG8_BAR; PG8_MMA(1, 0, At, B0); PG8_MMA(1, 1, At, B1); PG8_BAR; PG8_SCHED;
            } else {
            PG8_LDB(B0, 0, 0); PG8_SCHED; PG8_LDA(At, 0, 0); PG8_STAGE(PG8_SA(1, 1), a1 + hstep, voffA);
            PG8_WAIT_L(8); PG8_BAR; PG8_WAIT_L(0); PG8_MMA(0, 0, At, B0); PG8_BAR; PG8_SCHED;
            PG8_LDB(B1, 0, 1); PG8_STAGE(PG8_SB(0, 0), b2, voffB);
            PG8_BAR; PG8_WAIT_L(0); PG8_MMA(0, 1, At, B1); PG8_BAR;
            PG8_LDA(At, 0, 1); PG8_STAGE(PG8_SA(0, 0), a2, voffA);
            PG8_BAR; PG8_WAIT_L(0); PG8_MMA(1, 0, At, B0); PG8_BAR; PG8_SCHED;
            PG8_STAGE(PG8_SB(0, 1), b2 + hstep, voffB);
            PG8_WAIT_V(6); PG8_BAR; PG8_MMA(1, 1, At, B1); PG8_BAR;
            PG8_LDB(B0, 1, 0); PG8_SCHED; PG8_LDA(At, 1, 0); PG8_STAGE(PG8_SA(0, 1), a2 + hstep, voffA);
            PG8_WAIT_L(8); PG8_BAR; PG8_WAIT_L(0); PG8_MMA(0, 0, At, B0); PG8_BAR; PG8_SCHED;
            PG8_LDB(B1, 1, 1); PG8_STAGE(PG8_SB(1, 0), b3, voffB);
            PG8_BAR; PG8_WAIT_L(0); PG8_MMA(0, 1, At, B1); PG8_BAR;
            PG8_LDA(At, 1, 1); PG8_STAGE(PG8_SA(1, 0), a3, voffA);
            PG8_BAR; PG8_WAIT_L(0); PG8_MMA(1, 0, At, B0); PG8_BAR; PG8_SCHED;
            PG8_STAGE(PG8_SB(1, 1), b3 + hstep, voffB);
            PG8_WAIT_V(6); PG8_BAR; PG8_MMA(1, 1, At, B1); PG8_BAR;
            }
        }
        if constexpr (ALIGN_EPI) { if (wr == 0) PG8_BAR; }
        if constexpr (!Epi::AFTER_DRAIN) { E(acc, cur, wr, wc, fr, fq); S.done(cur); }
        if (!has_next) break;
#pragma unroll
        for (int a = 0; a < 2; ++a)
#pragma unroll
            for (int b = 0; b < 2; ++b)
#pragma unroll
                for (int m = 0; m < 4; ++m)
#pragma unroll
                    for (int n = 0; n < 2; ++n) acc[a][b][m][n] = (f32x4){0.f, 0.f, 0.f, 0.f};
        cur = nxt; cA = nA; cB = nB; ++ui;
        if constexpr (ALIGN_EPI) { if (wr == 1) PG8_BAR; }
    }
    PG8_WAIT_V(0);
    if constexpr (!ALIGN_EPI) { if (wr == 0) PG8_BAR; }
    PG8_BAR;
    if constexpr (Epi::AFTER_DRAIN) { E.fused(acc, cur, wr, wc, fr, fq, lds, wid, lane); S.done(cur); }
#undef PG8_SA
#undef PG8_SB
#undef PG8_STAGE
#undef PG8_LDA
#undef PG8_LDB
#undef PG8_MMA
#undef PG8_WAIT_V
#undef PG8_WAIT_L
#undef PG8_BAR
#undef PG8_SCHED
}
}

#define GAS __attribute__((address_space(1)))
#define LAS __attribute__((address_space(3)))
typedef unsigned short bf16;
typedef short bf16x8 __attribute__((ext_vector_type(8)));
typedef short bf16x4 __attribute__((ext_vector_type(4)));
typedef float f32x4 __attribute__((ext_vector_type(4)));
typedef float f32x2 __attribute__((ext_vector_type(2)));
typedef unsigned u32x4 __attribute__((ext_vector_type(4)));
typedef unsigned u32x2 __attribute__((ext_vector_type(2)));

constexpr int D = 4096, NB = 4, T = 4096, NSB = 16, TS = 16, PAST = 2048;
constexpr int MP = NB * T, MS = NSB * TS, M = MP + MS;
constexpr int NP = 13056, IN_DIM = 12832;
constexpr int C_Q = 0, C_K = 2048, C_V = 4096, C_ZDN = 6144, C_AQ = 8192, C_AK = 10240, C_AV = 10496, C_AZ = 10752, C_B = 12800, C_A = 12816;
constexpr float EPS = 1e-6f;
constexpr size_t O_YP = 0, O_YS = O_YP + (size_t)MP * D, O_CONVP = O_YS + (size_t)MS * D, O_DNP = O_CONVP + 2 * 4 * 3 * 6144, O_KP = O_DNP + 2 * 4 * 16 * 128 * 128,
                 O_VP = O_KP + 2 * 4 * 128 * 256, O_CONVS = O_VP + 2 * 4 * 128 * 256, O_DNS = O_CONVS + 2 * 16 * 3 * 6144, O_KS = O_DNS + (size_t)2 * 16 * 16 * 128 * 128,
                 O_VS = O_KS + 2 * 16 * 128 * 256, O_END = O_VS + 2 * 16 * 128 * 256;
static_assert(O_END == 82001920, "output size");
constexpr size_t MiB = 1u << 20;
constexpr size_t WS_CTL = 0, CTL_ZERO_BYTES = 1 * MiB;
constexpr size_t WS_MOD = 1 * MiB;
constexpr size_t WS_ROPE = 3 * MiB;
constexpr size_t WS_DEC = 4 * MiB;
constexpr size_t WS_YSQ = 5 * MiB;
constexpr size_t WS_BIN = 10 * MiB;
constexpr size_t BIN_BYTES = (size_t)NP * 4096 * 2;
constexpr size_t WS_BOUT = 214 * MiB;
constexpr size_t BOUT_BYTES = (size_t)4096 * 4096 * 2;
constexpr size_t WS_HO = 278 * MiB;
constexpr size_t WS_P = 408 * MiB;
constexpr size_t WS_REC = 823 * MiB;
constexpr int REC_W = 0, REC_QD = 16384, REC_KD = 32768, REC_QK = 49152, REC_U = 57344, REC_BYTES = 73728, REC_STAGE = 57344;
constexpr int NREC = 4096 + 256;
constexpr size_t WS_YS = WS_REC + (size_t)NREC * REC_BYTES;
constexpr size_t WS_END = WS_YS + (size_t)MS * D * 2;
constexpr int CW_C2DONE = 3072;
static_assert(WS_BIN + 2 * BIN_BYTES <= WS_BOUT && WS_HO + (size_t)M * D * 2 <= WS_P && WS_P + (size_t)M * NP * 2 <= WS_REC, "ws map");
constexpr int CW_BAR = 4096;
constexpr int LDS_BYTES = 147456;
constexpr int MISC_OFF = 147456 - 256;

#define RLX_AGENT __ATOMIC_RELAXED, __HIP_MEMORY_SCOPE_AGENT
#define LDS_WAIT() asm volatile("s_waitcnt lgkmcnt(0)" ::: "memory")
#define VM_WAIT() asm volatile("s_waitcnt vmcnt(0)" ::: "memory")
#define BAR_LDS() do { asm volatile("s_waitcnt lgkmcnt(0)" ::: "memory"); __builtin_amdgcn_s_barrier(); asm volatile("" ::: "memory"); } while (0)
typedef __bf16 hwbf16x2 __attribute__((ext_vector_type(2)));
__device__ __forceinline__ unsigned cvtpk(float lo, float hi) { const f32x2 v = {lo, hi}; return __builtin_bit_cast(unsigned, __builtin_convertvector(v, hwbf16x2)); }
__device__ __forceinline__ float bflo(unsigned w) { return __uint_as_float(w << 16); }
__device__ __forceinline__ float bfhi(unsigned w) { return __uint_as_float(w & 0xffff0000u); }
__device__ __forceinline__ float bf1(bf16 h) { return __uint_as_float(((unsigned)h) << 16); }
__device__ __forceinline__ float silu_f(float x) { return x * __builtin_amdgcn_rcpf(1.0f + __expf(-x)); }
__device__ __forceinline__ float sigmoid_f(float x) { return __builtin_amdgcn_rcpf(1.0f + __expf(-x)); }
__device__ __forceinline__ float sum16(float v) {
    v += __builtin_bit_cast(float, __builtin_amdgcn_update_dpp(0, __builtin_bit_cast(int, v), 0xB1, 0xf, 0xf, true));
    v += __builtin_bit_cast(float, __builtin_amdgcn_update_dpp(0, __builtin_bit_cast(int, v), 0x4E, 0xf, 0xf, true));
    v += __builtin_bit_cast(float, __builtin_amdgcn_update_dpp(0, __builtin_bit_cast(int, v), 0x141, 0xf, 0xf, true));
    v += __builtin_bit_cast(float, __builtin_amdgcn_update_dpp(0, __builtin_bit_cast(int, v), 0x140, 0xf, 0xf, true));
    return v;
}
__device__ __forceinline__ float wave_sum(float v) { v = sum16(v); v += __shfl_xor(v, 16); v += __shfl_xor(v, 32); return v; }
__device__ __forceinline__ float wave_max(float v) {
#pragma unroll
    for (int o = 1; o < 64; o <<= 1) v = fmaxf(v, __shfl_xor(v, o));
    return v;
}
__device__ __forceinline__ void unpack8(const u32x4 w, float (&f)[8]) {
    f[0] = bflo(w.x); f[1] = bfhi(w.x); f[2] = bflo(w.y); f[3] = bfhi(w.y); f[4] = bflo(w.z); f[5] = bfhi(w.z); f[6] = bflo(w.w); f[7] = bfhi(w.w);
}
__device__ __forceinline__ u32x4 pack8(const float (&f)[8]) { u32x4 w; w.x = cvtpk(f[0], f[1]); w.y = cvtpk(f[2], f[3]); w.z = cvtpk(f[4], f[5]); w.w = cvtpk(f[6], f[7]); return w; }
__device__ __forceinline__ u32x4 pack8v(const f32x2 (&f)[4]) { u32x4 w; w.x = cvtpk(f[0].x, f[0].y); w.y = cvtpk(f[1].x, f[1].y); w.z = cvtpk(f[2].x, f[2].y); w.w = cvtpk(f[3].x, f[3].y); return w; }
__device__ __forceinline__ bf16x8 as_bf16x8(const u32x4 w) { return __builtin_bit_cast(bf16x8, w); }
__device__ __forceinline__ bf16x4 as_bf16x4(const u32x2 w) { return __builtin_bit_cast(bf16x4, w); }

#define XB_TMO      128
#define XB_XCNT(j)  (256  + 64 * (j))
#define XB_XSUB(j)  (1280 + 64 * (j))
#define XB_XGEN(j)  (2304 + 64 * (j))
#define XB_TOP      3328
#define XB_TOPGEN   3392
#define XCD_BAR_WORDS 3456
#define XB_SPIN_CAP (1u << 18)

__device__ __forceinline__ unsigned xb_ld(unsigned* p)              { return __hip_atomic_load(p, __ATOMIC_RELAXED, __HIP_MEMORY_SCOPE_AGENT); }
__device__ __forceinline__ unsigned xb_add(unsigned* p, unsigned v) { return __hip_atomic_fetch_add(p, v, __ATOMIC_RELAXED, __HIP_MEMORY_SCOPE_AGENT); }
__device__ __forceinline__ unsigned xb_xcc_id() { return (unsigned)__builtin_amdgcn_s_getreg((3 << 11) | 20) & 0xFu; }
#define XB_SPIN(cond, bar) do { unsigned _sp = 0; while (cond) { __builtin_amdgcn_s_sleep(1); \
    if ((++_sp & 255u) == 0u) { if (xb_ld(&(bar)[XB_TMO])) break; if (_sp > XB_SPIN_CAP) { atomicAdd(&(bar)[XB_TMO], 1u); break; } } } } while (0)

struct XcdBarrier {
    unsigned* bar; unsigned x;
    volatile LAS unsigned* st;
};

__device__ __forceinline__ XcdBarrier xcd_barrier_post(unsigned* bar, volatile LAS unsigned* st) {
    XcdBarrier b; b.bar = bar; b.x = xb_xcc_id(); b.st = st;
    if (threadIdx.x == 0) (void)xb_add(&bar[XB_XCNT(b.x)], 1u);
    return b;
}
__device__ __forceinline__ void xcd_barrier_complete(unsigned* bar, unsigned x, unsigned& nloc, unsigned& nx) {
    const unsigned G = gridDim.x * gridDim.y * gridDim.z;
    unsigned sum, cnt, mine, sp = 0u;
    for (;;) {
        sum = 0u; cnt = 0u; mine = 0u;
#pragma unroll
        for (unsigned j = 0; j < 16; ++j) { const unsigned c = xb_ld(&bar[XB_XCNT(j)]); sum += c; cnt += (c > 0u) ? 1u : 0u; mine = (j == x) ? c : mine; }
        if (sum == G) break;
        __builtin_amdgcn_s_sleep(1);
        if ((++sp & 255u) == 0u) { if (xb_ld(&bar[XB_TMO])) break; if (sp > XB_SPIN_CAP) { atomicAdd(&bar[XB_TMO], 1u); break; } }
    }
    nloc = mine > 0u ? mine : 1u; nx = cnt > 0u ? cnt : 1u;
}

__device__ __forceinline__ void xcd_barrier(const XcdBarrier& b) {
    asm volatile("s_waitcnt vmcnt(0)" ::: "memory");
    __syncthreads();
    if (threadIdx.x == 0) {
        unsigned* bar = b.bar;
        __builtin_amdgcn_s_waitcnt(0);
        unsigned nloc = b.st[0], nx = b.st[1];
        if (nloc == 0u) { xcd_barrier_complete(bar, b.x, nloc, nx); b.st[0] = nloc; b.st[1] = nx; }
        const unsigned old = xb_add(&bar[XB_XSUB(b.x)], 1u);
        const unsigned gen = old / nloc;
        if (old + 1u == (gen + 1u) * nloc) {
            __builtin_amdgcn_fence(__ATOMIC_RELEASE, "agent");
            asm volatile("s_waitcnt vmcnt(0)" ::: "memory");
            const unsigned og = xb_add(&bar[XB_TOP], 1u);
            const unsigned tg = og / nx;
            if (og + 1u == (tg + 1u) * nx) xb_add(&bar[XB_TOPGEN], 1u);
            else XB_SPIN(xb_ld(&bar[XB_TOPGEN]) == tg, bar);
            __builtin_amdgcn_fence(__ATOMIC_ACQUIRE, "agent");
            xb_add(&bar[XB_XGEN(b.x)], 1u);
            asm volatile("s_waitcnt vmcnt(0)" ::: "memory");
        } else {
            XB_SPIN(xb_ld(&bar[XB_XGEN(b.x)]) == gen, bar);
            __builtin_amdgcn_fence(__ATOMIC_ACQUIRE, "agent");
            asm volatile("s_waitcnt vmcnt(0)" ::: "memory");
        }
    }
    __syncthreads();
}

struct Args { const float* in[19]; float* out; unsigned char* ws; int ph_lo, ph_hi; };

__device__ __forceinline__ void p0_transpose_item(const float* W, int K, int N, bf16* WT, int dst_row0, LAS float* scr, int k0, int n0, int lane) {
    const int r8 = lane >> 3, c4 = lane & 7;
    f32x4 v[8];
#pragma unroll
    for (int i = 0; i < 8; ++i) v[i] = *(const f32x4*)(W + (size_t)(k0 + 8 * i + r8) * N + n0 + 4 * c4);
#pragma unroll
    for (int i = 0; i < 8; ++i) { LAS float* d = scr + (8 * i + r8) * 33 + 4 * c4; d[0] = v[i][0]; d[1] = v[i][1]; d[2] = v[i][2]; d[3] = v[i][3]; }
    LDS_WAIT(); asm volatile("" ::: "memory");
    const int c = lane & 7;
#pragma unroll
    for (int j = 0; j < 4; ++j) { const int n = (lane >> 3) + 8 * j; const LAS float* s = scr + (8 * c) * 33 + n;
        u32x4 o; o.x = cvtpk(s[0 * 33], s[1 * 33]); o.y = cvtpk(s[2 * 33], s[3 * 33]); o.z = cvtpk(s[4 * 33], s[5 * 33]); o.w = cvtpk(s[6 * 33], s[7 * 33]);
        *(u32x4*)(WT + (size_t)(dst_row0 + n) * K + k0 + 8 * c) = o; }
    LDS_WAIT(); asm volatile("" ::: "memory");
}
__device__ __forceinline__ void prologue_work(const Args& a, LAS unsigned char* lds, int vb, int nvb, int ada_mask, int tr_mask, bool rope) {
    const int tid = tid_opaque(), lane = tid & 63, wave = tid >> 6;
    {
        const float* cp = a.in[6]; const float* cs = a.in[7]; const float* w_ada = a.in[8]; const float* b_ada = a.in[9];
        float* mod = (float*)(a.ws + WS_MOD);
        LAS float* sc = (LAS float*)lds;
        LAS float* red = (LAS float*)(lds + 40960);
        const int cgp = tid & 7, ksl = tid >> 3;
        const int it0 = (ada_mask & 1) ? 0 : 384, it1 = (ada_mask & 2) ? 768 : 384;
        for (int it = it0 + vb; it < it1 && ada_mask; it += nvb) {
            const int l = it / 384, col0 = (it % 384) * 32;
            f32x4 acc[20];
#pragma unroll
            for (int j = 0; j < 20; ++j) acc[j] = (f32x4){0.f, 0.f, 0.f, 0.f};
            for (int kt = 0; kt < 8; ++kt) {
                __syncthreads();
#pragma unroll
                for (int j = 0; j < 20; ++j) { const float cv = (j < 4) ? cp[j * 4096 + kt * 512 + tid] : cs[(j - 4) * 4096 + kt * 512 + tid]; sc[tid * 20 + j] = silu_f(cv); }
                __syncthreads();
                const float* wp = w_ada + ((size_t)l * 4096 + kt * 512 + ksl * 8) * 12288 + col0 + cgp * 4;
                f32x4 w[8];
#pragma unroll
                for (int kk = 0; kk < 8; ++kk) w[kk] = *(const f32x4*)(wp + (size_t)kk * 12288);
#pragma unroll
                for (int kk = 0; kk < 8; ++kk) {
                    const LAS f32x4* s4 = (const LAS f32x4*)(sc + (ksl * 8 + kk) * 20);
#pragma unroll
                    for (int j4 = 0; j4 < 5; ++j4) { const f32x4 s = s4[j4];
#pragma unroll
                        for (int jj = 0; jj < 4; ++jj) acc[j4 * 4 + jj] += s[jj] * w[kk]; }
                }
            }
#pragma unroll
            for (int j = 0; j < 20; ++j)
#pragma unroll
                for (int c = 0; c < 4; ++c) { float v = acc[j][c]; v += __shfl_xor(v, 8); v += __shfl_xor(v, 16); v += __shfl_xor(v, 32); acc[j][c] = v; }
            __syncthreads();
            if (lane < 8) {
#pragma unroll
                for (int j = 0; j < 20; ++j) *(LAS f32x4*)(red + (wave * 20 + j) * 32 + lane * 4) = acc[j];
            }
            __syncthreads();
            for (int o = tid; o < 640; o += 512) { const int j = o >> 5, c = o & 31; float s = 0.f;
#pragma unroll
                for (int w8 = 0; w8 < 8; ++w8) s += red[(w8 * 20 + j) * 32 + c];
                mod[((size_t)l * 20 + j) * 12288 + col0 + c] = s + b_ada[(size_t)l * 12288 + col0 + c]; }
        }
        __syncthreads();
    }
    {
        LAS float* scr = (LAS float*)(lds + wave * 8448);
        const int gw = vb * 8 + wave, NGW = nvb * 8;
        constexpr int I_IN = 64 * 401, I_OUT = 64 * 128;
#pragma unroll 1
        for (int mtx = 0; mtx < 4; ++mtx) {
            if (!((tr_mask >> mtx) & 1)) continue;
            const int l = mtx >> 1;
            if ((mtx & 1) == 0) {
                for (int r = gw; r < I_IN; r += NGW) { const int kb = r / 401, nb = r % 401, n0 = nb * 32; const int dst = (n0 < 8192) ? n0 : ((n0 < 8224) ? (C_B + (n0 - 8192)) : (n0 - 32));
                    p0_transpose_item(a.in[12] + (size_t)l * 4096 * IN_DIM, 4096, IN_DIM, (bf16*)(a.ws + WS_BIN + l * BIN_BYTES), dst, scr, kb * 64, n0, lane); }
                constexpr int ZU = (NP - IN_DIM) * 4096 * 2 / 16;
                for (int u = vb * 512 + tid; u < ZU; u += nvb * 512) *(u32x4*)(a.ws + WS_BIN + l * BIN_BYTES + (size_t)IN_DIM * 4096 * 2 + (size_t)u * 16) = (u32x4){0u, 0u, 0u, 0u};
            } else {
                for (int r = gw; r < I_OUT; r += NGW) { const int kb = r / 128, nb = r % 128;
                    p0_transpose_item(a.in[18] + (size_t)l * 4096 * 4096, 4096, 4096, (bf16*)(a.ws + WS_BOUT + l * BOUT_BYTES), nb * 32, scr, kb * 64, nb * 32, lane); }
            }
        }
        if (rope) { f32x2* rt = (f32x2*)(a.ws + WS_ROPE);
            for (int idx = vb * 512 + tid; idx < 4096 * 32; idx += nvb * 512) { const int pos = idx >> 5, i = idx & 31;
                const double inv = exp2(-(double)i * (13.287712379549449 / 32.0)); const double ang = (double)pos * inv;
                rt[idx] = (f32x2){(float)cos(ang), (float)sin(ang)}; } }
    }
}
#ifndef SPLIT_PROLOGUE
#define SPLIT_PROLOGUE 0
#endif
__device__ __forceinline__ void phase_prologue(const Args& a, LAS unsigned char* lds, int G) {
#if SPLIT_PROLOGUE
    prologue_work(a, lds, (int)blockIdx.x, G, 1, 0x7, true);
#else
    prologue_work(a, lds, (int)blockIdx.x, G, 3, 0xF, true);
#endif
}

__device__ __forceinline__ int row_j(int row) { return (row < MP) ? (row >> 12) : (4 + ((row - MP) >> 4)); }
__device__ __forceinline__ void stage_params(const Args& a, LAS float* pl, int tid, int mode  , int j) {
    const float* mod = (const float*)(a.ws + WS_MOD); const float* g_pre = a.in[10]; const float* g_post = a.in[11];
    for (int c = tid * 4; c < D; c += 2048) {
        if (mode == 0) { const float* mr = mod + (size_t)j * 12288;
            *(LAS f32x4*)(pl + 4096 + c) = *(const f32x4*)(g_pre + c) * (*(const f32x4*)(mr + 4096 + c) + 1.0f); *(LAS f32x4*)(pl + 8192 + c) = *(const f32x4*)(mr + c); }
        else { const int l = mode - 1; const float* mr = mod + ((size_t)l * 20 + j) * 12288;
            *(LAS f32x4*)(pl + c) = *(const f32x4*)(mr + 8192 + c) * *(const f32x4*)(g_post + (size_t)l * D + c);
            if (l == 0) { const float* m1 = mod + ((size_t)20 + j) * 12288;
                *(LAS f32x4*)(pl + 4096 + c) = *(const f32x4*)(g_pre + D + c) * (*(const f32x4*)(m1 + 4096 + c) + 1.0f); *(LAS f32x4*)(pl + 8192 + c) = *(const f32x4*)(m1 + c); } }
    }
}
template <int mode> __device__ __forceinline__ void phase_rows(const Args& a, LAS unsigned char* lds, int G) {
    const int tid = tid_opaque(), wave = tid >> 6;
    LAS float* pl = (LAS float*)lds;
    const bf16* Y = (const bf16*)(a.ws + WS_P); const float* ysq = (const float*)(a.ws + WS_YSQ);
    bf16* H = (bf16*)(a.ws + WS_HO);
    const int rpb = (M + G - 1) / G;
    const int r0 = blockIdx.x * rpb, r1 = (r0 + rpb < M) ? r0 + rpb : M;
    int cur_j = -1;
    for (int rb = r0; rb < r1; rb += 8) {
        const int jg = row_j(rb);
        if (jg != cur_j) { __syncthreads(); stage_params(a, pl, tid, mode, jg); cur_j = jg; __syncthreads(); }
        const int row = rb + wave;
        if (row >= r1) continue;
        const int lane = tid_opaque() & 63;
        const bool fast = row_j(row) == cur_j;
        float* orow = (row < MP) ? a.out + O_YP + (size_t)row * D : a.out + O_YS + (size_t)(row - MP) * D;
        const float* xr = (mode == 2) ? orow : ((row < MP) ? a.in[0] + (size_t)row * D : a.in[1] + (size_t)(row - MP) * D);
        f32x4 v[16]; float s = 0.f;
        if (mode == 0) {
#pragma unroll
            for (int q = 0; q < 16; ++q) { v[q] = *(const f32x4*)(xr + 4 * lane + 256 * q); s += (v[q][0] * v[q][0] + v[q][1] * v[q][1]) + (v[q][2] * v[q][2] + v[q][3] * v[q][3]); }
        } else {
            const int l = mode - 1; const int j = row_j(row);
            const bf16* yrow = (row < MP) ? Y + (size_t)row * D : (const bf16*)(a.ws + WS_YS) + (size_t)(row - MP) * D;
            const float rstd_y = rsqrtf(wave_sum(ysq[(size_t)row * 64 + lane]) * (1.f / D) + EPS);
            const float* mr = (const float*)(a.ws + WS_MOD) + ((size_t)l * 20 + j) * 12288; const float* gp = a.in[11] + (size_t)l * D;
#pragma unroll
            for (int hb = 0; hb < 2; ++hb) {
                u32x2 yw[8];
#pragma unroll
                for (int q8 = 0; q8 < 8; ++q8) { const int q = hb * 8 + q8, c = 4 * lane + 256 * q; v[q] = *(const f32x4*)(xr + c); yw[q8] = *(const u32x2*)(yrow + c); }
#pragma unroll
                for (int q8 = 0; q8 < 8; ++q8) { const int q = hb * 8 + q8, c = 4 * lane + 256 * q; const f32x4 y = (f32x4){bflo(yw[q8].x), bfhi(yw[q8].x), bflo(yw[q8].y), bfhi(yw[q8].y)};
                    const f32x4 pa = fast ? *(const LAS f32x4*)(pl + c) : (*(const f32x4*)(mr + 8192 + c) * *(const f32x4*)(gp + c));
                    v[q] = v[q] + pa * (y * rstd_y);
#if defined(DBG_MEAS) || defined(DBG_MEASC) || defined(DBG_CLK)
                    if (l == 1 && row >= MP && (unsigned)(row - MP) < ((const unsigned*)(a.ws + WS_CTL))[2000]) v[q] = (f32x4){0.f, 0.f, 0.f, 0.f};
#endif
                    s += (v[q][0] * v[q][0] + v[q][1] * v[q][1]) + (v[q][2] * v[q][2] + v[q][3] * v[q][3]);
                    *(f32x4*)(orow + c) = v[q]; }
            }
        }
        if (mode != 2) {
            const float rstd = rsqrtf(wave_sum(s) * (1.f / D) + EPS); const int j = row_j(row);
            const float* m1 = (const float*)(a.ws + WS_MOD) + ((size_t)(mode == 0 ? 0 : 20) + j) * 12288; const float* g1 = a.in[10] + (mode == 0 ? 0 : D);
#pragma unroll
            for (int q = 0; q < 16; ++q) { const int c = 4 * lane + 256 * q;
                const f32x4 pb = fast ? *(const LAS f32x4*)(pl + 4096 + c) : (*(const f32x4*)(g1 + c) * (*(const f32x4*)(m1 + 4096 + c) + 1.0f));
                const f32x4 pc = fast ? *(const LAS f32x4*)(pl + 8192 + c) : *(const f32x4*)(m1 + c);
                const f32x4 hv = v[q] * rstd * pb + pc; u32x2 w; w.x = cvtpk(hv[0], hv[1]); w.y = cvtpk(hv[2], hv[3]);
                *(u32x2*)(H + (size_t)row * D + c) = w; }
        }
    }
}


constexpr int L_KH = 0, L_QH = 18432, L_RT = 36864, L_XT = 77824, L_AI = 118784, L_DG = 129024, L_DI = 133120, L_GT = 135168;
constexpr int S128 = 144, S64 = 80;

__device__ __forceinline__ void phase_c1(const Args& a, int l, LAS unsigned char* lds, int G) {
    int tid, lane, wave, fr, fq;
#define RELANE() do { tid = tid_opaque(); lane = tid & 63; wave = __builtin_amdgcn_readfirstlane(tid >> 6); fr = lane & 15; fq = lane >> 4; } while (0)
    RELANE();
    const bf16* P = (const bf16*)(a.ws + WS_P);
    float* decbuf = (float*)(a.ws + WS_DEC);
    const float* conv_w = a.in[13] + (size_t)l * 4 * 6144;
    LAS bf16* KH = (LAS bf16*)(lds + L_KH); LAS bf16* QH = (LAS bf16*)(lds + L_QH); LAS bf16* RT = (LAS bf16*)(lds + L_RT); LAS bf16* XT = (LAS bf16*)(lds + L_XT);
    LAS bf16* AI = (LAS bf16*)(lds + L_AI); LAS float* DG = (LAS float*)(lds + L_DG); LAS bf16* DI = (LAS bf16*)(lds + L_DI);
    LAS unsigned char* STG = lds + L_XT;
    LAS float* g_beta = (LAS float*)(lds + L_GT); LAS float* g_gc = g_beta + 64; LAS float* g_egc = g_beta + 128; LAS float* g_misc = g_beta + 192;

    u32x4 raw[8]; unsigned gl = 0;
#define ITEM_PARAMS(it_, sample_, n_, c_, h_, ntok_, rowbase_) const bool sample_ = (it_) >= 4096; int n_, c_, h_, ntok_; size_t rowbase_; \
        if (!sample_) { h_ = (it_) & 15; c_ = ((it_) >> 4) & 63; n_ = (it_) >> 10; rowbase_ = (size_t)n_ * 4096 + c_ * 64; ntok_ = 64; } \
        else { const int s_ = (it_) - 4096; h_ = s_ & 15; n_ = s_ >> 4; c_ = 0; rowbase_ = (size_t)MP + n_ * 16; ntok_ = 16; }
#define PREFETCH(it_) do { ITEM_PARAMS(it_, ps_, pn_, pc_, ph_, pnt_, prb_); const int pt_ = tid_opaque(); \
        if (pt_ < 384) { const int pch0_ = (pt_ >> 7) * 2048 + ph_ * 128 + (pt_ & 15) * 8, pt0_ = ((pt_ >> 4) & 7) * 8; \
            _Pragma("unroll") for (int i = 0; i < 8; ++i) { const int tt = pt0_ + i; raw[i] = (u32x4){0u, 0u, 0u, 0u}; \
                if (tt < pnt_) raw[i] = *(const u32x4*)(P + (prb_ + tt) * NP + pch0_); } } \
        else { const int ptz_ = pt_ - 384; \
            if (ptz_ < 64 && ptz_ < pnt_) gl = (unsigned)P[(prb_ + ptz_) * NP + C_B + ph_] | ((unsigned)P[(prb_ + ptz_) * NP + C_A + ph_] << 16); } } while (0)

#ifdef DBG_MEASC
    unsigned long long dmacc_ = 0; const unsigned long long dmt0_ = __builtin_amdgcn_s_memtime(); unsigned long long dml_ = dmt0_;
#define DM(k) do { const unsigned long long n_ = __builtin_amdgcn_s_memtime(); if ((k) == DBG_MEASC) dmacc_ += n_ - dml_; dml_ = n_; } while (0)
#else
#define DM(k) do {} while (0)
#endif
    for (int item = blockIdx.x; item < NREC; item += G) {
        ITEM_PARAMS(item, sample, n, c, h, ntok, rowbase);
        const int reci = sample ? item : ((n * 16 + h) * 64 + c);
        unsigned char* rec = a.ws + WS_REC + (size_t)reci * REC_BYTES;
        const bool last = sample || (c == 63);
        DM(5); BAR_LDS(); DM(0);
        PREFETCH(item);
        RELANE();
        f32x2 val2[8][4];
        float ssq[8];
        int g = 3, cgl, seg;
        if (tid < 384) {
            cgl = tid & 15; g = __builtin_amdgcn_readfirstlane(tid >> 7); seg = (tid >> 4) & 7;
            const int ch0 = g * 2048 + h * 128 + cgl * 8;
            const int t0 = seg * 8;
            f32x4 wq[4][2];
#pragma unroll
            for (int j = 0; j < 4; ++j) { wq[j][0] = *(const f32x4*)(conv_w + (size_t)j * 6144 + ch0); wq[j][1] = *(const f32x4*)(conv_w + (size_t)j * 6144 + ch0 + 4); }
            u32x4 hist[3];
#pragma unroll
            for (int i = 0; i < 3; ++i) { const int tt = t0 - 3 + i; hist[i] = (u32x4){0u, 0u, 0u, 0u};
                if (tt < ntok && (tt >= 0 || (!sample && c > 0))) hist[i] = *(const u32x4*)(P + (rowbase + tt) * NP + ch0); }
            if (sample && seg == 0) {
                const float* sc = a.in[2] + (((size_t)l * 16 + n) * 3) * 6144 + ch0;
#pragma unroll
                for (int i = 0; i < 3; ++i) { const f32x4 s0 = *(const f32x4*)(sc + (size_t)i * 6144), s1 = *(const f32x4*)(sc + (size_t)i * 6144 + 4);
                    hist[i].x = cvtpk(s0[0], s0[1]); hist[i].y = cvtpk(s0[2], s0[3]); hist[i].z = cvtpk(s1[0], s1[1]); hist[i].w = cvtpk(s1[2], s1[3]); }
            }
            f32x2 sq2[8];
#pragma unroll
            for (int tok = 0; tok < 8; ++tok) sq2[tok] = (f32x2){0.f, 0.f};
#pragma unroll
            for (int cp = 0; cp < 4; ++cp) {
                f32x2 w2[4], x2[11];
#pragma unroll
                for (int j = 0; j < 4; ++j) w2[j] = (f32x2){wq[j][cp >> 1][2 * (cp & 1)], wq[j][cp >> 1][2 * (cp & 1) + 1]};
#pragma unroll
                for (int r = 0; r < 11; ++r) { const unsigned dw = (r < 3) ? hist[r < 3 ? r : 0][cp] : raw[r >= 3 ? r - 3 : 0][cp]; x2[r] = (f32x2){bflo(dw), bfhi(dw)}; }
#pragma unroll
                for (int tok = 0; tok < 8; ++tok) {
                    const f32x2 y = w2[0] * x2[tok] + w2[1] * x2[tok + 1] + w2[2] * x2[tok + 2] + w2[3] * x2[tok + 3];
                    const f32x2 t = y * -1.4426950408889634f; f32x2 e; e.x = __builtin_amdgcn_exp2f(t.x); e.y = __builtin_amdgcn_exp2f(t.y);
                    const f32x2 d = e + 1.0f; f32x2 r; r.x = __builtin_amdgcn_rcpf(d.x); r.y = __builtin_amdgcn_rcpf(d.y);
                    f32x2 v = y * r; if (!((t0 + tok) < ntok)) v = (f32x2){0.f, 0.f};
                    val2[tok][cp] = v; sq2[tok] += v * v; }
            }
#pragma unroll
            for (int tok = 0; tok < 8; ++tok) ssq[tok] = sq2[tok].x + sq2[tok].y;
            if (last && seg == (sample ? 1 : 7)) {
#pragma unroll
                for (int tok = 5; tok < 8; ++tok) { float rf[8]; unpack8(raw[tok], rf);
                    float* co = sample ? a.out + O_CONVS + (((size_t)l * 16 + n) * 3 + (tok - 5)) * 6144 + ch0 : a.out + O_CONVP + (((size_t)l * 4 + n) * 3 + (tok - 5)) * 6144 + ch0;
                    *(f32x4*)co = (f32x4){rf[0], rf[1], rf[2], rf[3]}; *(f32x4*)(co + 4) = (f32x4){rf[4], rf[5], rf[6], rf[7]}; }
            }
#pragma unroll
            for (int tok = 0; tok < 8; ++tok) ssq[tok] = sum16(ssq[tok]);
        } else {
            const int tz = tid - 384; cgl = tz & 15; seg = tz >> 4;
            if (wave == 6) {
                float beta = 0.f, gg = 0.f;
                if (lane < ntok) { const float b = bflo(gl), av = bfhi(gl);
                    beta = sigmoid_f(b); const float xx = av + a.in[15][l * 16 + h]; const float sp = fmaxf(xx, 0.f) + log1pf(__expf(-fabsf(xx)));
                    gg = -__expf(a.in[14][l * 16 + h]) * sp; }
                float gc = gg;
#pragma unroll
                for (int o = 1; o < 64; o <<= 1) { const float t = __shfl_up(gc, o); if (lane >= o) gc += t; }
                g_beta[lane] = beta; g_gc[lane] = gc; g_egc[lane] = __expf(gc);
                const float gcl = __shfl(gc, 63);
                if (lane == 0) { g_misc[0] = gcl; decbuf[reci] = __expf(gcl); }
            }
        }
        DM(1); BAR_LDS(); DM(2);
#ifndef DBG_C1_REP
#define DBG_C1_REP 0
#endif
        for (int rp1_ = 0; rp1_ < ((DBG_C1_REP) & 1) + 1; ++rp1_)
        {
            { const int t1 = tid_opaque(); cgl = t1 & 15; seg = (t1 >> 4) & 7; }
            const int t0 = seg * 8;
            float bt[8], gcv[8], eg[8];
            { const f32x4 b0 = *(const LAS f32x4*)(g_beta + t0), b1 = *(const LAS f32x4*)(g_beta + t0 + 4), c0 = *(const LAS f32x4*)(g_gc + t0), c1 = *(const LAS f32x4*)(g_gc + t0 + 4),
                  e0 = *(const LAS f32x4*)(g_egc + t0), e1 = *(const LAS f32x4*)(g_egc + t0 + 4);
#pragma unroll
              for (int i = 0; i < 4; ++i) { bt[i] = b0[i]; bt[4 + i] = b1[i]; gcv[i] = c0[i]; gcv[4 + i] = c1[i]; eg[i] = e0[i]; eg[4 + i] = e1[i]; } }
            const float gcl = g_misc[0];
            const int qs0 = ((cgl * 8) & 15) >> 2, half0 = ((cgl * 8) >> 4) & 1, ks0 = (cgl * 8) >> 5;
            const int tq0 = (t0 & 15) >> 2, thalf = (t0 >> 4) & 1, tks = t0 >> 5;
            if (g == 0) {
#pragma unroll
                for (int tok = 0; tok < 8; ++tok) { const int t = t0 + tok; const float r = rsqrtf(ssq[tok] + EPS) * 0.08838834764831845f; f32x2 qv[4];
#pragma unroll
                    for (int i = 0; i < 4; ++i) qv[i] = val2[tok][i] * r;
                    *(LAS u32x4*)(QH + t * S128 + cgl * 8) = pack8v(qv);
                    const float e = eg[tok];
                    const int fq_ = (t >> 4) * 4 + ks0; LAS unsigned char* fp = STG + fq_ * 1024 + ((((t & 15) + 16 * qs0) ^ (fq_ & 7)) * 16) + 8 * half0;
#pragma unroll
                    for (int i = 0; i < 4; ++i) qv[i] = qv[i] * e;
                    u32x2 w0, w1; w0.x = cvtpk(qv[0].x, qv[0].y); w0.y = cvtpk(qv[1].x, qv[1].y); w1.x = cvtpk(qv[2].x, qv[2].y); w1.y = cvtpk(qv[3].x, qv[3].y);
                    *(LAS u32x2*)fp = w0; *(LAS u32x2*)(fp + 256) = w1; }
            } else if (g == 1) {
#pragma unroll
                for (int tok = 0; tok < 8; ++tok) { const float r = rsqrtf(ssq[tok] + EPS);
#pragma unroll
                    for (int i = 0; i < 4; ++i) val2[tok][i] = val2[tok][i] * r;
                    *(LAS u32x4*)(KH + (t0 + tok) * S128 + cgl * 8) = pack8v(val2[tok]); }
                float f1[8], f2[8];
#pragma unroll
                for (int tok = 0; tok < 8; ++tok) { f1[tok] = bt[tok] * eg[tok]; f2[tok] = __expf(gcl - gcv[tok]); }
#pragma unroll
                for (int ip = 0; ip < 4; ++ip) {
                    f32x2 rr[8], kd[8];
#pragma unroll
                    for (int tok = 0; tok < 8; ++tok) { rr[tok] = val2[tok][ip] * f1[tok]; kd[tok] = val2[tok][ip] * f2[tok]; }
#pragma unroll
                    for (int hh = 0; hh < 2; ++hh) { const int i = 2 * ip + hh, d = cgl * 8 + i;
                        u32x4 rw; rw.x = cvtpk(rr[0][hh], rr[1][hh]); rw.y = cvtpk(rr[2][hh], rr[3][hh]); rw.z = cvtpk(rr[4][hh], rr[5][hh]); rw.w = cvtpk(rr[6][hh], rr[7][hh]);
                        *(LAS u32x4*)(RT + (128 + i * 16 + cgl) * S64 + t0) = rw;
                        const int fk_ = 16 + (d >> 4) * 2 + tks; LAS unsigned char* fp = STG + fk_ * 1024 + ((((d & 15) + 16 * tq0) ^ (fk_ & 7)) * 16) + 8 * thalf;
                        u32x2 w0, w1; w0.x = cvtpk(kd[0][hh], kd[1][hh]); w0.y = cvtpk(kd[2][hh], kd[3][hh]); w1.x = cvtpk(kd[4][hh], kd[5][hh]); w1.y = cvtpk(kd[6][hh], kd[7][hh]);
                        *(LAS u32x2*)fp = w0; *(LAS u32x2*)(fp + 256) = w1; } }
            } else if (g == 2) {
#pragma unroll
                for (int ip = 0; ip < 4; ++ip) { f32x2 rr[8];
#pragma unroll
                    for (int tok = 0; tok < 8; ++tok) rr[tok] = val2[tok][ip] * bt[tok];
#pragma unroll
                    for (int hh = 0; hh < 2; ++hh) { const int i = 2 * ip + hh;
                        u32x4 rw; rw.x = cvtpk(rr[0][hh], rr[1][hh]); rw.y = cvtpk(rr[2][hh], rr[3][hh]); rw.z = cvtpk(rr[4][hh], rr[5][hh]); rw.w = cvtpk(rr[6][hh], rr[7][hh]);
                        *(LAS u32x4*)(RT + (i * 16 + cgl) * S64 + t0) = rw; } }
            }
        }
        DM(3); BAR_LDS(); DM(4);
#if defined(DBG_C1_STOP) && DBG_C1_STOP <= 1
        continue;
#endif
        RELANE();
        for (int rp2_ = 0; rp2_ < (((DBG_C1_REP) >> 1) & 1) + 1; ++rp2_)
#pragma unroll
        for (int k2 = 0; k2 < 2; ++k2) {
            const int tile = wave * 2 + k2, ti = tile >> 2, tj = tile & 3;
            f32x4 acq = (f32x4){0.f, 0.f, 0.f, 0.f}, ack = (f32x4){0.f, 0.f, 0.f, 0.f};
#pragma unroll
            for (int ks = 0; ks < 4; ++ks) {
                const bf16x8 kj = *(const LAS bf16x8*)(KH + (16 * tj + fr) * S128 + 32 * ks + 8 * fq);
                const bf16x8 qi = *(const LAS bf16x8*)(QH + (16 * ti + fr) * S128 + 32 * ks + 8 * fq);
                acq = __builtin_amdgcn_mfma_f32_16x16x32_bf16(kj, qi, acq, 0, 0, 0);
                if (ti >= tj) { const bf16x8 ki = *(const LAS bf16x8*)(KH + (16 * ti + fr) * S128 + 32 * ks + 8 * fq);
                    ack = __builtin_amdgcn_mfma_f32_16x16x32_bf16(ki, kj, ack, 0, 0, 0); }
            }
            {
                const int i = 16 * ti + fr; const float gi = g_gc[i]; const f32x4 gj = *(const LAS f32x4*)(g_gc + 16 * tj + 4 * fq); float o[4];
#pragma unroll
                for (int r = 0; r < 4; ++r) { const int j = 16 * tj + 4 * fq + r; o[r] = (i >= j) ? acq[r] * __expf(fminf(gi - gj[r], 0.f)) : 0.f; }
                u32x2 w; w.x = cvtpk(o[0], o[1]); w.y = cvtpk(o[2], o[3]);
                { const int fk2_ = 32 + ti * 2 + (tj >> 1); *(LAS u32x2*)(STG + fk2_ * 1024 + ((lane ^ (fk2_ & 7)) * 16) + 8 * (tj & 1)) = w; }
            }
            if (ti >= tj) {
                const int j = 16 * tj + fr; const float gj = g_gc[j]; const f32x4 gi = *(const LAS f32x4*)(g_gc + 16 * ti + 4 * fq), bi = *(const LAS f32x4*)(g_beta + 16 * ti + 4 * fq);
#pragma unroll
                for (int r = 0; r < 4; ++r) { const int i = 16 * ti + 4 * fq + r; const float v = (i > j) ? bi[r] * ack[r] * __expf(fminf(gi[r] - gj, 0.f)) : 0.f;
                    AI[i * S64 + j] = (bf16)(cvtpk(v, 0.f) & 0xffffu);
                    if (ti == tj) DG[(ti * 16 + (i & 15)) * 16 + fr] = v; }
            }
        }
        BAR_LDS();
#if defined(DBG_C1_STOP) && DBG_C1_STOP <= 2
        continue;
#endif
        RELANE();
#pragma unroll
        for (int k5 = 0; k5 < 5; ++k5) { const int u = tid + 512 * k5, fu_ = u >> 6; *(u32x4*)(rec + REC_QD + (size_t)u * 16) = *(const LAS u32x4*)(STG + fu_ * 1024 + (((u & 63) ^ (fu_ & 7)) * 16)); }
        for (int rp3_ = 0; rp3_ < (((DBG_C1_REP) >> 2) & 1) + 1; ++rp3_)
        if (wave == 0) {
            const int b = fq, cc = fr; float x[16];
            {   f32x4 dg[10][3];
#pragma unroll
                for (int r = 1; r < 10; ++r)
#pragma unroll
                    for (int j4 = 0; j4 < (r + 3) / 4; ++j4) dg[r][j4] = *(const LAS f32x4*)(DG + (b * 16 + r) * 16 + 4 * j4);
                __builtin_amdgcn_sched_barrier(0);
#pragma unroll
                for (int r = 0; r < 10; ++r) { float s = (r == cc) ? 1.f : 0.f;
#pragma unroll
                    for (int j = 0; j < r; ++j) s -= dg[r][j >> 2][j & 3] * x[j];
                    x[r] = s; DI[(b * 16 + r) * 16 + cc] = (bf16)(cvtpk(s, 0.f) & 0xffffu); } }
            __builtin_amdgcn_sched_barrier(0);
            {   f32x4 dg[6][4];
#pragma unroll
                for (int r = 10; r < 16; ++r)
#pragma unroll
                    for (int j4 = 0; j4 < (r + 3) / 4; ++j4) dg[r - 10][j4] = *(const LAS f32x4*)(DG + (b * 16 + r) * 16 + 4 * j4);
                __builtin_amdgcn_sched_barrier(0);
#pragma unroll
                for (int r = 10; r < 16; ++r) { float s = (r == cc) ? 1.f : 0.f;
#pragma unroll
                    for (int j = 0; j < r; ++j) s -= dg[r - 10][j >> 2][j & 3] * x[j];
                    x[r] = s; DI[(b * 16 + r) * 16 + cc] = (bf16)(cvtpk(s, 0.f) & 0xffffu); } }
        }
        BAR_LDS();
#if defined(DBG_C1_STOP) && DBG_C1_STOP <= 3
        continue;
#endif
        for (int rp4_ = 0; rp4_ < (((DBG_C1_REP) >> 3) & 1) + 1; ++rp4_)
#pragma unroll
        for (int b = 0; b < 4; ++b) {
            RELANE();
#pragma unroll
            for (int k2 = 0; k2 < 2; ++k2) {
                const int nt = wave * 2 + k2;
                f32x4 y = (f32x4){0.f, 0.f, 0.f, 0.f};
#pragma unroll
                for (int ks = 0; ks < (b + 1) / 2; ++ks) {
                    const bool ok = (32 * ks + 8 * fq) < 16 * b;
                    u32x4 av = *(const LAS u32x4*)(AI + (16 * b + fr) * S64 + 32 * ks + 8 * fq), xv = *(const LAS u32x4*)(XT + (16 * nt + fr) * S64 + 32 * ks + 8 * fq);
                    if (!ok) { av = (u32x4){0u, 0u, 0u, 0u}; xv = (u32x4){0u, 0u, 0u, 0u}; }
                    y = __builtin_amdgcn_mfma_f32_16x16x32_bf16(as_bf16x8(av), as_bf16x8(xv), y, 0, 0, 0);
                }
                const int rn = 16 * nt + fr; const u32x2 rv = *(const LAS u32x2*)(RT + ((rn & 128) + (rn & 7) * 16 + ((rn & 127) >> 3)) * S64 + 16 * b + 4 * fq);
                const float z0 = bflo(rv.x) - y[0], z1 = bfhi(rv.x) - y[1], z2 = bflo(rv.y) - y[2], z3 = bfhi(rv.y) - y[3];
                u32x2 zb; zb.x = cvtpk(z0, z1); zb.y = cvtpk(z2, z3);
                const u32x2 dv = *(const LAS u32x2*)(DI + (b * 16 + fr) * 16 + 4 * fq);
                const f32x4 xo = __builtin_amdgcn_mfma_f32_16x16x16bf16_1k(as_bf16x4(dv), as_bf16x4(zb), (f32x4){0.f, 0.f, 0.f, 0.f}, 0, 0, 0);
                u32x2 xw; xw.x = cvtpk(xo[0], xo[1]); xw.y = cvtpk(xo[2], xo[3]);
                *(LAS u32x2*)(XT + (16 * nt + fr) * S64 + 16 * b + 4 * fq) = xw;
                if (nt < 8) *(u32x2*)(rec + REC_U + (size_t)(((nt * 4 + b) * 64 + lane) * 8)) = xw;
            }
            LDS_WAIT(); asm volatile("" ::: "memory");
        }
        BAR_LDS();
#if defined(DBG_C1_STOP) && DBG_C1_STOP <= 4
        continue;
#endif
        RELANE();
        for (int rp5_ = 0; rp5_ < (((DBG_C1_REP) >> 4) & 1) + 1; ++rp5_)
#pragma unroll
        for (int k2 = 0; k2 < 2; ++k2) {
            const int u = tid + 512 * k2, frag = u >> 6, tt = frag >> 2, ks = frag & 3;
            float wv[8];
#pragma unroll
            for (int j = 0; j < 8; ++j) wv[j] = bf1(XT[(128 + 32 * ks + 16 * (j >> 2) + 4 * fq + (j & 3)) * S64 + 16 * tt + fr]);
            *(u32x4*)(rec + REC_W + (size_t)((frag * 64 + lane) * 16)) = pack8(wv);
        }
    }
#ifdef DBG_MEASC
    if (l == 1 && blockIdx.x == 0 && tid_opaque() == 0) { DM(5); const unsigned long long tot_ = __builtin_amdgcn_s_memtime() - dmt0_; const float fr_ = (float)dmacc_ / (float)tot_;
        ((unsigned*)(a.ws + WS_CTL))[2000] = 32u * (unsigned)(fr_ * 8.0f + 0.5f); }
#endif
#undef DM
#undef RELANE
#undef PREFETCH
#undef ITEM_PARAMS
}


constexpr int L_SS = 2 * REC_STAGE, L_RS = L_SS + 2048, L_DN = L_RS + 256, L_OB = L_DN + 512, OBS = 136;
__device__ __forceinline__ void scan_seq(const Args& a, int l, LAS unsigned char* lds, int seq) {
    int tid = tid_opaque(), lane = tid & 63, wave = __builtin_amdgcn_readfirstlane(tid >> 6);
    int fr = lane & 15, fq = lane >> 4;
    const bool sample = seq >= 64;
    const int s2 = sample ? seq - 64 : seq, n = s2 >> 4, h = s2 & 15;
    const int nsteps = sample ? 1 : 64, ntok = sample ? 16 : 64;
    const int rec0 = sample ? 4096 + s2 : s2 * 64;
    const size_t rowbase0 = sample ? (size_t)MP + n * 16 : (size_t)n * 4096;
    const unsigned char* recs = a.ws + WS_REC;
    const float* decbuf = (const float*)(a.ws + WS_DEC);
    bf16* Ob = (bf16*)(a.ws + WS_HO);
    LAS float* ss = (LAS float*)(lds + L_SS); LAS float* rs = (LAS float*)(lds + L_RS); LAS bf16* ob = (LAS bf16*)(lds + L_OB);
    f32x4 st[8];
    if (sample) { const float* s0 = a.in[3] + (((size_t)l * 16 + n) * 16 + h) * 16384;
#pragma unroll
        for (int t = 0; t < 8; ++t)
#pragma unroll
            for (int j = 0; j < 4; ++j) st[t][j] = s0[(16 * t + 4 * fq + j) * 128 + 16 * wave + fr];
    } else {
#pragma unroll
        for (int t = 0; t < 8; ++t) st[t] = (f32x4){0.f, 0.f, 0.f, 0.f};
    }
    __syncthreads();
    {   const unsigned char* src = recs + (size_t)rec0 * REC_BYTES;
#pragma unroll
        for (int k = 0; k < 7; ++k) { const int p = wave * 7 + k;
            __builtin_amdgcn_global_load_lds((const unsigned*)(src + p * 1024 + lane * 16), (LAS unsigned*)(lds + p * 1024), 16, 0, 0); } }
    u32x2 u_cur[4], u_nxt[4]; float dec_cur, dec_nxt = 0.f; f32x4 o_prev[4];
    u32x4 zq[2], zn[2]; LAS float* dnl = (LAS float*)(lds + L_DN);
    if (tid < 128) dnl[tid] = a.in[16][(size_t)l * 128 + tid];
    zq[0] = zq[1] = zn[0] = zn[1] = (u32x4){0u, 0u, 0u, 0u};
    {   const unsigned char* rec = recs + (size_t)rec0 * REC_BYTES;
#pragma unroll
        for (int t = 0; t < 4; ++t) { u_cur[t] = *(const u32x2*)(rec + REC_U + ((wave * 4 + t) * 64 + lane) * 8); u_nxt[t] = u_cur[t]; o_prev[t] = (f32x4){0.f, 0.f, 0.f, 0.f}; }
        dec_cur = decbuf[rec0]; }
#define SCAN_STORE(cc) do {   \
        _Pragma("unroll") for (int t = 0; t < 4; ++t) { const f32x4 r4 = *(const LAS f32x4*)(rs + 16 * t + 4 * fq); \
            _Pragma("unroll") for (int j = 0; j < 4; ++j) ob[(16 * t + 4 * fq + j) * OBS + 16 * wave + fr] = (bf16)(cvtpk(o_prev[t][j] * r4[j], 0.f) & 0xffffu); } } while (0)
#define SCAN_ZLOAD(cc, Z) do { const int tok_ = tid >> 3; if (tok_ < ntok) { const bf16* zp_ = (const bf16*)(a.ws + WS_P) + (rowbase0 + (size_t)(cc) * 64 + tok_) * NP + C_ZDN + h * 128 + (tid & 7) * 8; \
            Z[0] = *(const u32x4*)zp_; Z[1] = *(const u32x4*)(zp_ + 64); } } while (0)
#define SCAN_FLUSH(cc, Z) do {   \
        const int tok_ = tid >> 3, pc_ = tid & 7; \
        if (tok_ < ntok) { bf16* op_ = Ob + (rowbase0 + (size_t)(cc) * 64 + tok_) * D + h * 128 + pc_ * 8; \
            _Pragma("unroll") for (int hh = 0; hh < 2; ++hh) { float ov_[8], zv_[8]; unpack8(*(const LAS u32x4*)(ob + tok_ * OBS + 64 * hh + pc_ * 8), ov_); unpack8(Z[hh], zv_); \
                _Pragma("unroll") for (int i = 0; i < 8; ++i) ov_[i] = ov_[i] * zv_[i];     \
                *(u32x4*)(op_ + 64 * hh) = pack8(ov_); } } } while (0)
#define SCAN_RS() do { if (tid < 64) { float tsum = 0.f; \
            _Pragma("unroll") for (int w8 = 0; w8 < 8; ++w8) tsum += ss[w8 * 64 + tid]; \
            rs[tid] = rsqrtf(tsum * (1.f / 128.f) + EPS); } } while (0)
#ifdef DBG_MEAS
    unsigned long long dbg_w_ = 0, dbg_b_ = 0, dbg_b2_ = 0; const unsigned long long dbg_t0_ = __builtin_amdgcn_s_memtime(); const unsigned long long dbg_r0_ = __builtin_amdgcn_s_memrealtime();
#endif
    for (int c = 0; c < nsteps; ++c) {
        tid = tid_opaque(); lane = tid & 63; wave = __builtin_amdgcn_readfirstlane(tid >> 6); fr = lane & 15; fq = lane >> 4;
        const LAS unsigned char* buf = lds + (c & 1) * REC_STAGE;
        const unsigned char* rec = recs + (size_t)(rec0 + c) * REC_BYTES;
#ifdef DBG_MEAS
        const unsigned long long tm0_ = __builtin_amdgcn_s_memtime();
        VM_WAIT();
        const unsigned long long tm1_ = __builtin_amdgcn_s_memtime();
        __syncthreads();
        const unsigned long long tm2_ = __builtin_amdgcn_s_memtime();
        dbg_w_ += tm1_ - tm0_; dbg_b_ += tm2_ - tm1_;
#else
        VM_WAIT(); __syncthreads();
#endif; everybody is done with the other buffer; ss of step c-1 is complete
        if (c + 1 < nsteps) { const unsigned char* src = rec + REC_BYTES; LAS unsigned char* dst = lds + ((c + 1) & 1) * REC_STAGE;
#pragma unroll
            for (int k = 0; k < 7; ++k) { const int p = wave * 7 + k;
                __builtin_amdgcn_global_load_lds((const unsigned*)(src + p * 1024 + lane * 16), (LAS unsigned*)(dst + p * 1024), 16, 0, 0); }
#pragma unroll
            for (int t = 0; t < 4; ++t) u_nxt[t] = *(const u32x2*)(src + REC_U + ((wave * 4 + t) * 64 + lane) * 8);
            dec_nxt = decbuf[rec0 + c + 1]; }
        if (c > 0) SCAN_RS();
        if (c > 1) SCAN_FLUSH(c - 2, zn);
        if (c > 0) SCAN_ZLOAD(c - 1, zn);
        bf16x8 Bs[4];
#pragma unroll
        for (int ks = 0; ks < 4; ++ks) { u32x4 w; w.x = cvtpk(st[2 * ks][0], st[2 * ks][1]); w.y = cvtpk(st[2 * ks][2], st[2 * ks][3]); w.z = cvtpk(st[2 * ks + 1][0], st[2 * ks + 1][1]); w.w = cvtpk(st[2 * ks + 1][2], st[2 * ks + 1][3]); Bs[ks] = as_bf16x8(w); }
        f32x4 ws4[4], oacc[4];
        bf16x8 FX[8], FY[8];
#define LDG(F, off) do { _Pragma("unroll") for (int i_ = 0; i_ < 8; ++i_) F[i_] = *(const LAS bf16x8*)(buf + (off) + (i_ * 64 + lane) * 16); } while (0)
#define SB() __builtin_amdgcn_sched_barrier(0)
        LDG(FX, REC_W); LDG(FY, REC_W + 8192); SB();
#pragma unroll
        for (int i = 0; i < 8; ++i) ws4[i >> 2] = __builtin_amdgcn_mfma_f32_16x16x32_bf16(FX[i], Bs[i & 3], (i & 3) ? ws4[i >> 2] : (f32x4){0.f, 0.f, 0.f, 0.f}, 0, 0, 0);
        SB(); LDG(FX, REC_QD); SB();
#pragma unroll
        for (int i = 0; i < 8; ++i) ws4[2 + (i >> 2)] = __builtin_amdgcn_mfma_f32_16x16x32_bf16(FY[i], Bs[i & 3], (i & 3) ? ws4[2 + (i >> 2)] : (f32x4){0.f, 0.f, 0.f, 0.f}, 0, 0, 0);
        SB(); LDG(FY, REC_QD + 8192); SB();
#pragma unroll
        for (int i = 0; i < 8; ++i) oacc[i >> 2] = __builtin_amdgcn_mfma_f32_16x16x32_bf16(FX[i], Bs[i & 3], (i & 3) ? oacc[i >> 2] : (f32x4){0.f, 0.f, 0.f, 0.f}, 0, 0, 0);
        SB(); LDG(FX, REC_QK); SB();
#pragma unroll
        for (int i = 0; i < 8; ++i) oacc[2 + (i >> 2)] = __builtin_amdgcn_mfma_f32_16x16x32_bf16(FY[i], Bs[i & 3], (i & 3) ? oacc[2 + (i >> 2)] : (f32x4){0.f, 0.f, 0.f, 0.f}, 0, 0, 0);
        SB(); LDG(FY, REC_KD); SB();
        bf16x8 Bv[2];
        {   f32x4 vn[4];
#pragma unroll
            for (int t = 0; t < 4; ++t) vn[t] = (f32x4){bflo(u_cur[t].x), bfhi(u_cur[t].x), bflo(u_cur[t].y), bfhi(u_cur[t].y)} - ws4[t];
#pragma unroll
            for (int k2 = 0; k2 < 2; ++k2) { u32x4 w; w.x = cvtpk(vn[2 * k2][0], vn[2 * k2][1]); w.y = cvtpk(vn[2 * k2][2], vn[2 * k2][3]); w.z = cvtpk(vn[2 * k2 + 1][0], vn[2 * k2 + 1][1]); w.w = cvtpk(vn[2 * k2 + 1][2], vn[2 * k2 + 1][3]); Bv[k2] = as_bf16x8(w); } }
#pragma unroll
        for (int t = 0; t < 8; ++t) st[t] = st[t] * dec_cur;
        SB();
#pragma unroll
        for (int i = 0; i < 8; ++i) oacc[i >> 1] = __builtin_amdgcn_mfma_f32_16x16x32_bf16(FX[i], Bv[i & 1], oacc[i >> 1], 0, 0, 0);
        SB(); LDG(FX, REC_KD + 8192); SB();
#pragma unroll
        for (int i = 0; i < 8; ++i) st[i >> 1] = __builtin_amdgcn_mfma_f32_16x16x32_bf16(FY[i], Bv[i & 1], st[i >> 1], 0, 0, 0);
        SB();
#pragma unroll
        for (int i = 0; i < 8; ++i) st[4 + (i >> 1)] = __builtin_amdgcn_mfma_f32_16x16x32_bf16(FX[i], Bv[i & 1], st[4 + (i >> 1)], 0, 0, 0);
#undef LDG
#undef SB
#ifdef DBG_MEAS
        const unsigned long long tm3_ = __builtin_amdgcn_s_memtime();
#endif
        BAR_LDS();
#ifdef DBG_MEAS
        dbg_b2_ += __builtin_amdgcn_s_memtime() - tm3_;
#endif
        if (c > 0) SCAN_STORE(c - 1);
#pragma unroll
        for (int t = 0; t < 4; ++t) { f32x4 q = oacc[t] * oacc[t];
#pragma unroll
            for (int j = 0; j < 4; ++j) q[j] = sum16(q[j]);
            if (fr == 0) *(LAS f32x4*)(ss + wave * 64 + 16 * t + 4 * fq) = q; }
#pragma unroll
        for (int t = 0; t < 4; ++t) { o_prev[t] = oacc[t]; u_cur[t] = u_nxt[t]; }
        dec_cur = dec_nxt;
    }
#ifdef DBG_MEAS
    if (l == 1 && seq == 0 && tid == 0) { const unsigned long long tot_ = __builtin_amdgcn_s_memtime() - dbg_t0_; const unsigned long long rt_ = __builtin_amdgcn_s_memrealtime() - dbg_r0_;
        float fr_ = 0.f;
        if (DBG_MEAS == 1) fr_ = (float)dbg_w_ / (float)tot_; else if (DBG_MEAS == 2) fr_ = (float)dbg_b_ / (float)tot_; else if (DBG_MEAS == 3) fr_ = (float)dbg_b2_ / (float)tot_;
        else if (DBG_MEAS == 4) fr_ = (float)rt_ * 0.01f / 500.0f;
        else if (DBG_MEAS == 5) fr_ = (float)tot_ / (float)rt_ / 100.0f * 0.25f;
        ((unsigned*)(a.ws + WS_CTL))[2000] = 8u * (unsigned)(fr_ * 32.0f + 0.5f); }
#endif
    __syncthreads();
    SCAN_RS();
    if (nsteps > 1) SCAN_FLUSH(nsteps - 2, zn);
    SCAN_ZLOAD(nsteps - 1, zq);
    __syncthreads();
    SCAN_STORE(nsteps - 1);
    __syncthreads();
    SCAN_FLUSH(nsteps - 1, zq);
#undef SCAN_FLUSH
#undef SCAN_ZLOAD
#undef SCAN_STORE
#undef SCAN_RS
    {   float* so = sample ? a.out + O_DNS + (((size_t)l * 16 + n) * 16 + h) * 16384 : a.out + O_DNP + (((size_t)l * 4 + n) * 16 + h) * 16384;
#pragma unroll
        for (int t = 0; t < 8; ++t)
#pragma unroll
            for (int j = 0; j < 4; ++j) so[(16 * t + 4 * fq + j) * 128 + 16 * wave + fr] = st[t][j]; }
}

constexpr int L_KI = 0, L_VT = 30720, SKI = 80, SVT = 200;
__device__ __forceinline__ void attn_item(const Args& a, int l, LAS unsigned char* lds, int it) {
    const int tid = tid_opaque(), lane = tid & 63, wave = __builtin_amdgcn_readfirstlane(tid >> 6);
    const int fr = lane & 15, fq = lane >> 4;
    const bool sample = it >= 1024;
    const int kv = it & 3, c = sample ? 0 : ((it >> 2) & 63), n = sample ? ((it - 1024) >> 2) : (it >> 8);
    const bf16* P = (const bf16*)(a.ws + WS_P); const f32x2* rope = (const f32x2*)(a.ws + WS_ROPE);
    bf16* Ob = (bf16*)(a.ws + WS_HO);
    LAS bf16* KI = (LAS bf16*)(lds + L_KI); LAS bf16* VT = (LAS bf16*)(lds + L_VT);
    const int kt0 = sample ? 0 : ((c >= 2) ? 0 : (8 - 4 * c));
    const int nkt = sample ? 9 : 12, nqt = sample ? 1 : 4;
    const size_t qrow0 = sample ? (size_t)MP + n * 16 : (size_t)n * 4096 + c * 64;
    const int pos0 = sample ? PAST : c * 64;
    __syncthreads();
    if (!sample) {
#pragma unroll
        for (int k2 = 0; k2 < 2; ++k2) { const int u = tid + 512 * k2; if (u < 768) { const int key = u >> 2, dg = u & 3, tok = (c - 2) * 64 + key;
            if (tok >= 0) { const bf16* kp = P + ((size_t)n * 4096 + tok) * NP + C_AK + kv * 64 + dg * 8; float x1[8], x2[8], o1[8], o2[8];
                unpack8(*(const u32x4*)kp, x1); unpack8(*(const u32x4*)(kp + 32), x2);
#pragma unroll
                for (int j = 0; j < 8; ++j) { const f32x2 cs = rope[tok * 32 + dg * 8 + j]; o1[j] = x1[j] * cs.x - x2[j] * cs.y; o2[j] = x2[j] * cs.x + x1[j] * cs.y; }
                *(LAS u32x4*)(KI + key * SKI + dg * 8) = pack8(o1); *(LAS u32x4*)(KI + key * SKI + 32 + dg * 8) = pack8(o2);
                if (c == 63 && key >= 64) { float* ko = a.out + O_KP + ((((size_t)l * 4 + n) * 128 + (key - 64)) * 4 + kv) * 64 + dg * 8;
                    *(f32x4*)ko = (f32x4){o1[0], o1[1], o1[2], o1[3]}; *(f32x4*)(ko + 4) = (f32x4){o1[4], o1[5], o1[6], o1[7]};
                    *(f32x4*)(ko + 32) = (f32x4){o2[0], o2[1], o2[2], o2[3]}; *(f32x4*)(ko + 36) = (f32x4){o2[4], o2[5], o2[6], o2[7]}; } } } }
#pragma unroll
        for (int k3 = 0; k3 < 3; ++k3) { const int u = tid + 512 * k3, key = u >> 3, dg = u & 7, tok = (c - 2) * 64 + key;
            if (tok >= 0) { const u32x4 vw = *(const u32x4*)(P + ((size_t)n * 4096 + tok) * NP + C_AV + kv * 64 + dg * 8);
                const unsigned ww[4] = {vw.x, vw.y, vw.z, vw.w};
#pragma unroll
                for (int j = 0; j < 8; ++j) VT[(dg * 8 + j) * SVT + key] = (bf16)((j & 1) ? (ww[j >> 1] >> 16) : (ww[j >> 1] & 0xffffu));
                if (c == 63 && key >= 64) { float vf[8]; unpack8(vw, vf); float* vo = a.out + O_VP + ((((size_t)l * 4 + n) * 128 + (key - 64)) * 4 + kv) * 64 + dg * 8;
                    *(f32x4*)vo = (f32x4){vf[0], vf[1], vf[2], vf[3]}; *(f32x4*)(vo + 4) = (f32x4){vf[4], vf[5], vf[6], vf[7]}; } } }
    } else {
        const float* ck = a.in[4] + ((size_t)l * 16 + n) * 128 * 256 + kv * 64; const float* cv = a.in[5] + ((size_t)l * 16 + n) * 128 * 256 + kv * 64;
        float* kso = a.out + O_KS + (((size_t)l * 16 + n) * 128 * 4 + kv) * 64; float* vso = a.out + O_VS + (((size_t)l * 16 + n) * 128 * 4 + kv) * 64;
#pragma unroll
        for (int k2 = 0; k2 < 3; ++k2) { const int u = tid + 512 * k2; if (u < 144 * 8) { const int key = u >> 3, dg = u & 7; float kf[8], vf[8];
            if (key < 128) { const f32x4 k0 = *(const f32x4*)(ck + (size_t)key * 256 + dg * 8), k1 = *(const f32x4*)(ck + (size_t)key * 256 + dg * 8 + 4), v0 = *(const f32x4*)(cv + (size_t)key * 256 + dg * 8), v1 = *(const f32x4*)(cv + (size_t)key * 256 + dg * 8 + 4);
#pragma unroll
                for (int j = 0; j < 4; ++j) { kf[j] = k0[j]; kf[4 + j] = k1[j]; vf[j] = v0[j]; vf[4 + j] = v1[j]; } }
            else { const int t = key - 128; const bf16* kp = P + ((size_t)MP + n * 16 + t) * NP + C_AK + kv * 64; float x1[8], x2[8];
                const int d1 = (dg & 3) * 8; unpack8(*(const u32x4*)(kp + d1), x1); unpack8(*(const u32x4*)(kp + 32 + d1), x2);
#pragma unroll
                for (int j = 0; j < 8; ++j) { const f32x2 cs = rope[(PAST + t) * 32 + d1 + j]; kf[j] = (dg < 4) ? (x1[j] * cs.x - x2[j] * cs.y) : (x2[j] * cs.x + x1[j] * cs.y); }
                unpack8(*(const u32x4*)(P + ((size_t)MP + n * 16 + t) * NP + C_AV + kv * 64 + dg * 8), vf); }
            *(LAS u32x4*)(KI + key * SKI + dg * 8) = pack8(kf);
            const u32x4 vw = pack8(vf); const unsigned ww[4] = {vw.x, vw.y, vw.z, vw.w};
#pragma unroll
            for (int j = 0; j < 8; ++j) VT[(dg * 8 + j) * SVT + key] = (bf16)((j & 1) ? (ww[j >> 1] >> 16) : (ww[j >> 1] & 0xffffu));
            if (key >= 16) { float* ko = kso + (size_t)(key - 16) * 256 + dg * 8; float* vo = vso + (size_t)(key - 16) * 256 + dg * 8;
                *(f32x4*)ko = (f32x4){kf[0], kf[1], kf[2], kf[3]}; *(f32x4*)(ko + 4) = (f32x4){kf[4], kf[5], kf[6], kf[7]};
                *(f32x4*)vo = (f32x4){vf[0], vf[1], vf[2], vf[3]}; *(f32x4*)(vo + 4) = (f32x4){vf[4], vf[5], vf[6], vf[7]}; } } }
    }
    __syncthreads();
    const int hq = kv * 8 + wave;
    const float sink = a.in[17][l * 32 + hq];
    for (int qt = 0; qt < nqt; ++qt) {
        const int tq = pos0 + 16 * qt + fr; const size_t row = qrow0 + 16 * qt + fr;
        bf16x8 Qf[2];
        {   const bf16* qp = P + row * NP + C_AQ + hq * 64 + 8 * fq; float x1[8], x2[8], o1[8], o2[8];
            unpack8(*(const u32x4*)qp, x1); unpack8(*(const u32x4*)(qp + 32), x2);
#pragma unroll
            for (int j = 0; j < 8; ++j) { const f32x2 cs = rope[tq * 32 + 8 * fq + j]; o1[j] = (x1[j] * cs.x - x2[j] * cs.y) * 0.125f; o2[j] = (x2[j] * cs.x + x1[j] * cs.y) * 0.125f; }
            Qf[0] = as_bf16x8(pack8(o1)); Qf[1] = as_bf16x8(pack8(o2)); }
        u32x2 zw[4];
#pragma unroll
        for (int dt = 0; dt < 4; ++dt) zw[dt] = *(const u32x2*)(P + row * NP + C_AZ + hq * 64 + 16 * dt + 4 * fq);
        f32x4 s[12]; float m = sink;
#pragma unroll
        for (int kt = 0; kt < 12; ++kt) { s[kt] = (f32x4){0.f, 0.f, 0.f, 0.f};
            if (kt >= kt0 && kt < nkt) {
#pragma unroll
                for (int ks = 0; ks < 2; ++ks) { const bf16x8 kf = *(const LAS bf16x8*)(KI + (16 * kt + fr) * SKI + 32 * ks + 8 * fq); s[kt] = __builtin_amdgcn_mfma_f32_16x16x32_bf16(kf, Qf[ks], s[kt], 0, 0, 0); }
                m = fmaxf(m, fmaxf(fmaxf(s[kt][0], s[kt][1]), fmaxf(s[kt][2], s[kt][3]))); } }
        m = fmaxf(m, __shfl_xor(m, 16)); m = fmaxf(m, __shfl_xor(m, 32));
        float sum = 0.f; f32x4 oc[4];
#pragma unroll
        for (int dt = 0; dt < 4; ++dt) oc[dt] = (f32x4){0.f, 0.f, 0.f, 0.f};
#pragma unroll
        for (int kt = 0; kt < 12; ++kt) { if (kt >= kt0 && kt < nkt) {
            const float p0 = __expf(s[kt][0] - m), p1 = __expf(s[kt][1] - m), p2 = __expf(s[kt][2] - m), p3 = __expf(s[kt][3] - m); sum += (p0 + p1) + (p2 + p3);
            u32x2 pw; pw.x = cvtpk(p0, p1); pw.y = cvtpk(p2, p3);
#pragma unroll
            for (int dt = 0; dt < 4; ++dt) { const u32x2 vf = *(const LAS u32x2*)(VT + (16 * dt + fr) * SVT + 16 * kt + 4 * fq);
                oc[dt] = __builtin_amdgcn_mfma_f32_16x16x16bf16_1k(as_bf16x4(vf), as_bf16x4(pw), oc[dt], 0, 0, 0); } } }
        sum += __shfl_xor(sum, 16); sum += __shfl_xor(sum, 32);
        const float inv = 1.0f / (sum + __expf(sink - m));
#pragma unroll
        for (int dt = 0; dt < 4; ++dt) { const int d0 = 16 * dt + 4 * fq;
            const float o0 = oc[dt][0] * inv * silu_f(bflo(zw[dt].x)), o1 = oc[dt][1] * inv * silu_f(bfhi(zw[dt].x)), o2 = oc[dt][2] * inv * silu_f(bflo(zw[dt].y)), o3 = oc[dt][3] * inv * silu_f(bfhi(zw[dt].y));
            u32x2 ow; ow.x = cvtpk(o0, o1); ow.y = cvtpk(o2, o3);
            *(u32x2*)(Ob + row * D + 2048 + hq * 64 + d0) = ow; }
    }
}

struct OneUnit { int pn; __device__ __forceinline__ bool next(int i, pg8::Unit& u) const { if (i) return false; u.pm = 0; u.pn = pn; return true; }
    __device__ __forceinline__ void a_ready(const pg8::Unit&) const {} __device__ __forceinline__ void done(const pg8::Unit&) const {} };
#ifndef DBG_REPEAT
#define DBG_REPEAT 0
#endif
__device__ __forceinline__ void phase_c2(const Args& a, int l, LAS unsigned char* lds, int G) {
    const int b = blockIdx.x;
    unsigned* cnt = (unsigned*)(a.ws + WS_CTL) + CW_C2DONE + 64 * l;
    if (b < 64) { for (int r_ = 0; r_ < ((((DBG_REPEAT) >> 7) & 1) ? 2 : 1); ++r_) scan_seq(a, l, lds, b); }
    else if (b < 80) {
        if (threadIdx.x == 0) { unsigned sp = 0; while (__hip_atomic_load(cnt, __ATOMIC_RELAXED, __HIP_MEMORY_SCOPE_AGENT) < (unsigned)(G - 80)) { __builtin_amdgcn_s_sleep(8); if (++sp > (1u << 22)) break; }
            __builtin_amdgcn_fence(__ATOMIC_ACQUIRE, "agent"); VM_WAIT(); }
        __syncthreads();
        pg8::Gemm g{(const pg8::bf16_t*)(a.ws + WS_HO) + (size_t)MP * D, (const pg8::bf16_t*)(a.ws + WS_BOUT + l * BOUT_BYTES), MS, D, D};
        OneUnit S; S.pn = b - 64;
        pg8::EpiY E{(pg8::bf16_t*)(a.ws + WS_YS), D, (float*)(a.ws + WS_YSQ) + (size_t)MP * 64};
        pg8::gemm_phase<pg8::EpiY, OneUnit, true, true>(lds, g, S, E);
    } else {
        const int vb = b - 80, nvb = G - 80;
        for (int it = vb; it < 320; it += nvb) { if (it < 256) scan_seq(a, l, lds, 64 + it); else attn_item(a, l, lds, 1024 + (it - 256)); }
        VM_WAIT(); __syncthreads();
        if (threadIdx.x == 0) { __builtin_amdgcn_fence(__ATOMIC_RELEASE, "agent"); VM_WAIT(); __hip_atomic_fetch_add(cnt, 1u, __ATOMIC_RELAXED, __HIP_MEMORY_SCOPE_AGENT); }
        for (int it = vb; it < 1024; it += nvb) { for (int r_ = 0; r_ < ((((DBG_REPEAT) >> 8) & 1) ? 2 : 1); ++r_) attn_item(a, l, lds, it); }
#if SPLIT_PROLOGUE
        if (l == 0) { __syncthreads(); prologue_work(a, lds, vb, nvb, 2, 0x8, false); }
#endif
    }
}

constexpr int N_PHASES = 12;
__device__ __forceinline__ Args load_args(const __attribute__((address_space(4))) Args* p) {
    Args a;
#pragma unroll
    for (int i = 0; i < 19; ++i) a.in[i] = (const float*)(const GAS float*)p->in[i];
    a.out = (float*)(GAS float*)p->out; a.ws = (unsigned char*)(GAS unsigned char*)p->ws; a.ph_lo = p->ph_lo; a.ph_hi = p->ph_hi; return a;
}
__global__ void __launch_bounds__(512, 2) fwd(Args args) {
    extern __shared__ __attribute__((aligned(16))) unsigned char lds_raw[];
    LAS unsigned char* lds = (LAS unsigned char*)lds_raw;
    const int G = gridDim.x;
    typedef const __attribute__((address_space(4))) Args* KArgs;
    const KArgs kp = (KArgs)__builtin_amdgcn_kernarg_segment_ptr();
#define ARGS(name) KArgs name##_p = kp; asm volatile("" : "+s"(name##_p)); const Args name = load_args(name##_p)
    const int lo = kp->ph_lo, hi = kp->ph_hi;
    volatile LAS unsigned* MISC = (volatile LAS unsigned*)(lds + MISC_OFF);
    for (int u = threadIdx.x; u < 64; u += 512) MISC[u] = 0u;
    __syncthreads();
    unsigned* barw = (unsigned*)(GAS unsigned*)((GAS unsigned char*)kp->ws + WS_CTL) + CW_BAR;
    XcdBarrier bar; bar.bar = barw; bar.x = 0; bar.st = nullptr;
    const bool multi = (hi - lo) > 1;
    if (multi) bar = xcd_barrier_post(barw, MISC + 8);
#define IN(k) (lo <= (k) && (k) < hi)
#ifndef DBG_REPEAT
#define DBG_REPEAT 0
#endif
#define REP(bit) for (int rep_ = 0; rep_ < (((DBG_REPEAT) >> (bit)) & 1) + 1; ++rep_)
#define SEAM(k) do { if (IN(k) && IN((k) + 1)) xcd_barrier(bar); } while (0)
    if (IN(0)) REP(0) { ARGS(a0); phase_prologue(a0, lds, G); }
    SEAM(0);
    if (IN(1)) REP(1) { ARGS(a1); phase_rows<0>(a1, lds, G); }
    SEAM(1);
    for (int l = 0; l < 2; ++l) {
        const int pb = 2 + 5 * l;
        if (IN(pb + 0)) REP(2) {
            ARGS(args);
            pg8::Gemm g{(const pg8::bf16_t*)(args.ws + WS_HO), (const pg8::bf16_t*)(args.ws + WS_BIN + l * BIN_BYTES), M, NP, D};
            pg8::StaticOrder S; S.init(M, NP, G, (int)blockIdx.x);
            pg8::EpiP E{(pg8::bf16_t*)(args.ws + WS_P), NP, args.in[16] + (size_t)l * 128, C_ZDN / 256, (C_ZDN + 2048) / 256};
#ifdef DBG_CLK
            const unsigned long long ck0_ = __builtin_amdgcn_s_memtime(), cr0_ = __builtin_amdgcn_s_memrealtime();
#endif
            pg8::gemm_phase<pg8::EpiP, pg8::StaticOrder, true, true>(lds, g, S, E);
#ifdef DBG_CLK
            if (l == 1 && blockIdx.x == 0 && threadIdx.x == 0) { const unsigned long long dc_ = __builtin_amdgcn_s_memtime() - ck0_, dr_ = __builtin_amdgcn_s_memrealtime() - cr0_;
                const float ghz_ = (float)dc_ / ((float)dr_ * 10.0f);
                float fr_ = (DBG_CLK == 1) ? (ghz_ - 1.0f) / 1.6f : (float)dr_ * 0.01f / 2000.0f;
                fr_ = fr_ < 0.f ? 0.f : (fr_ > 1.f ? 1.f : fr_);
                ((unsigned*)(args.ws + WS_CTL))[2000] = 16u * (unsigned)(fr_ * 16.0f + 0.5f); }
#endif
        }
        SEAM(pb + 0);
        if (IN(pb + 1)) REP(3) { ARGS(a2); phase_c1(a2, l, lds, G); }
        SEAM(pb + 1);
        if (IN(pb + 2)) REP(4) { ARGS(a3); phase_c2(a3, l, lds, G); }
        SEAM(pb + 2);
        if (IN(pb + 3)) REP(5) {
            ARGS(args);
            pg8::Gemm g{(const pg8::bf16_t*)(args.ws + WS_HO), (const pg8::bf16_t*)(args.ws + WS_BOUT + l * BOUT_BYTES), MP, D, D};
            pg8::StaticOrder S; S.init(MP, D, G, (int)blockIdx.x);
            pg8::EpiY E{(pg8::bf16_t*)(args.ws + WS_P), D, (float*)(args.ws + WS_YSQ)};
            pg8::gemm_phase<pg8::EpiY, pg8::StaticOrder, true, true>(lds, g, S, E);
        }
        SEAM(pb + 3);
        if (IN(pb + 4)) for (int rep_ = 0; rep_ < ((((DBG_REPEAT) >> 6) & 1) && l == 0 ? 2 : 1); ++rep_) { ARGS(a4); if (l == 0) phase_rows<1>(a4, lds, G); else phase_rows<2>(a4, lds, G); }
        SEAM(pb + 4);
    }
#undef IN
#undef SEAM
#undef ARGS
}


#ifdef DBG_STOP_AFTER
__global__ void dbg_dump(const unsigned char* ws, float* out) {
    const size_t regs[9][2] = {{WS_MOD, 1966080}, {WS_ROPE, 1048576}, {WS_DEC, 17408}, {WS_YSQ, (size_t)M * 64 * 4}, {WS_BIN, 2 * BIN_BYTES}, {WS_BOUT, 2 * BOUT_BYTES}, {WS_HO, (size_t)M * D * 2}, {WS_P, (size_t)M * NP * 2}, {WS_REC, (size_t)NREC * REC_BYTES}};
    size_t obase = 0;
    for (int r = 0; r < 9; ++r) { const size_t nchunk = regs[r][1] / 128; const unsigned short* p = (const unsigned short*)(ws + regs[r][0]);
        for (size_t i = (size_t)blockIdx.x * blockDim.x + threadIdx.x; i < nchunk; i += (size_t)gridDim.x * blockDim.x) { unsigned s = 0; for (int k = 0; k < 64; ++k) s += p[i * 64 + k]; out[obase + i] = (float)s; }
        obase += nchunk; }
}
#endif
#ifndef MK_PER_PHASE
#define MK_PER_PHASE 1
#endif
extern "C" void kernel_launch(void* const* d_in, const int* in_sizes, int n_in, void* d_out, int out_size, void* d_ws, size_t ws_size, hipStream_t stream) {
    static int grid = 0;
    if (grid == 0) {
        if (n_in != 19 || out_size != (int)O_END || ws_size < WS_END) { fprintf(stderr, "kernel_launch: unexpected shapes (n_in %d out %d ws %zu need %zu)\n", n_in, out_size, ws_size, (size_t)WS_END); grid = -1; return; }
        int dev = 0, cus = 0;
        if (hipGetDevice(&dev) != hipSuccess || hipDeviceGetAttribute(&cus, hipDeviceAttributeMultiprocessorCount, dev) != hipSuccess) { grid = -1; return; }
        if (hipFuncSetAttribute((const void*)fwd, hipFuncAttributeMaxDynamicSharedMemorySize, LDS_BYTES) != hipSuccess) { fprintf(stderr, "kernel_launch: hipFuncSetAttribute failed\n"); grid = -1; return; }
        int per_cu = 0;
        if (hipOccupancyMaxActiveBlocksPerMultiprocessor(&per_cu, (const void*)fwd, 512, LDS_BYTES) != hipSuccess || per_cu < 1) fprintf(stderr, "kernel_launch: occupancy query says %d\n", per_cu);
        (void)hipGetLastError();
        grid = cus;
        if (grid < 128) { fprintf(stderr, "kernel_launch: needs >= 128 CUs\n"); grid = -1; return; }
    }
    if (grid < 0) return;
    (void)in_sizes;
    if (hipMemsetAsync((char*)d_ws + WS_CTL, 0, CTL_ZERO_BYTES, stream) != hipSuccess) return;
    Args a{};
    for (int i = 0; i < 19; ++i) a.in[i] = (const float*)d_in[i];
    a.out = (float*)d_out; a.ws = (unsigned char*)d_ws;
#ifdef DBG_STOP_AFTER
    for (int p = 0; p <= DBG_STOP_AFTER; ++p) { a.ph_lo = p; a.ph_hi = p + 1; hipLaunchKernelGGL(fwd, dim3(grid), dim3(512), LDS_BYTES, stream, a); }
    hipLaunchKernelGGL(dbg_dump, dim3(2048), dim3(256), 0, stream, (const unsigned char*)d_ws, (float*)d_out);
#elif MK_PER_PHASE
    for (int p = 0; p < N_PHASES; ++p) { a.ph_lo = p; a.ph_hi = p + 1; hipLaunchKernelGGL(fwd, dim3(grid), dim3(512), LDS_BYTES, stream, a); }
#else
    a.ph_lo = 0; a.ph_hi = N_PHASES;
    hipLaunchKernelGGL(fwd, dim3(grid), dim3(512), LDS_BYTES, stream, a);
#endif
}
```

```cpp
#include <hip/hip_runtime.h>
#include <cstdio>
#include <cstdint>
#define MK_PER_PHASE 0
__device__ __forceinline__ int tid_opaque() { int t = threadIdx.x; asm volatile("" : "+v"(t)); return t; }
namespace pg8 {
#define PG8_LAS __attribute__((address_space(3)))
typedef unsigned short bf16_t;
typedef short bf16x8 __attribute__((ext_vector_type(8)));
typedef float f32x4 __attribute__((ext_vector_type(4)));
typedef unsigned u32x4 __attribute__((ext_vector_type(4)));
constexpr int BM = 256, BK = 64, HALF = 128, HTB = HALF * BK * 2  , STAGE_BYTES = 8 * HTB, NXCD = 8, WGM = 8;

__host__ __device__ __forceinline__ int lds_byte(int r, int c) { const int st = (r >> 4) * 2 + (c >> 5), rr = r & 15, cc = c & 31, ob = rr * 64 + cc * 2; return st * 1024 + (ob ^ (((ob >> 9) & 1) << 5)); }
__host__ __device__ __forceinline__ void stage_rc(int b, int& R, int& C) { const int st = b / 1024, sb = b % 1024, swz = sb ^ (((sb >> 9) & 1) << 5); R = (st >> 1) * 16 + swz / 64; C = (st & 1) * 32 + (swz % 64) / 2; }
__host__ __device__ __forceinline__ int perm32(int rho) { const int n = rho >> 4, i = rho & 15; return 8 * (i >> 2) + 4 * n + (i & 3); }

struct Unit { int pm, pn; };
struct Gemm { const bf16_t* A; const bf16_t* Bt; int M, N, K; };

struct StaticOrder {
    int nM, nN, nwg, G, c;
    __host__ __device__ void init(int M, int N, int G_, int c_) { nM = M / BM; nN = N / BM; nwg = nM * nN; G = G_; c = c_; }
    __host__ __device__ bool next(int i, Unit& u) const {
        const long L = (long)i * G + c; if (L >= nwg) return false;
        int wgid = (int)L; { const int q = nwg / NXCD, r = nwg % NXCD, xcd = wgid % NXCD, off = wgid / NXCD; wgid = (xcd < r ? xcd * (q + 1) : r * (q + 1) + (xcd - r) * q) + off; }
        const int nig = WGM * nN, gid = wgid / nig, fm = gid * WGM, gsz = (nM - fm) < WGM ? (nM - fm) : WGM;
        u.pm = fm + ((wgid % nig) % gsz); u.pn = (wgid % nig) / gsz; return true;
    }
    __device__ __forceinline__ void a_ready(const Unit&) const {}
    __device__ __forceinline__ void done(const Unit&) const {}
};

typedef __bf16 hwbf16x2_t __attribute__((ext_vector_type(2))); typedef float f32x2_t __attribute__((ext_vector_type(2)));
__device__ __forceinline__ unsigned cvt_pk_bf16(float lo, float hi) { const f32x2_t v = {lo, hi}; return __builtin_bit_cast(unsigned, __builtin_convertvector(v, hwbf16x2_t)); }
struct EpiP {
    static constexpr bool PERM = true, AFTER_DRAIN = false;
    bf16_t* O; int ldc; const float* dn; int gate_lo, gate_hi;
    __device__ __forceinline__ void operator()(const f32x4 (&acc)[2][2][4][2], const Unit& u, int wr, int wc, int fr, int fq) const {
        const int row0 = u.pm * BM + wr * 64 + fr, col0 = u.pn * BM + wc * 32 + 8 * fq;
        if (u.pn >= gate_lo && u.pn < gate_hi) {
            f32x4 dv[2][2];
#pragma unroll
            for (int bj = 0; bj < 2; ++bj) { const int e0 = (wc * 32 + 8 * fq) & 127; dv[bj][0] = *(const f32x4*)(dn + e0); dv[bj][1] = *(const f32x4*)(dn + e0 + 4); }
#pragma unroll
            for (int ai = 0; ai < 2; ++ai)
#pragma unroll
                for (int m = 0; m < 4; ++m) { bf16_t* rowp = O + (size_t)(row0 + ai * HALF + m * 16) * ldc + col0;
#pragma unroll
                    for (int bj = 0; bj < 2; ++bj) { f32x4 v[2] = {acc[ai][bj][m][0], acc[ai][bj][m][1]};
#pragma unroll
                        for (int n = 0; n < 2; ++n) { const f32x4 t = v[n] * -1.4426950408889634f; f32x4 s;
#pragma unroll
                            for (int j = 0; j < 4; ++j) s[j] = __builtin_amdgcn_rcpf(1.0f + __builtin_amdgcn_exp2f(t[j]));
                            v[n] = v[n] * s * dv[bj][n]; }
                        u32x4 w; w.x = cvt_pk_bf16(v[0][0], v[0][1]); w.y = cvt_pk_bf16(v[0][2], v[0][3]); w.z = cvt_pk_bf16(v[1][0], v[1][1]); w.w = cvt_pk_bf16(v[1][2], v[1][3]);
                        *(u32x4*)(rowp + bj * HALF) = w; } }
            return;
        }
#pragma unroll
        for (int ai = 0; ai < 2; ++ai)
#pragma unroll
            for (int m = 0; m < 4; ++m) { bf16_t* rowp = O + (size_t)(row0 + ai * HALF + m * 16) * ldc + col0;
#pragma unroll
                for (int bj = 0; bj < 2; ++bj) { const f32x4 v0 = acc[ai][bj][m][0], v1 = acc[ai][bj][m][1];
                    u32x4 w; w.x = cvt_pk_bf16(v0[0], v0[1]); w.y = cvt_pk_bf16(v0[2], v0[3]); w.z = cvt_pk_bf16(v1[0], v1[1]); w.w = cvt_pk_bf16(v1[2], v1[3]);
                    *(u32x4*)(rowp + bj * HALF) = w; } }
    }
};
struct EpiY {
    static constexpr bool PERM = true, AFTER_DRAIN = false;
    bf16_t* O; int ldc; float* part;
    __device__ __forceinline__ void operator()(const f32x4 (&acc)[2][2][4][2], const Unit& u, int wr, int wc, int fr, int fq) const {
        const int row0 = u.pm * BM + wr * 64 + fr, col0 = u.pn * BM + wc * 32 + 8 * fq;
#pragma unroll
        for (int ai = 0; ai < 2; ++ai)
#pragma unroll
            for (int m = 0; m < 4; ++m) { const int row = row0 + ai * HALF + m * 16; bf16_t* rowp = O + (size_t)row * ldc + col0; float s = 0.f;
#pragma unroll
                for (int bj = 0; bj < 2; ++bj) { const f32x4 v0 = acc[ai][bj][m][0], v1 = acc[ai][bj][m][1];
                    s += (v0[0] * v0[0] + v0[1] * v0[1]) + (v0[2] * v0[2] + v0[3] * v0[3]) + (v1[0] * v1[0] + v1[1] * v1[1]) + (v1[2] * v1[2] + v1[3] * v1[3]);
                    u32x4 w; w.x = cvt_pk_bf16(v0[0], v0[1]); w.y = cvt_pk_bf16(v0[2], v0[3]); w.z = cvt_pk_bf16(v1[0], v1[1]); w.w = cvt_pk_bf16(v1[2], v1[3]);
                    *(u32x4*)(rowp + bj * HALF) = w; }
                s += __shfl_xor(s, 16); s += __shfl_xor(s, 32);
                if (fq == 0) part[(size_t)row * 64 + u.pn * 4 + wc] = s; }
    }
};

template <class Epi, class Sched, bool ALIGN_EPI = false, bool SP2 = false>
__device__ __forceinline__ void gemm_phase(PG8_LAS unsigned char* lds, const Gemm g, const Sched& S, const Epi& E) {
    const int tid = tid_opaque(), wid = __builtin_amdgcn_readfirstlane(tid >> 6), lane = tid & 63, wr = wid >> 2, wc = wid & 3, fr = lane & 15, fq = lane >> 4;
    const int K = g.K, nt = K / BK;
    unsigned voffA[2], voffB[2];
#pragma unroll
    for (int i = 0; i < 2; ++i) { int R, C; stage_rc(tid * 16 + i * 8192, R, C); const int Rb = Epi::PERM ? ((R & ~31) + perm32(R & 31)) : R;
        voffA[i] = (unsigned)(R * K + C) * 2u; voffB[i] = (unsigned)(Rb * K + C) * 2u; }
    const size_t kstep = (size_t)(BK * 2);
    const size_t hstep = (size_t)HALF * K * 2;
    const size_t tstep = 2 * hstep;
    const unsigned ldsw = (unsigned)wid * 1024u;
    const int aoff = lds_byte(wr * 64 + fr, fq * 8), boff = lds_byte(wc * 32 + fr, fq * 8);
#define PG8_SA(b, h) (((b) * 2 + (h)) * HTB)
#define PG8_SB(b, h) ((4 + (b) * 2 + (h)) * HTB)
#define PG8_STAGE(bufoff, gbase, voff) do { _Pragma("unroll") for (int _i = 0; _i < 2; ++_i) \
        __builtin_amdgcn_global_load_lds((const unsigned*)((const char*)(gbase) + (voff)[_i]), (PG8_LAS unsigned*)(lds + (bufoff) + ldsw + _i * 8192), 16, 0, 0); } while (0)
#define PG8_LDA(dst, b, h) do { _Pragma("unroll") for (int m = 0; m < 4; ++m) _Pragma("unroll") for (int k = 0; k < 2; ++k) dst[m][k] = *(const PG8_LAS bf16x8*)(lds + PG8_SA(b, h) + aoff + m * 2048 + k * 1024); } while (0)
#define PG8_LDB(dst, b, h) do { _Pragma("unroll") for (int n = 0; n < 2; ++n) _Pragma("unroll") for (int k = 0; k < 2; ++k) dst[n][k] = *(const PG8_LAS bf16x8*)(lds + PG8_SB(b, h) + boff + n * 2048 + k * 1024); } while (0)
#define PG8_MMA(ai, bj, At, Bt) do { __builtin_amdgcn_s_setprio(1); _Pragma("unroll") for (int m = 0; m < 4; ++m) _Pragma("unroll") for (int n = 0; n < 2; ++n) _Pragma("unroll") for (int k = 0; k < 2; ++k) \
        acc[ai][bj][m][n] = __builtin_amdgcn_mfma_f32_16x16x32_bf16(Bt[n][k], At[m][k], acc[ai][bj][m][n], 0, 0, 0); __builtin_amdgcn_s_setprio(0); } while (0)
#define PG8_WAIT_V(n) asm volatile("s_waitcnt vmcnt(" #n ")" ::: "memory")
#define PG8_WAIT_L(n) asm volatile("s_waitcnt lgkmcnt(" #n ")" ::: "memory")
#define PG8_BAR __builtin_amdgcn_s_barrier()
#define PG8_SCHED __builtin_amdgcn_sched_barrier(0)
    Unit cur, nxt; int ui = 0;
    if (!S.next(0, cur)) return;
    f32x4 acc[2][2][4][2];
#pragma unroll
    for (int a = 0; a < 2; ++a)
#pragma unroll
        for (int b = 0; b < 2; ++b)
#pragma unroll
            for (int m = 0; m < 4; ++m)
#pragma unroll
                for (int n = 0; n < 2; ++n) acc[a][b][m][n] = (f32x4){0.f, 0.f, 0.f, 0.f};
    bf16x8 At[4][2], B0[2][2], B1[2][2];
    const char* cA = (const char*)g.A + (size_t)cur.pm * tstep; const char* cB = (const char*)g.Bt + (size_t)cur.pn * tstep;
    S.a_ready(cur);
    if constexpr (SP2) {
        PG8_STAGE(PG8_SB(0, 0), cB, voffB); PG8_STAGE(PG8_SB(0, 1), cB + hstep, voffB); PG8_STAGE(PG8_SA(0, 0), cA, voffA); PG8_STAGE(PG8_SA(0, 1), cA + hstep, voffA);
        if (wr == 1) PG8_BAR;
        PG8_WAIT_V(2); PG8_BAR;
        PG8_STAGE(PG8_SB(1, 0), cB + kstep, voffB); PG8_STAGE(PG8_SA(1, 0), cA + kstep, voffA); PG8_STAGE(PG8_SB(1, 1), cB + hstep + kstep, voffB);
        PG8_WAIT_V(6); PG8_BAR;
    } else {
        PG8_STAGE(PG8_SB(0, 0), cB, voffB); PG8_STAGE(PG8_SA(0, 0), cA, voffA); PG8_STAGE(PG8_SB(0, 1), cB + hstep, voffB); PG8_STAGE(PG8_SA(0, 1), cA + hstep, voffA);
        if (wr == 1) PG8_BAR;
        PG8_WAIT_V(4); PG8_BAR;
        PG8_STAGE(PG8_SB(1, 0), cB + kstep, voffB); PG8_STAGE(PG8_SA(1, 0), cA + kstep, voffA); PG8_STAGE(PG8_SB(1, 1), cB + hstep + kstep, voffB);
        PG8_WAIT_V(6); PG8_BAR;
    }
    for (;;) {
        const bool has_next = S.next(ui + 1, nxt);
        const char* nA = has_next ? (const char*)g.A + (size_t)nxt.pm * tstep : cA; const char* nB = has_next ? (const char*)g.Bt + (size_t)nxt.pn * tstep : cB;
        for (int t = 0; t < nt; t += 2) {
            const bool last = (t == nt - 2);
            const char* a1 = cA + (size_t)(t + 1) * kstep;
            const char* a2 = last ? nA : cA + (size_t)(t + 2) * kstep; const char* b2 = last ? nB : cB + (size_t)(t + 2) * kstep;
            const char* a3 = a2 + kstep; const char* b3 = b2 + kstep;
            if (last && has_next) S.a_ready(nxt);
            if constexpr (SP2) {
            PG8_LDB(B0, 0, 0); PG8_LDB(B1, 0, 1); PG8_SCHED; PG8_LDA(At, 0, 0); PG8_STAGE(PG8_SA(1, 1), a1 + hstep, voffA);
            PG8_WAIT_V(8); PG8_WAIT_L(0); PG8_BAR; PG8_MMA(0, 0, At, B0); PG8_MMA(0, 1, At, B1); PG8_BAR; PG8_SCHED;
            PG8_LDA(At, 0, 1); PG8_STAGE(PG8_SB(0, 0), b2, voffB); PG8_STAGE(PG8_SB(0, 1), b2 + hstep, voffB); PG8_STAGE(PG8_SA(0, 0), a2, voffA);
            PG8_WAIT_V(8); PG8_WAIT_L(0); PG8_BAR; PG8_MMA(1, 0, At, B0); PG8_MMA(1, 1, At, B1); PG8_BAR; PG8_SCHED;
            PG8_LDB(B0, 1, 0); PG8_LDB(B1, 1, 1); PG8_SCHED; PG8_LDA(At, 1, 0); PG8_STAGE(PG8_SA(0, 1), a2 + hstep, voffA);
            PG8_WAIT_V(8); PG8_WAIT_L(0); PG8_BAR; PG8_MMA(0, 0, At, B0); PG8_MMA(0, 1, At, B1); PG8_BAR; PG8_SCHED;
            PG8_LDA(At, 1, 1); PG8_STAGE(PG8_SB(1, 0), b3, voffB); PG8_STAGE(PG8_SB(1, 1), b3 + hstep, voffB); PG8_STAGE(PG8_SA(1, 0), a3, voffA);
            PG8_WAIT_V(8); PG8_WAIT_L(0); PG8_BAR; PG8_MMA(1, 0, At, B0); PG8_MMA(1, 1, At, B1); PG8_BAR; PG8_SCHED;
            } else {
            PG8_LDB(B0, 0, 0); PG8_SCHED; PG8_LDA(At, 0, 0); PG8_STAGE(PG8_SA(1, 1), a1 + hstep, voffA);
            PG8_WAIT_L(8); PG8_BAR; PG8_WAIT_L(0); PG8_MMA(0, 0, At, B0); PG8_BAR; PG8_SCHED;
            PG8_LDB(B1, 0, 1); PG8_STAGE(PG8_SB(0, 0), b2, voffB);
            PG8_BAR; PG8_WAIT_L(0); PG8_MMA(0, 1, At, B1); PG8_BAR;
            PG8_LDA(At, 0, 1); PG8_STAGE(PG8_SA(0, 0), a2, voffA);
            PG8_BAR; PG8_WAIT_L(0); PG8_MMA(1, 0, At, B0); PG8_BAR; PG8_SCHED;
            PG8_STAGE(PG8_SB(0, 1), b2 + hstep, voffB);
            PG8_WAIT_V(6); PG8_BAR; PG8_MMA(1, 1, At, B1); PG8_BAR;
            PG8_LDB(B0, 1, 0); PG8_SCHED; PG8_LDA(At, 1, 0); PG8_STAGE(PG8_SA(0, 1), a2 + hstep, voffA);
            PG8_WAIT_L(8); PG8_BAR; PG8_WAIT_L(0); PG8_MMA(0, 0, At, B0); PG8_BAR; PG8_SCHED;
            PG8_LDB(B1, 1, 1); PG8_STAGE(PG8_SB(1, 0), b3, voffB);
            PG8_BAR; PG8_WAIT_L(0); PG8_MMA(0, 1, At, B1); PG8_BAR;
            PG8_LDA(At, 1, 1); PG8_STAGE(PG8_SA(1, 0), a3, voffA);
            PG8_BAR; PG8_WAIT_L(0); PG8_MMA(1, 0, At, B0); PG8_BAR; PG8_SCHED;
            PG8_STAGE(PG8_SB(1, 1), b3 + hstep, voffB);
            PG8_WAIT_V(6); PG8_BAR; PG8_MMA(1, 1, At, B1); PG8_BAR;
            }
        }
        if constexpr (ALIGN_EPI) { if (wr == 0) PG8_BAR; }
        if constexpr (!Epi::AFTER_DRAIN) { E(acc, cur, wr, wc, fr, fq); S.done(cur); }
        if (!has_next) break;
#pragma unroll
        for (int a = 0; a < 2; ++a)
#pragma unroll
            for (int b = 0; b < 2; ++b)
#pragma unroll
                for (int m = 0; m < 4; ++m)
#pragma unroll
                    for (int n = 0; n < 2; ++n) acc[a][b][m][n] = (f32x4){0.f, 0.f, 0.f, 0.f};
        cur = nxt; cA = nA; cB = nB; ++ui;
        if constexpr (ALIGN_EPI) { if (wr == 1) PG8_BAR; }
    }
    PG8_WAIT_V(0);
    if constexpr (!ALIGN_EPI) { if (wr == 0) PG8_BAR; }
    PG8_BAR;
    if constexpr (Epi::AFTER_DRAIN) { E.fused(acc, cur, wr, wc, fr, fq, lds, wid, lane); S.done(cur); }
#undef PG8_SA
#undef PG8_SB
#undef PG8_STAGE
#undef PG8_LDA
#undef PG8_LDB
#undef PG8_MMA
#undef PG8_WAIT_V
#undef PG8_WAIT_L
#undef PG8_BAR
#undef PG8_SCHED
}
}

#define GAS __attribute__((address_space(1)))
#define LAS __attribute__((address_space(3)))
typedef unsigned short bf16;
typedef short bf16x8 __attribute__((ext_vector_type(8)));
typedef short bf16x4 __attribute__((ext_vector_type(4)));
typedef float f32x4 __attribute__((ext_vector_type(4)));
typedef float f32x2 __attribute__((ext_vector_type(2)));
typedef unsigned u32x4 __attribute__((ext_vector_type(4)));
typedef unsigned u32x2 __attribute__((ext_vector_type(2)));

constexpr int D = 4096, NB = 4, T = 4096, NSB = 16, TS = 16, PAST = 2048;
constexpr int MP = NB * T, MS = NSB * TS, M = MP + MS;
constexpr int NP = 13056, IN_DIM = 12832;
constexpr int C_Q = 0, C_K = 2048, C_V = 4096, C_ZDN = 6144, C_AQ = 8192, C_AK = 10240, C_AV = 10496, C_AZ = 10752, C_B = 12800, C_A = 12816;
constexpr float EPS = 1e-6f;
constexpr size_t O_YP = 0, O_YS = O_YP + (size_t)MP * D, O_CONVP = O_YS + (size_t)MS * D, O_DNP = O_CONVP + 2 * 4 * 3 * 6144, O_KP = O_DNP + 2 * 4 * 16 * 128 * 128,
                 O_VP = O_KP + 2 * 4 * 128 * 256, O_CONVS = O_VP + 2 * 4 * 128 * 256, O_DNS = O_CONVS + 2 * 16 * 3 * 6144, O_KS = O_DNS + (size_t)2 * 16 * 16 * 128 * 128,
                 O_VS = O_KS + 2 * 16 * 128 * 256, O_END = O_VS + 2 * 16 * 128 * 256;
static_assert(O_END == 82001920, "output size");
constexpr size_t MiB = 1u << 20;
constexpr size_t WS_CTL = 0, CTL_ZERO_BYTES = 1 * MiB;
constexpr size_t WS_MOD = 1 * MiB;
constexpr size_t WS_ROPE = 3 * MiB;
constexpr size_t WS_DEC = 4 * MiB;
constexpr size_t WS_YSQ = 5 * MiB;
constexpr size_t WS_BIN = 10 * MiB;
constexpr size_t BIN_BYTES = (size_t)NP * 4096 * 2;
constexpr size_t WS_BOUT = 214 * MiB;
constexpr size_t BOUT_BYTES = (size_t)4096 * 4096 * 2;
constexpr size_t WS_HO = 278 * MiB;
constexpr size_t WS_P = 408 * MiB;
constexpr size_t WS_REC = 823 * MiB;
constexpr int REC_W = 0, REC_QD = 16384, REC_KD = 32768, REC_QK = 49152, REC_U = 57344, REC_BYTES = 73728, REC_STAGE = 57344;
constexpr int NREC = 4096 + 256;
constexpr size_t WS_YS = WS_REC + (size_t)NREC * REC_BYTES;
constexpr size_t WS_END = WS_YS + (size_t)MS * D * 2;
constexpr int CW_C2DONE = 3072;
static_assert(WS_BIN + 2 * BIN_BYTES <= WS_BOUT && WS_HO + (size_t)M * D * 2 <= WS_P && WS_P + (size_t)M * NP * 2 <= WS_REC, "ws map");
constexpr int CW_BAR = 4096;
constexpr int LDS_BYTES = 147456;
constexpr int MISC_OFF = 147456 - 256;

#define RLX_AGENT __ATOMIC_RELAXED, __HIP_MEMORY_SCOPE_AGENT
#define LDS_WAIT() asm volatile("s_waitcnt lgkmcnt(0)" ::: "memory")
#define VM_WAIT() asm volatile("s_waitcnt vmcnt(0)" ::: "memory")
#define BAR_LDS() do { asm volatile("s_waitcnt lgkmcnt(0)" ::: "memory"); __builtin_amdgcn_s_barrier(); asm volatile("" ::: "memory"); } while (0)
typedef __bf16 hwbf16x2 __attribute__((ext_vector_type(2)));
__device__ __forceinline__ unsigned cvtpk(float lo, float hi) { const f32x2 v = {lo, hi}; return __builtin_bit_cast(unsigned, __builtin_convertvector(v, hwbf16x2)); }
__device__ __forceinline__ float bflo(unsigned w) { return __uint_as_float(w << 16); }
__device__ __forceinline__ float bfhi(unsigned w) { return __uint_as_float(w & 0xffff0000u); }
__device__ __forceinline__ float bf1(bf16 h) { return __uint_as_float(((unsigned)h) << 16); }
__device__ __forceinline__ float silu_f(float x) { return x * __builtin_amdgcn_rcpf(1.0f + __expf(-x)); }
__device__ __forceinline__ float sigmoid_f(float x) { return __builtin_amdgcn_rcpf(1.0f + __expf(-x)); }
__device__ __forceinline__ float sum16(float v) {
    v += __builtin_bit_cast(float, __builtin_amdgcn_update_dpp(0, __builtin_bit_cast(int, v), 0xB1, 0xf, 0xf, true));
    v += __builtin_bit_cast(float, __builtin_amdgcn_update_dpp(0, __builtin_bit_cast(int, v), 0x4E, 0xf, 0xf, true));
    v += __builtin_bit_cast(float, __builtin_amdgcn_update_dpp(0, __builtin_bit_cast(int, v), 0x141, 0xf, 0xf, true));
    v += __builtin_bit_cast(float, __builtin_amdgcn_update_dpp(0, __builtin_bit_cast(int, v), 0x140, 0xf, 0xf, true));
    return v;
}
__device__ __forceinline__ float quadsum16(const f32x4 q, int fr) {
    const bool o1 = fr & 1, o2 = fr & 2;
    float kA = o1 ? q[1] : q[0], sA = o1 ? q[0] : q[1], kB = o1 ? q[3] : q[2], sB = o1 ? q[2] : q[3];
    kA += __builtin_bit_cast(float, __builtin_amdgcn_update_dpp(0, __builtin_bit_cast(int, sA), 0xB1, 0xf, 0xf, true));
    kB += __builtin_bit_cast(float, __builtin_amdgcn_update_dpp(0, __builtin_bit_cast(int, sB), 0xB1, 0xf, 0xf, true));
    float k = o2 ? kB : kA; const float s = o2 ? kA : kB;
    k += __builtin_bit_cast(float, __builtin_amdgcn_update_dpp(0, __builtin_bit_cast(int, s), 0x4E, 0xf, 0xf, true));
    k += __builtin_bit_cast(float, __builtin_amdgcn_update_dpp(0, __builtin_bit_cast(int, k), 0x124, 0xf, 0xf, true));
    k += __builtin_bit_cast(float, __builtin_amdgcn_update_dpp(0, __builtin_bit_cast(int, k), 0x128, 0xf, 0xf, true));
    return k;
}
__device__ __forceinline__ float wave_sum(float v) { v = sum16(v); v += __shfl_xor(v, 16); v += __shfl_xor(v, 32); return v; }
__device__ __forceinline__ float wave_max(float v) {
#pragma unroll
    for (int o = 1; o < 64; o <<= 1) v = fmaxf(v, __shfl_xor(v, o));
    return v;
}
__device__ __forceinline__ void unpack8(const u32x4 w, float (&f)[8]) {
    f[0] = bflo(w.x); f[1] = bfhi(w.x); f[2] = bflo(w.y); f[3] = bfhi(w.y); f[4] = bflo(w.z); f[5] = bfhi(w.z); f[6] = bflo(w.w); f[7] = bfhi(w.w);
}
__device__ __forceinline__ u32x4 pack8(const float (&f)[8]) { u32x4 w; w.x = cvtpk(f[0], f[1]); w.y = cvtpk(f[2], f[3]); w.z = cvtpk(f[4], f[5]); w.w = cvtpk(f[6], f[7]); return w; }
__device__ __forceinline__ u32x4 pack8v(const f32x2 (&f)[4]) { u32x4 w; w.x = cvtpk(f[0].x, f[0].y); w.y = cvtpk(f[1].x, f[1].y); w.z = cvtpk(f[2].x, f[2].y); w.w = cvtpk(f[3].x, f[3].y); return w; }
__device__ __forceinline__ bf16x8 as_bf16x8(const u32x4 w) { return __builtin_bit_cast(bf16x8, w); }
__device__ __forceinline__ bf16x4 as_bf16x4(const u32x2 w) { return __builtin_bit_cast(bf16x4, w); }

#define XB_TMO      128
#define XB_XCNT(j)  (256  + 64 * (j))
#define XB_XSUB(j)  (1280 + 64 * (j))
#define XB_XGEN(j)  (2304 + 64 * (j))
#define XB_TOP      3328
#define XB_TOPGEN   3392
#define XCD_BAR_WORDS 3456
#define XB_SPIN_CAP (1u << 18)

__device__ __forceinline__ unsigned xb_ld(unsigned* p)              { return __hip_atomic_load(p, __ATOMIC_RELAXED, __HIP_MEMORY_SCOPE_AGENT); }
__device__ __forceinline__ unsigned xb_add(unsigned* p, unsigned v) { return __hip_atomic_fetch_add(p, v, __ATOMIC_RELAXED, __HIP_MEMORY_SCOPE_AGENT); }
__device__ __forceinline__ unsigned xb_xcc_id() { return (unsigned)__builtin_amdgcn_s_getreg((3 << 11) | 20) & 0xFu; }
#define XB_SPIN(cond, bar) do { unsigned _sp = 0; while (cond) { __builtin_amdgcn_s_sleep(1); \
    if ((++_sp & 255u) == 0u) { if (xb_ld(&(bar)[XB_TMO])) break; if (_sp > XB_SPIN_CAP) { atomicAdd(&(bar)[XB_TMO], 1u); break; } } } } while (0)

struct XcdBarrier {
    unsigned* bar; unsigned x;
    volatile LAS unsigned* st;
};

__device__ __forceinline__ XcdBarrier xcd_barrier_post(unsigned* bar, volatile LAS unsigned* st) {
    XcdBarrier b; b.bar = bar; b.x = xb_xcc_id(); b.st = st;
    if (threadIdx.x == 0) (void)xb_add(&bar[XB_XCNT(b.x)], 1u);
    return b;
}
__device__ __forceinline__ void xcd_barrier_complete(unsigned* bar, unsigned x, unsigned& nloc, unsigned& nx) {
    const unsigned G = gridDim.x * gridDim.y * gridDim.z;
    unsigned sum, cnt, mine, sp = 0u;
    for (;;) {
        sum = 0u; cnt = 0u; mine = 0u;
#pragma unroll
        for (unsigned j = 0; j < 16; ++j) { const unsigned c = xb_ld(&bar[XB_XCNT(j)]); sum += c; cnt += (c > 0u) ? 1u : 0u; mine = (j == x) ? c : mine; }
        if (sum == G) break;
        __builtin_amdgcn_s_sleep(1);
        if ((++sp & 255u) == 0u) { if (xb_ld(&bar[XB_TMO])) break; if (sp > XB_SPIN_CAP) { atomicAdd(&bar[XB_TMO], 1u); break; } }
    }
    nloc = mine > 0u ? mine : 1u; nx = cnt > 0u ? cnt : 1u;
}

__device__ __forceinline__ void xcd_barrier(const XcdBarrier& b) {
    asm volatile("s_waitcnt vmcnt(0)" ::: "memory");
    __syncthreads();
    if (threadIdx.x == 0) {
        unsigned* bar = b.bar;
        __builtin_amdgcn_s_waitcnt(0);
        unsigned nloc = b.st[0], nx = b.st[1];
        if (nloc == 0u) { xcd_barrier_complete(bar, b.x, nloc, nx); b.st[0] = nloc; b.st[1] = nx; }
        const unsigned old = xb_add(&bar[XB_XSUB(b.x)], 1u);
        const unsigned gen = old / nloc;
        if (old + 1u == (gen + 1u) * nloc) {
            __builtin_amdgcn_fence(__ATOMIC_RELEASE, "agent");
            asm volatile("s_waitcnt vmcnt(0)" ::: "memory");
            const unsigned og = xb_add(&bar[XB_TOP], 1u);
            const unsigned tg = og / nx;
            if (og + 1u == (tg + 1u) * nx) xb_add(&bar[XB_TOPGEN], 1u);
            else XB_SPIN(xb_ld(&bar[XB_TOPGEN]) == tg, bar);
            __builtin_amdgcn_fence(__ATOMIC_ACQUIRE, "agent");
            xb_add(&bar[XB_XGEN(b.x)], 1u);
            asm volatile("s_waitcnt vmcnt(0)" ::: "memory");
        } else {
            XB_SPIN(xb_ld(&bar[XB_XGEN(b.x)]) == gen, bar);
            __builtin_amdgcn_fence(__ATOMIC_ACQUIRE, "agent");
            asm volatile("s_waitcnt vmcnt(0)" ::: "memory");
        }
    }
    __syncthreads();
}

struct Args { const float* in[19]; float* out; unsigned char* ws; int ph_lo, ph_hi; };

__device__ __forceinline__ void p0_transpose_item(const float* W, int K, int N, bf16* WT, int dst_row0, LAS float* scr, int k0, int n0, int lane) {
    const int r8 = lane >> 3, c4 = lane & 7;
    f32x4 v[8];
#pragma unroll
    for (int i = 0; i < 8; ++i) v[i] = *(const f32x4*)(W + (size_t)(k0 + 8 * i + r8) * N + n0 + 4 * c4);
#pragma unroll
    for (int i = 0; i < 8; ++i) { LAS float* d = scr + (8 * i + r8) * 33 + 4 * c4; d[0] = v[i][0]; d[1] = v[i][1]; d[2] = v[i][2]; d[3] = v[i][3]; }
    LDS_WAIT(); asm volatile("" ::: "memory");
    const int c = lane & 7;
#pragma unroll
    for (int j = 0; j < 4; ++j) { const int n = (lane >> 3) + 8 * j; const LAS float* s = scr + (8 * c) * 33 + n;
        u32x4 o; o.x = cvtpk(s[0 * 33], s[1 * 33]); o.y = cvtpk(s[2 * 33], s[3 * 33]); o.z = cvtpk(s[4 * 33], s[5 * 33]); o.w = cvtpk(s[6 * 33], s[7 * 33]);
        *(u32x4*)(WT + (size_t)(dst_row0 + n) * K + k0 + 8 * c) = o; }
    LDS_WAIT(); asm volatile("" ::: "memory");
}
__device__ __forceinline__ void prologue_work(const Args& a, LAS unsigned char* lds, int vb, int nvb, int ada_mask, int tr_mask, bool rope) {
    const int tid = tid_opaque(), lane = tid & 63, wave = tid >> 6;
    {
        const float* cp = a.in[6]; const float* cs = a.in[7]; const float* w_ada = a.in[8]; const float* b_ada = a.in[9];
        float* mod = (float*)(a.ws + WS_MOD);
        LAS float* sc = (LAS float*)lds;
        LAS float* red = (LAS float*)(lds + 40960);
        const int cgp = tid & 7, ksl = tid >> 3;
        const int it0 = (ada_mask & 1) ? 0 : 384, it1 = (ada_mask & 2) ? 768 : 384;
        for (int it = it0 + vb; it < it1 && ada_mask; it += nvb) {
            const int l = it / 384, col0 = (it % 384) * 32;
            f32x4 acc[20];
#pragma unroll
            for (int j = 0; j < 20; ++j) acc[j] = (f32x4){0.f, 0.f, 0.f, 0.f};
            for (int kt = 0; kt < 8; ++kt) {
                __syncthreads();
#pragma unroll
                for (int j = 0; j < 20; ++j) { const float cv = (j < 4) ? cp[j * 4096 + kt * 512 + tid] : cs[(j - 4) * 4096 + kt * 512 + tid]; sc[tid * 20 + j] = silu_f(cv); }
                __syncthreads();
                const float* wp = w_ada + ((size_t)l * 4096 + kt * 512 + ksl * 8) * 12288 + col0 + cgp * 4;
                f32x4 w[8];
#pragma unroll
                for (int kk = 0; kk < 8; ++kk) w[kk] = *(const f32x4*)(wp + (size_t)kk * 12288);
#pragma unroll
                for (int kk = 0; kk < 8; ++kk) {
                    const LAS f32x4* s4 = (const LAS f32x4*)(sc + (ksl * 8 + kk) * 20);
#pragma unroll
                    for (int j4 = 0; j4 < 5; ++j4) { const f32x4 s = s4[j4];
#pragma unroll
                        for (int jj = 0; jj < 4; ++jj) acc[j4 * 4 + jj] += s[jj] * w[kk]; }
                }
            }
#pragma unroll
            for (int j = 0; j < 20; ++j)
#pragma unroll
                for (int c = 0; c < 4; ++c) { float v = acc[j][c]; v += __shfl_xor(v, 8); v += __shfl_xor(v, 16); v += __shfl_xor(v, 32); acc[j][c] = v; }
            __syncthreads();
            if (lane < 8) {
#pragma unroll
                for (int j = 0; j < 20; ++j) *(LAS f32x4*)(red + (wave * 20 + j) * 32 + lane * 4) = acc[j];
            }
            __syncthreads();
            for (int o = tid; o < 640; o += 512) { const int j = o >> 5, c = o & 31; float s = 0.f;
#pragma unroll
                for (int w8 = 0; w8 < 8; ++w8) s += red[(w8 * 20 + j) * 32 + c];
                mod[((size_t)l * 20 + j) * 12288 + col0 + c] = s + b_ada[(size_t)l * 12288 + col0 + c]; }
        }
        __syncthreads();
    }
    {
        LAS float* scr = (LAS float*)(lds + wave * 8448);
        const int gw = vb * 8 + wave, NGW = nvb * 8;
        constexpr int I_IN = 64 * 401, I_OUT = 64 * 128;
#pragma unroll 1
        for (int mtx = 0; mtx < 4; ++mtx) {
            if (!((tr_mask >> mtx) & 1)) continue;
            const int l = mtx >> 1;
            if ((mtx & 1) == 0) {
                for (int r = gw; r < I_IN; r += NGW) { const int kb = r / 401, nb = r % 401, n0 = nb * 32; const int dst = (n0 < 8192) ? n0 : ((n0 < 8224) ? (C_B + (n0 - 8192)) : (n0 - 32));
                    p0_transpose_item(a.in[12] + (size_t)l * 4096 * IN_DIM, 4096, IN_DIM, (bf16*)(a.ws + WS_BIN + l * BIN_BYTES), dst, scr, kb * 64, n0, lane); }
                constexpr int ZU = (NP - IN_DIM) * 4096 * 2 / 16;
                for (int u = vb * 512 + tid; u < ZU; u += nvb * 512) *(u32x4*)(a.ws + WS_BIN + l * BIN_BYTES + (size_t)IN_DIM * 4096 * 2 + (size_t)u * 16) = (u32x4){0u, 0u, 0u, 0u};
            } else {
                for (int r = gw; r < I_OUT; r += NGW) { const int kb = r / 128, nb = r % 128;
                    p0_transpose_item(a.in[18] + (size_t)l * 4096 * 4096, 4096, 4096, (bf16*)(a.ws + WS_BOUT + l * BOUT_BYTES), nb * 32, scr, kb * 64, nb * 32, lane); }
            }
        }
        if (rope) { f32x2* rt = (f32x2*)(a.ws + WS_ROPE);
            for (int idx = vb * 512 + tid; idx < 4096 * 32; idx += nvb * 512) { const int pos = idx >> 5, i = idx & 31;
                const double inv = exp2(-(double)i * (13.287712379549449 / 32.0)); const double ang = (double)pos * inv;
                rt[idx] = (f32x2){(float)cos(ang), (float)sin(ang)}; } }
    }
}
#ifndef SPLIT_PROLOGUE
#define SPLIT_PROLOGUE 0
#endif
__device__ __forceinline__ void phase_prologue(const Args& a, LAS unsigned char* lds, int G) {
#if SPLIT_PROLOGUE
    prologue_work(a, lds, (int)blockIdx.x, G, 1, 0x7, true);
#else
    prologue_work(a, lds, (int)blockIdx.x, G, 3, 0xF, true);
#endif
}

__device__ __forceinline__ int row_j(int row) { return (row < MP) ? (row >> 12) : (4 + ((row - MP) >> 4)); }
__device__ __forceinline__ void stage_params(const Args& a, LAS float* pl, int tid, int mode  , int j) {
    const float* mod = (const float*)(a.ws + WS_MOD); const float* g_pre = a.in[10]; const float* g_post = a.in[11];
    for (int c = tid * 4; c < D; c += 2048) {
        if (mode == 0) { const float* mr = mod + (size_t)j * 12288;
            *(LAS f32x4*)(pl + 4096 + c) = *(const f32x4*)(g_pre + c) * (*(const f32x4*)(mr + 4096 + c) + 1.0f); *(LAS f32x4*)(pl + 8192 + c) = *(const f32x4*)(mr + c); }
        else { const int l = mode - 1; const float* mr = mod + ((size_t)l * 20 + j) * 12288;
            *(LAS f32x4*)(pl + c) = *(const f32x4*)(mr + 8192 + c) * *(const f32x4*)(g_post + (size_t)l * D + c);
            if (l == 0) { const float* m1 = mod + ((size_t)20 + j) * 12288;
                *(LAS f32x4*)(pl + 4096 + c) = *(const f32x4*)(g_pre + D + c) * (*(const f32x4*)(m1 + 4096 + c) + 1.0f); *(LAS f32x4*)(pl + 8192 + c) = *(const f32x4*)(m1 + c); } }
    }
}
template <int mode> __device__ __forceinline__ void phase_rows(const Args& a, LAS unsigned char* lds, int G) {
    const int tid = tid_opaque(), wave = tid >> 6;
    LAS float* pl = (LAS float*)lds;
    const bf16* Y = (const bf16*)(a.ws + WS_P); const float* ysq = (const float*)(a.ws + WS_YSQ);
    bf16* H = (bf16*)(a.ws + WS_HO);
    const int rpb = (M + G - 1) / G;
    const int r0 = blockIdx.x * rpb, r1 = (r0 + rpb < M) ? r0 + rpb : M;
    int cur_j = -1;
    for (int rb = r0; rb < r1; rb += 8) {
        const int jg = row_j(rb);
        if (jg != cur_j) { __syncthreads(); stage_params(a, pl, tid, mode, jg); cur_j = jg; __syncthreads(); }
        const int row = rb + wave;
        if (row >= r1) continue;
        const int lane = tid_opaque() & 63;
        const bool fast = row_j(row) == cur_j;
        float* orow = (row < MP) ? a.out + O_YP + (size_t)row * D : a.out + O_YS + (size_t)(row - MP) * D;
        const float* xr = (mode == 2) ? orow : ((row < MP) ? a.in[0] + (size_t)row * D : a.in[1] + (size_t)(row - MP) * D);
        f32x4 v[16]; float s = 0.f;
        if (mode == 0) {
#pragma unroll
            for (int q = 0; q < 16; ++q) { v[q] = *(const f32x4*)(xr + 4 * lane + 256 * q); s += (v[q][0] * v[q][0] + v[q][1] * v[q][1]) + (v[q][2] * v[q][2] + v[q][3] * v[q][3]); }
        } else {
            const int l = mode - 1; const int j = row_j(row);
            const bf16* yrow = (row < MP) ? Y + (size_t)row * D : (const bf16*)(a.ws + WS_YS) + (size_t)(row - MP) * D;
            const float rstd_y = rsqrtf(wave_sum(ysq[(size_t)row * 64 + lane]) * (1.f / D) + EPS);
            const float* mr = (const float*)(a.ws + WS_MOD) + ((size_t)l * 20 + j) * 12288; const float* gp = a.in[11] + (size_t)l * D;
#pragma unroll
            for (int hb = 0; hb < 2; ++hb) {
                u32x2 yw[8];
#pragma unroll
                for (int q8 = 0; q8 < 8; ++q8) { const int q = hb * 8 + q8, c = 4 * lane + 256 * q; v[q] = *(const f32x4*)(xr + c); yw[q8] = *(const u32x2*)(yrow + c); }
#pragma unroll
                for (int q8 = 0; q8 < 8; ++q8) { const int q = hb * 8 + q8, c = 4 * lane + 256 * q; const f32x4 y = (f32x4){bflo(yw[q8].x), bfhi(yw[q8].x), bflo(yw[q8].y), bfhi(yw[q8].y)};
                    const f32x4 pa = fast ? *(const LAS f32x4*)(pl + c) : (*(const f32x4*)(mr + 8192 + c) * *(const f32x4*)(gp + c));
                    v[q] = v[q] + pa * (y * rstd_y);
#if defined(DBG_MEAS) || defined(DBG_MEASC) || defined(DBG_CLK)
                    if (l == 1 && row >= MP && (unsigned)(row - MP) < ((const unsigned*)(a.ws + WS_CTL))[2000]) v[q] = (f32x4){0.f, 0.f, 0.f, 0.f};
#endif
                    s += (v[q][0] * v[q][0] + v[q][1] * v[q][1]) + (v[q][2] * v[q][2] + v[q][3] * v[q][3]);
                    *(f32x4*)(orow + c) = v[q]; }
            }
        }
        if (mode != 2) {
            const float rstd = rsqrtf(wave_sum(s) * (1.f / D) + EPS); const int j = row_j(row);
            const float* m1 = (const float*)(a.ws + WS_MOD) + ((size_t)(mode == 0 ? 0 : 20) + j) * 12288; const float* g1 = a.in[10] + (mode == 0 ? 0 : D);
#pragma unroll
            for (int q = 0; q < 16; ++q) { const int c = 4 * lane + 256 * q;
                const f32x4 pb = fast ? *(const LAS f32x4*)(pl + 4096 + c) : (*(const f32x4*)(g1 + c) * (*(const f32x4*)(m1 + 4096 + c) + 1.0f));
                const f32x4 pc = fast ? *(const LAS f32x4*)(pl + 8192 + c) : *(const f32x4*)(m1 + c);
                const f32x4 hv = v[q] * rstd * pb + pc; u32x2 w; w.x = cvtpk(hv[0], hv[1]); w.y = cvtpk(hv[2], hv[3]);
                *(u32x2*)(H + (size_t)row * D + c) = w; }
        }
    }
}


constexpr int L_KH = 0, L_QH = 18432, L_RT = 36864, L_XT = 77824, L_AI = 118784, L_DG = 129024, L_DI = 133120, L_GT = 135168;
constexpr int S128 = 144, S64 = 80;

__device__ __forceinline__ void phase_c1(const Args& a, int l, LAS unsigned char* lds, int G) {
    int tid, lane, wave, fr, fq;
#define RELANE() do { tid = tid_opaque(); lane = tid & 63; wave = __builtin_amdgcn_readfirstlane(tid >> 6); fr = lane & 15; fq = lane >> 4; } while (0)
    RELANE();
    const bf16* P = (const bf16*)(a.ws + WS_P);
    float* decbuf = (float*)(a.ws + WS_DEC);
    const float* conv_w = a.in[13] + (size_t)l * 4 * 6144;
    LAS bf16* KH = (LAS bf16*)(lds + L_KH); LAS bf16* QH = (LAS bf16*)(lds + L_QH); LAS bf16* RT = (LAS bf16*)(lds + L_RT); LAS bf16* XT = (LAS bf16*)(lds + L_XT);
    LAS bf16* AI = (LAS bf16*)(lds + L_AI); LAS float* DG = (LAS float*)(lds + L_DG); LAS bf16* DI = (LAS bf16*)(lds + L_DI);
    LAS unsigned char* STG = lds + L_XT;
    LAS float* g_beta = (LAS float*)(lds + L_GT); LAS float* g_gc = g_beta + 64; LAS float* g_egc = g_beta + 128; LAS float* g_misc = g_beta + 192;

    u32x4 raw[8]; unsigned gl = 0;
#define ITEM_PARAMS(it_, sample_, n_, c_, h_, ntok_, rowbase_) const bool sample_ = (it_) >= 4096; int n_, c_, h_, ntok_; size_t rowbase_; \
        if (!sample_) { h_ = (it_) & 15; c_ = ((it_) >> 4) & 63; n_ = (it_) >> 10; rowbase_ = (size_t)n_ * 4096 + c_ * 64; ntok_ = 64; } \
        else { const int s_ = (it_) - 4096; h_ = s_ & 15; n_ = s_ >> 4; c_ = 0; rowbase_ = (size_t)MP + n_ * 16; ntok_ = 16; }
#define PREFETCH(it_) do { ITEM_PARAMS(it_, ps_, pn_, pc_, ph_, pnt_, prb_); const int pt_ = tid_opaque(); \
        if (pt_ < 384) { const int pch0_ = (pt_ >> 7) * 2048 + ph_ * 128 + (pt_ & 15) * 8, pt0_ = ((pt_ >> 4) & 7) * 8; \
            _Pragma("unroll") for (int i = 0; i < 8; ++i) { const int tt = pt0_ + i; raw[i] = (u32x4){0u, 0u, 0u, 0u}; \
                if (tt < pnt_) raw[i] = *(const u32x4*)(P + (prb_ + tt) * NP + pch0_); } } \
        else { const int ptz_ = pt_ - 384; \
            if (ptz_ < 64 && ptz_ < pnt_) gl = (unsigned)P[(prb_ + ptz_) * NP + C_B + ph_] | ((unsigned)P[(prb_ + ptz_) * NP + C_A + ph_] << 16); } } while (0)

#ifdef DBG_MEASC
    unsigned long long dmacc_ = 0; const unsigned long long dmt0_ = __builtin_amdgcn_s_memtime(); unsigned long long dml_ = dmt0_;
#define DM(k) do { const unsigned long long n_ = __builtin_amdgcn_s_memtime(); if ((k) == DBG_MEASC) dmacc_ += n_ - dml_; dml_ = n_; } while (0)
#else
#define DM(k) do {} while (0)
#endif
    for (int item = blockIdx.x; item < NREC; item += G) {
        ITEM_PARAMS(item, sample, n, c, h, ntok, rowbase);
        const int reci = sample ? item : ((n * 16 + h) * 64 + c);
        unsigned char* rec = a.ws + WS_REC + (size_t)reci * REC_BYTES;
        const bool last = sample || (c == 63);
        DM(5); BAR_LDS(); DM(0);
        PREFETCH(item);
        RELANE();
        f32x2 val2[8][4];
        float ssq[8];
        int g = 3, cgl, seg;
        if (tid < 384) {
            cgl = tid & 15; g = __builtin_amdgcn_readfirstlane(tid >> 7); seg = (tid >> 4) & 7;
            const int ch0 = g * 2048 + h * 128 + cgl * 8;
            const int t0 = seg * 8;
            f32x4 wq[4][2];
#pragma unroll
            for (int j = 0; j < 4; ++j) { wq[j][0] = *(const f32x4*)(conv_w + (size_t)j * 6144 + ch0); wq[j][1] = *(const f32x4*)(conv_w + (size_t)j * 6144 + ch0 + 4); }
            u32x4 hist[3];
#pragma unroll
            for (int i = 0; i < 3; ++i) { const int tt = t0 - 3 + i; hist[i] = (u32x4){0u, 0u, 0u, 0u};
                if (tt < ntok && (tt >= 0 || (!sample && c > 0))) hist[i] = *(const u32x4*)(P + (rowbase + tt) * NP + ch0); }
            if (sample && seg == 0) {
                const float* sc = a.in[2] + (((size_t)l * 16 + n) * 3) * 6144 + ch0;
#pragma unroll
                for (int i = 0; i < 3; ++i) { const f32x4 s0 = *(const f32x4*)(sc + (size_t)i * 6144), s1 = *(const f32x4*)(sc + (size_t)i * 6144 + 4);
                    hist[i].x = cvtpk(s0[0], s0[1]); hist[i].y = cvtpk(s0[2], s0[3]); hist[i].z = cvtpk(s1[0], s1[1]); hist[i].w = cvtpk(s1[2], s1[3]); }
            }
            f32x2 sq2[8];
#pragma unroll
            for (int tok = 0; tok < 8; ++tok) sq2[tok] = (f32x2){0.f, 0.f};
#pragma unroll
            for (int cp = 0; cp < 4; ++cp) {
                f32x2 w2[4], x2[11];
#pragma unroll
                for (int j = 0; j < 4; ++j) w2[j] = (f32x2){wq[j][cp >> 1][2 * (cp & 1)], wq[j][cp >> 1][2 * (cp & 1) + 1]};
#pragma unroll
                for (int r = 0; r < 11; ++r) { const unsigned dw = (r < 3) ? hist[r < 3 ? r : 0][cp] : raw[r >= 3 ? r - 3 : 0][cp]; x2[r] = (f32x2){bflo(dw), bfhi(dw)}; }
#pragma unroll
                for (int tok = 0; tok < 8; ++tok) {
                    const f32x2 y = w2[0] * x2[tok] + w2[1] * x2[tok + 1] + w2[2] * x2[tok + 2] + w2[3] * x2[tok + 3];
                    const f32x2 t = y * -1.4426950408889634f; f32x2 e; e.x = __builtin_amdgcn_exp2f(t.x); e.y = __builtin_amdgcn_exp2f(t.y);
                    const f32x2 d = e + 1.0f; f32x2 r; r.x = __builtin_amdgcn_rcpf(d.x); r.y = __builtin_amdgcn_rcpf(d.y);
                    f32x2 v = y * r; if (!((t0 + tok) < ntok)) v = (f32x2){0.f, 0.f};
                    val2[tok][cp] = v; sq2[tok] += v * v; }
            }
#pragma unroll
            for (int tok = 0; tok < 8; ++tok) ssq[tok] = sq2[tok].x + sq2[tok].y;
            if (last && seg == (sample ? 1 : 7)) {
#pragma unroll
                for (int tok = 5; tok < 8; ++tok) { float rf[8]; unpack8(raw[tok], rf);
                    float* co = sample ? a.out + O_CONVS + (((size_t)l * 16 + n) * 3 + (tok - 5)) * 6144 + ch0 : a.out + O_CONVP + (((size_t)l * 4 + n) * 3 + (tok - 5)) * 6144 + ch0;
                    *(f32x4*)co = (f32x4){rf[0], rf[1], rf[2], rf[3]}; *(f32x4*)(co + 4) = (f32x4){rf[4], rf[5], rf[6], rf[7]}; }
            }
#pragma unroll
            for (int tok = 0; tok < 8; ++tok) ssq[tok] = sum16(ssq[tok]);
        } else {
            const int tz = tid - 384; cgl = tz & 15; seg = tz >> 4;
            if (wave == 6) {
                float beta = 0.f, gg = 0.f;
                if (lane < ntok) { const float b = bflo(gl), av = bfhi(gl);
                    beta = sigmoid_f(b); const float xx = av + a.in[15][l * 16 + h]; const float sp = fmaxf(xx, 0.f) + log1pf(__expf(-fabsf(xx)));
                    gg = -__expf(a.in[14][l * 16 + h]) * sp; }
                float gc = gg;
#pragma unroll
                for (int o = 1; o < 64; o <<= 1) { const float t = __shfl_up(gc, o); if (lane >= o) gc += t; }
                g_beta[lane] = beta; g_gc[lane] = gc; g_egc[lane] = __expf(gc);
                const float gcl = __shfl(gc, 63);
                if (lane == 0) { g_misc[0] = gcl; decbuf[reci] = __expf(gcl); }
            }
        }
        DM(1); BAR_LDS(); DM(2);
#ifndef DBG_C1_REP
#define DBG_C1_REP 0
#endif
        for (int rp1_ = 0; rp1_ < ((DBG_C1_REP) & 1) + 1; ++rp1_)
        {
            { const int t1 = tid_opaque(); cgl = t1 & 15; seg = (t1 >> 4) & 7; }
            const int t0 = seg * 8;
            float bt[8], gcv[8], eg[8];
            { const f32x4 b0 = *(const LAS f32x4*)(g_beta + t0), b1 = *(const LAS f32x4*)(g_beta + t0 + 4), c0 = *(const LAS f32x4*)(g_gc + t0), c1 = *(const LAS f32x4*)(g_gc + t0 + 4),
                  e0 = *(const LAS f32x4*)(g_egc + t0), e1 = *(const LAS f32x4*)(g_egc + t0 + 4);
#pragma unroll
              for (int i = 0; i < 4; ++i) { bt[i] = b0[i]; bt[4 + i] = b1[i]; gcv[i] = c0[i]; gcv[4 + i] = c1[i]; eg[i] = e0[i]; eg[4 + i] = e1[i]; } }
            const float gcl = g_misc[0];
            const int qs0 = ((cgl * 8) & 15) >> 2, half0 = ((cgl * 8) >> 4) & 1, ks0 = (cgl * 8) >> 5;
            const int tq0 = (t0 & 15) >> 2, thalf = (t0 >> 4) & 1, tks = t0 >> 5;
            if (g == 0) {
#pragma unroll
                for (int tok = 0; tok < 8; ++tok) { const int t = t0 + tok; const float r = rsqrtf(ssq[tok] + EPS) * 0.08838834764831845f; f32x2 qv[4];
#pragma unroll
                    for (int i = 0; i < 4; ++i) qv[i] = val2[tok][i] * r;
                    *(LAS u32x4*)(QH + t * S128 + cgl * 8) = pack8v(qv);
                    const float e = eg[tok];
                    const int fq_ = (t >> 4) * 4 + ks0; LAS unsigned char* fp = STG + fq_ * 1024 + ((((t & 15) + 16 * qs0) ^ (fq_ & 7)) * 16) + 8 * half0;
#pragma unroll
                    for (int i = 0; i < 4; ++i) qv[i] = qv[i] * e;
                    u32x2 w0, w1; w0.x = cvtpk(qv[0].x, qv[0].y); w0.y = cvtpk(qv[1].x, qv[1].y); w1.x = cvtpk(qv[2].x, qv[2].y); w1.y = cvtpk(qv[3].x, qv[3].y);
                    *(LAS u32x2*)fp = w0; *(LAS u32x2*)(fp + 256) = w1; }
            } else if (g == 1) {
#pragma unroll
                for (int tok = 0; tok < 8; ++tok) { const float r = rsqrtf(ssq[tok] + EPS);
#pragma unroll
                    for (int i = 0; i < 4; ++i) val2[tok][i] = val2[tok][i] * r;
                    *(LAS u32x4*)(KH + (t0 + tok) * S128 + cgl * 8) = pack8v(val2[tok]); }
                float f1[8], f2[8];
#pragma unroll
                for (int tok = 0; tok < 8; ++tok) { f1[tok] = bt[tok] * eg[tok]; f2[tok] = __expf(gcl - gcv[tok]); }
#pragma unroll
                for (int ip = 0; ip < 4; ++ip) {
                    f32x2 rr[8], kd[8];
#pragma unroll
                    for (int tok = 0; tok < 8; ++tok) { rr[tok] = val2[tok][ip] * f1[tok]; kd[tok] = val2[tok][ip] * f2[tok]; }
#pragma unroll
                    for (int hh = 0; hh < 2; ++hh) { const int i = 2 * ip + hh, d = cgl * 8 + i;
                        u32x4 rw; rw.x = cvtpk(rr[0][hh], rr[1][hh]); rw.y = cvtpk(rr[2][hh], rr[3][hh]); rw.z = cvtpk(rr[4][hh], rr[5][hh]); rw.w = cvtpk(rr[6][hh], rr[7][hh]);
                        *(LAS u32x4*)(RT + (128 + i * 16 + cgl) * S64 + t0) = rw;
                        const int fk_ = 16 + (d >> 4) * 2 + tks; LAS unsigned char* fp = STG + fk_ * 1024 + ((((d & 15) + 16 * tq0) ^ (fk_ & 7)) * 16) + 8 * thalf;
                        u32x2 w0, w1; w0.x = cvtpk(kd[0][hh], kd[1][hh]); w0.y = cvtpk(kd[2][hh], kd[3][hh]); w1.x = cvtpk(kd[4][hh], kd[5][hh]); w1.y = cvtpk(kd[6][hh], kd[7][hh]);
                        *(LAS u32x2*)fp = w0; *(LAS u32x2*)(fp + 256) = w1; } }
            } else if (g == 2) {
#pragma unroll
                for (int ip = 0; ip < 4; ++ip) { f32x2 rr[8];
#pragma unroll
                    for (int tok = 0; tok < 8; ++tok) rr[tok] = val2[tok][ip] * bt[tok];
#pragma unroll
                    for (int hh = 0; hh < 2; ++hh) { const int i = 2 * ip + hh;
                        u32x4 rw; rw.x = cvtpk(rr[0][hh], rr[1][hh]); rw.y = cvtpk(rr[2][hh], rr[3][hh]); rw.z = cvtpk(rr[4][hh], rr[5][hh]); rw.w = cvtpk(rr[6][hh], rr[7][hh]);
                        *(LAS u32x4*)(RT + (i * 16 + cgl) * S64 + t0) = rw; } }
            }
        }
        DM(3); BAR_LDS(); DM(4);
#if defined(DBG_C1_STOP) && DBG_C1_STOP <= 1
        continue;
#endif
        RELANE();
        for (int rp2_ = 0; rp2_ < (((DBG_C1_REP) >> 1) & 1) + 1; ++rp2_)
#pragma unroll
        for (int k2 = 0; k2 < 2; ++k2) {
            const int tile = wave * 2 + k2, ti = tile >> 2, tj = tile & 3;
            f32x4 acq = (f32x4){0.f, 0.f, 0.f, 0.f}, ack = (f32x4){0.f, 0.f, 0.f, 0.f};
#pragma unroll
            for (int ks = 0; ks < 4; ++ks) {
                const bf16x8 kj = *(const LAS bf16x8*)(KH + (16 * tj + fr) * S128 + 32 * ks + 8 * fq);
                const bf16x8 qi = *(const LAS bf16x8*)(QH + (16 * ti + fr) * S128 + 32 * ks + 8 * fq);
                acq = __builtin_amdgcn_mfma_f32_16x16x32_bf16(kj, qi, acq, 0, 0, 0);
                if (ti >= tj) { const bf16x8 ki = *(const LAS bf16x8*)(KH + (16 * ti + fr) * S128 + 32 * ks + 8 * fq);
                    ack = __builtin_amdgcn_mfma_f32_16x16x32_bf16(ki, kj, ack, 0, 0, 0); }
            }
            {
                const int i = 16 * ti + fr; const float gi = g_gc[i]; const f32x4 gj = *(const LAS f32x4*)(g_gc + 16 * tj + 4 * fq); float o[4];
#pragma unroll
                for (int r = 0; r < 4; ++r) { const int j = 16 * tj + 4 * fq + r; o[r] = (i >= j) ? acq[r] * __expf(fminf(gi - gj[r], 0.f)) : 0.f; }
                u32x2 w; w.x = cvtpk(o[0], o[1]); w.y = cvtpk(o[2], o[3]);
                { const int fk2_ = 32 + ti * 2 + (tj >> 1); *(LAS u32x2*)(STG + fk2_ * 1024 + ((lane ^ (fk2_ & 7)) * 16) + 8 * (tj & 1)) = w; }
            }
            if (ti >= tj) {
                const int j = 16 * tj + fr; const float gj = g_gc[j]; const f32x4 gi = *(const LAS f32x4*)(g_gc + 16 * ti + 4 * fq), bi = *(const LAS f32x4*)(g_beta + 16 * ti + 4 * fq);
#pragma unroll
                for (int r = 0; r < 4; ++r) { const int i = 16 * ti + 4 * fq + r; const float v = (i > j) ? bi[r] * ack[r] * __expf(fminf(gi[r] - gj, 0.f)) : 0.f;
                    AI[i * S64 + j] = (bf16)(cvtpk(v, 0.f) & 0xffffu);
                    if (ti == tj) DG[(ti * 16 + (i & 15)) * 16 + fr] = v; }
            }
        }
        BAR_LDS();
#if defined(DBG_C1_STOP) && DBG_C1_STOP <= 2
        continue;
#endif
        RELANE();
#pragma unroll
        for (int k5 = 0; k5 < 5; ++k5) { const int u = tid + 512 * k5, fu_ = u >> 6; *(u32x4*)(rec + REC_QD + (size_t)u * 16) = *(const LAS u32x4*)(STG + fu_ * 1024 + (((u & 63) ^ (fu_ & 7)) * 16)); }
        for (int rp3_ = 0; rp3_ < (((DBG_C1_REP) >> 2) & 1) + 1; ++rp3_)
        if (wave == 0) {
            const int b = fq, cc = fr; float x[16];
            {   f32x4 dg[10][3];
#pragma unroll
                for (int r = 1; r < 10; ++r)
#pragma unroll
                    for (int j4 = 0; j4 < (r + 3) / 4; ++j4) dg[r][j4] = *(const LAS f32x4*)(DG + (b * 16 + r) * 16 + 4 * j4);
                __builtin_amdgcn_sched_barrier(0);
#pragma unroll
                for (int r = 0; r < 10; ++r) { float s = (r == cc) ? 1.f : 0.f;
#pragma unroll
                    for (int j = 0; j < r; ++j) s -= dg[r][j >> 2][j & 3] * x[j];
                    x[r] = s; DI[(b * 16 + r) * 16 + cc] = (bf16)(cvtpk(s, 0.f) & 0xffffu); } }
            __builtin_amdgcn_sched_barrier(0);
            {   f32x4 dg[6][4];
#pragma unroll
                for (int r = 10; r < 16; ++r)
#pragma unroll
                    for (int j4 = 0; j4 < (r + 3) / 4; ++j4) dg[r - 10][j4] = *(const LAS f32x4*)(DG + (b * 16 + r) * 16 + 4 * j4);
                __builtin_amdgcn_sched_barrier(0);
#pragma unroll
                for (int r = 10; r < 16; ++r) { float s = (r == cc) ? 1.f : 0.f;
#pragma unroll
                    for (int j = 0; j < r; ++j) s -= dg[r - 10][j >> 2][j & 3] * x[j];
                    x[r] = s; DI[(b * 16 + r) * 16 + cc] = (bf16)(cvtpk(s, 0.f) & 0xffffu); } }
        }
        BAR_LDS();
#if defined(DBG_C1_STOP) && DBG_C1_STOP <= 3
        continue;
#endif
        for (int rp4_ = 0; rp4_ < (((DBG_C1_REP) >> 3) & 1) + 1; ++rp4_)
#pragma unroll
        for (int b = 0; b < 4; ++b) {
            RELANE();
#pragma unroll
            for (int k2 = 0; k2 < 2; ++k2) {
                const int nt = wave * 2 + k2;
                f32x4 y = (f32x4){0.f, 0.f, 0.f, 0.f};
#pragma unroll
                for (int ks = 0; ks < (b + 1) / 2; ++ks) {
                    const bool ok = (32 * ks + 8 * fq) < 16 * b;
                    u32x4 av = *(const LAS u32x4*)(AI + (16 * b + fr) * S64 + 32 * ks + 8 * fq), xv = *(const LAS u32x4*)(XT + (16 * nt + fr) * S64 + 32 * ks + 8 * fq);
                    if (!ok) { av = (u32x4){0u, 0u, 0u, 0u}; xv = (u32x4){0u, 0u, 0u, 0u}; }
                    y = __builtin_amdgcn_mfma_f32_16x16x32_bf16(as_bf16x8(av), as_bf16x8(xv), y, 0, 0, 0);
                }
                const int rn = 16 * nt + fr; const u32x2 rv = *(const LAS u32x2*)(RT + ((rn & 128) + (rn & 7) * 16 + ((rn & 127) >> 3)) * S64 + 16 * b + 4 * fq);
                const float z0 = bflo(rv.x) - y[0], z1 = bfhi(rv.x) - y[1], z2 = bflo(rv.y) - y[2], z3 = bfhi(rv.y) - y[3];
                u32x2 zb; zb.x = cvtpk(z0, z1); zb.y = cvtpk(z2, z3);
                const u32x2 dv = *(const LAS u32x2*)(DI + (b * 16 + fr) * 16 + 4 * fq);
                const f32x4 xo = __builtin_amdgcn_mfma_f32_16x16x16bf16_1k(as_bf16x4(dv), as_bf16x4(zb), (f32x4){0.f, 0.f, 0.f, 0.f}, 0, 0, 0);
                u32x2 xw; xw.x = cvtpk(xo[0], xo[1]); xw.y = cvtpk(xo[2], xo[3]);
                *(LAS u32x2*)(XT + (16 * nt + fr) * S64 + 16 * b + 4 * fq) = xw;
                if (nt < 8) *(u32x2*)(rec + REC_U + (size_t)(((nt * 4 + b) * 64 + lane) * 8)) = xw;
            }
            LDS_WAIT(); asm volatile("" ::: "memory");
        }
        BAR_LDS();
#if defined(DBG_C1_STOP) && DBG_C1_STOP <= 4
        continue;
#endif
        RELANE();
        for (int rp5_ = 0; rp5_ < (((DBG_C1_REP) >> 4) & 1) + 1; ++rp5_)
#pragma unroll
        for (int k2 = 0; k2 < 2; ++k2) {
            const int u = tid + 512 * k2, frag = u >> 6, tt = frag >> 2, ks = frag & 3;
            float wv[8];
#pragma unroll
            for (int j = 0; j < 8; ++j) wv[j] = -bf1(XT[(128 + 32 * ks + 16 * (j >> 2) + 4 * fq + (j & 3)) * S64 + 16 * tt + fr]);
            *(u32x4*)(rec + REC_W + (size_t)((frag * 64 + lane) * 16)) = pack8(wv);
        }
    }
#ifdef DBG_MEASC
    if (l == 1 && blockIdx.x == 0 && tid_opaque() == 0) { DM(5); const unsigned long long tot_ = __builtin_amdgcn_s_memtime() - dmt0_; const float fr_ = (float)dmacc_ / (float)tot_;
        ((unsigned*)(a.ws + WS_CTL))[2000] = 32u * (unsigned)(fr_ * 8.0f + 0.5f); }
#endif
#undef DM
#undef RELANE
#undef PREFETCH
#undef ITEM_PARAMS
}


constexpr int L_SS = 2 * REC_STAGE, L_RS = L_SS + 2048, L_DN = L_RS + 256, L_OB = L_DN + 512, OBS = 136;
__device__ __forceinline__ void scan_seq(const Args& a, int l, LAS unsigned char* lds, int seq) {
    int tid = tid_opaque(), lane = tid & 63, wave = __builtin_amdgcn_readfirstlane(tid >> 6);
    int fr = lane & 15, fq = lane >> 4;
    const bool sample = seq >= 64;
    const int s2 = sample ? seq - 64 : seq, n = s2 >> 4, h = s2 & 15;
    const int nsteps = sample ? 1 : 64, ntok = sample ? 16 : 64;
    const int rec0 = sample ? 4096 + s2 : s2 * 64;
    const size_t rowbase0 = sample ? (size_t)MP + n * 16 : (size_t)n * 4096;
    const unsigned char* recs = a.ws + WS_REC;
    const float* decbuf = (const float*)(a.ws + WS_DEC);
    bf16* Ob = (bf16*)(a.ws + WS_HO);
    LAS float* ss = (LAS float*)(lds + L_SS); LAS float* rs = (LAS float*)(lds + L_RS); LAS bf16* ob = (LAS bf16*)(lds + L_OB);
    f32x4 st[8];
    if (sample) { const float* s0 = a.in[3] + (((size_t)l * 16 + n) * 16 + h) * 16384;
#pragma unroll
        for (int t = 0; t < 8; ++t)
#pragma unroll
            for (int j = 0; j < 4; ++j) st[t][j] = s0[(16 * t + 4 * fq + j) * 128 + 16 * wave + fr];
    } else {
#pragma unroll
        for (int t = 0; t < 8; ++t) st[t] = (f32x4){0.f, 0.f, 0.f, 0.f};
    }
    __syncthreads();
    {   const unsigned char* src = recs + (size_t)rec0 * REC_BYTES;
#pragma unroll
        for (int k = 0; k < 7; ++k) { const int p = wave * 7 + k;
            __builtin_amdgcn_global_load_lds((const unsigned*)(src + p * 1024 + lane * 16), (LAS unsigned*)(lds + p * 1024), 16, 0, 0); } }
    u32x2 u_cur[4], u_nxt[4]; float dec_cur, dec_nxt = 0.f; f32x4 o_prev[4];
    u32x4 zq[2], zn[2]; LAS float* dnl = (LAS float*)(lds + L_DN);
    if (tid < 128) dnl[tid] = a.in[16][(size_t)l * 128 + tid];
    zq[0] = zq[1] = zn[0] = zn[1] = (u32x4){0u, 0u, 0u, 0u};
    {   const unsigned char* rec = recs + (size_t)rec0 * REC_BYTES;
#pragma unroll
        for (int t = 0; t < 4; ++t) { u_cur[t] = *(const u32x2*)(rec + REC_U + ((wave * 4 + t) * 64 + lane) * 8); u_nxt[t] = u_cur[t]; o_prev[t] = (f32x4){0.f, 0.f, 0.f, 0.f}; }
        dec_cur = decbuf[rec0]; }
#define SCAN_STORE(cc) do {   \
        _Pragma("unroll") for (int t = 0; t < 4; ++t) { const f32x4 r4 = *(const LAS f32x4*)(rs + 16 * t + 4 * fq); \
            _Pragma("unroll") for (int j = 0; j < 4; ++j) ob[(16 * t + 4 * fq + j) * OBS + 16 * wave + fr] = (bf16)(cvtpk(o_prev[t][j] * r4[j], 0.f) & 0xffffu); } } while (0)
#define SCAN_ZLOAD(cc, Z) do { const int tok_ = tid >> 3; if (tok_ < ntok) { const bf16* zp_ = (const bf16*)(a.ws + WS_P) + (rowbase0 + (size_t)(cc) * 64 + tok_) * NP + C_ZDN + h * 128 + (tid & 7) * 8; \
            Z[0] = *(const u32x4*)zp_; Z[1] = *(const u32x4*)(zp_ + 64); } } while (0)
#define SCAN_FLUSH(cc, Z) do {   \
        const int tok_ = tid >> 3, pc_ = tid & 7; \
        if (tok_ < ntok) { bf16* op_ = Ob + (rowbase0 + (size_t)(cc) * 64 + tok_) * D + h * 128 + pc_ * 8; \
            _Pragma("unroll") for (int hh = 0; hh < 2; ++hh) { float ov_[8], zv_[8]; unpack8(*(const LAS u32x4*)(ob + tok_ * OBS + 64 * hh + pc_ * 8), ov_); unpack8(Z[hh], zv_); \
                _Pragma("unroll") for (int i = 0; i < 8; ++i) ov_[i] = ov_[i] * zv_[i];     \
                *(u32x4*)(op_ + 64 * hh) = pack8(ov_); } } } while (0)
#define SCAN_RS() do { if (tid < 64) { float tsum = 0.f; \
            _Pragma("unroll") for (int w8 = 0; w8 < 8; ++w8) tsum += ss[w8 * 64 + tid]; \
            rs[tid] = rsqrtf(tsum * (1.f / 128.f) + EPS); } } while (0)
#ifdef DBG_MEAS
    unsigned long long dbg_w_ = 0, dbg_b_ = 0, dbg_b2_ = 0; const unsigned long long dbg_t0_ = __builtin_amdgcn_s_memtime(); const unsigned long long dbg_r0_ = __builtin_amdgcn_s_memrealtime();
#endif
    for (int c = 0; c < nsteps; ++c) {
        tid = tid_opaque(); lane = tid & 63; wave = __builtin_amdgcn_readfirstlane(tid >> 6); fr = lane & 15; fq = lane >> 4;
        const LAS unsigned char* buf = lds + (c & 1) * REC_STAGE;
        const unsigned char* rec = recs + (size_t)(rec0 + c) * REC_BYTES;
#ifdef DBG_MEAS
        const unsigned long long tm0_ = __builtin_amdgcn_s_memtime();
        VM_WAIT();
        const unsigned long long tm1_ = __builtin_amdgcn_s_memtime();
        __syncthreads();
        const unsigned long long tm2_ = __builtin_amdgcn_s_memtime();
        dbg_w_ += tm1_ - tm0_; dbg_b_ += tm2_ - tm1_;
#else
        VM_WAIT(); __syncthreads();
#endif; everybody is done with the other buffer; ss of step c-1 is complete
        if (c + 1 < nsteps) { const unsigned char* src = rec + REC_BYTES; LAS unsigned char* dst = lds + ((c + 1) & 1) * REC_STAGE;
#pragma unroll
            for (int k = 0; k < 7; ++k) { const int p = wave * 7 + k;
                __builtin_amdgcn_global_load_lds((const unsigned*)(src + p * 1024 + lane * 16), (LAS unsigned*)(dst + p * 1024), 16, 0, 0); }
#pragma unroll
            for (int t = 0; t < 4; ++t) u_nxt[t] = *(const u32x2*)(src + REC_U + ((wave * 4 + t) * 64 + lane) * 8);
            dec_nxt = decbuf[rec0 + c + 1]; }
        if (c > 0) SCAN_RS();
        if (c > 1) SCAN_FLUSH(c - 2, zn);
        if (c > 0) SCAN_ZLOAD(c - 1, zn);
        bf16x8 Bs[4];
#pragma unroll
        for (int ks = 0; ks < 4; ++ks) { u32x4 w; w.x = cvtpk(st[2 * ks][0], st[2 * ks][1]); w.y = cvtpk(st[2 * ks][2], st[2 * ks][3]); w.z = cvtpk(st[2 * ks + 1][0], st[2 * ks + 1][1]); w.w = cvtpk(st[2 * ks + 1][2], st[2 * ks + 1][3]); Bs[ks] = as_bf16x8(w); }
        f32x4 ws4[4], oacc[4];
#pragma unroll
        for (int t = 0; t < 4; ++t) ws4[t] = (f32x4){bflo(u_cur[t].x), bfhi(u_cur[t].x), bflo(u_cur[t].y), bfhi(u_cur[t].y)};
        bf16x8 FX[8], FY[8];
#define LDG(F, off) do { _Pragma("unroll") for (int i_ = 0; i_ < 8; ++i_) F[i_] = *(const LAS bf16x8*)(buf + (off) + (i_ * 64 + lane) * 16); } while (0)
#define SB() __builtin_amdgcn_sched_barrier(0)
        LDG(FX, REC_W); LDG(FY, REC_W + 8192); SB();
#pragma unroll
        for (int i = 0; i < 8; ++i) ws4[i >> 2] = __builtin_amdgcn_mfma_f32_16x16x32_bf16(FX[i], Bs[i & 3], ws4[i >> 2], 0, 0, 0);
        SB(); LDG(FX, REC_QD); SB();
#pragma unroll
        for (int i = 0; i < 8; ++i) ws4[2 + (i >> 2)] = __builtin_amdgcn_mfma_f32_16x16x32_bf16(FY[i], Bs[i & 3], ws4[2 + (i >> 2)], 0, 0, 0);
        SB(); LDG(FY, REC_QD + 8192); SB();
#pragma unroll
        for (int i = 0; i < 8; ++i) oacc[i >> 2] = __builtin_amdgcn_mfma_f32_16x16x32_bf16(FX[i], Bs[i & 3], (i & 3) ? oacc[i >> 2] : (f32x4){0.f, 0.f, 0.f, 0.f}, 0, 0, 0);
        SB(); LDG(FX, REC_QK); SB();
#pragma unroll
        for (int i = 0; i < 8; ++i) oacc[2 + (i >> 2)] = __builtin_amdgcn_mfma_f32_16x16x32_bf16(FY[i], Bs[i & 3], (i & 3) ? oacc[2 + (i >> 2)] : (f32x4){0.f, 0.f, 0.f, 0.f}, 0, 0, 0);
        SB(); LDG(FY, REC_KD); SB();
        bf16x8 Bv[2];
        {   f32x4 vn[4];
#pragma unroll
            for (int t = 0; t < 4; ++t) vn[t] = ws4[t];
#pragma unroll
            for (int k2 = 0; k2 < 2; ++k2) { u32x4 w; w.x = cvtpk(vn[2 * k2][0], vn[2 * k2][1]); w.y = cvtpk(vn[2 * k2][2], vn[2 * k2][3]); w.z = cvtpk(vn[2 * k2 + 1][0], vn[2 * k2 + 1][1]); w.w = cvtpk(vn[2 * k2 + 1][2], vn[2 * k2 + 1][3]); Bv[k2] = as_bf16x8(w); } }
#pragma unroll
        for (int t = 0; t < 8; ++t) st[t] = st[t] * dec_cur;
        SB();
#pragma unroll
        for (int i = 0; i < 8; ++i) oacc[i >> 1] = __builtin_amdgcn_mfma_f32_16x16x32_bf16(FX[i], Bv[i & 1], oacc[i >> 1], 0, 0, 0);
        SB(); LDG(FX, REC_KD + 8192); SB();
#pragma unroll
        for (int i = 0; i < 8; ++i) st[i >> 1] = __builtin_amdgcn_mfma_f32_16x16x32_bf16(FY[i], Bv[i & 1], st[i >> 1], 0, 0, 0);
        SB();
#pragma unroll
        for (int i = 0; i < 8; ++i) st[4 + (i >> 1)] = __builtin_amdgcn_mfma_f32_16x16x32_bf16(FX[i], Bv[i & 1], st[4 + (i >> 1)], 0, 0, 0);
#undef LDG
#undef SB
#ifdef DBG_MEAS
        const unsigned long long tm3_ = __builtin_amdgcn_s_memtime();
#endif
        BAR_LDS();
#ifdef DBG_MEAS
        dbg_b2_ += __builtin_amdgcn_s_memtime() - tm3_;
#endif
        if (c > 0) SCAN_STORE(c - 1);
#pragma unroll
        for (int t = 0; t < 4; ++t) { const float k = quadsum16(oacc[t] * oacc[t], fr);
            if (fr < 4) ss[wave * 64 + 16 * t + 4 * fq + fr] = k; }
#pragma unroll
        for (int t = 0; t < 4; ++t) { o_prev[t] = oacc[t]; u_cur[t] = u_nxt[t]; }
        dec_cur = dec_nxt;
    }
#ifdef DBG_MEAS
    if (l == 1 && seq == 0 && tid == 0) { const unsigned long long tot_ = __builtin_amdgcn_s_memtime() - dbg_t0_; const unsigned long long rt_ = __builtin_amdgcn_s_memrealtime() - dbg_r0_;
        float fr_ = 0.f;
        if (DBG_MEAS == 1) fr_ = (float)dbg_w_ / (float)tot_; else if (DBG_MEAS == 2) fr_ = (float)dbg_b_ / (float)tot_; else if (DBG_MEAS == 3) fr_ = (float)dbg_b2_ / (float)tot_;
        else if (DBG_MEAS == 4) fr_ = (float)rt_ * 0.01f / 500.0f;
        else if (DBG_MEAS == 5) fr_ = (float)tot_ / (float)rt_ / 100.0f * 0.25f;
        ((unsigned*)(a.ws + WS_CTL))[2000] = 8u * (unsigned)(fr_ * 32.0f + 0.5f); }
#endif
    __syncthreads();
    SCAN_RS();
    if (nsteps > 1) SCAN_FLUSH(nsteps - 2, zn);
    SCAN_ZLOAD(nsteps - 1, zq);
    __syncthreads();
    SCAN_STORE(nsteps - 1);
    __syncthreads();
    SCAN_FLUSH(nsteps - 1, zq);
#undef SCAN_FLUSH
#undef SCAN_ZLOAD
#undef SCAN_STORE
#undef SCAN_RS
    {   float* so = sample ? a.out + O_DNS + (((size_t)l * 16 + n) * 16 + h) * 16384 : a.out + O_DNP + (((size_t)l * 4 + n) * 16 + h) * 16384;
#pragma unroll
        for (int t = 0; t < 8; ++t)
#pragma unroll
            for (int j = 0; j < 4; ++j) so[(16 * t + 4 * fq + j) * 128 + 16 * wave + fr] = st[t][j]; }
}

constexpr int L_KI = 0, L_VT = 30720, SKI = 80, SVT = 200;
__device__ __forceinline__ void attn_item(const Args& a, int l, LAS unsigned char* lds, int it) {
    const int tid = tid_opaque(), lane = tid & 63, wave = __builtin_amdgcn_readfirstlane(tid >> 6);
    const int fr = lane & 15, fq = lane >> 4;
    const bool sample = it >= 1024;
    const int kv = it & 3, c = sample ? 0 : ((it >> 2) & 63), n = sample ? ((it - 1024) >> 2) : (it >> 8);
    const bf16* P = (const bf16*)(a.ws + WS_P); const f32x2* rope = (const f32x2*)(a.ws + WS_ROPE);
    bf16* Ob = (bf16*)(a.ws + WS_HO);
    LAS bf16* KI = (LAS bf16*)(lds + L_KI); LAS bf16* VT = (LAS bf16*)(lds + L_VT);
    const int kt0 = sample ? 0 : ((c >= 2) ? 0 : (8 - 4 * c));
    const int nkt = sample ? 9 : 12, nqt = sample ? 1 : 4;
    const size_t qrow0 = sample ? (size_t)MP + n * 16 : (size_t)n * 4096 + c * 64;
    const int pos0 = sample ? PAST : c * 64;
    __syncthreads();
    if (!sample) {
#pragma unroll
        for (int k2 = 0; k2 < 2; ++k2) { const int u = tid + 512 * k2; if (u < 768) { const int key = u >> 2, dg = u & 3, tok = (c - 2) * 64 + key;
            if (tok >= 0) { const bf16* kp = P + ((size_t)n * 4096 + tok) * NP + C_AK + kv * 64 + dg * 8; float x1[8], x2[8], o1[8], o2[8];
                unpack8(*(const u32x4*)kp, x1); unpack8(*(const u32x4*)(kp + 32), x2);
#pragma unroll
                for (int j = 0; j < 8; ++j) { const f32x2 cs = rope[tok * 32 + dg * 8 + j]; o1[j] = x1[j] * cs.x - x2[j] * cs.y; o2[j] = x2[j] * cs.x + x1[j] * cs.y; }
                *(LAS u32x4*)(KI + key * SKI + dg * 8) = pack8(o1); *(LAS u32x4*)(KI + key * SKI + 32 + dg * 8) = pack8(o2);
                if (c == 63 && key >= 64) { float* ko = a.out + O_KP + ((((size_t)l * 4 + n) * 128 + (key - 64)) * 4 + kv) * 64 + dg * 8;
                    *(f32x4*)ko = (f32x4){o1[0], o1[1], o1[2], o1[3]}; *(f32x4*)(ko + 4) = (f32x4){o1[4], o1[5], o1[6], o1[7]};
                    *(f32x4*)(ko + 32) = (f32x4){o2[0], o2[1], o2[2], o2[3]}; *(f32x4*)(ko + 36) = (f32x4){o2[4], o2[5], o2[6], o2[7]}; } } } }
#pragma unroll
        for (int k3 = 0; k3 < 3; ++k3) { const int u = tid + 512 * k3, key = u >> 3, dg = u & 7, tok = (c - 2) * 64 + key;
            if (tok >= 0) { const u32x4 vw = *(const u32x4*)(P + ((size_t)n * 4096 + tok) * NP + C_AV + kv * 64 + dg * 8);
                const unsigned ww[4] = {vw.x, vw.y, vw.z, vw.w};
#pragma unroll
                for (int j = 0; j < 8; ++j) VT[(dg * 8 + j) * SVT + key] = (bf16)((j & 1) ? (ww[j >> 1] >> 16) : (ww[j >> 1] & 0xffffu));
                if (c == 63 && key >= 64) { float vf[8]; unpack8(vw, vf); float* vo = a.out + O_VP + ((((size_t)l * 4 + n) * 128 + (key - 64)) * 4 + kv) * 64 + dg * 8;
                    *(f32x4*)vo = (f32x4){vf[0], vf[1], vf[2], vf[3]}; *(f32x4*)(vo + 4) = (f32x4){vf[4], vf[5], vf[6], vf[7]}; } } }
    } else {
        const float* ck = a.in[4] + ((size_t)l * 16 + n) * 128 * 256 + kv * 64; const float* cv = a.in[5] + ((size_t)l * 16 + n) * 128 * 256 + kv * 64;
        float* kso = a.out + O_KS + (((size_t)l * 16 + n) * 128 * 4 + kv) * 64; float* vso = a.out + O_VS + (((size_t)l * 16 + n) * 128 * 4 + kv) * 64;
#pragma unroll
        for (int k2 = 0; k2 < 3; ++k2) { const int u = tid + 512 * k2; if (u < 144 * 8) { const int key = u >> 3, dg = u & 7; float kf[8], vf[8];
            if (key < 128) { const f32x4 k0 = *(const f32x4*)(ck + (size_t)key * 256 + dg * 8), k1 = *(const f32x4*)(ck + (size_t)key * 256 + dg * 8 + 4), v0 = *(const f32x4*)(cv + (size_t)key * 256 + dg * 8), v1 = *(const f32x4*)(cv + (size_t)key * 256 + dg * 8 + 4);
#pragma unroll
                for (int j = 0; j < 4; ++j) { kf[j] = k0[j]; kf[4 + j] = k1[j]; vf[j] = v0[j]; vf[4 + j] = v1[j]; } }
            else { const int t = key - 128; const bf16* kp = P + ((size_t)MP + n * 16 + t) * NP + C_AK + kv * 64; float x1[8], x2[8];
                const int d1 = (dg & 3) * 8; unpack8(*(const u32x4*)(kp + d1), x1); unpack8(*(const u32x4*)(kp + 32 + d1), x2);
#pragma unroll
                for (int j = 0; j < 8; ++j) { const f32x2 cs = rope[(PAST + t) * 32 + d1 + j]; kf[j] = (dg < 4) ? (x1[j] * cs.x - x2[j] * cs.y) : (x2[j] * cs.x + x1[j] * cs.y); }
                unpack8(*(const u32x4*)(P + ((size_t)MP + n * 16 + t) * NP + C_AV + kv * 64 + dg * 8), vf); }
            *(LAS u32x4*)(KI + key * SKI + dg * 8) = pack8(kf);
            const u32x4 vw = pack8(vf); const unsigned ww[4] = {vw.x, vw.y, vw.z, vw.w};
#pragma unroll
            for (int j = 0; j < 8; ++j) VT[(dg * 8 + j) * SVT + key] = (bf16)((j & 1) ? (ww[j >> 1] >> 16) : (ww[j >> 1] & 0xffffu));
            if (key >= 16) { float* ko = kso + (size_t)(key - 16) * 256 + dg * 8; float* vo = vso + (size_t)(key - 16) * 256 + dg * 8;
                *(f32x4*)ko = (f32x4){kf[0], kf[1], kf[2], kf[3]}; *(f32x4*)(ko + 4) = (f32x4){kf[4], kf[5], kf[6], kf[7]};
                *(f32x4*)vo = (f32x4){vf[0], vf[1], vf[2], vf[3]}; *(f32x4*)(vo + 4) = (f32x4){vf[4], vf[5], vf[6], vf[7]}; } } }
    }
    __syncthreads();
    const int hq = kv * 8 + wave;
    const float sink = a.in[17][l * 32 + hq];
    for (int qt = 0; qt < nqt; ++qt) {
        const int tq = pos0 + 16 * qt + fr; const size_t row = qrow0 + 16 * qt + fr;
        bf16x8 Qf[2];
        {   const bf16* qp = P + row * NP + C_AQ + hq * 64 + 8 * fq; float x1[8], x2[8], o1[8], o2[8];
            unpack8(*(const u32x4*)qp, x1); unpack8(*(const u32x4*)(qp + 32), x2);
#pragma unroll
            for (int j = 0; j < 8; ++j) { const f32x2 cs = rope[tq * 32 + 8 * fq + j]; o1[j] = (x1[j] * cs.x - x2[j] * cs.y) * 0.125f; o2[j] = (x2[j] * cs.x + x1[j] * cs.y) * 0.125f; }
            Qf[0] = as_bf16x8(pack8(o1)); Qf[1] = as_bf16x8(pack8(o2)); }
        u32x2 zw[4];
#pragma unroll
        for (int dt = 0; dt < 4; ++dt) zw[dt] = *(const u32x2*)(P + row * NP + C_AZ + hq * 64 + 16 * dt + 4 * fq);
        f32x4 s[12]; float m = sink;
#pragma unroll
        for (int kt = 0; kt < 12; ++kt) { s[kt] = (f32x4){0.f, 0.f, 0.f, 0.f};
            if (kt >= kt0 && kt < nkt) {
#pragma unroll
                for (int ks = 0; ks < 2; ++ks) { const bf16x8 kf = *(const LAS bf16x8*)(KI + (16 * kt + fr) * SKI + 32 * ks + 8 * fq); s[kt] = __builtin_amdgcn_mfma_f32_16x16x32_bf16(kf, Qf[ks], s[kt], 0, 0, 0); }
                m = fmaxf(m, fmaxf(fmaxf(s[kt][0], s[kt][1]), fmaxf(s[kt][2], s[kt][3]))); } }
        m = fmaxf(m, __shfl_xor(m, 16)); m = fmaxf(m, __shfl_xor(m, 32));
        float sum = 0.f; f32x4 oc[4];
#pragma unroll
        for (int dt = 0; dt < 4; ++dt) oc[dt] = (f32x4){0.f, 0.f, 0.f, 0.f};
#pragma unroll
        for (int kt = 0; kt < 12; ++kt) { if (kt >= kt0 && kt < nkt) {
            const float p0 = __expf(s[kt][0] - m), p1 = __expf(s[kt][1] - m), p2 = __expf(s[kt][2] - m), p3 = __expf(s[kt][3] - m); sum += (p0 + p1) + (p2 + p3);
            u32x2 pw; pw.x = cvtpk(p0, p1); pw.y = cvtpk(p2, p3);
#pragma unroll
            for (int dt = 0; dt < 4; ++dt) { const u32x2 vf = *(const LAS u32x2*)(VT + (16 * dt + fr) * SVT + 16 * kt + 4 * fq);
                oc[dt] = __builtin_amdgcn_mfma_f32_16x16x16bf16_1k(as_bf16x4(vf), as_bf16x4(pw), oc[dt], 0, 0, 0); } } }
        sum += __shfl_xor(sum, 16); sum += __shfl_xor(sum, 32);
        const float inv = 1.0f / (sum + __expf(sink - m));
#pragma unroll
        for (int dt = 0; dt < 4; ++dt) { const int d0 = 16 * dt + 4 * fq;
            const float o0 = oc[dt][0] * inv * silu_f(bflo(zw[dt].x)), o1 = oc[dt][1] * inv * silu_f(bfhi(zw[dt].x)), o2 = oc[dt][2] * inv * silu_f(bflo(zw[dt].y)), o3 = oc[dt][3] * inv * silu_f(bfhi(zw[dt].y));
            u32x2 ow; ow.x = cvtpk(o0, o1); ow.y = cvtpk(o2, o3);
            *(u32x2*)(Ob + row * D + 2048 + hq * 64 + d0) = ow; }
    }
}

struct OneUnit { int pn; __device__ __forceinline__ bool next(int i, pg8::Unit& u) const { if (i) return false; u.pm = 0; u.pn = pn; return true; }
    __device__ __forceinline__ void a_ready(const pg8::Unit&) const {} __device__ __forceinline__ void done(const pg8::Unit&) const {} };
#ifndef DBG_REPEAT
#define DBG_REPEAT 0
#endif
__device__ __forceinline__ void phase_c2(const Args& a, int l, LAS unsigned char* lds, int G) {
    const int b = blockIdx.x;
    unsigned* cnt = (unsigned*)(a.ws + WS_CTL) + CW_C2DONE + 64 * l;
    if (b < 64) { for (int r_ = 0; r_ < ((((DBG_REPEAT) >> 7) & 1) ? 2 : 1); ++r_) scan_seq(a, l, lds, b); }
    else if (b < 80) {
        if (threadIdx.x == 0) { unsigned sp = 0; while (__hip_atomic_load(cnt, __ATOMIC_RELAXED, __HIP_MEMORY_SCOPE_AGENT) < (unsigned)(G - 80)) { __builtin_amdgcn_s_sleep(8); if (++sp > (1u << 22)) break; }
            __builtin_amdgcn_fence(__ATOMIC_ACQUIRE, "agent"); VM_WAIT(); }
        __syncthreads();
        pg8::Gemm g{(const pg8::bf16_t*)(a.ws + WS_HO) + (size_t)MP * D, (const pg8::bf16_t*)(a.ws + WS_BOUT + l * BOUT_BYTES), MS, D, D};
        OneUnit S; S.pn = b - 64;
        pg8::EpiY E{(pg8::bf16_t*)(a.ws + WS_YS), D, (float*)(a.ws + WS_YSQ) + (size_t)MP * 64};
        pg8::gemm_phase<pg8::EpiY, OneUnit, true, true>(lds, g, S, E);
    } else {
        const int vb = b - 80, nvb = G - 80;
        for (int it = vb; it < 320; it += nvb) { if (it < 256) scan_seq(a, l, lds, 64 + it); else attn_item(a, l, lds, 1024 + (it - 256)); }
        VM_WAIT(); __syncthreads();
        if (threadIdx.x == 0) { __builtin_amdgcn_fence(__ATOMIC_RELEASE, "agent"); VM_WAIT(); __hip_atomic_fetch_add(cnt, 1u, __ATOMIC_RELAXED, __HIP_MEMORY_SCOPE_AGENT); }
        for (int it = vb; it < 1024; it += nvb) { for (int r_ = 0; r_ < ((((DBG_REPEAT) >> 8) & 1) ? 2 : 1); ++r_) attn_item(a, l, lds, it); }
#if SPLIT_PROLOGUE
        if (l == 0) { __syncthreads(); prologue_work(a, lds, vb, nvb, 2, 0x8, false); }
#endif
    }
}

constexpr int N_PHASES = 12;
__device__ __forceinline__ Args load_args(const __attribute__((address_space(4))) Args* p) {
    Args a;
#pragma unroll
    for (int i = 0; i < 19; ++i) a.in[i] = (const float*)(const GAS float*)p->in[i];
    a.out = (float*)(GAS float*)p->out; a.ws = (unsigned char*)(GAS unsigned char*)p->ws; a.ph_lo = p->ph_lo; a.ph_hi = p->ph_hi; return a;
}
__global__ void __launch_bounds__(512, 2) fwd(Args args) {
    extern __shared__ __attribute__((aligned(16))) unsigned char lds_raw[];
    LAS unsigned char* lds = (LAS unsigned char*)lds_raw;
    const int G = gridDim.x;
    typedef const __attribute__((address_space(4))) Args* KArgs;
    const KArgs kp = (KArgs)__builtin_amdgcn_kernarg_segment_ptr();
#define ARGS(name) KArgs name##_p = kp; asm volatile("" : "+s"(name##_p)); const Args name = load_args(name##_p)
    const int lo = kp->ph_lo, hi = kp->ph_hi;
    volatile LAS unsigned* MISC = (volatile LAS unsigned*)(lds + MISC_OFF);
    for (int u = threadIdx.x; u < 64; u += 512) MISC[u] = 0u;
    __syncthreads();
    unsigned* barw = (unsigned*)(GAS unsigned*)((GAS unsigned char*)kp->ws + WS_CTL) + CW_BAR;
    XcdBarrier bar; bar.bar = barw; bar.x = 0; bar.st = nullptr;
    const bool multi = (hi - lo) > 1;
    if (multi) bar = xcd_barrier_post(barw, MISC + 8);
#define IN(k) (lo <= (k) && (k) < hi)
#ifndef DBG_REPEAT
#define DBG_REPEAT 0
#endif
#define REP(bit) for (int rep_ = 0; rep_ < (((DBG_REPEAT) >> (bit)) & 1) + 1; ++rep_)
#define SEAM(k) do { if (IN(k) && IN((k) + 1)) xcd_barrier(bar); } while (0)
    if (IN(0)) REP(0) { ARGS(a0); phase_prologue(a0, lds, G); }
    SEAM(0);
    if (IN(1)) REP(1) { ARGS(a1); phase_rows<0>(a1, lds, G); }
    SEAM(1);
    for (int l = 0; l < 2; ++l) {
        const int pb = 2 + 5 * l;
        if (IN(pb + 0)) REP(2) {
            ARGS(args);
            pg8::Gemm g{(const pg8::bf16_t*)(args.ws + WS_HO), (const pg8::bf16_t*)(args.ws + WS_BIN + l * BIN_BYTES), M, NP, D};
            pg8::StaticOrder S; S.init(M, NP, G, (int)blockIdx.x);
            pg8::EpiP E{(pg8::bf16_t*)(args.ws + WS_P), NP, args.in[16] + (size_t)l * 128, C_ZDN / 256, (C_ZDN + 2048) / 256};
#ifdef DBG_CLK
            const unsigned long long ck0_ = __builtin_amdgcn_s_memtime(), cr0_ = __builtin_amdgcn_s_memrealtime();
#endif
            pg8::gemm_phase<pg8::EpiP, pg8::StaticOrder, true, true>(lds, g, S, E);
#ifdef DBG_CLK
            if (l == 1 && blockIdx.x == 0 && threadIdx.x == 0) { const unsigned long long dc_ = __builtin_amdgcn_s_memtime() - ck0_, dr_ = __builtin_amdgcn_s_memrealtime() - cr0_;
                const float ghz_ = (float)dc_ / ((float)dr_ * 10.0f);
                float fr_ = (DBG_CLK == 1) ? (ghz_ - 1.0f) / 1.6f : (float)dr_ * 0.01f / 2000.0f;
                fr_ = fr_ < 0.f ? 0.f : (fr_ > 1.f ? 1.f : fr_);
                ((unsigned*)(args.ws + WS_CTL))[2000] = 16u * (unsigned)(fr_ * 16.0f + 0.5f); }
#endif
        }
        SEAM(pb + 0);
        if (IN(pb + 1)) REP(3) { ARGS(a2); phase_c1(a2, l, lds, G); }
        SEAM(pb + 1);
        if (IN(pb + 2)) REP(4) { ARGS(a3); phase_c2(a3, l, lds, G); }
        SEAM(pb + 2);
        if (IN(pb + 3)) REP(5) {
            ARGS(args);
            pg8::Gemm g{(const pg8::bf16_t*)(args.ws + WS_HO), (const pg8::bf16_t*)(args.ws + WS_BOUT + l * BOUT_BYTES), MP, D, D};
            pg8::StaticOrder S; S.init(MP, D, G, (int)blockIdx.x);
            pg8::EpiY E{(pg8::bf16_t*)(args.ws + WS_P), D, (float*)(args.ws + WS_YSQ)};
            pg8::gemm_phase<pg8::EpiY, pg8::StaticOrder, true, true>(lds, g, S, E);
        }
        SEAM(pb + 3);
        if (IN(pb + 4)) for (int rep_ = 0; rep_ < ((((DBG_REPEAT) >> 6) & 1) && l == 0 ? 2 : 1); ++rep_) { ARGS(a4); if (l == 0) phase_rows<1>(a4, lds, G); else phase_rows<2>(a4, lds, G); }
        SEAM(pb + 4);
    }
#undef IN
#undef SEAM
#undef ARGS
}


#ifdef DBG_STOP_AFTER
__global__ void dbg_dump(const unsigned char* ws, float* out) {
    const size_t regs[9][2] = {{WS_MOD, 1966080}, {WS_ROPE, 1048576}, {WS_DEC, 17408}, {WS_YSQ, (size_t)M * 64 * 4}, {WS_BIN, 2 * BIN_BYTES}, {WS_BOUT, 2 * BOUT_BYTES}, {WS_HO, (size_t)M * D * 2}, {WS_P, (size_t)M * NP * 2}, {WS_REC, (size_t)NREC * REC_BYTES}};
    size_t obase = 0;
    for (int r = 0; r < 9; ++r) { const size_t nchunk = regs[r][1] / 128; const unsigned short* p = (const unsigned short*)(ws + regs[r][0]);
        for (size_t i = (size_t)blockIdx.x * blockDim.x + threadIdx.x; i < nchunk; i += (size_t)gridDim.x * blockDim.x) { unsigned s = 0; for (int k = 0; k < 64; ++k) s += p[i * 64 + k]; out[obase + i] = (float)s; }
        obase += nchunk; }
}
#endif
#ifndef MK_PER_PHASE
#define MK_PER_PHASE 1
#endif
extern "C" void kernel_launch(void* const* d_in, const int* in_sizes, int n_in, void* d_out, int out_size, void* d_ws, size_t ws_size, hipStream_t stream) {
    static int grid = 0;
    if (grid == 0) {
        if (n_in != 19 || out_size != (int)O_END || ws_size < WS_END) { fprintf(stderr, "kernel_launch: unexpected shapes (n_in %d out %d ws %zu need %zu)\n", n_in, out_size, ws_size, (size_t)WS_END); grid = -1; return; }
        int dev = 0, cus = 0;
        if (hipGetDevice(&dev) != hipSuccess || hipDeviceGetAttribute(&cus, hipDeviceAttributeMultiprocessorCount, dev) != hipSuccess) { grid = -1; return; }
        if (hipFuncSetAttribute((const void*)fwd, hipFuncAttributeMaxDynamicSharedMemorySize, LDS_BYTES) != hipSuccess) { fprintf(stderr, "kernel_launch: hipFuncSetAttribute failed\n"); grid = -1; return; }
        int per_cu = 0;
        if (hipOccupancyMaxActiveBlocksPerMultiprocessor(&per_cu, (const void*)fwd, 512, LDS_BYTES) != hipSuccess || per_cu < 1) fprintf(stderr, "kernel_launch: occupancy query says %d\n", per_cu);
        (void)hipGetLastError();
        grid = cus;
        if (grid < 128) { fprintf(stderr, "kernel_launch: needs >= 128 CUs\n"); grid = -1; return; }
    }
    if (grid < 0) return;
    (void)in_sizes;
    if (hipMemsetAsync((char*)d_ws + WS_CTL, 0, CTL_ZERO_BYTES, stream) != hipSuccess) return;
    Args a{};
    for (int i = 0; i < 19; ++i) a.in[i] = (const float*)d_in[i];
    a.out = (float*)d_out; a.ws = (unsigned char*)d_ws;
#ifdef DBG_STOP_AFTER
    for (int p = 0; p <= DBG_STOP_AFTER; ++p) { a.ph_lo = p; a.ph_hi = p + 1; hipLaunchKernelGGL(fwd, dim3(grid), dim3(512), LDS_BYTES, stream, a); }
    hipLaunchKernelGGL(dbg_dump, dim3(2048), dim3(256), 0, stream, (const unsigned char*)d_ws, (float*)d_out);
#elif MK_PER_PHASE
    for (int p = 0; p < N_PHASES; ++p) { a.ph_lo = p; a.ph_hi = p + 1; hipLaunchKernelGGL(fwd, dim3(grid), dim3(512), LDS_BYTES, stream, a); }
#else
    a.ph_lo = 0; a.ph_hi = N_PHASES;
    hipLaunchKernelGGL(fwd, dim3(grid), dim3(512), LDS_BYTES, stream, a);
#endif
}
```

```cpp
#include <hip/hip_runtime.h>
#include <cstdio>
#include <cstdint>
#define MK_PER_PHASE 0
__device__ __forceinline__ int tid_opaque() { int t = threadIdx.x; asm volatile("" : "+v"(t)); return t; }
namespace pg8 {
#define PG8_LAS __attribute__((address_space(3)))
typedef unsigned short bf16_t;
typedef short bf16x8 __attribute__((ext_vector_type(8)));
typedef float f32x4 __attribute__((ext_vector_type(4)));
typedef unsigned u32x4 __attribute__((ext_vector_type(4)));
constexpr int BM = 256, BK = 64, HALF = 128, HTB = HALF * BK * 2  , STAGE_BYTES = 8 * HTB, NXCD = 8, WGM = 8;

__host__ __device__ __forceinline__ int lds_byte(int r, int c) { const int st = (r >> 4) * 2 + (c >> 5), rr = r & 15, cc = c & 31, ob = rr * 64 + cc * 2; return st * 1024 + (ob ^ (((ob >> 9) & 1) << 5)); }
__host__ __device__ __forceinline__ void stage_rc(int b, int& R, int& C) { const int st = b / 1024, sb = b % 1024, swz = sb ^ (((sb >> 9) & 1) << 5); R = (st >> 1) * 16 + swz / 64; C = (st & 1) * 32 + (swz % 64) / 2; }
__host__ __device__ __forceinline__ int perm32(int rho) { const int n = rho >> 4, i = rho & 15; return 8 * (i >> 2) + 4 * n + (i & 3); }

struct Unit { int pm, pn; };
struct Gemm { const bf16_t* A; const bf16_t* Bt; int M, N, K; };

struct StaticOrder {
    int nM, nN, nwg, G, c;
    __host__ __device__ void init(int M, int N, int G_, int c_) { nM = M / BM; nN = N / BM; nwg = nM * nN; G = G_; c = c_; }
    __host__ __device__ bool next(int i, Unit& u) const {
        const long L = (long)i * G + c; if (L >= nwg) return false;
        int wgid = (int)L; { const int q = nwg / NXCD, r = nwg % NXCD, xcd = wgid % NXCD, off = wgid / NXCD; wgid = (xcd < r ? xcd * (q + 1) : r * (q + 1) + (xcd - r) * q) + off; }
        const int nig = WGM * nN, gid = wgid / nig, fm = gid * WGM, gsz = (nM - fm) < WGM ? (nM - fm) : WGM;
        u.pm = fm + ((wgid % nig) % gsz); u.pn = (wgid % nig) / gsz; return true;
    }
    __device__ __forceinline__ void a_ready(const Unit&) const {}
    __device__ __forceinline__ void done(const Unit&) const {}
};

typedef __bf16 hwbf16x2_t __attribute__((ext_vector_type(2))); typedef float f32x2_t __attribute__((ext_vector_type(2)));
__device__ __forceinline__ unsigned cvt_pk_bf16(float lo, float hi) { const f32x2_t v = {lo, hi}; return __builtin_bit_cast(unsigned, __builtin_convertvector(v, hwbf16x2_t)); }
struct EpiP {
    static constexpr bool PERM = true, AFTER_DRAIN = false;
    bf16_t* O; int ldc; const float* dn; int gate_lo, gate_hi;
    __device__ __forceinline__ void operator()(const f32x4 (&acc)[2][2][4][2], const Unit& u, int wr, int wc, int fr, int fq) const {
        const int row0 = u.pm * BM + wr * 64 + fr, col0 = u.pn * BM + wc * 32 + 8 * fq;
        if (u.pn >= gate_lo && u.pn < gate_hi) {
            f32x4 dv[2][2];
#pragma unroll
            for (int bj = 0; bj < 2; ++bj) { const int e0 = (wc * 32 + 8 * fq) & 127; dv[bj][0] = *(const f32x4*)(dn + e0); dv[bj][1] = *(const f32x4*)(dn + e0 + 4); }
#pragma unroll
            for (int ai = 0; ai < 2; ++ai)
#pragma unroll
                for (int m = 0; m < 4; ++m) { bf16_t* rowp = O + (size_t)(row0 + ai * HALF + m * 16) * ldc + col0;
#pragma unroll
                    for (int bj = 0; bj < 2; ++bj) { f32x4 v[2] = {acc[ai][bj][m][0], acc[ai][bj][m][1]};
#pragma unroll
                        for (int n = 0; n < 2; ++n) { const f32x4 t = v[n] * -1.4426950408889634f; f32x4 s;
#pragma unroll
                            for (int j = 0; j < 4; ++j) s[j] = __builtin_amdgcn_rcpf(1.0f + __builtin_amdgcn_exp2f(t[j]));
                            v[n] = v[n] * s * dv[bj][n]; }
                        u32x4 w; w.x = cvt_pk_bf16(v[0][0], v[0][1]); w.y = cvt_pk_bf16(v[0][2], v[0][3]); w.z = cvt_pk_bf16(v[1][0], v[1][1]); w.w = cvt_pk_bf16(v[1][2], v[1][3]);
                        *(u32x4*)(rowp + bj * HALF) = w; } }
            return;
        }
#pragma unroll
        for (int ai = 0; ai < 2; ++ai)
#pragma unroll
            for (int m = 0; m < 4; ++m) { bf16_t* rowp = O + (size_t)(row0 + ai * HALF + m * 16) * ldc + col0;
#pragma unroll
                for (int bj = 0; bj < 2; ++bj) { const f32x4 v0 = acc[ai][bj][m][0], v1 = acc[ai][bj][m][1];
                    u32x4 w; w.x = cvt_pk_bf16(v0[0], v0[1]); w.y = cvt_pk_bf16(v0[2], v0[3]); w.z = cvt_pk_bf16(v1[0], v1[1]); w.w = cvt_pk_bf16(v1[2], v1[3]);
                    *(u32x4*)(rowp + bj * HALF) = w; } }
    }
};
struct EpiY {
    static constexpr bool PERM = true, AFTER_DRAIN = false;
    bf16_t* O; int ldc; float* part;
    __device__ __forceinline__ void operator()(const f32x4 (&acc)[2][2][4][2], const Unit& u, int wr, int wc, int fr, int fq) const {
        const int row0 = u.pm * BM + wr * 64 + fr, col0 = u.pn * BM + wc * 32 + 8 * fq;
#pragma unroll
        for (int ai = 0; ai < 2; ++ai)
#pragma unroll
            for (int m = 0; m < 4; ++m) { const int row = row0 + ai * HALF + m * 16; bf16_t* rowp = O + (size_t)row * ldc + col0; float s = 0.f;
#pragma unroll
                for (int bj = 0; bj < 2; ++bj) { const f32x4 v0 = acc[ai][bj][m][0], v1 = acc[ai][bj][m][1];
                    s += (v0[0] * v0[0] + v0[1] * v0[1]) + (v0[2] * v0[2] + v0[3] * v0[3]) + (v1[0] * v1[0] + v1[1] * v1[1]) + (v1[2] * v1[2] + v1[3] * v1[3]);
                    u32x4 w; w.x = cvt_pk_bf16(v0[0], v0[1]); w.y = cvt_pk_bf16(v0[2], v0[3]); w.z = cvt_pk_bf16(v1[0], v1[1]); w.w = cvt_pk_bf16(v1[2], v1[3]);
                    *(u32x4*)(rowp + bj * HALF) = w; }
                s += __shfl_xor(s, 16); s += __shfl_xor(s, 32);
                if (fq == 0) part[(size_t)row * 64 + u.pn * 4 + wc] = s; }
    }
};

template <class Epi, class Sched, bool ALIGN_EPI = false, bool SP2 = false>
__device__ __forceinline__ void gemm_phase(PG8_LAS unsigned char* lds, const Gemm g, const Sched& S, const Epi& E) {
    const int tid = tid_opaque(), wid = __builtin_amdgcn_readfirstlane(tid >> 6), lane = tid & 63, wr = wid >> 2, wc = wid & 3, fr = lane & 15, fq = lane >> 4;
    const int K = g.K, nt = K / BK;
    unsigned voffA[2], voffB[2];
#pragma unroll
    for (int i = 0; i < 2; ++i) { int R, C; stage_rc(tid * 16 + i * 8192, R, C); const int Rb = Epi::PERM ? ((R & ~31) + perm32(R & 31)) : R;
        voffA[i] = (unsigned)(R * K + C) * 2u; voffB[i] = (unsigned)(Rb * K + C) * 2u; }
    const size_t kstep = (size_t)(BK * 2);
    const size_t hstep = (size_t)HALF * K * 2;
    const size_t tstep = 2 * hstep;
    const unsigned ldsw = (unsigned)wid * 1024u;
    const int aoff = lds_byte(wr * 64 + fr, fq * 8), boff = lds_byte(wc * 32 + fr, fq * 8);
#define PG8_SA(b, h) (((b) * 2 + (h)) * HTB)
#define PG8_SB(b, h) ((4 + (b) * 2 + (h)) * HTB)
#define PG8_STAGE(bufoff, gbase, voff) do { _Pragma("unroll") for (int _i = 0; _i < 2; ++_i) \
        __builtin_amdgcn_global_load_lds((const unsigned*)((const char*)(gbase) + (voff)[_i]), (PG8_LAS unsigned*)(lds + (bufoff) + ldsw + _i * 8192), 16, 0, 0); } while (0)
#define PG8_LDA(dst, b, h) do { _Pragma("unroll") for (int m = 0; m < 4; ++m) _Pragma("unroll") for (int k = 0; k < 2; ++k) dst[m][k] = *(const PG8_LAS bf16x8*)(lds + PG8_SA(b, h) + aoff + m * 2048 + k * 1024); } while (0)
#define PG8_LDB(dst, b, h) do { _Pragma("unroll") for (int n = 0; n < 2; ++n) _Pragma("unroll") for (int k = 0; k < 2; ++k) dst[n][k] = *(const PG8_LAS bf16x8*)(lds + PG8_SB(b, h) + boff + n * 2048 + k * 1024); } while (0)
#define PG8_MMA(ai, bj, At, Bt) do { __builtin_amdgcn_s_setprio(1); _Pragma("unroll") for (int m = 0; m < 4; ++m) _Pragma("unroll") for (int n = 0; n < 2; ++n) _Pragma("unroll") for (int k = 0; k < 2; ++k) \
        acc[ai][bj][m][n] = __builtin_amdgcn_mfma_f32_16x16x32_bf16(Bt[n][k], At[m][k], acc[ai][bj][m][n], 0, 0, 0); __builtin_amdgcn_s_setprio(0); } while (0)
#define PG8_WAIT_V(n) asm volatile("s_waitcnt vmcnt(" #n ")" ::: "memory")
#define PG8_WAIT_L(n) asm volatile("s_waitcnt lgkmcnt(" #n ")" ::: "memory")
#define PG8_BAR __builtin_amdgcn_s_barrier()
#define PG8_SCHED __builtin_amdgcn_sched_barrier(0)
    Unit cur, nxt; int ui = 0;
    if (!S.next(0, cur)) return;
    f32x4 acc[2][2][4][2];
#pragma unroll
    for (int a = 0; a < 2; ++a)
#pragma unroll
        for (int b = 0; b < 2; ++b)
#pragma unroll
            for (int m = 0; m < 4; ++m)
#pragma unroll
                for (int n = 0; n < 2; ++n) acc[a][b][m][n] = (f32x4){0.f, 0.f, 0.f, 0.f};
    bf16x8 At[4][2], B0[2][2], B1[2][2];
    const char* cA = (const char*)g.A + (size_t)cur.pm * tstep; const char* cB = (const char*)g.Bt + (size_t)cur.pn * tstep;
    S.a_ready(cur);
    if constexpr (SP2) {
        PG8_STAGE(PG8_SB(0, 0), cB, voffB); PG8_STAGE(PG8_SB(0, 1), cB + hstep, voffB); PG8_STAGE(PG8_SA(0, 0), cA, voffA); PG8_STAGE(PG8_SA(0, 1), cA + hstep, voffA);
        if (wr == 1) PG8_BAR;
        PG8_WAIT_V(2); PG8_BAR;
        PG8_STAGE(PG8_SB(1, 0), cB + kstep, voffB); PG8_STAGE(PG8_SA(1, 0), cA + kstep, voffA); PG8_STAGE(PG8_SB(1, 1), cB + hstep + kstep, voffB);
        PG8_WAIT_V(6); PG8_BAR;
    } else {
        PG8_STAGE(PG8_SB(0, 0), cB, voffB); PG8_STAGE(PG8_SA(0, 0), cA, voffA); PG8_STAGE(PG8_SB(0, 1), cB + hstep, voffB); PG8_STAGE(PG8_SA(0, 1), cA + hstep, voffA);
        if (wr == 1) PG8_BAR;
        PG8_WAIT_V(4); PG8_BAR;
        PG8_STAGE(PG8_SB(1, 0), cB + kstep, voffB); PG8_STAGE(PG8_SA(1, 0), cA + kstep, voffA); PG8_STAGE(PG8_SB(1, 1), cB + hstep + kstep, voffB);
        PG8_WAIT_V(6); PG8_BAR;
    }
    for (;;) {
        const bool has_next = S.next(ui + 1, nxt);
        const char* nA = has_next ? (const char*)g.A + (size_t)nxt.pm * tstep : cA; const char* nB = has_next ? (const char*)g.Bt + (size_t)nxt.pn * tstep : cB;
        for (int t = 0; t < nt; t += 2) {
            const bool last = (t == nt - 2);
            const char* a1 = cA + (size_t)(t + 1) * kstep;
            const char* a2 = last ? nA : cA + (size_t)(t + 2) * kstep; const char* b2 = last ? nB : cB + (size_t)(t + 2) * kstep;
            const char* a3 = a2 + kstep; const char* b3 = b2 + kstep;
            if (last && has_next) S.a_ready(nxt);
            if constexpr (SP2) {
            PG8_LDB(B0, 0, 0); PG8_LDB(B1, 0, 1); PG8_SCHED; PG8_LDA(At, 0, 0); PG8_STAGE(PG8_SA(1, 1), a1 + hstep, voffA);
            PG8_WAIT_V(8); PG8_WAIT_L(0); PG8_BAR; PG8_MMA(0, 0, At, B0); PG8_MMA(0, 1, At, B1); PG8_BAR; PG8_SCHED;
            PG8_LDA(At, 0, 1); PG8_STAGE(PG8_SB(0, 0), b2, voffB); PG8_STAGE(PG8_SB(0, 1), b2 + hstep, voffB); PG8_STAGE(PG8_SA(0, 0), a2, voffA);
            PG8_WAIT_V(8); PG8_WAIT_L(0); PG8_BAR; PG8_MMA(1, 0, At, B0); PG8_MMA(1, 1, At, B1); PG8_BAR; PG8_SCHED;
            PG8_LDB(B0, 1, 0); PG8_LDB(B1, 1, 1); PG8_SCHED; PG8_LDA(At, 1, 0); PG8_STAGE(PG8_SA(0, 1), a2 + hstep, voffA);
            PG8_WAIT_V(8); PG8_WAIT_L(0); PG8_BAR; PG8_MMA(0, 0, At, B0); PG8_MMA(0, 1, At, B1); PG8_BAR; PG8_SCHED;
            PG8_LDA(At, 1, 1); PG8_STAGE(PG8_SB(1, 0), b3, voffB); PG8_STAGE(PG8_SB(1, 1), b3 + hstep, voffB); PG8_STAGE(PG8_SA(1, 0), a3, voffA);
            PG8_WAIT_V(8); PG8_WAIT_L(0); PG8_BAR; PG8_MMA(1, 0, At, B0); PG8_MMA(1, 1, At, B1); PG8_BAR; PG8_SCHED;
            } else {
            PG8_LDB(B0, 0, 0); PG8_SCHED; PG8_LDA(At, 0, 0); PG8_STAGE(PG8_SA(1, 1), a1 + hstep, voffA);
            PG8_WAIT_L(8); PG8_BAR; PG8_WAIT_L(0); PG8_MMA(0, 0, At, B0); PG8_BAR; PG8_SCHED;
            PG8_LDB(B1, 0, 1); PG8_STAGE(PG8_SB(0, 0), b2, voffB);
            PG8_BAR; PG8_WAIT_L(0); PG8_MMA(0, 1, At, B1); PG8_BAR;
            PG8_LDA(At, 0, 1); PG8_STAGE(PG8_SA(0, 0), a2, voffA);
            PG8_BAR; PG8_WAIT_L(0); PG8_MMA(1, 0, At, B0); PG8_BAR; PG8_SCHED;
            PG8_STAGE(PG8_SB(0, 1), b2 + hstep, voffB);
            PG8_WAIT_V(6); PG8_BAR; PG8_MMA(1, 1, At, B1); PG8_BAR;
            PG8_LDB(B0, 1, 0); PG8_SCHED; PG8_LDA(At, 1, 0); PG8_STAGE(PG8_SA(0, 1), a2 + hstep, voffA);
            PG8_WAIT_L(8); PG8_BAR; PG8_WAIT_L(0); PG8_MMA(0, 0, At, B0); PG8_BAR; PG8_SCHED;
            PG8_LDB(B1, 1, 1); PG8_STAGE(PG8_SB(1, 0), b3, voffB);
            PG8_BAR; PG8_WAIT_L(0); PG8_MMA(0, 1, At, B1); PG8_BAR;
            PG8_LDA(At, 1, 1); PG8_STAGE(PG8_SA(1, 0), a3, voffA);
            PG8_BAR; PG8_WAIT_L(0); PG8_MMA(1, 0, At, B0); PG8_BAR; PG8_SCHED;
            PG8_STAGE(PG8_SB(1, 1), b3 + hstep, voffB);
            PG8_WAIT_V(6); PG8_BAR; PG8_MMA(1, 1, At, B1); PG8_BAR;
            }
        }
        if constexpr (ALIGN_EPI) { if (wr == 0) PG8_BAR; }
        if constexpr (!Epi::AFTER_DRAIN) { E(acc, cur, wr, wc, fr, fq); S.done(cur); }
        if (!has_next) break;
#pragma unroll
        for (int a = 0; a < 2; ++a)
#pragma unroll
            for (int b = 0; b < 2; ++b)
#pragma unroll
                for (int m = 0; m < 4; ++m)
#pragma unroll
                    for (int n = 0; n < 2; ++n) acc[a][b][m][n] = (f32x4){0.f, 0.f, 0.f, 0.f};
        cur = nxt; cA = nA; cB = nB; ++ui;
        if constexpr (ALIGN_EPI) { if (wr == 1) PG8_BAR; }
    }
    PG8_WAIT_V(0);
    if constexpr (!ALIGN_EPI) { if (wr == 0) PG8_BAR; }
    PG8_BAR;
    if constexpr (Epi::AFTER_DRAIN) { E.fused(acc, cur, wr, wc, fr, fq, lds, wid, lane); S.done(cur); }
#undef PG8_SA
#undef PG8_SB
#undef PG8_STAGE
#undef PG8_LDA
#undef PG8_LDB
#undef PG8_MMA
#undef PG8_WAIT_V
#undef PG8_WAIT_L
#undef PG8_BAR
#undef PG8_SCHED
}
}

#define GAS __attribute__((address_space(1)))
#define LAS __attribute__((address_space(3)))
typedef unsigned short bf16;
typedef short bf16x8 __attribute__((ext_vector_type(8)));
typedef short bf16x4 __attribute__((ext_vector_type(4)));
typedef float f32x4 __attribute__((ext_vector_type(4)));
typedef float f32x2 __attribute__((ext_vector_type(2)));
typedef unsigned u32x4 __attribute__((ext_vector_type(4)));
typedef unsigned u32x2 __attribute__((ext_vector_type(2)));

constexpr int D = 4096, NB = 4, T = 4096, NSB = 16, TS = 16, PAST = 2048;
constexpr int MP = NB * T, MS = NSB * TS, M = MP + MS;
constexpr int NP = 13056, IN_DIM = 12832;
constexpr int C_Q = 0, C_K = 2048, C_V = 4096, C_ZDN = 6144, C_AQ = 8192, C_AK = 10240, C_AV = 10496, C_AZ = 10752, C_B = 12800, C_A = 12816;
constexpr float EPS = 1e-6f;
constexpr size_t O_YP = 0, O_YS = O_YP + (size_t)MP * D, O_CONVP = O_YS + (size_t)MS * D, O_DNP = O_CONVP + 2 * 4 * 3 * 6144, O_KP = O_DNP + 2 * 4 * 16 * 128 * 128,
                 O_VP = O_KP + 2 * 4 * 128 * 256, O_CONVS = O_VP + 2 * 4 * 128 * 256, O_DNS = O_CONVS + 2 * 16 * 3 * 6144, O_KS = O_DNS + (size_t)2 * 16 * 16 * 128 * 128,
                 O_VS = O_KS + 2 * 16 * 128 * 256, O_END = O_VS + 2 * 16 * 128 * 256;
static_assert(O_END == 82001920, "output size");
constexpr size_t MiB = 1u << 20;
constexpr size_t WS_CTL = 0, CTL_ZERO_BYTES = 1 * MiB;
constexpr size_t WS_MOD = 1 * MiB;
constexpr size_t WS_ROPE = 3 * MiB;
constexpr size_t WS_DEC = 4 * MiB;
constexpr size_t WS_YSQ = 5 * MiB;
constexpr size_t WS_BIN = 10 * MiB;
constexpr size_t BIN_BYTES = (size_t)NP * 4096 * 2;
constexpr size_t WS_BOUT = 214 * MiB;
constexpr size_t BOUT_BYTES = (size_t)4096 * 4096 * 2;
constexpr size_t WS_HO = 278 * MiB;
constexpr size_t WS_P = 408 * MiB;
constexpr size_t WS_REC = 823 * MiB;
constexpr int REC_W = 0, REC_QD = 16384, REC_KD = 32768, REC_QK = 49152, REC_U = 57344, REC_BYTES = 73728, REC_STAGE = 57344;
constexpr int NREC = 4096 + 256;
constexpr size_t WS_YS = WS_REC + (size_t)NREC * REC_BYTES;
constexpr size_t WS_END = WS_YS + (size_t)MS * D * 2;
constexpr int CW_C2DONE = 3072;
static_assert(WS_BIN + 2 * BIN_BYTES <= WS_BOUT && WS_HO + (size_t)M * D * 2 <= WS_P && WS_P + (size_t)M * NP * 2 <= WS_REC, "ws map");
constexpr int CW_BAR = 4096;
constexpr int LDS_BYTES = 147456;
constexpr int MISC_OFF = 147456 - 256;

#define RLX_AGENT __ATOMIC_RELAXED, __HIP_MEMORY_SCOPE_AGENT
#define LDS_WAIT() asm volatile("s_waitcnt lgkmcnt(0)" ::: "memory")
#define VM_WAIT() asm volatile("s_waitcnt vmcnt(0)" ::: "memory")
#define BAR_LDS() do { asm volatile("s_waitcnt lgkmcnt(0)" ::: "memory"); __builtin_amdgcn_s_barrier(); asm volatile("" ::: "memory"); } while (0)
typedef __bf16 hwbf16x2 __attribute__((ext_vector_type(2)));
__device__ __forceinline__ unsigned cvtpk(float lo, float hi) { const f32x2 v = {lo, hi}; return __builtin_bit_cast(unsigned, __builtin_convertvector(v, hwbf16x2)); }
__device__ __forceinline__ float bflo(unsigned w) { return __uint_as_float(w << 16); }
__device__ __forceinline__ float bfhi(unsigned w) { return __uint_as_float(w & 0xffff0000u); }
__device__ __forceinline__ float bf1(bf16 h) { return __uint_as_float(((unsigned)h) << 16); }
__device__ __forceinline__ float silu_f(float x) { return x * __builtin_amdgcn_rcpf(1.0f + __expf(-x)); }
__device__ __forceinline__ float sigmoid_f(float x) { return __builtin_amdgcn_rcpf(1.0f + __expf(-x)); }
__device__ __forceinline__ float sum16(float v) {
    v += __builtin_bit_cast(float, __builtin_amdgcn_update_dpp(0, __builtin_bit_cast(int, v), 0xB1, 0xf, 0xf, true));
    v += __builtin_bit_cast(float, __builtin_amdgcn_update_dpp(0, __builtin_bit_cast(int, v), 0x4E, 0xf, 0xf, true));
    v += __builtin_bit_cast(float, __builtin_amdgcn_update_dpp(0, __builtin_bit_cast(int, v), 0x141, 0xf, 0xf, true));
    v += __builtin_bit_cast(float, __builtin_amdgcn_update_dpp(0, __builtin_bit_cast(int, v), 0x140, 0xf, 0xf, true));
    return v;
}
__device__ __forceinline__ float quadsum16(const f32x4 q, int fr) {
    const bool o1 = fr & 1, o2 = fr & 2;
    float kA = o1 ? q[1] : q[0], sA = o1 ? q[0] : q[1], kB = o1 ? q[3] : q[2], sB = o1 ? q[2] : q[3];
    kA += __builtin_bit_cast(float, __builtin_amdgcn_update_dpp(0, __builtin_bit_cast(int, sA), 0xB1, 0xf, 0xf, true));
    kB += __builtin_bit_cast(float, __builtin_amdgcn_update_dpp(0, __builtin_bit_cast(int, sB), 0xB1, 0xf, 0xf, true));
    float k = o2 ? kB : kA; const float s = o2 ? kA : kB;
    k += __builtin_bit_cast(float, __builtin_amdgcn_update_dpp(0, __builtin_bit_cast(int, s), 0x4E, 0xf, 0xf, true));
    k += __builtin_bit_cast(float, __builtin_amdgcn_update_dpp(0, __builtin_bit_cast(int, k), 0x124, 0xf, 0xf, true));
    k += __builtin_bit_cast(float, __builtin_amdgcn_update_dpp(0, __builtin_bit_cast(int, k), 0x128, 0xf, 0xf, true));
    return k;
}
__device__ __forceinline__ float wave_sum(float v) { v = sum16(v); v += __shfl_xor(v, 16); v += __shfl_xor(v, 32); return v; }
__device__ __forceinline__ float wave_max(float v) {
#pragma unroll
    for (int o = 1; o < 64; o <<= 1) v = fmaxf(v, __shfl_xor(v, o));
    return v;
}
__device__ __forceinline__ void unpack8(const u32x4 w, float (&f)[8]) {
    f[0] = bflo(w.x); f[1] = bfhi(w.x); f[2] = bflo(w.y); f[3] = bfhi(w.y); f[4] = bflo(w.z); f[5] = bfhi(w.z); f[6] = bflo(w.w); f[7] = bfhi(w.w);
}
__device__ __forceinline__ u32x4 pack8(const float (&f)[8]) { u32x4 w; w.x = cvtpk(f[0], f[1]); w.y = cvtpk(f[2], f[3]); w.z = cvtpk(f[4], f[5]); w.w = cvtpk(f[6], f[7]); return w; }
__device__ __forceinline__ u32x4 pack8v(const f32x2 (&f)[4]) { u32x4 w; w.x = cvtpk(f[0].x, f[0].y); w.y = cvtpk(f[1].x, f[1].y); w.z = cvtpk(f[2].x, f[2].y); w.w = cvtpk(f[3].x, f[3].y); return w; }
__device__ __forceinline__ bf16x8 as_bf16x8(const u32x4 w) { return __builtin_bit_cast(bf16x8, w); }
__device__ __forceinline__ bf16x4 as_bf16x4(const u32x2 w) { return __builtin_bit_cast(bf16x4, w); }

#define XB_TMO      128
#define XB_XCNT(j)  (256  + 64 * (j))
#define XB_XSUB(j)  (1280 + 64 * (j))
#define XB_XGEN(j)  (2304 + 64 * (j))
#define XB_TOP      3328
#define XB_TOPGEN   3392
#define XCD_BAR_WORDS 3456
#define XB_SPIN_CAP (1u << 18)

__device__ __forceinline__ unsigned xb_ld(unsigned* p)              { return __hip_atomic_load(p, __ATOMIC_RELAXED, __HIP_MEMORY_SCOPE_AGENT); }
__device__ __forceinline__ unsigned xb_add(unsigned* p, unsigned v) { return __hip_atomic_fetch_add(p, v, __ATOMIC_RELAXED, __HIP_MEMORY_SCOPE_AGENT); }
__device__ __forceinline__ unsigned xb_xcc_id() { return (unsigned)__builtin_amdgcn_s_getreg((3 << 11) | 20) & 0xFu; }
#define XB_SPIN(cond, bar) do { unsigned _sp = 0; while (cond) { __builtin_amdgcn_s_sleep(1); \
    if ((++_sp & 255u) == 0u) { if (xb_ld(&(bar)[XB_TMO])) break; if (_sp > XB_SPIN_CAP) { atomicAdd(&(bar)[XB_TMO], 1u); break; } } } } while (0)

struct XcdBarrier {
    unsigned* bar; unsigned x;
    volatile LAS unsigned* st;
};

__device__ __forceinline__ XcdBarrier xcd_barrier_post(unsigned* bar, volatile LAS unsigned* st) {
    XcdBarrier b; b.bar = bar; b.x = xb_xcc_id(); b.st = st;
    if (threadIdx.x == 0) (void)xb_add(&bar[XB_XCNT(b.x)], 1u);
    return b;
}
__device__ __forceinline__ void xcd_barrier_complete(unsigned* bar, unsigned x, unsigned& nloc, unsigned& nx) {
    const unsigned G = gridDim.x * gridDim.y * gridDim.z;
    unsigned sum, cnt, mine, sp = 0u;
    for (;;) {
        sum = 0u; cnt = 0u; mine = 0u;
#pragma unroll
        for (unsigned j = 0; j < 16; ++j) { const unsigned c = xb_ld(&bar[XB_XCNT(j)]); sum += c; cnt += (c > 0u) ? 1u : 0u; mine = (j == x) ? c : mine; }
        if (sum == G) break;
        __builtin_amdgcn_s_sleep(1);
        if ((++sp & 255u) == 0u) { if (xb_ld(&bar[XB_TMO])) break; if (sp > XB_SPIN_CAP) { atomicAdd(&bar[XB_TMO], 1u); break; } }
    }
    nloc = mine > 0u ? mine : 1u; nx = cnt > 0u ? cnt : 1u;
}

__device__ __forceinline__ void xcd_barrier(const XcdBarrier& b) {
    asm volatile("s_waitcnt vmcnt(0)" ::: "memory");
    __syncthreads();
    if (threadIdx.x == 0) {
        unsigned* bar = b.bar;
        __builtin_amdgcn_s_waitcnt(0);
        unsigned nloc = b.st[0], nx = b.st[1];
        if (nloc == 0u) { xcd_barrier_complete(bar, b.x, nloc, nx); b.st[0] = nloc; b.st[1] = nx; }
        const unsigned old = xb_add(&bar[XB_XSUB(b.x)], 1u);
        const unsigned gen = old / nloc;
        if (old + 1u == (gen + 1u) * nloc) {
            __builtin_amdgcn_fence(__ATOMIC_RELEASE, "agent");
            asm volatile("s_waitcnt vmcnt(0)" ::: "memory");
            const unsigned og = xb_add(&bar[XB_TOP], 1u);
            const unsigned tg = og / nx;
            if (og + 1u == (tg + 1u) * nx) xb_add(&bar[XB_TOPGEN], 1u);
            else XB_SPIN(xb_ld(&bar[XB_TOPGEN]) == tg, bar);
            __builtin_amdgcn_fence(__ATOMIC_ACQUIRE, "agent");
            xb_add(&bar[XB_XGEN(b.x)], 1u);
            asm volatile("s_waitcnt vmcnt(0)" ::: "memory");
        } else {
            XB_SPIN(xb_ld(&bar[XB_XGEN(b.x)]) == gen, bar);
            __builtin_amdgcn_fence(__ATOMIC_ACQUIRE, "agent");
            asm volatile("s_waitcnt vmcnt(0)" ::: "memory");
        }
    }
    __syncthreads();
}

struct Args { const float* in[19]; float* out; unsigned char* ws; int ph_lo, ph_hi; };

__device__ __forceinline__ void p0_transpose_item(const float* W, int K, int N, bf16* WT, int dst_row0, LAS float* scr, int k0, int n0, int lane) {
    const int r8 = lane >> 3, c4 = lane & 7;
    f32x4 v[8];
#pragma unroll
    for (int i = 0; i < 8; ++i) v[i] = *(const f32x4*)(W + (size_t)(k0 + 8 * i + r8) * N + n0 + 4 * c4);
#pragma unroll
    for (int i = 0; i < 8; ++i) { LAS float* d = scr + (8 * i + r8) * 33 + 4 * c4; d[0] = v[i][0]; d[1] = v[i][1]; d[2] = v[i][2]; d[3] = v[i][3]; }
    LDS_WAIT(); asm volatile("" ::: "memory");
    const int c = lane & 7;
#pragma unroll
    for (int j = 0; j < 4; ++j) { const int n = (lane >> 3) + 8 * j; const LAS float* s = scr + (8 * c) * 33 + n;
        u32x4 o; o.x = cvtpk(s[0 * 33], s[1 * 33]); o.y = cvtpk(s[2 * 33], s[3 * 33]); o.z = cvtpk(s[4 * 33], s[5 * 33]); o.w = cvtpk(s[6 * 33], s[7 * 33]);
        *(u32x4*)(WT + (size_t)(dst_row0 + n) * K + k0 + 8 * c) = o; }
    LDS_WAIT(); asm volatile("" ::: "memory");
}
__device__ __forceinline__ void prologue_work(const Args& a, LAS unsigned char* lds, int vb, int nvb, int ada_mask, int tr_mask, bool rope) {
    const int tid = tid_opaque(), lane = tid & 63, wave = tid >> 6;
    {
        const float* cp = a.in[6]; const float* cs = a.in[7]; const float* w_ada = a.in[8]; const float* b_ada = a.in[9];
        float* mod = (float*)(a.ws + WS_MOD);
        LAS float* sc = (LAS float*)lds;
        LAS float* red = (LAS float*)(lds + 40960);
        const int cgp = tid & 7, ksl = tid >> 3;
        const int it0 = (ada_mask & 1) ? 0 : 384, it1 = (ada_mask & 2) ? 768 : 384;
        for (int it = it0 + vb; it < it1 && ada_mask; it += nvb) {
            const int l = it / 384, col0 = (it % 384) * 32;
            f32x4 acc[20];
#pragma unroll
            for (int j = 0; j < 20; ++j) acc[j] = (f32x4){0.f, 0.f, 0.f, 0.f};
            for (int kt = 0; kt < 8; ++kt) {
                __syncthreads();
#pragma unroll
                for (int j = 0; j < 20; ++j) { const float cv = (j < 4) ? cp[j * 4096 + kt * 512 + tid] : cs[(j - 4) * 4096 + kt * 512 + tid]; sc[tid * 20 + j] = silu_f(cv); }
                __syncthreads();
                const float* wp = w_ada + ((size_t)l * 4096 + kt * 512 + ksl * 8) * 12288 + col0 + cgp * 4;
                f32x4 w[8];
#pragma unroll
                for (int kk = 0; kk < 8; ++kk) w[kk] = *(const f32x4*)(wp + (size_t)kk * 12288);
#pragma unroll
                for (int kk = 0; kk < 8; ++kk) {
                    const LAS f32x4* s4 = (const LAS f32x4*)(sc + (ksl * 8 + kk) * 20);
#pragma unroll
                    for (int j4 = 0; j4 < 5; ++j4) { const f32x4 s = s4[j4];
#pragma unroll
                        for (int jj = 0; jj < 4; ++jj) acc[j4 * 4 + jj] += s[jj] * w[kk]; }
                }
            }
#pragma unroll
            for (int j = 0; j < 20; ++j)
#pragma unroll
                for (int c = 0; c < 4; ++c) { float v = acc[j][c]; v += __shfl_xor(v, 8); v += __shfl_xor(v, 16); v += __shfl_xor(v, 32); acc[j][c] = v; }
            __syncthreads();
            if (lane < 8) {
#pragma unroll
                for (int j = 0; j < 20; ++j) *(LAS f32x4*)(red + (wave * 20 + j) * 32 + lane * 4) = acc[j];
            }
            __syncthreads();
            for (int o = tid; o < 640; o += 512) { const int j = o >> 5, c = o & 31; float s = 0.f;
#pragma unroll
                for (int w8 = 0; w8 < 8; ++w8) s += red[(w8 * 20 + j) * 32 + c];
                mod[((size_t)l * 20 + j) * 12288 + col0 + c] = s + b_ada[(size_t)l * 12288 + col0 + c]; }
        }
        __syncthreads();
    }
    {
        LAS float* scr = (LAS float*)(lds + wave * 8448);
        const int gw = vb * 8 + wave, NGW = nvb * 8;
        constexpr int I_IN = 64 * 401, I_OUT = 64 * 128;
#pragma unroll 1
        for (int mtx = 0; mtx < 4; ++mtx) {
            if (!((tr_mask >> mtx) & 1)) continue;
            const int l = mtx >> 1;
            if ((mtx & 1) == 0) {
                for (int r = gw; r < I_IN; r += NGW) { const int kb = r / 401, nb = r % 401, n0 = nb * 32; const int dst = (n0 < 8192) ? n0 : ((n0 < 8224) ? (C_B + (n0 - 8192)) : (n0 - 32));
                    p0_transpose_item(a.in[12] + (size_t)l * 4096 * IN_DIM, 4096, IN_DIM, (bf16*)(a.ws + WS_BIN + l * BIN_BYTES), dst, scr, kb * 64, n0, lane); }
                constexpr int ZU = (NP - IN_DIM) * 4096 * 2 / 16;
                for (int u = vb * 512 + tid; u < ZU; u += nvb * 512) *(u32x4*)(a.ws + WS_BIN + l * BIN_BYTES + (size_t)IN_DIM * 4096 * 2 + (size_t)u * 16) = (u32x4){0u, 0u, 0u, 0u};
            } else {
                for (int r = gw; r < I_OUT; r += NGW) { const int kb = r / 128, nb = r % 128;
                    p0_transpose_item(a.in[18] + (size_t)l * 4096 * 4096, 4096, 4096, (bf16*)(a.ws + WS_BOUT + l * BOUT_BYTES), nb * 32, scr, kb * 64, nb * 32, lane); }
            }
        }
        if (rope) { f32x2* rt = (f32x2*)(a.ws + WS_ROPE);
            for (int idx = vb * 512 + tid; idx < 4096 * 32; idx += nvb * 512) { const int pos = idx >> 5, i = idx & 31;
                const double inv = exp2(-(double)i * (13.287712379549449 / 32.0)); const double ang = (double)pos * inv;
                rt[idx] = (f32x2){(float)cos(ang), (float)sin(ang)}; } }
    }
}
#ifndef SPLIT_PROLOGUE
#define SPLIT_PROLOGUE 0
#endif
__device__ __forceinline__ void phase_prologue(const Args& a, LAS unsigned char* lds, int G) {
#if SPLIT_PROLOGUE
    prologue_work(a, lds, (int)blockIdx.x, G, 1, 0x7, true);
#else
    prologue_work(a, lds, (int)blockIdx.x, G, 3, 0xF, true);
#endif
}

__device__ __forceinline__ int row_j(int row) { return (row < MP) ? (row >> 12) : (4 + ((row - MP) >> 4)); }
__device__ __forceinline__ void stage_params(const Args& a, LAS float* pl, int tid, int mode  , int j) {
    const float* mod = (const float*)(a.ws + WS_MOD); const float* g_pre = a.in[10]; const float* g_post = a.in[11];
    for (int c = tid * 4; c < D; c += 2048) {
        if (mode == 0) { const float* mr = mod + (size_t)j * 12288;
            *(LAS f32x4*)(pl + 4096 + c) = *(const f32x4*)(g_pre + c) * (*(const f32x4*)(mr + 4096 + c) + 1.0f); *(LAS f32x4*)(pl + 8192 + c) = *(const f32x4*)(mr + c); }
        else { const int l = mode - 1; const float* mr = mod + ((size_t)l * 20 + j) * 12288;
            *(LAS f32x4*)(pl + c) = *(const f32x4*)(mr + 8192 + c) * *(const f32x4*)(g_post + (size_t)l * D + c);
            if (l == 0) { const float* m1 = mod + ((size_t)20 + j) * 12288;
                *(LAS f32x4*)(pl + 4096 + c) = *(const f32x4*)(g_pre + D + c) * (*(const f32x4*)(m1 + 4096 + c) + 1.0f); *(LAS f32x4*)(pl + 8192 + c) = *(const f32x4*)(m1 + c); } }
    }
}
template <int mode> __device__ __forceinline__ void phase_rows(const Args& a, LAS unsigned char* lds, int G) {
    const int tid = tid_opaque(), wave = tid >> 6;
    LAS float* pl = (LAS float*)lds;
    const bf16* Y = (const bf16*)(a.ws + WS_P); const float* ysq = (const float*)(a.ws + WS_YSQ);
    bf16* H = (bf16*)(a.ws + WS_HO);
    const int rpb = (M + G - 1) / G;
    const int r0 = blockIdx.x * rpb, r1 = (r0 + rpb < M) ? r0 + rpb : M;
    int cur_a = -1, cur_b = -1;
    f32x4 xn[16]; u32x2 yn[16]; float ysn = 0.f;
#define ROW_LOAD(row_) do { const int lane_ = tid_opaque() & 63; float* orow_ = ((row_) < MP) ? a.out + O_YP + (size_t)(row_) * D : a.out + O_YS + (size_t)((row_) - MP) * D; \
        const float* xr_ = (mode == 2) ? orow_ : (((row_) < MP) ? a.in[0] + (size_t)(row_) * D : a.in[1] + (size_t)((row_) - MP) * D); \
        _Pragma("unroll") for (int q = 0; q < 16; ++q) xn[q] = *(const f32x4*)(xr_ + 4 * lane_ + 256 * q); \
        if (mode != 0) { const bf16* yrow_ = ((row_) < MP) ? Y + (size_t)(row_) * D : (const bf16*)(a.ws + WS_YS) + (size_t)((row_) - MP) * D; \
            _Pragma("unroll") for (int q = 0; q < 16; ++q) yn[q] = *(const u32x2*)(yrow_ + 4 * lane_ + 256 * q); \
            ysn = ysq[(size_t)(row_) * 64 + lane_]; } } while (0)
    if (r0 + wave < r1) ROW_LOAD(r0 + wave);
    for (int rb = r0; rb < r1; rb += 8) {
        const int ja = row_j(rb), jb = row_j((rb + 7 < r1) ? rb + 7 : r1 - 1);
        if (ja != cur_a || jb != cur_b) { BAR_LDS(); stage_params(a, pl, tid, mode, ja); if (jb != ja) stage_params(a, pl + 12288, tid, mode, jb); cur_a = ja; cur_b = jb; BAR_LDS(); }
        const int row = rb + wave;
        if (row >= r1) continue;
        const int lane = tid_opaque() & 63;
        const LAS float* plw = pl + ((row_j(row) == ja) ? 0 : 12288);
        float* orow = (row < MP) ? a.out + O_YP + (size_t)row * D : a.out + O_YS + (size_t)(row - MP) * D;
        f32x4 v[16]; u32x2 yw[16]; float ysc = ysn;
#pragma unroll
        for (int q = 0; q < 16; ++q) { v[q] = xn[q]; yw[q] = yn[q]; }
        if (row + 8 < r1) ROW_LOAD(row + 8);
        float s = 0.f;
        if (mode == 0) {
#pragma unroll
            for (int q = 0; q < 16; ++q) s += (v[q][0] * v[q][0] + v[q][1] * v[q][1]) + (v[q][2] * v[q][2] + v[q][3] * v[q][3]);
        } else {
            const float rstd_y = rsqrtf(wave_sum(ysc) * (1.f / D) + EPS);
#pragma unroll
            for (int q = 0; q < 16; ++q) { const int c = 4 * lane + 256 * q; const f32x4 y = (f32x4){bflo(yw[q].x), bfhi(yw[q].x), bflo(yw[q].y), bfhi(yw[q].y)};
                const f32x4 pa = *(const LAS f32x4*)(plw + c);
                v[q] = v[q] + pa * (y * rstd_y);
                s += (v[q][0] * v[q][0] + v[q][1] * v[q][1]) + (v[q][2] * v[q][2] + v[q][3] * v[q][3]);
                *(f32x4*)(orow + c) = v[q]; }
        }
        if (mode != 2) {
            const float rstd = rsqrtf(wave_sum(s) * (1.f / D) + EPS);
#pragma unroll
            for (int q = 0; q < 16; ++q) { const int c = 4 * lane + 256 * q;
                const f32x4 pb = *(const LAS f32x4*)(plw + 4096 + c), pc = *(const LAS f32x4*)(plw + 8192 + c);
                const f32x4 hv = v[q] * rstd * pb + pc; u32x2 w; w.x = cvtpk(hv[0], hv[1]); w.y = cvtpk(hv[2], hv[3]);
                *(u32x2*)(H + (size_t)row * D + c) = w; }
        }
    }
#undef ROW_LOAD
}


constexpr int L_KH = 0, L_QH = 18432, L_RT = 36864, L_XT = 77824, L_AI = 118784, L_DG = 129024, L_DI = 133120, L_GT = 135168;
constexpr int S128 = 144, S64 = 80;

__device__ __forceinline__ void phase_c1(const Args& a, int l, LAS unsigned char* lds, int G) {
    int tid, lane, wave, fr, fq;
#define RELANE() do { tid = tid_opaque(); lane = tid & 63; wave = __builtin_amdgcn_readfirstlane(tid >> 6); fr = lane & 15; fq = lane >> 4; } while (0)
    RELANE();
    const bf16* P = (const bf16*)(a.ws + WS_P);
    float* decbuf = (float*)(a.ws + WS_DEC);
    const float* conv_w = a.in[13] + (size_t)l * 4 * 6144;
    LAS bf16* KH = (LAS bf16*)(lds + L_KH); LAS bf16* QH = (LAS bf16*)(lds + L_QH); LAS bf16* RT = (LAS bf16*)(lds + L_RT); LAS bf16* XT = (LAS bf16*)(lds + L_XT);
    LAS bf16* AI = (LAS bf16*)(lds + L_AI); LAS float* DG = (LAS float*)(lds + L_DG); LAS bf16* DI = (LAS bf16*)(lds + L_DI);
    LAS unsigned char* STG = lds + L_XT;
    LAS float* g_beta = (LAS float*)(lds + L_GT); LAS float* g_gc = g_beta + 64; LAS float* g_egc = g_beta + 128; LAS float* g_misc = g_beta + 192;

    u32x4 raw[8]; unsigned gl = 0;
#define ITEM_PARAMS(it_, sample_, n_, c_, h_, ntok_, rowbase_) const bool sample_ = (it_) >= 4096; int n_, c_, h_, ntok_; size_t rowbase_; \
        if (!sample_) { h_ = (it_) & 15; c_ = ((it_) >> 4) & 63; n_ = (it_) >> 10; rowbase_ = (size_t)n_ * 4096 + c_ * 64; ntok_ = 64; } \
        else { const int s_ = (it_) - 4096; h_ = s_ & 15; n_ = s_ >> 4; c_ = 0; rowbase_ = (size_t)MP + n_ * 16; ntok_ = 16; }
#define PREFETCH(it_) do { ITEM_PARAMS(it_, ps_, pn_, pc_, ph_, pnt_, prb_); const int pt_ = tid_opaque(); \
        if (pt_ < 384) { const int pch0_ = (pt_ >> 7) * 2048 + ph_ * 128 + (pt_ & 15) * 8, pt0_ = ((pt_ >> 4) & 7) * 8; \
            _Pragma("unroll") for (int i = 0; i < 8; ++i) { const int tt = pt0_ + i; raw[i] = (u32x4){0u, 0u, 0u, 0u}; \
                if (tt < pnt_) raw[i] = *(const u32x4*)(P + (prb_ + tt) * NP + pch0_); } } \
        else { const int ptz_ = pt_ - 384; \
            if (ptz_ < 64 && ptz_ < pnt_) gl = (unsigned)P[(prb_ + ptz_) * NP + C_B + ph_] | ((unsigned)P[(prb_ + ptz_) * NP + C_A + ph_] << 16); } } while (0)

#ifdef DBG_MEASC
    unsigned long long dmacc_ = 0; const unsigned long long dmt0_ = __builtin_amdgcn_s_memtime(); unsigned long long dml_ = dmt0_;
#define DM(k) do { const unsigned long long n_ = __builtin_amdgcn_s_memtime(); if ((k) == DBG_MEASC) dmacc_ += n_ - dml_; dml_ = n_; } while (0)
#else
#define DM(k) do {} while (0)
#endif
    for (int item = blockIdx.x; item < NREC; item += G) {
        ITEM_PARAMS(item, sample, n, c, h, ntok, rowbase);
        const int reci = sample ? item : ((n * 16 + h) * 64 + c);
        unsigned char* rec = a.ws + WS_REC + (size_t)reci * REC_BYTES;
        const bool last = sample || (c == 63);
        DM(5); BAR_LDS(); DM(0);
        PREFETCH(item);
        RELANE();
        f32x2 val2[8][4];
        float ssq[8];
        int g = 3, cgl, seg;
        if (tid < 384) {
            cgl = tid & 15; g = __builtin_amdgcn_readfirstlane(tid >> 7); seg = (tid >> 4) & 7;
            const int ch0 = g * 2048 + h * 128 + cgl * 8;
            const int t0 = seg * 8;
            f32x4 wq[4][2];
#pragma unroll
            for (int j = 0; j < 4; ++j) { wq[j][0] = *(const f32x4*)(conv_w + (size_t)j * 6144 + ch0); wq[j][1] = *(const f32x4*)(conv_w + (size_t)j * 6144 + ch0 + 4); }
            u32x4 hist[3];
#pragma unroll
            for (int i = 0; i < 3; ++i) { const int tt = t0 - 3 + i; hist[i] = (u32x4){0u, 0u, 0u, 0u};
                if (tt < ntok && (tt >= 0 || (!sample && c > 0))) hist[i] = *(const u32x4*)(P + (rowbase + tt) * NP + ch0); }
            if (sample && seg == 0) {
                const float* sc = a.in[2] + (((size_t)l * 16 + n) * 3) * 6144 + ch0;
#pragma unroll
                for (int i = 0; i < 3; ++i) { const f32x4 s0 = *(const f32x4*)(sc + (size_t)i * 6144), s1 = *(const f32x4*)(sc + (size_t)i * 6144 + 4);
                    hist[i].x = cvtpk(s0[0], s0[1]); hist[i].y = cvtpk(s0[2], s0[3]); hist[i].z = cvtpk(s1[0], s1[1]); hist[i].w = cvtpk(s1[2], s1[3]); }
            }
            f32x2 sq2[8];
#pragma unroll
            for (int tok = 0; tok < 8; ++tok) sq2[tok] = (f32x2){0.f, 0.f};
#pragma unroll
            for (int cp = 0; cp < 4; ++cp) {
                f32x2 w2[4], x2[11];
#pragma unroll
                for (int j = 0; j < 4; ++j) w2[j] = (f32x2){wq[j][cp >> 1][2 * (cp & 1)], wq[j][cp >> 1][2 * (cp & 1) + 1]};
#pragma unroll
                for (int r = 0; r < 11; ++r) { const unsigned dw = (r < 3) ? hist[r < 3 ? r : 0][cp] : raw[r >= 3 ? r - 3 : 0][cp]; x2[r] = (f32x2){bflo(dw), bfhi(dw)}; }
#pragma unroll
                for (int tok = 0; tok < 8; ++tok) {
                    const f32x2 y = w2[0] * x2[tok] + w2[1] * x2[tok + 1] + w2[2] * x2[tok + 2] + w2[3] * x2[tok + 3];
                    const f32x2 t = y * -1.4426950408889634f; f32x2 e; e.x = __builtin_amdgcn_exp2f(t.x); e.y = __builtin_amdgcn_exp2f(t.y);
                    const f32x2 d = e + 1.0f; f32x2 r; r.x = __builtin_amdgcn_rcpf(d.x); r.y = __builtin_amdgcn_rcpf(d.y);
                    f32x2 v = y * r; if (!((t0 + tok) < ntok)) v = (f32x2){0.f, 0.f};
                    val2[tok][cp] = v; sq2[tok] += v * v; }
            }
#pragma unroll
            for (int tok = 0; tok < 8; ++tok) ssq[tok] = sq2[tok].x + sq2[tok].y;
            if (last && seg == (sample ? 1 : 7)) {
#pragma unroll
                for (int tok = 5; tok < 8; ++tok) { float rf[8]; unpack8(raw[tok], rf);
                    float* co = sample ? a.out + O_CONVS + (((size_t)l * 16 + n) * 3 + (tok - 5)) * 6144 + ch0 : a.out + O_CONVP + (((size_t)l * 4 + n) * 3 + (tok - 5)) * 6144 + ch0;
                    *(f32x4*)co = (f32x4){rf[0], rf[1], rf[2], rf[3]}; *(f32x4*)(co + 4) = (f32x4){rf[4], rf[5], rf[6], rf[7]}; }
            }
#pragma unroll
            for (int tok = 0; tok < 8; ++tok) ssq[tok] = sum16(ssq[tok]);
        } else {
            const int tz = tid - 384; cgl = tz & 15; seg = tz >> 4;
            if (wave == 6) {
                float beta = 0.f, gg = 0.f;
                if (lane < ntok) { const float b = bflo(gl), av = bfhi(gl);
                    beta = sigmoid_f(b); const float xx = av + a.in[15][l * 16 + h]; const float sp = fmaxf(xx, 0.f) + log1pf(__expf(-fabsf(xx)));
                    gg = -__expf(a.in[14][l * 16 + h]) * sp; }
                float gc = gg;
#pragma unroll
                for (int o = 1; o < 64; o <<= 1) { const float t = __shfl_up(gc, o); if (lane >= o) gc += t; }
                g_beta[lane] = beta; g_gc[lane] = gc; g_egc[lane] = __expf(gc);
                const float gcl = __shfl(gc, 63);
                if (lane == 0) { g_misc[0] = gcl; decbuf[reci] = __expf(gcl); }
            }
        }
        DM(1); BAR_LDS(); DM(2);
#ifndef DBG_C1_REP
#define DBG_C1_REP 0
#endif
        for (int rp1_ = 0; rp1_ < ((DBG_C1_REP) & 1) + 1; ++rp1_)
        {
            { const int t1 = tid_opaque(); cgl = t1 & 15; seg = (t1 >> 4) & 7; }
            const int t0 = seg * 8;
            float bt[8], gcv[8], eg[8];
            { const f32x4 b0 = *(const LAS f32x4*)(g_beta + t0), b1 = *(const LAS f32x4*)(g_beta + t0 + 4), c0 = *(const LAS f32x4*)(g_gc + t0), c1 = *(const LAS f32x4*)(g_gc + t0 + 4),
                  e0 = *(const LAS f32x4*)(g_egc + t0), e1 = *(const LAS f32x4*)(g_egc + t0 + 4);
#pragma unroll
              for (int i = 0; i < 4; ++i) { bt[i] = b0[i]; bt[4 + i] = b1[i]; gcv[i] = c0[i]; gcv[4 + i] = c1[i]; eg[i] = e0[i]; eg[4 + i] = e1[i]; } }
            const float gcl = g_misc[0];
            const int qs0 = ((cgl * 8) & 15) >> 2, half0 = ((cgl * 8) >> 4) & 1, ks0 = (cgl * 8) >> 5;
            const int tq0 = (t0 & 15) >> 2, thalf = (t0 >> 4) & 1, tks = t0 >> 5;
            if (g == 0) {
#pragma unroll
                for (int tok = 0; tok < 8; ++tok) { const int t = t0 + tok; const float r = rsqrtf(ssq[tok] + EPS) * 0.08838834764831845f; f32x2 qv[4];
#pragma unroll
                    for (int i = 0; i < 4; ++i) qv[i] = val2[tok][i] * r;
                    *(LAS u32x4*)(QH + t * S128 + cgl * 8) = pack8v(qv);
                    const float e = eg[tok];
                    const int fq_ = (t >> 4) * 4 + ks0; LAS unsigned char* fp = STG + fq_ * 1024 + ((((t & 15) + 16 * qs0) ^ (fq_ & 7)) * 16) + 8 * half0;
#pragma unroll
                    for (int i = 0; i < 4; ++i) qv[i] = qv[i] * e;
                    u32x2 w0, w1; w0.x = cvtpk(qv[0].x, qv[0].y); w0.y = cvtpk(qv[1].x, qv[1].y); w1.x = cvtpk(qv[2].x, qv[2].y); w1.y = cvtpk(qv[3].x, qv[3].y);
                    *(LAS u32x2*)fp = w0; *(LAS u32x2*)(fp + 256) = w1; }
            } else if (g == 1) {
#pragma unroll
                for (int tok = 0; tok < 8; ++tok) { const float r = rsqrtf(ssq[tok] + EPS);
#pragma unroll
                    for (int i = 0; i < 4; ++i) val2[tok][i] = val2[tok][i] * r;
                    *(LAS u32x4*)(KH + (t0 + tok) * S128 + cgl * 8) = pack8v(val2[tok]); }
                float f1[8], f2[8];
#pragma unroll
                for (int tok = 0; tok < 8; ++tok) { f1[tok] = bt[tok] * eg[tok]; f2[tok] = __expf(gcl - gcv[tok]); }
#pragma unroll
                for (int ip = 0; ip < 4; ++ip) {
                    f32x2 rr[8], kd[8];
#pragma unroll
                    for (int tok = 0; tok < 8; ++tok) { rr[tok] = val2[tok][ip] * f1[tok]; kd[tok] = val2[tok][ip] * f2[tok]; }
#pragma unroll
                    for (int hh = 0; hh < 2; ++hh) { const int i = 2 * ip + hh, d = cgl * 8 + i;
                        u32x4 rw; rw.x = cvtpk(rr[0][hh], rr[1][hh]); rw.y = cvtpk(rr[2][hh], rr[3][hh]); rw.z = cvtpk(rr[4][hh], rr[5][hh]); rw.w = cvtpk(rr[6][hh], rr[7][hh]);
                        *(LAS u32x4*)(RT + (128 + i * 16 + cgl) * S64 + t0) = rw;
                        const int fk_ = 16 + (d >> 4) * 2 + tks; LAS unsigned char* fp = STG + fk_ * 1024 + ((((d & 15) + 16 * tq0) ^ (fk_ & 7)) * 16) + 8 * thalf;
                        u32x2 w0, w1; w0.x = cvtpk(kd[0][hh], kd[1][hh]); w0.y = cvtpk(kd[2][hh], kd[3][hh]); w1.x = cvtpk(kd[4][hh], kd[5][hh]); w1.y = cvtpk(kd[6][hh], kd[7][hh]);
                        *(LAS u32x2*)fp = w0; *(LAS u32x2*)(fp + 256) = w1; } }
            } else if (g == 2) {
#pragma unroll
                for (int ip = 0; ip < 4; ++ip) { f32x2 rr[8];
#pragma unroll
                    for (int tok = 0; tok < 8; ++tok) rr[tok] = val2[tok][ip] * bt[tok];
#pragma unroll
                    for (int hh = 0; hh < 2; ++hh) { const int i = 2 * ip + hh;
                        u32x4 rw; rw.x = cvtpk(rr[0][hh], rr[1][hh]); rw.y = cvtpk(rr[2][hh], rr[3][hh]); rw.z = cvtpk(rr[4][hh], rr[5][hh]); rw.w = cvtpk(rr[6][hh], rr[7][hh]);
                        *(LAS u32x4*)(RT + (i * 16 + cgl) * S64 + t0) = rw; } }
            }
        }
        DM(3); BAR_LDS(); DM(4);
#if defined(DBG_C1_STOP) && DBG_C1_STOP <= 1
        continue;
#endif
        RELANE();
        for (int rp2_ = 0; rp2_ < (((DBG_C1_REP) >> 1) & 1) + 1; ++rp2_)
#pragma unroll
        for (int k2 = 0; k2 < 2; ++k2) {
            const int tile = wave * 2 + k2, ti = tile >> 2, tj = tile & 3;
            f32x4 acq = (f32x4){0.f, 0.f, 0.f, 0.f}, ack = (f32x4){0.f, 0.f, 0.f, 0.f};
#pragma unroll
            for (int ks = 0; ks < 4; ++ks) {
                const bf16x8 kj = *(const LAS bf16x8*)(KH + (16 * tj + fr) * S128 + 32 * ks + 8 * fq);
                const bf16x8 qi = *(const LAS bf16x8*)(QH + (16 * ti + fr) * S128 + 32 * ks + 8 * fq);
                acq = __builtin_amdgcn_mfma_f32_16x16x32_bf16(kj, qi, acq, 0, 0, 0);
                if (ti >= tj) { const bf16x8 ki = *(const LAS bf16x8*)(KH + (16 * ti + fr) * S128 + 32 * ks + 8 * fq);
                    ack = __builtin_amdgcn_mfma_f32_16x16x32_bf16(ki, kj, ack, 0, 0, 0); }
            }
            {
                const int i = 16 * ti + fr; const float gi = g_gc[i]; const f32x4 gj = *(const LAS f32x4*)(g_gc + 16 * tj + 4 * fq); float o[4];
#pragma unroll
                for (int r = 0; r < 4; ++r) { const int j = 16 * tj + 4 * fq + r; o[r] = (i >= j) ? acq[r] * __expf(fminf(gi - gj[r], 0.f)) : 0.f; }
                u32x2 w; w.x = cvtpk(o[0], o[1]); w.y = cvtpk(o[2], o[3]);
                { const int fk2_ = 32 + ti * 2 + (tj >> 1); *(LAS u32x2*)(STG + fk2_ * 1024 + ((lane ^ (fk2_ & 7)) * 16) + 8 * (tj & 1)) = w; }
            }
            if (ti >= tj) {
                const int j = 16 * tj + fr; const float gj = g_gc[j]; const f32x4 gi = *(const LAS f32x4*)(g_gc + 16 * ti + 4 * fq), bi = *(const LAS f32x4*)(g_beta + 16 * ti + 4 * fq);
#pragma unroll
                for (int r = 0; r < 4; ++r) { const int i = 16 * ti + 4 * fq + r; const float v = (i > j) ? bi[r] * ack[r] * __expf(fminf(gi[r] - gj, 0.f)) : 0.f;
                    AI[i * S64 + j] = (bf16)(cvtpk(v, 0.f) & 0xffffu);
                    if (ti == tj) DG[(ti * 16 + (i & 15)) * 16 + fr] = v; }
            }
        }
        BAR_LDS();
#if defined(DBG_C1_STOP) && DBG_C1_STOP <= 2
        continue;
#endif
        RELANE();
#pragma unroll
        for (int k5 = 0; k5 < 5; ++k5) { const int u = tid + 512 * k5, fu_ = u >> 6; *(u32x4*)(rec + REC_QD + (size_t)u * 16) = *(const LAS u32x4*)(STG + fu_ * 1024 + (((u & 63) ^ (fu_ & 7)) * 16)); }
        for (int rp3_ = 0; rp3_ < (((DBG_C1_REP) >> 2) & 1) + 1; ++rp3_)
        if (wave == 0) {
            const int b = fq, cc = fr; float x[16];
            {   f32x4 dg[10][3];
#pragma unroll
                for (int r = 1; r < 10; ++r)
#pragma unroll
                    for (int j4 = 0; j4 < (r + 3) / 4; ++j4) dg[r][j4] = *(const LAS f32x4*)(DG + (b * 16 + r) * 16 + 4 * j4);
                __builtin_amdgcn_sched_barrier(0);
#pragma unroll
                for (int r = 0; r < 10; ++r) { float s = (r == cc) ? 1.f : 0.f;
#pragma unroll
                    for (int j = 0; j < r; ++j) s -= dg[r][j >> 2][j & 3] * x[j];
                    x[r] = s; DI[(b * 16 + r) * 16 + cc] = (bf16)(cvtpk(s, 0.f) & 0xffffu); } }
            __builtin_amdgcn_sched_barrier(0);
            {   f32x4 dg[6][4];
#pragma unroll
                for (int r = 10; r < 16; ++r)
#pragma unroll
                    for (int j4 = 0; j4 < (r + 3) / 4; ++j4) dg[r - 10][j4] = *(const LAS f32x4*)(DG + (b * 16 + r) * 16 + 4 * j4);
                __builtin_amdgcn_sched_barrier(0);
#pragma unroll
                for (int r = 10; r < 16; ++r) { float s = (r == cc) ? 1.f : 0.f;
#pragma unroll
                    for (int j = 0; j < r; ++j) s -= dg[r - 10][j >> 2][j & 3] * x[j];
                    x[r] = s; DI[(b * 16 + r) * 16 + cc] = (bf16)(cvtpk(s, 0.f) & 0xffffu); } }
        }
        BAR_LDS();
#if defined(DBG_C1_STOP) && DBG_C1_STOP <= 3
        continue;
#endif
        for (int rp4_ = 0; rp4_ < (((DBG_C1_REP) >> 3) & 1) + 1; ++rp4_)
#pragma unroll
        for (int b = 0; b < 4; ++b) {
            RELANE();
#pragma unroll
            for (int k2 = 0; k2 < 2; ++k2) {
                const int nt = wave * 2 + k2;
                f32x4 y = (f32x4){0.f, 0.f, 0.f, 0.f};
#pragma unroll
                for (int ks = 0; ks < (b + 1) / 2; ++ks) {
                    const bool ok = (32 * ks + 8 * fq) < 16 * b;
                    u32x4 av = *(const LAS u32x4*)(AI + (16 * b + fr) * S64 + 32 * ks + 8 * fq), xv = *(const LAS u32x4*)(XT + (16 * nt + fr) * S64 + 32 * ks + 8 * fq);
                    if (!ok) { av = (u32x4){0u, 0u, 0u, 0u}; xv = (u32x4){0u, 0u, 0u, 0u}; }
                    y = __builtin_amdgcn_mfma_f32_16x16x32_bf16(as_bf16x8(av), as_bf16x8(xv), y, 0, 0, 0);
                }
                const int rn = 16 * nt + fr; const u32x2 rv = *(const LAS u32x2*)(RT + ((rn & 128) + (rn & 7) * 16 + ((rn & 127) >> 3)) * S64 + 16 * b + 4 * fq);
                const float z0 = bflo(rv.x) - y[0], z1 = bfhi(rv.x) - y[1], z2 = bflo(rv.y) - y[2], z3 = bfhi(rv.y) - y[3];
                u32x2 zb; zb.x = cvtpk(z0, z1); zb.y = cvtpk(z2, z3);
                const u32x2 dv = *(const LAS u32x2*)(DI + (b * 16 + fr) * 16 + 4 * fq);
                const f32x4 xo = __builtin_amdgcn_mfma_f32_16x16x16bf16_1k(as_bf16x4(dv), as_bf16x4(zb), (f32x4){0.f, 0.f, 0.f, 0.f}, 0, 0, 0);
                u32x2 xw; xw.x = cvtpk(xo[0], xo[1]); xw.y = cvtpk(xo[2], xo[3]);
                *(LAS u32x2*)(XT + (16 * nt + fr) * S64 + 16 * b + 4 * fq) = xw;
                if (nt < 8) *(u32x2*)(rec + REC_U + (size_t)(((nt * 4 + b) * 64 + lane) * 8)) = xw;
            }
            LDS_WAIT(); asm volatile("" ::: "memory");
        }
        BAR_LDS();
#if defined(DBG_C1_STOP) && DBG_C1_STOP <= 4
        continue;
#endif
        RELANE();
        for (int rp5_ = 0; rp5_ < (((DBG_C1_REP) >> 4) & 1) + 1; ++rp5_)
#pragma unroll
        for (int k2 = 0; k2 < 2; ++k2) {
            const int u = tid + 512 * k2, frag = u >> 6, tt = frag >> 2, ks = frag & 3;
            float wv[8];
#pragma unroll
            for (int j = 0; j < 8; ++j) wv[j] = -bf1(XT[(128 + 32 * ks + 16 * (j >> 2) + 4 * fq + (j & 3)) * S64 + 16 * tt + fr]);
            *(u32x4*)(rec + REC_W + (size_t)((frag * 64 + lane) * 16)) = pack8(wv);
        }
    }
#ifdef DBG_MEASC
    if (l == 1 && blockIdx.x == 0 && tid_opaque() == 0) { DM(5); const unsigned long long tot_ = __builtin_amdgcn_s_memtime() - dmt0_; const float fr_ = (float)dmacc_ / (float)tot_;
        ((unsigned*)(a.ws + WS_CTL))[2000] = 32u * (unsigned)(fr_ * 8.0f + 0.5f); }
#endif
#undef DM
#undef RELANE
#undef PREFETCH
#undef ITEM_PARAMS
}


constexpr int L_SS = 2 * REC_STAGE, L_RS = L_SS + 2048, L_DN = L_RS + 256, L_OB = L_DN + 512, OBS = 136;
__device__ __forceinline__ void scan_seq(const Args& a, int l, LAS unsigned char* lds, int seq) {
    int tid = tid_opaque(), lane = tid & 63, wave = __builtin_amdgcn_readfirstlane(tid >> 6);
    int fr = lane & 15, fq = lane >> 4;
    const bool sample = seq >= 64;
    const int s2 = sample ? seq - 64 : seq, n = s2 >> 4, h = s2 & 15;
    const int nsteps = sample ? 1 : 64, ntok = sample ? 16 : 64;
    const int rec0 = sample ? 4096 + s2 : s2 * 64;
    const size_t rowbase0 = sample ? (size_t)MP + n * 16 : (size_t)n * 4096;
    const unsigned char* recs = a.ws + WS_REC;
    const float* decbuf = (const float*)(a.ws + WS_DEC);
    bf16* Ob = (bf16*)(a.ws + WS_HO);
    LAS float* ss = (LAS float*)(lds + L_SS); LAS float* rs = (LAS float*)(lds + L_RS); LAS bf16* ob = (LAS bf16*)(lds + L_OB);
    f32x4 st[8];
    if (sample) { const float* s0 = a.in[3] + (((size_t)l * 16 + n) * 16 + h) * 16384;
#pragma unroll
        for (int t = 0; t < 8; ++t)
#pragma unroll
            for (int j = 0; j < 4; ++j) st[t][j] = s0[(16 * t + 4 * fq + j) * 128 + 16 * wave + fr];
    } else {
#pragma unroll
        for (int t = 0; t < 8; ++t) st[t] = (f32x4){0.f, 0.f, 0.f, 0.f};
    }
    __syncthreads();
    {   const unsigned char* src = recs + (size_t)rec0 * REC_BYTES;
#pragma unroll
        for (int k = 0; k < 7; ++k) { const int p = wave * 7 + k;
            __builtin_amdgcn_global_load_lds((const unsigned*)(src + p * 1024 + lane * 16), (LAS unsigned*)(lds + p * 1024), 16, 0, 0); } }
    u32x2 u_cur[4], u_nxt[4]; float dec_cur, dec_nxt = 0.f; f32x4 o_prev[4];
    u32x4 zq[2], zn[2]; LAS float* dnl = (LAS float*)(lds + L_DN);
    if (tid < 128) dnl[tid] = a.in[16][(size_t)l * 128 + tid];
    zq[0] = zq[1] = zn[0] = zn[1] = (u32x4){0u, 0u, 0u, 0u};
    {   const unsigned char* rec = recs + (size_t)rec0 * REC_BYTES;
#pragma unroll
        for (int t = 0; t < 4; ++t) { u_cur[t] = *(const u32x2*)(rec + REC_U + ((wave * 4 + t) * 64 + lane) * 8); u_nxt[t] = u_cur[t]; o_prev[t] = (f32x4){0.f, 0.f, 0.f, 0.f}; }
        dec_cur = decbuf[rec0]; }
#define SCAN_STORE(cc) do {   \
        _Pragma("unroll") for (int t = 0; t < 4; ++t) { const f32x4 r4 = *(const LAS f32x4*)(rs + 16 * t + 4 * fq); \
            _Pragma("unroll") for (int j = 0; j < 4; ++j) ob[(16 * t + 4 * fq + j) * OBS + 16 * wave + fr] = (bf16)(cvtpk(o_prev[t][j] * r4[j], 0.f) & 0xffffu); } } while (0)
#define SCAN_ZLOAD(cc, Z) do { const int tok_ = tid >> 3; if (tok_ < ntok) { const bf16* zp_ = (const bf16*)(a.ws + WS_P) + (rowbase0 + (size_t)(cc) * 64 + tok_) * NP + C_ZDN + h * 128 + (tid & 7) * 8; \
            Z[0] = *(const u32x4*)zp_; Z[1] = *(const u32x4*)(zp_ + 64); } } while (0)
#define SCAN_FLUSH(cc, Z) do {   \
        const int tok_ = tid >> 3, pc_ = tid & 7; \
        if (tok_ < ntok) { bf16* op_ = Ob + (rowbase0 + (size_t)(cc) * 64 + tok_) * D + h * 128 + pc_ * 8; \
            _Pragma("unroll") for (int hh = 0; hh < 2; ++hh) { float ov_[8], zv_[8]; unpack8(*(const LAS u32x4*)(ob + tok_ * OBS + 64 * hh + pc_ * 8), ov_); unpack8(Z[hh], zv_); \
                _Pragma("unroll") for (int i = 0; i < 8; ++i) ov_[i] = ov_[i] * zv_[i];     \
                *(u32x4*)(op_ + 64 * hh) = pack8(ov_); } } } while (0)
#define SCAN_RS() do { if (tid < 64) { float tsum = 0.f; \
            _Pragma("unroll") for (int w8 = 0; w8 < 8; ++w8) tsum += ss[w8 * 64 + tid]; \
            rs[tid] = rsqrtf(tsum * (1.f / 128.f) + EPS); } } while (0)
#ifdef DBG_MEAS
    unsigned long long dbg_w_ = 0, dbg_b_ = 0, dbg_b2_ = 0; const unsigned long long dbg_t0_ = __builtin_amdgcn_s_memtime(); const unsigned long long dbg_r0_ = __builtin_amdgcn_s_memrealtime();
#endif
    for (int c = 0; c < nsteps; ++c) {
        tid = tid_opaque(); lane = tid & 63; wave = __builtin_amdgcn_readfirstlane(tid >> 6); fr = lane & 15; fq = lane >> 4;
        const LAS unsigned char* buf = lds + (c & 1) * REC_STAGE;
        const unsigned char* rec = recs + (size_t)(rec0 + c) * REC_BYTES;
#ifdef DBG_MEAS
        const unsigned long long tm0_ = __builtin_amdgcn_s_memtime();
        VM_WAIT();
        const unsigned long long tm1_ = __builtin_amdgcn_s_memtime();
        __syncthreads();
        const unsigned long long tm2_ = __builtin_amdgcn_s_memtime();
        dbg_w_ += tm1_ - tm0_; dbg_b_ += tm2_ - tm1_;
#else
        VM_WAIT(); __syncthreads();
#endif; everybody is done with the other buffer; ss of step c-1 is complete
        if (c + 1 < nsteps) { const unsigned char* src = rec + REC_BYTES; LAS unsigned char* dst = lds + ((c + 1) & 1) * REC_STAGE;
#pragma unroll
            for (int k = 0; k < 7; ++k) { const int p = wave * 7 + k;
                __builtin_amdgcn_global_load_lds((const unsigned*)(src + p * 1024 + lane * 16), (LAS unsigned*)(dst + p * 1024), 16, 0, 0); }
#pragma unroll
            for (int t = 0; t < 4; ++t) u_nxt[t] = *(const u32x2*)(src + REC_U + ((wave * 4 + t) * 64 + lane) * 8);
            dec_nxt = decbuf[rec0 + c + 1]; }
        if (c > 0) SCAN_RS();
        if (c > 1) SCAN_FLUSH(c - 2, zn);
        if (c > 0) SCAN_ZLOAD(c - 1, zn);
        bf16x8 Bs[4];
#pragma unroll
        for (int ks = 0; ks < 4; ++ks) { u32x4 w; w.x = cvtpk(st[2 * ks][0], st[2 * ks][1]); w.y = cvtpk(st[2 * ks][2], st[2 * ks][3]); w.z = cvtpk(st[2 * ks + 1][0], st[2 * ks + 1][1]); w.w = cvtpk(st[2 * ks + 1][2], st[2 * ks + 1][3]); Bs[ks] = as_bf16x8(w); }
        f32x4 ws4[4], oacc[4];
#pragma unroll
        for (int t = 0; t < 4; ++t) ws4[t] = (f32x4){bflo(u_cur[t].x), bfhi(u_cur[t].x), bflo(u_cur[t].y), bfhi(u_cur[t].y)};
        bf16x8 FX[8], FY[8];
#define LDG(F, off) do { _Pragma("unroll") for (int i_ = 0; i_ < 8; ++i_) F[i_] = *(const LAS bf16x8*)(buf + (off) + (i_ * 64 + lane) * 16); } while (0)
#define SB() __builtin_amdgcn_sched_barrier(0)
        LDG(FX, REC_W); LDG(FY, REC_W + 8192); SB();
#pragma unroll
        for (int i = 0; i < 8; ++i) ws4[i >> 2] = __builtin_amdgcn_mfma_f32_16x16x32_bf16(FX[i], Bs[i & 3], ws4[i >> 2], 0, 0, 0);
        SB(); LDG(FX, REC_QD); SB();
#pragma unroll
        for (int i = 0; i < 8; ++i) ws4[2 + (i >> 2)] = __builtin_amdgcn_mfma_f32_16x16x32_bf16(FY[i], Bs[i & 3], ws4[2 + (i >> 2)], 0, 0, 0);
        SB(); LDG(FY, REC_QD + 8192); SB();
#pragma unroll
        for (int i = 0; i < 8; ++i) oacc[i >> 2] = __builtin_amdgcn_mfma_f32_16x16x32_bf16(FX[i], Bs[i & 3], (i & 3) ? oacc[i >> 2] : (f32x4){0.f, 0.f, 0.f, 0.f}, 0, 0, 0);
        SB(); LDG(FX, REC_QK); SB();
#pragma unroll
        for (int i = 0; i < 8; ++i) oacc[2 + (i >> 2)] = __builtin_amdgcn_mfma_f32_16x16x32_bf16(FY[i], Bs[i & 3], (i & 3) ? oacc[2 + (i >> 2)] : (f32x4){0.f, 0.f, 0.f, 0.f}, 0, 0, 0);
        SB(); LDG(FY, REC_KD); SB();
        bf16x8 Bv[2];
        {   f32x4 vn[4];
#pragma unroll
            for (int t = 0; t < 4; ++t) vn[t] = ws4[t];
#pragma unroll
            for (int k2 = 0; k2 < 2; ++k2) { u32x4 w; w.x = cvtpk(vn[2 * k2][0], vn[2 * k2][1]); w.y = cvtpk(vn[2 * k2][2], vn[2 * k2][3]); w.z = cvtpk(vn[2 * k2 + 1][0], vn[2 * k2 + 1][1]); w.w = cvtpk(vn[2 * k2 + 1][2], vn[2 * k2 + 1][3]); Bv[k2] = as_bf16x8(w); } }
#pragma unroll
        for (int t = 0; t < 8; ++t) st[t] = st[t] * dec_cur;
        SB();
#pragma unroll
        for (int i = 0; i < 8; ++i) oacc[i >> 1] = __builtin_amdgcn_mfma_f32_16x16x32_bf16(FX[i], Bv[i & 1], oacc[i >> 1], 0, 0, 0);
        SB(); LDG(FX, REC_KD + 8192); SB();
#pragma unroll
        for (int i = 0; i < 8; ++i) st[i >> 1] = __builtin_amdgcn_mfma_f32_16x16x32_bf16(FY[i], Bv[i & 1], st[i >> 1], 0, 0, 0);
        SB();
#pragma unroll
        for (int i = 0; i < 8; ++i) st[4 + (i >> 1)] = __builtin_amdgcn_mfma_f32_16x16x32_bf16(FX[i], Bv[i & 1], st[4 + (i >> 1)], 0, 0, 0);
#undef LDG
#undef SB
#ifdef DBG_MEAS
        const unsigned long long tm3_ = __builtin_amdgcn_s_memtime();
#endif
        BAR_LDS();
#ifdef DBG_MEAS
        dbg_b2_ += __builtin_amdgcn_s_memtime() - tm3_;
#endif
        if (c > 0) SCAN_STORE(c - 1);
#pragma unroll
        for (int t = 0; t < 4; ++t) { const float k = quadsum16(oacc[t] * oacc[t], fr);
            if (fr < 4) ss[wave * 64 + 16 * t + 4 * fq + fr] = k; }
#pragma unroll
        for (int t = 0; t < 4; ++t) { o_prev[t] = oacc[t]; u_cur[t] = u_nxt[t]; }
        dec_cur = dec_nxt;
    }
#ifdef DBG_MEAS
    if (l == 1 && seq == 0 && tid == 0) { const unsigned long long tot_ = __builtin_amdgcn_s_memtime() - dbg_t0_; const unsigned long long rt_ = __builtin_amdgcn_s_memrealtime() - dbg_r0_;
        float fr_ = 0.f;
        if (DBG_MEAS == 1) fr_ = (float)dbg_w_ / (float)tot_; else if (DBG_MEAS == 2) fr_ = (float)dbg_b_ / (float)tot_; else if (DBG_MEAS == 3) fr_ = (float)dbg_b2_ / (float)tot_;
        else if (DBG_MEAS == 4) fr_ = (float)rt_ * 0.01f / 500.0f;
        else if (DBG_MEAS == 5) fr_ = (float)tot_ / (float)rt_ / 100.0f * 0.25f;
        ((unsigned*)(a.ws + WS_CTL))[2000] = 8u * (unsigned)(fr_ * 32.0f + 0.5f); }
#endif
    __syncthreads();
    SCAN_RS();
    if (nsteps > 1) SCAN_FLUSH(nsteps - 2, zn);
    SCAN_ZLOAD(nsteps - 1, zq);
    __syncthreads();
    SCAN_STORE(nsteps - 1);
    __syncthreads();
    SCAN_FLUSH(nsteps - 1, zq);
#undef SCAN_FLUSH
#undef SCAN_ZLOAD
#undef SCAN_STORE
#undef SCAN_RS
    {   float* so = sample ? a.out + O_DNS + (((size_t)l * 16 + n) * 16 + h) * 16384 : a.out + O_DNP + (((size_t)l * 4 + n) * 16 + h) * 16384;
#pragma unroll
        for (int t = 0; t < 8; ++t)
#pragma unroll
            for (int j = 0; j < 4; ++j) so[(16 * t + 4 * fq + j) * 128 + 16 * wave + fr] = st[t][j]; }
}

constexpr int L_KI = 0, L_VT = 30720, SKI = 80, SVT = 200;
__device__ __forceinline__ void attn_item(const Args& a, int l, LAS unsigned char* lds, int it) {
    const int tid = tid_opaque(), lane = tid & 63, wave = __builtin_amdgcn_readfirstlane(tid >> 6);
    const int fr = lane & 15, fq = lane >> 4;
    const bool sample = it >= 1024;
    const int kv = it & 3, c = sample ? 0 : ((it >> 2) & 63), n = sample ? ((it - 1024) >> 2) : (it >> 8);
    const bf16* P = (const bf16*)(a.ws + WS_P); const f32x2* rope = (const f32x2*)(a.ws + WS_ROPE);
    bf16* Ob = (bf16*)(a.ws + WS_HO);
    LAS bf16* KI = (LAS bf16*)(lds + L_KI); LAS bf16* VT = (LAS bf16*)(lds + L_VT);
    const int kt0 = sample ? 0 : ((c >= 2) ? 0 : (8 - 4 * c));
    const int nkt = sample ? 9 : 12, nqt = sample ? 1 : 4;
    const size_t qrow0 = sample ? (size_t)MP + n * 16 : (size_t)n * 4096 + c * 64;
    const int pos0 = sample ? PAST : c * 64;
    __syncthreads();
    if (!sample) {
#pragma unroll
        for (int k2 = 0; k2 < 2; ++k2) { const int u = tid + 512 * k2; if (u < 768) { const int key = u >> 2, dg = u & 3, tok = (c - 2) * 64 + key;
            if (tok >= 0) { const bf16* kp = P + ((size_t)n * 4096 + tok) * NP + C_AK + kv * 64 + dg * 8; float x1[8], x2[8], o1[8], o2[8];
                unpack8(*(const u32x4*)kp, x1); unpack8(*(const u32x4*)(kp + 32), x2);
#pragma unroll
                for (int j = 0; j < 8; ++j) { const f32x2 cs = rope[tok * 32 + dg * 8 + j]; o1[j] = x1[j] * cs.x - x2[j] * cs.y; o2[j] = x2[j] * cs.x + x1[j] * cs.y; }
                *(LAS u32x4*)(KI + key * SKI + dg * 8) = pack8(o1); *(LAS u32x4*)(KI + key * SKI + 32 + dg * 8) = pack8(o2);
                if (c == 63 && key >= 64) { float* ko = a.out + O_KP + ((((size_t)l * 4 + n) * 128 + (key - 64)) * 4 + kv) * 64 + dg * 8;
                    *(f32x4*)ko = (f32x4){o1[0], o1[1], o1[2], o1[3]}; *(f32x4*)(ko + 4) = (f32x4){o1[4], o1[5], o1[6], o1[7]};
                    *(f32x4*)(ko + 32) = (f32x4){o2[0], o2[1], o2[2], o2[3]}; *(f32x4*)(ko + 36) = (f32x4){o2[4], o2[5], o2[6], o2[7]}; } } } }
#pragma unroll
        for (int k3 = 0; k3 < 3; ++k3) { const int u = tid + 512 * k3, key = u >> 3, dg = u & 7, tok = (c - 2) * 64 + key;
            if (tok >= 0) { const u32x4 vw = *(const u32x4*)(P + ((size_t)n * 4096 + tok) * NP + C_AV + kv * 64 + dg * 8);
                const unsigned ww[4] = {vw.x, vw.y, vw.z, vw.w};
#pragma unroll
                for (int j = 0; j < 8; ++j) VT[(dg * 8 + j) * SVT + key] = (bf16)((j & 1) ? (ww[j >> 1] >> 16) : (ww[j >> 1] & 0xffffu));
                if (c == 63 && key >= 64) { float vf[8]; unpack8(vw, vf); float* vo = a.out + O_VP + ((((size_t)l * 4 + n) * 128 + (key - 64)) * 4 + kv) * 64 + dg * 8;
                    *(f32x4*)vo = (f32x4){vf[0], vf[1], vf[2], vf[3]}; *(f32x4*)(vo + 4) = (f32x4){vf[4], vf[5], vf[6], vf[7]}; } } }
    } else {
        const float* ck = a.in[4] + ((size_t)l * 16 + n) * 128 * 256 + kv * 64; const float* cv = a.in[5] + ((size_t)l * 16 + n) * 128 * 256 + kv * 64;
        float* kso = a.out + O_KS + (((size_t)l * 16 + n) * 128 * 4 + kv) * 64; float* vso = a.out + O_VS + (((size_t)l * 16 + n) * 128 * 4 + kv) * 64;
#pragma unroll
        for (int k2 = 0; k2 < 3; ++k2) { const int u = tid + 512 * k2; if (u < 144 * 8) { const int key = u >> 3, dg = u & 7; float kf[8], vf[8];
            if (key < 128) { const f32x4 k0 = *(const f32x4*)(ck + (size_t)key * 256 + dg * 8), k1 = *(const f32x4*)(ck + (size_t)key * 256 + dg * 8 + 4), v0 = *(const f32x4*)(cv + (size_t)key * 256 + dg * 8), v1 = *(const f32x4*)(cv + (size_t)key * 256 + dg * 8 + 4);
#pragma unroll
                for (int j = 0; j < 4; ++j) { kf[j] = k0[j]; kf[4 + j] = k1[j]; vf[j] = v0[j]; vf[4 + j] = v1[j]; } }
            else { const int t = key - 128; const bf16* kp = P + ((size_t)MP + n * 16 + t) * NP + C_AK + kv * 64; float x1[8], x2[8];
                const int d1 = (dg & 3) * 8; unpack8(*(const u32x4*)(kp + d1), x1); unpack8(*(const u32x4*)(kp + 32 + d1), x2);
#pragma unroll
                for (int j = 0; j < 8; ++j) { const f32x2 cs = rope[(PAST + t) * 32 + d1 + j]; kf[j] = (dg < 4) ? (x1[j] * cs.x - x2[j] * cs.y) : (x2[j] * cs.x + x1[j] * cs.y); }
                unpack8(*(const u32x4*)(P + ((size_t)MP + n * 16 + t) * NP + C_AV + kv * 64 + dg * 8), vf); }
            *(LAS u32x4*)(KI + key * SKI + dg * 8) = pack8(kf);
            const u32x4 vw = pack8(vf); const unsigned ww[4] = {vw.x, vw.y, vw.z, vw.w};
#pragma unroll
            for (int j = 0; j < 8; ++j) VT[(dg * 8 + j) * SVT + key] = (bf16)((j & 1) ? (ww[j >> 1] >> 16) : (ww[j >> 1] & 0xffffu));
            if (key >= 16) { float* ko = kso + (size_t)(key - 16) * 256 + dg * 8; float* vo = vso + (size_t)(key - 16) * 256 + dg * 8;
                *(f32x4*)ko = (f32x4){kf[0], kf[1], kf[2], kf[3]}; *(f32x4*)(ko + 4) = (f32x4){kf[4], kf[5], kf[6], kf[7]};
                *(f32x4*)vo = (f32x4){vf[0], vf[1], vf[2], vf[3]}; *(f32x4*)(vo + 4) = (f32x4){vf[4], vf[5], vf[6], vf[7]}; } } }
    }
    __syncthreads();
    const int hq = kv * 8 + wave;
    const float sink = a.in[17][l * 32 + hq];
    for (int qt = 0; qt < nqt; ++qt) {
        const int tq = pos0 + 16 * qt + fr; const size_t row = qrow0 + 16 * qt + fr;
        bf16x8 Qf[2];
        {   const bf16* qp = P + row * NP + C_AQ + hq * 64 + 8 * fq; float x1[8], x2[8], o1[8], o2[8];
            unpack8(*(const u32x4*)qp, x1); unpack8(*(const u32x4*)(qp + 32), x2);
#pragma unroll
            for (int j = 0; j < 8; ++j) { const f32x2 cs = rope[tq * 32 + 8 * fq + j]; o1[j] = (x1[j] * cs.x - x2[j] * cs.y) * 0.125f; o2[j] = (x2[j] * cs.x + x1[j] * cs.y) * 0.125f; }
            Qf[0] = as_bf16x8(pack8(o1)); Qf[1] = as_bf16x8(pack8(o2)); }
        u32x2 zw[4];
#pragma unroll
        for (int dt = 0; dt < 4; ++dt) zw[dt] = *(const u32x2*)(P + row * NP + C_AZ + hq * 64 + 16 * dt + 4 * fq);
        f32x4 s[12]; float m = sink;
#pragma unroll
        for (int kt = 0; kt < 12; ++kt) { s[kt] = (f32x4){0.f, 0.f, 0.f, 0.f};
            if (kt >= kt0 && kt < nkt) {
#pragma unroll
                for (int ks = 0; ks < 2; ++ks) { const bf16x8 kf = *(const LAS bf16x8*)(KI + (16 * kt + fr) * SKI + 32 * ks + 8 * fq); s[kt] = __builtin_amdgcn_mfma_f32_16x16x32_bf16(kf, Qf[ks], s[kt], 0, 0, 0); }
                m = fmaxf(m, fmaxf(fmaxf(s[kt][0], s[kt][1]), fmaxf(s[kt][2], s[kt][3]))); } }
        m = fmaxf(m, __shfl_xor(m, 16)); m = fmaxf(m, __shfl_xor(m, 32));
        float sum = 0.f; f32x4 oc[4];
#pragma unroll
        for (int dt = 0; dt < 4; ++dt) oc[dt] = (f32x4){0.f, 0.f, 0.f, 0.f};
#pragma unroll
        for (int kt = 0; kt < 12; ++kt) { if (kt >= kt0 && kt < nkt) {
            const float p0 = __expf(s[kt][0] - m), p1 = __expf(s[kt][1] - m), p2 = __expf(s[kt][2] - m), p3 = __expf(s[kt][3] - m); sum += (p0 + p1) + (p2 + p3);
            u32x2 pw; pw.x = cvtpk(p0, p1); pw.y = cvtpk(p2, p3);
#pragma unroll
            for (int dt = 0; dt < 4; ++dt) { const u32x2 vf = *(const LAS u32x2*)(VT + (16 * dt + fr) * SVT + 16 * kt + 4 * fq);
                oc[dt] = __builtin_amdgcn_mfma_f32_16x16x16bf16_1k(as_bf16x4(vf), as_bf16x4(pw), oc[dt], 0, 0, 0); } } }
        sum += __shfl_xor(sum, 16); sum += __shfl_xor(sum, 32);
        const float inv = 1.0f / (sum + __expf(sink - m));
#pragma unroll
        for (int dt = 0; dt < 4; ++dt) { const int d0 = 16 * dt + 4 * fq;
            const float o0 = oc[dt][0] * inv * silu_f(bflo(zw[dt].x)), o1 = oc[dt][1] * inv * silu_f(bfhi(zw[dt].x)), o2 = oc[dt][2] * inv * silu_f(bflo(zw[dt].y)), o3 = oc[dt][3] * inv * silu_f(bfhi(zw[dt].y));
            u32x2 ow; ow.x = cvtpk(o0, o1); ow.y = cvtpk(o2, o3);
            *(u32x2*)(Ob + row * D + 2048 + hq * 64 + d0) = ow; }
    }
}

struct OneUnit { int pn; __device__ __forceinline__ bool next(int i, pg8::Unit& u) const { if (i) return false; u.pm = 0; u.pn = pn; return true; }
    __device__ __forceinline__ void a_ready(const pg8::Unit&) const {} __device__ __forceinline__ void done(const pg8::Unit&) const {} };
#ifndef DBG_REPEAT
#define DBG_REPEAT 0
#endif
__device__ __forceinline__ void phase_c2(const Args& a, int l, LAS unsigned char* lds, int G) {
    const int b = blockIdx.x;
    unsigned* cnt = (unsigned*)(a.ws + WS_CTL) + CW_C2DONE + 64 * l;
    if (b < 64) { for (int r_ = 0; r_ < ((((DBG_REPEAT) >> 7) & 1) ? 2 : 1); ++r_) scan_seq(a, l, lds, b); }
    else if (b < 80) {
        if (threadIdx.x == 0) { unsigned sp = 0; while (__hip_atomic_load(cnt, __ATOMIC_RELAXED, __HIP_MEMORY_SCOPE_AGENT) < (unsigned)(G - 80)) { __builtin_amdgcn_s_sleep(8); if (++sp > (1u << 22)) break; }
            __builtin_amdgcn_fence(__ATOMIC_ACQUIRE, "agent"); VM_WAIT(); }
        __syncthreads();
        pg8::Gemm g{(const pg8::bf16_t*)(a.ws + WS_HO) + (size_t)MP * D, (const pg8::bf16_t*)(a.ws + WS_BOUT + l * BOUT_BYTES), MS, D, D};
        OneUnit S; S.pn = b - 64;
        pg8::EpiY E{(pg8::bf16_t*)(a.ws + WS_YS), D, (float*)(a.ws + WS_YSQ) + (size_t)MP * 64};
        pg8::gemm_phase<pg8::EpiY, OneUnit, true, true>(lds, g, S, E);
    } else {
        const int vb = b - 80, nvb = G - 80;
        for (int it = vb; it < 320; it += nvb) { if (it < 256) scan_seq(a, l, lds, 64 + it); else attn_item(a, l, lds, 1024 + (it - 256)); }
        VM_WAIT(); __syncthreads();
        if (threadIdx.x == 0) { __builtin_amdgcn_fence(__ATOMIC_RELEASE, "agent"); VM_WAIT(); __hip_atomic_fetch_add(cnt, 1u, __ATOMIC_RELAXED, __HIP_MEMORY_SCOPE_AGENT); }
        for (int it = vb; it < 1024; it += nvb) { for (int r_ = 0; r_ < ((((DBG_REPEAT) >> 8) & 1) ? 2 : 1); ++r_) attn_item(a, l, lds, it); }
#if SPLIT_PROLOGUE
        if (l == 0) { __syncthreads(); prologue_work(a, lds, vb, nvb, 2, 0x8, false); }
#endif
    }
}

constexpr int N_PHASES = 12;
__device__ __forceinline__ Args load_args(const __attribute__((address_space(4))) Args* p) {
    Args a;
#pragma unroll
    for (int i = 0; i < 19; ++i) a.in[i] = (const float*)(const GAS float*)p->in[i];
    a.out = (float*)(GAS float*)p->out; a.ws = (unsigned char*)(GAS unsigned char*)p->ws; a.ph_lo = p->ph_lo; a.ph_hi = p->ph_hi; return a;
}
__global__ void __launch_bounds__(512, 2) fwd(Args args) {
    extern __shared__ __attribute__((aligned(16))) unsigned char lds_raw[];
    LAS unsigned char* lds = (LAS unsigned char*)lds_raw;
    const int G = gridDim.x;
    typedef const __attribute__((address_space(4))) Args* KArgs;
    const KArgs kp = (KArgs)__builtin_amdgcn_kernarg_segment_ptr();
#define ARGS(name) KArgs name##_p = kp; asm volatile("" : "+s"(name##_p)); const Args name = load_args(name##_p)
    const int lo = kp->ph_lo, hi = kp->ph_hi;
    volatile LAS unsigned* MISC = (volatile LAS unsigned*)(lds + MISC_OFF);
    for (int u = threadIdx.x; u < 64; u += 512) MISC[u] = 0u;
    __syncthreads();
    unsigned* barw = (unsigned*)(GAS unsigned*)((GAS unsigned char*)kp->ws + WS_CTL) + CW_BAR;
    XcdBarrier bar; bar.bar = barw; bar.x = 0; bar.st = nullptr;
    const bool multi = (hi - lo) > 1;
    if (multi) bar = xcd_barrier_post(barw, MISC + 8);
#define IN(k) (lo <= (k) && (k) < hi)
#ifndef DBG_REPEAT
#define DBG_REPEAT 0
#endif
#define REP(bit) for (int rep_ = 0; rep_ < (((DBG_REPEAT) >> (bit)) & 1) + 1; ++rep_)
#define SEAM(k) do { if (IN(k) && IN((k) + 1)) xcd_barrier(bar); } while (0)
    if (IN(0)) REP(0) { ARGS(a0); phase_prologue(a0, lds, G); }
    SEAM(0);
    if (IN(1)) REP(1) { ARGS(a1); phase_rows<0>(a1, lds, G); }
    SEAM(1);
    for (int l = 0; l < 2; ++l) {
        const int pb = 2 + 5 * l;
        if (IN(pb + 0)) REP(2) {
            ARGS(args);
            pg8::Gemm g{(const pg8::bf16_t*)(args.ws + WS_HO), (const pg8::bf16_t*)(args.ws + WS_BIN + l * BIN_BYTES), M, NP, D};
            pg8::StaticOrder S; S.init(M, NP, G, (int)blockIdx.x);
            pg8::EpiP E{(pg8::bf16_t*)(args.ws + WS_P), NP, args.in[16] + (size_t)l * 128, C_ZDN / 256, (C_ZDN + 2048) / 256};
#ifdef DBG_CLK
            const unsigned long long ck0_ = __builtin_amdgcn_s_memtime(), cr0_ = __builtin_amdgcn_s_memrealtime();
#endif
            pg8::gemm_phase<pg8::EpiP, pg8::StaticOrder, true, true>(lds, g, S, E);
#ifdef DBG_CLK
            if (l == 1 && blockIdx.x == 0 && threadIdx.x == 0) { const unsigned long long dc_ = __builtin_amdgcn_s_memtime() - ck0_, dr_ = __builtin_amdgcn_s_memrealtime() - cr0_;
                const float ghz_ = (float)dc_ / ((float)dr_ * 10.0f);
                float fr_ = (DBG_CLK == 1) ? (ghz_ - 1.0f) / 1.6f : (float)dr_ * 0.01f / 2000.0f;
                fr_ = fr_ < 0.f ? 0.f : (fr_ > 1.f ? 1.f : fr_);
                ((unsigned*)(args.ws + WS_CTL))[2000] = 16u * (unsigned)(fr_ * 16.0f + 0.5f); }
#endif
        }
        SEAM(pb + 0);
        if (IN(pb + 1)) REP(3) { ARGS(a2); phase_c1(a2, l, lds, G); }
        SEAM(pb + 1);
        if (IN(pb + 2)) REP(4) { ARGS(a3); phase_c2(a3, l, lds, G); }
        SEAM(pb + 2);
        if (IN(pb + 3)) REP(5) {
            ARGS(args);
            pg8::Gemm g{(const pg8::bf16_t*)(args.ws + WS_HO), (const pg8::bf16_t*)(args.ws + WS_BOUT + l * BOUT_BYTES), MP, D, D};
            pg8::StaticOrder S; S.init(MP, D, G, (int)blockIdx.x);
            pg8::EpiY E{(pg8::bf16_t*)(args.ws + WS_P), D, (float*)(args.ws + WS_YSQ)};
            pg8::gemm_phase<pg8::EpiY, pg8::StaticOrder, true, true>(lds, g, S, E);
        }
        SEAM(pb + 3);
        if (IN(pb + 4)) for (int rep_ = 0; rep_ < ((((DBG_REPEAT) >> 6) & 1) && l == 0 ? 2 : 1); ++rep_) { ARGS(a4); if (l == 0) phase_rows<1>(a4, lds, G); else phase_rows<2>(a4, lds, G); }
        SEAM(pb + 4);
    }
#undef IN
#undef SEAM
#undef ARGS
}


#ifdef DBG_STOP_AFTER
__global__ void dbg_dump(const unsigned char* ws, float* out) {
    const size_t regs[9][2] = {{WS_MOD, 1966080}, {WS_ROPE, 1048576}, {WS_DEC, 17408}, {WS_YSQ, (size_t)M * 64 * 4}, {WS_BIN, 2 * BIN_BYTES}, {WS_BOUT, 2 * BOUT_BYTES}, {WS_HO, (size_t)M * D * 2}, {WS_P, (size_t)M * NP * 2}, {WS_REC, (size_t)NREC * REC_BYTES}};
    size_t obase = 0;
    for (int r = 0; r < 9; ++r) { const size_t nchunk = regs[r][1] / 128; const unsigned short* p = (const unsigned short*)(ws + regs[r][0]);
        for (size_t i = (size_t)blockIdx.x * blockDim.x + threadIdx.x; i < nchunk; i += (size_t)gridDim.x * blockDim.x) { unsigned s = 0; for (int k = 0; k < 64; ++k) s += p[i * 64 + k]; out[obase + i] = (float)s; }
        obase += nchunk; }
}
#endif
#ifndef MK_PER_PHASE
#define MK_PER_PHASE 1
#endif
extern "C" void kernel_launch(void* const* d_in, const int* in_sizes, int n_in, void* d_out, int out_size, void* d_ws, size_t ws_size, hipStream_t stream) {
    static int grid = 0;
    if (grid == 0) {
        if (n_in != 19 || out_size != (int)O_END || ws_size < WS_END) { fprintf(stderr, "kernel_launch: unexpected shapes (n_in %d out %d ws %zu need %zu)\n", n_in, out_size, ws_size, (size_t)WS_END); grid = -1; return; }
        int dev = 0, cus = 0;
        if (hipGetDevice(&dev) != hipSuccess || hipDeviceGetAttribute(&cus, hipDeviceAttributeMultiprocessorCount, dev) != hipSuccess) { grid = -1; return; }
        if (hipFuncSetAttribute((const void*)fwd, hipFuncAttributeMaxDynamicSharedMemorySize, LDS_BYTES) != hipSuccess) { fprintf(stderr, "kernel_launch: hipFuncSetAttribute failed\n"); grid = -1; return; }
        int per_cu = 0;
        if (hipOccupancyMaxActiveBlocksPerMultiprocessor(&per_cu, (const void*)fwd, 512, LDS_BYTES) != hipSuccess || per_cu < 1) fprintf(stderr, "kernel_launch: occupancy query says %d\n", per_cu);
        (void)hipGetLastError();
        grid = cus;
        if (grid < 128) { fprintf(stderr, "kernel_launch: needs >= 128 CUs\n"); grid = -1; return; }
    }
    if (grid < 0) return;
    (void)in_sizes;
    if (hipMemsetAsync((char*)d_ws + WS_CTL, 0, CTL_ZERO_BYTES, stream) != hipSuccess) return;
    Args a{};
    for (int i = 0; i < 19; ++i) a.in[i] = (const float*)d_in[i];
    a.out = (float*)d_out; a.ws = (unsigned char*)d_ws;
#ifdef DBG_STOP_AFTER
    for (int p = 0; p <= DBG_STOP_AFTER; ++p) { a.ph_lo = p; a.ph_hi = p + 1; hipLaunchKernelGGL(fwd, dim3(grid), dim3(512), LDS_BYTES, stream, a); }
    hipLaunchKernelGGL(dbg_dump, dim3(2048), dim3(256), 0, stream, (const unsigned char*)d_ws, (float*)d_out);
#elif MK_PER_PHASE
    for (int p = 0; p < N_PHASES; ++p) { a.ph_lo = p; a.ph_hi = p + 1; hipLaunchKernelGGL(fwd, dim3(grid), dim3(512), LDS_BYTES, stream, a); }
#else
    a.ph_lo = 0; a.ph_hi = N_PHASES;
    hipLaunchKernelGGL(fwd, dim3(grid), dim3(512), LDS_BYTES, stream, a);
#endif
}
```

```cpp
#include <hip/hip_runtime.h>
#include <cstdio>
#include <cstdint>
#define MK_PER_PHASE 0
__device__ __forceinline__ int tid_opaque() { int t = threadIdx.x; asm volatile("" : "+v"(t)); return t; }
namespace pg8 {
#define PG8_LAS __attribute__((address_space(3)))
typedef unsigned short bf16_t;
typedef short bf16x8 __attribute__((ext_vector_type(8)));
typedef float f32x4 __attribute__((ext_vector_type(4)));
typedef unsigned u32x4 __attribute__((ext_vector_type(4)));
constexpr int BM = 256, BK = 64, HALF = 128, HTB = HALF * BK * 2  , STAGE_BYTES = 8 * HTB, NXCD = 8, WGM = 8;

__host__ __device__ __forceinline__ int lds_byte(int r, int c) { const int st = (r >> 4) * 2 + (c >> 5), rr = r & 15, cc = c & 31, ob = rr * 64 + cc * 2; return st * 1024 + (ob ^ (((ob >> 9) & 1) << 5)); }
__host__ __device__ __forceinline__ void stage_rc(int b, int& R, int& C) { const int st = b / 1024, sb = b % 1024, swz = sb ^ (((sb >> 9) & 1) << 5); R = (st >> 1) * 16 + swz / 64; C = (st & 1) * 32 + (swz % 64) / 2; }
__host__ __device__ __forceinline__ int perm32(int rho) { const int n = rho >> 4, i = rho & 15; return 8 * (i >> 2) + 4 * n + (i & 3); }

struct Unit { int pm, pn; };
struct Gemm { const bf16_t* A; const bf16_t* Bt; int M, N, K; };

struct StaticOrder {
    int nM, nN, nwg, G, c;
    __host__ __device__ void init(int M, int N, int G_, int c_) { nM = M / BM; nN = N / BM; nwg = nM * nN; G = G_; c = c_; }
    __host__ __device__ bool next(int i, Unit& u) const {
        const long L = (long)i * G + c; if (L >= nwg) return false;
        int wgid = (int)L; { const int q = nwg / NXCD, r = nwg % NXCD, xcd = wgid % NXCD, off = wgid / NXCD; wgid = (xcd < r ? xcd * (q + 1) : r * (q + 1) + (xcd - r) * q) + off; }
        const int nig = WGM * nN, gid = wgid / nig, fm = gid * WGM, gsz = (nM - fm) < WGM ? (nM - fm) : WGM;
        u.pm = fm + ((wgid % nig) % gsz); u.pn = (wgid % nig) / gsz; return true;
    }
    __device__ __forceinline__ void a_ready(const Unit&) const {}
    __device__ __forceinline__ void done(const Unit&) const {}
};

typedef __bf16 hwbf16x2_t __attribute__((ext_vector_type(2))); typedef float f32x2_t __attribute__((ext_vector_type(2)));
__device__ __forceinline__ unsigned cvt_pk_bf16(float lo, float hi) { const f32x2_t v = {lo, hi}; return __builtin_bit_cast(unsigned, __builtin_convertvector(v, hwbf16x2_t)); }
struct EpiP {
    static constexpr bool PERM = true, AFTER_DRAIN = false;
    bf16_t* O; int ldc; const float* dn; int gate_lo, gate_hi;
    __device__ __forceinline__ void operator()(const f32x4 (&acc)[2][2][4][2], const Unit& u, int wr, int wc, int fr, int fq) const {
        const int row0 = u.pm * BM + wr * 64 + fr, col0 = u.pn * BM + wc * 32 + 8 * fq;
        if (u.pn >= gate_lo && u.pn < gate_hi) {
            f32x4 dv[2][2];
#pragma unroll
            for (int bj = 0; bj < 2; ++bj) { const int e0 = (wc * 32 + 8 * fq) & 127; dv[bj][0] = *(const f32x4*)(dn + e0); dv[bj][1] = *(const f32x4*)(dn + e0 + 4); }
#pragma unroll
            for (int ai = 0; ai < 2; ++ai)
#pragma unroll
                for (int m = 0; m < 4; ++m) { bf16_t* rowp = O + (size_t)(row0 + ai * HALF + m * 16) * ldc + col0;
#pragma unroll
                    for (int bj = 0; bj < 2; ++bj) { f32x4 v[2] = {acc[ai][bj][m][0], acc[ai][bj][m][1]};
#pragma unroll
                        for (int n = 0; n < 2; ++n) { const f32x4 t = v[n] * -1.4426950408889634f; f32x4 s;
#pragma unroll
                            for (int j = 0; j < 4; ++j) s[j] = __builtin_amdgcn_rcpf(1.0f + __builtin_amdgcn_exp2f(t[j]));
                            v[n] = v[n] * s * dv[bj][n]; }
                        u32x4 w; w.x = cvt_pk_bf16(v[0][0], v[0][1]); w.y = cvt_pk_bf16(v[0][2], v[0][3]); w.z = cvt_pk_bf16(v[1][0], v[1][1]); w.w = cvt_pk_bf16(v[1][2], v[1][3]);
                        *(u32x4*)(rowp + bj * HALF) = w; } }
            return;
        }
#pragma unroll
        for (int ai = 0; ai < 2; ++ai)
#pragma unroll
            for (int m = 0; m < 4; ++m) { bf16_t* rowp = O + (size_t)(row0 + ai * HALF + m * 16) * ldc + col0;
#pragma unroll
                for (int bj = 0; bj < 2; ++bj) { const f32x4 v0 = acc[ai][bj][m][0], v1 = acc[ai][bj][m][1];
                    u32x4 w; w.x = cvt_pk_bf16(v0[0], v0[1]); w.y = cvt_pk_bf16(v0[2], v0[3]); w.z = cvt_pk_bf16(v1[0], v1[1]); w.w = cvt_pk_bf16(v1[2], v1[3]);
                    *(u32x4*)(rowp + bj * HALF) = w; } }
    }
};
struct EpiY {
    static constexpr bool PERM = true, AFTER_DRAIN = false;
    bf16_t* O; int ldc; float* part;
    __device__ __forceinline__ void operator()(const f32x4 (&acc)[2][2][4][2], const Unit& u, int wr, int wc, int fr, int fq) const {
        const int row0 = u.pm * BM + wr * 64 + fr, col0 = u.pn * BM + wc * 32 + 8 * fq;
#pragma unroll
        for (int ai = 0; ai < 2; ++ai)
#pragma unroll
            for (int m = 0; m < 4; ++m) { const int row = row0 + ai * HALF + m * 16; bf16_t* rowp = O + (size_t)row * ldc + col0; float s = 0.f;
#pragma unroll
                for (int bj = 0; bj < 2; ++bj) { const f32x4 v0 = acc[ai][bj][m][0], v1 = acc[ai][bj][m][1];
                    s += (v0[0] * v0[0] + v0[1] * v0[1]) + (v0[2] * v0[2] + v0[3] * v0[3]) + (v1[0] * v1[0] + v1[1] * v1[1]) + (v1[2] * v1[2] + v1[3] * v1[3]);
                    u32x4 w; w.x = cvt_pk_bf16(v0[0], v0[1]); w.y = cvt_pk_bf16(v0[2], v0[3]); w.z = cvt_pk_bf16(v1[0], v1[1]); w.w = cvt_pk_bf16(v1[2], v1[3]);
                    *(u32x4*)(rowp + bj * HALF) = w; }
                s += __shfl_xor(s, 16); s += __shfl_xor(s, 32);
                if (fq == 0) part[(size_t)row * 64 + u.pn * 4 + wc] = s; }
    }
};

template <class Epi, class Sched, bool ALIGN_EPI = false, bool SP2 = false>
__device__ __forceinline__ void gemm_phase(PG8_LAS unsigned char* lds, const Gemm g, const Sched& S, const Epi& E) {
    const int tid = tid_opaque(), wid = __builtin_amdgcn_readfirstlane(tid >> 6), lane = tid & 63, wr = wid >> 2, wc = wid & 3, fr = lane & 15, fq = lane >> 4;
    const int K = g.K, nt = K / BK;
    unsigned voffA[2], voffB[2];
#pragma unroll
    for (int i = 0; i < 2; ++i) { int R, C; stage_rc(tid * 16 + i * 8192, R, C); const int Rb = Epi::PERM ? ((R & ~31) + perm32(R & 31)) : R;
        voffA[i] = (unsigned)(R * K + C) * 2u; voffB[i] = (unsigned)(Rb * K + C) * 2u; }
    const size_t kstep = (size_t)(BK * 2);
    const size_t hstep = (size_t)HALF * K * 2;
    const size_t tstep = 2 * hstep;
    const unsigned ldsw = (unsigned)wid * 1024u;
    const int aoff = lds_byte(wr * 64 + fr, fq * 8), boff = lds_byte(wc * 32 + fr, fq * 8);
#define PG8_SA(b, h) (((b) * 2 + (h)) * HTB)
#define PG8_SB(b, h) ((4 + (b) * 2 + (h)) * HTB)
#define PG8_STAGE(bufoff, gbase, voff) do { _Pragma("unroll") for (int _i = 0; _i < 2; ++_i) \
        __builtin_amdgcn_global_load_lds((const unsigned*)((const char*)(gbase) + (voff)[_i]), (PG8_LAS unsigned*)(lds + (bufoff) + ldsw + _i * 8192), 16, 0, 0); } while (0)
#define PG8_LDA(dst, b, h) do { _Pragma("unroll") for (int m = 0; m < 4; ++m) _Pragma("unroll") for (int k = 0; k < 2; ++k) dst[m][k] = *(const PG8_LAS bf16x8*)(lds + PG8_SA(b, h) + aoff + m * 2048 + k * 1024); } while (0)
#define PG8_LDB(dst, b, h) do { _Pragma("unroll") for (int n = 0; n < 2; ++n) _Pragma("unroll") for (int k = 0; k < 2; ++k) dst[n][k] = *(const PG8_LAS bf16x8*)(lds + PG8_SB(b, h) + boff + n * 2048 + k * 1024); } while (0)
#define PG8_MMA(ai, bj, At, Bt) do { __builtin_amdgcn_s_setprio(1); _Pragma("unroll") for (int m = 0; m < 4; ++m) _Pragma("unroll") for (int n = 0; n < 2; ++n) _Pragma("unroll") for (int k = 0; k < 2; ++k) \
        acc[ai][bj][m][n] = __builtin_amdgcn_mfma_f32_16x16x32_bf16(Bt[n][k], At[m][k], acc[ai][bj][m][n], 0, 0, 0); __builtin_amdgcn_s_setprio(0); } while (0)
#define PG8_WAIT_V(n) asm volatile("s_waitcnt vmcnt(" #n ")" ::: "memory")
#define PG8_WAIT_L(n) asm volatile("s_waitcnt lgkmcnt(" #n ")" ::: "memory")
#define PG8_BAR __builtin_amdgcn_s_barrier()
#define PG8_SCHED __builtin_amdgcn_sched_barrier(0)
    Unit cur, nxt; int ui = 0;
    if (!S.next(0, cur)) return;
    f32x4 acc[2][2][4][2];
#pragma unroll
    for (int a = 0; a < 2; ++a)
#pragma unroll
        for (int b = 0; b < 2; ++b)
#pragma unroll
            for (int m = 0; m < 4; ++m)
#pragma unroll
                for (int n = 0; n < 2; ++n) acc[a][b][m][n] = (f32x4){0.f, 0.f, 0.f, 0.f};
    bf16x8 At[4][2], B0[2][2], B1[2][2];
    const char* cA = (const char*)g.A + (size_t)cur.pm * tstep; const char* cB = (const char*)g.Bt + (size_t)cur.pn * tstep;
    S.a_ready(cur);
    if constexpr (SP2) {
        PG8_STAGE(PG8_SB(0, 0), cB, voffB); PG8_STAGE(PG8_SB(0, 1), cB + hstep, voffB); PG8_STAGE(PG8_SA(0, 0), cA, voffA); PG8_STAGE(PG8_SA(0, 1), cA + hstep, voffA);
        if (wr == 1) PG8_BAR;
        PG8_WAIT_V(2); PG8_BAR;
        PG8_STAGE(PG8_SB(1, 0), cB + kstep, voffB); PG8_STAGE(PG8_SA(1, 0), cA + kstep, voffA); PG8_STAGE(PG8_SB(1, 1), cB + hstep + kstep, voffB);
        PG8_WAIT_V(6); PG8_BAR;
    } else {
        PG8_STAGE(PG8_SB(0, 0), cB, voffB); PG8_STAGE(PG8_SA(0, 0), cA, voffA); PG8_STAGE(PG8_SB(0, 1), cB + hstep, voffB); PG8_STAGE(PG8_SA(0, 1), cA + hstep, voffA);
        if (wr == 1) PG8_BAR;
        PG8_WAIT_V(4); PG8_BAR;
        PG8_STAGE(PG8_SB(1, 0), cB + kstep, voffB); PG8_STAGE(PG8_SA(1, 0), cA + kstep, voffA); PG8_STAGE(PG8_SB(1, 1), cB + hstep + kstep, voffB);
        PG8_WAIT_V(6); PG8_BAR;
    }
    for (;;) {
        const bool has_next = S.next(ui + 1, nxt);
        const char* nA = has_next ? (const char*)g.A + (size_t)nxt.pm * tstep : cA; const char* nB = has_next ? (const char*)g.Bt + (size_t)nxt.pn * tstep : cB;
        for (int t = 0; t < nt; t += 2) {
            const bool last = (t == nt - 2);
            const char* a1 = cA + (size_t)(t + 1) * kstep;
            const char* a2 = last ? nA : cA + (size_t)(t + 2) * kstep; const char* b2 = last ? nB : cB + (size_t)(t + 2) * kstep;
            const char* a3 = a2 + kstep; const char* b3 = b2 + kstep;
            if (last && has_next) S.a_ready(nxt);
            if constexpr (SP2) {
            PG8_LDB(B0, 0, 0); PG8_LDB(B1, 0, 1); PG8_SCHED; PG8_LDA(At, 0, 0); PG8_STAGE(PG8_SA(1, 1), a1 + hstep, voffA);
            PG8_WAIT_V(8); PG8_WAIT_L(0); PG8_BAR; PG8_MMA(0, 0, At, B0); PG8_MMA(0, 1, At, B1); PG8_BAR; PG8_SCHED;
            PG8_LDA(At, 0, 1); PG8_STAGE(PG8_SB(0, 0), b2, voffB); PG8_STAGE(PG8_SB(0, 1), b2 + hstep, voffB); PG8_STAGE(PG8_SA(0, 0), a2, voffA);
            PG8_WAIT_V(8); PG8_WAIT_L(0); PG8_BAR; PG8_MMA(1, 0, At, B0); PG8_MMA(1, 1, At, B1); PG8_BAR; PG8_SCHED;
            PG8_LDB(B0, 1, 0); PG8_LDB(B1, 1, 1); PG8_SCHED; PG8_LDA(At, 1, 0); PG8_STAGE(PG8_SA(0, 1), a2 + hstep, voffA);
            PG8_WAIT_V(8); PG8_WAIT_L(0); PG8_BAR; PG8_MMA(0, 0, At, B0); PG8_MMA(0, 1, At, B1); PG8_BAR; PG8_SCHED;
            PG8_LDA(At, 1, 1); PG8_STAGE(PG8_SB(1, 0), b3, voffB); PG8_STAGE(PG8_SB(1, 1), b3 + hstep, voffB); PG8_STAGE(PG8_SA(1, 0), a3, voffA);
            PG8_WAIT_V(8); PG8_WAIT_L(0); PG8_BAR; PG8_MMA(1, 0, At, B0); PG8_MMA(1, 1, At, B1); PG8_BAR; PG8_SCHED;
            } else {
            PG8_LDB(B0, 0, 0); PG8_SCHED; PG8_LDA(At, 0, 0); PG8_STAGE(PG8_SA(1, 1), a1 + hstep, voffA);
            PG8_WAIT_L(8); PG8_BAR; PG8_WAIT_L(0); PG8_MMA(0, 0, At, B0); PG8_BAR; PG8_SCHED;
            PG8_LDB(B1, 0, 1); PG8_STAGE(PG8_SB(0, 0), b2, voffB);
            PG8_BAR; PG8_WAIT_L(0); PG8_MMA(0, 1, At, B1); PG8_BAR;
            PG8_LDA(At, 0, 1); PG8_STAGE(PG8_SA(0, 0), a2, voffA);
            PG8_BAR; PG8_WAIT_L(0); PG8_MMA(1, 0, At, B0); PG8_BAR; PG8_SCHED;
            PG8_STAGE(PG8_SB(0, 1), b2 + hstep, voffB);
            PG8_WAIT_V(6); PG8_BAR; PG8_MMA(1, 1, At, B1); PG8_BAR;
            PG8_LDB(B0, 1, 0); PG8_SCHED; PG8_LDA(At, 1, 0); PG8_STAGE(PG8_SA(0, 1), a2 + hstep, voffA);
            PG8_WAIT_L(8); PG8_BAR; PG8_WAIT_L(0); PG8_MMA(0, 0, At, B0); PG8_BAR; PG8_SCHED;
            PG8_LDB(B1, 1, 1); PG8_STAGE(PG8_SB(1, 0), b3, voffB);
            PG8_BAR; PG8_WAIT_L(0); PG8_MMA(0, 1, At, B1); PG8_BAR;
            PG8_LDA(At, 1, 1); PG8_STAGE(PG8_SA(1, 0), a3, voffA);
            PG8_BAR; PG8_WAIT_L(0); PG8_MMA(1, 0, At, B0); PG8_BAR; PG8_SCHED;
            PG8_STAGE(PG8_SB(1, 1), b3 + hstep, voffB);
            PG8_WAIT_V(6); PG8_BAR; PG8_MMA(1, 1, At, B1); PG8_BAR;
            }
        }
        if constexpr (ALIGN_EPI) { if (wr == 0) PG8_BAR; }
        if constexpr (!Epi::AFTER_DRAIN) { E(acc, cur, wr, wc, fr, fq); S.done(cur); }
        if (!has_next) break;
#pragma unroll
        for (int a = 0; a < 2; ++a)
#pragma unroll
            for (int b = 0; b < 2; ++b)
#pragma unroll
                for (int m = 0; m < 4; ++m)
#pragma unroll
                    for (int n = 0; n < 2; ++n) acc[a][b][m][n] = (f32x4){0.f, 0.f, 0.f, 0.f};
        cur = nxt; cA = nA; cB = nB; ++ui;
        if constexpr (ALIGN_EPI) { if (wr == 1) PG8_BAR; }
    }
    PG8_WAIT_V(0);
    if constexpr (!ALIGN_EPI) { if (wr == 0) PG8_BAR; }
    PG8_BAR;
    if constexpr (Epi::AFTER_DRAIN) { E.fused(acc, cur, wr, wc, fr, fq, lds, wid, lane); S.done(cur); }
#undef PG8_SA
#undef PG8_SB
#undef PG8_STAGE
#undef PG8_LDA
#undef PG8_LDB
#undef PG8_MMA
#undef PG8_WAIT_V
#undef PG8_WAIT_L
#undef PG8_BAR
#undef PG8_SCHED
}
}

#define GAS __attribute__((address_space(1)))
#define LAS __attribute__((address_space(3)))
typedef unsigned short bf16;
typedef short bf16x8 __attribute__((ext_vector_type(8)));
typedef short bf16x4 __attribute__((ext_vector_type(4)));
typedef float f32x4 __attribute__((ext_vector_type(4)));
typedef float f32x2 __attribute__((ext_vector_type(2)));
typedef unsigned u32x4 __attribute__((ext_vector_type(4)));
typedef unsigned u32x2 __attribute__((ext_vector_type(2)));

constexpr int D = 4096, NB = 4, T = 4096, NSB = 16, TS = 16, PAST = 2048;
constexpr int MP = NB * T, MS = NSB * TS, M = MP + MS;
constexpr int NP = 13056, IN_DIM = 12832;
constexpr int C_Q = 0, C_K = 2048, C_V = 4096, C_ZDN = 6144, C_AQ = 8192, C_AK = 10240, C_AV = 10496, C_AZ = 10752, C_B = 12800, C_A = 12816;
constexpr float EPS = 1e-6f;
constexpr size_t O_YP = 0, O_YS = O_YP + (size_t)MP * D, O_CONVP = O_YS + (size_t)MS * D, O_DNP = O_CONVP + 2 * 4 * 3 * 6144, O_KP = O_DNP + 2 * 4 * 16 * 128 * 128,
                 O_VP = O_KP + 2 * 4 * 128 * 256, O_CONVS = O_VP + 2 * 4 * 128 * 256, O_DNS = O_CONVS + 2 * 16 * 3 * 6144, O_KS = O_DNS + (size_t)2 * 16 * 16 * 128 * 128,
                 O_VS = O_KS + 2 * 16 * 128 * 256, O_END = O_VS + 2 * 16 * 128 * 256;
static_assert(O_END == 82001920, "output size");
constexpr size_t MiB = 1u << 20;
constexpr size_t WS_CTL = 0, CTL_ZERO_BYTES = 1 * MiB;
constexpr size_t WS_MOD = 1 * MiB;
constexpr size_t WS_ROPE = 3 * MiB;
constexpr size_t WS_DEC = 4 * MiB;
constexpr size_t WS_YSQ = 5 * MiB;
constexpr size_t WS_BIN = 10 * MiB;
constexpr size_t BIN_BYTES = (size_t)NP * 4096 * 2;
constexpr size_t WS_BOUT = 214 * MiB;
constexpr size_t BOUT_BYTES = (size_t)4096 * 4096 * 2;
constexpr size_t WS_HO = 278 * MiB;
constexpr size_t WS_P = 408 * MiB;
constexpr size_t WS_REC = 823 * MiB;
constexpr int REC_W = 0, REC_QD = 16384, REC_KD = 32768, REC_QK = 49152, REC_U = 57344, REC_BYTES = 73728, REC_STAGE = 57344;
constexpr int NREC = 4096 + 256;
constexpr size_t WS_YS = WS_REC + (size_t)NREC * REC_BYTES;
constexpr size_t WS_END = WS_YS + (size_t)MS * D * 2;
constexpr int CW_C2DONE = 3072;
static_assert(WS_BIN + 2 * BIN_BYTES <= WS_BOUT && WS_HO + (size_t)M * D * 2 <= WS_P && WS_P + (size_t)M * NP * 2 <= WS_REC, "ws map");
constexpr int CW_BAR = 4096;
constexpr int LDS_BYTES = 147456;
constexpr int MISC_OFF = 147456 - 256;

#define RLX_AGENT __ATOMIC_RELAXED, __HIP_MEMORY_SCOPE_AGENT
#define LDS_WAIT() asm volatile("s_waitcnt lgkmcnt(0)" ::: "memory")
#define VM_WAIT() asm volatile("s_waitcnt vmcnt(0)" ::: "memory")
#define BAR_LDS() do { asm volatile("s_waitcnt lgkmcnt(0)" ::: "memory"); __builtin_amdgcn_s_barrier(); asm volatile("" ::: "memory"); } while (0)
typedef __bf16 hwbf16x2 __attribute__((ext_vector_type(2)));
__device__ __forceinline__ unsigned cvtpk(float lo, float hi) { const f32x2 v = {lo, hi}; return __builtin_bit_cast(unsigned, __builtin_convertvector(v, hwbf16x2)); }
__device__ __forceinline__ float bflo(unsigned w) { return __uint_as_float(w << 16); }
__device__ __forceinline__ float bfhi(unsigned w) { return __uint_as_float(w & 0xffff0000u); }
__device__ __forceinline__ float bf1(bf16 h) { return __uint_as_float(((unsigned)h) << 16); }
__device__ __forceinline__ float silu_f(float x) { return x * __builtin_amdgcn_rcpf(1.0f + __expf(-x)); }
__device__ __forceinline__ float sigmoid_f(float x) { return __builtin_amdgcn_rcpf(1.0f + __expf(-x)); }
__device__ __forceinline__ float sum16(float v) {
    v += __builtin_bit_cast(float, __builtin_amdgcn_update_dpp(0, __builtin_bit_cast(int, v), 0xB1, 0xf, 0xf, true));
    v += __builtin_bit_cast(float, __builtin_amdgcn_update_dpp(0, __builtin_bit_cast(int, v), 0x4E, 0xf, 0xf, true));
    v += __builtin_bit_cast(float, __builtin_amdgcn_update_dpp(0, __builtin_bit_cast(int, v), 0x141, 0xf, 0xf, true));
    v += __builtin_bit_cast(float, __builtin_amdgcn_update_dpp(0, __builtin_bit_cast(int, v), 0x140, 0xf, 0xf, true));
    return v;
}
__device__ __forceinline__ float quadsum16(const f32x4 q, int fr) {
    const bool o1 = fr & 1, o2 = fr & 2;
    float kA = o1 ? q[1] : q[0], sA = o1 ? q[0] : q[1], kB = o1 ? q[3] : q[2], sB = o1 ? q[2] : q[3];
    kA += __builtin_bit_cast(float, __builtin_amdgcn_update_dpp(0, __builtin_bit_cast(int, sA), 0xB1, 0xf, 0xf, true));
    kB += __builtin_bit_cast(float, __builtin_amdgcn_update_dpp(0, __builtin_bit_cast(int, sB), 0xB1, 0xf, 0xf, true));
    float k = o2 ? kB : kA; const float s = o2 ? kA : kB;
    k += __builtin_bit_cast(float, __builtin_amdgcn_update_dpp(0, __builtin_bit_cast(int, s), 0x4E, 0xf, 0xf, true));
    k += __builtin_bit_cast(float, __builtin_amdgcn_update_dpp(0, __builtin_bit_cast(int, k), 0x124, 0xf, 0xf, true));
    k += __builtin_bit_cast(float, __builtin_amdgcn_update_dpp(0, __builtin_bit_cast(int, k), 0x128, 0xf, 0xf, true));
    return k;
}
__device__ __forceinline__ float wave_sum(float v) { v = sum16(v); v += __shfl_xor(v, 16); v += __shfl_xor(v, 32); return v; }
__device__ __forceinline__ float wave_max(float v) {
#pragma unroll
    for (int o = 1; o < 64; o <<= 1) v = fmaxf(v, __shfl_xor(v, o));
    return v;
}
__device__ __forceinline__ void unpack8(const u32x4 w, float (&f)[8]) {
    f[0] = bflo(w.x); f[1] = bfhi(w.x); f[2] = bflo(w.y); f[3] = bfhi(w.y); f[4] = bflo(w.z); f[5] = bfhi(w.z); f[6] = bflo(w.w); f[7] = bfhi(w.w);
}
__device__ __forceinline__ u32x4 pack8(const float (&f)[8]) { u32x4 w; w.x = cvtpk(f[0], f[1]); w.y = cvtpk(f[2], f[3]); w.z = cvtpk(f[4], f[5]); w.w = cvtpk(f[6], f[7]); return w; }
__device__ __forceinline__ u32x4 pack8v(const f32x2 (&f)[4]) { u32x4 w; w.x = cvtpk(f[0].x, f[0].y); w.y = cvtpk(f[1].x, f[1].y); w.z = cvtpk(f[2].x, f[2].y); w.w = cvtpk(f[3].x, f[3].y); return w; }
__device__ __forceinline__ bf16x8 as_bf16x8(const u32x4 w) { return __builtin_bit_cast(bf16x8, w); }
__device__ __forceinline__ bf16x4 as_bf16x4(const u32x2 w) { return __builtin_bit_cast(bf16x4, w); }

#define XB_TMO      128
#define XB_XCNT(j)  (256  + 64 * (j))
#define XB_XSUB(j)  (1280 + 64 * (j))
#define XB_XGEN(j)  (2304 + 64 * (j))
#define XB_TOP      3328
#define XB_TOPGEN   3392
#define XCD_BAR_WORDS 3456
#define XB_SPIN_CAP (1u << 18)

__device__ __forceinline__ unsigned xb_ld(unsigned* p)              { return __hip_atomic_load(p, __ATOMIC_RELAXED, __HIP_MEMORY_SCOPE_AGENT); }
__device__ __forceinline__ unsigned xb_add(unsigned* p, unsigned v) { return __hip_atomic_fetch_add(p, v, __ATOMIC_RELAXED, __HIP_MEMORY_SCOPE_AGENT); }
__device__ __forceinline__ unsigned xb_xcc_id() { return (unsigned)__builtin_amdgcn_s_getreg((3 << 11) | 20) & 0xFu; }
#define XB_SPIN(cond, bar) do { unsigned _sp = 0; while (cond) { __builtin_amdgcn_s_sleep(1); \
    if ((++_sp & 255u) == 0u) { if (xb_ld(&(bar)[XB_TMO])) break; if (_sp > XB_SPIN_CAP) { atomicAdd(&(bar)[XB_TMO], 1u); break; } } } } while (0)

struct XcdBarrier {
    unsigned* bar; unsigned x;
    volatile LAS unsigned* st;
};

__device__ __forceinline__ XcdBarrier xcd_barrier_post(unsigned* bar, volatile LAS unsigned* st) {
    XcdBarrier b; b.bar = bar; b.x = xb_xcc_id(); b.st = st;
    if (threadIdx.x == 0) (void)xb_add(&bar[XB_XCNT(b.x)], 1u);
    return b;
}
__device__ __forceinline__ void xcd_barrier_complete(unsigned* bar, unsigned x, unsigned& nloc, unsigned& nx) {
    const unsigned G = gridDim.x * gridDim.y * gridDim.z;
    unsigned sum, cnt, mine, sp = 0u;
    for (;;) {
        sum = 0u; cnt = 0u; mine = 0u;
#pragma unroll
        for (unsigned j = 0; j < 16; ++j) { const unsigned c = xb_ld(&bar[XB_XCNT(j)]); sum += c; cnt += (c > 0u) ? 1u : 0u; mine = (j == x) ? c : mine; }
        if (sum == G) break;
        __builtin_amdgcn_s_sleep(1);
        if ((++sp & 255u) == 0u) { if (xb_ld(&bar[XB_TMO])) break; if (sp > XB_SPIN_CAP) { atomicAdd(&bar[XB_TMO], 1u); break; } }
    }
    nloc = mine > 0u ? mine : 1u; nx = cnt > 0u ? cnt : 1u;
}

__device__ __forceinline__ void xcd_barrier(const XcdBarrier& b) {
    asm volatile("s_waitcnt vmcnt(0)" ::: "memory");
    __syncthreads();
    if (threadIdx.x == 0) {
        unsigned* bar = b.bar;
        __builtin_amdgcn_s_waitcnt(0);
        unsigned nloc = b.st[0], nx = b.st[1];
        if (nloc == 0u) { xcd_barrier_complete(bar, b.x, nloc, nx); b.st[0] = nloc; b.st[1] = nx; }
        const unsigned old = xb_add(&bar[XB_XSUB(b.x)], 1u);
        const unsigned gen = old / nloc;
        if (old + 1u == (gen + 1u) * nloc) {
            __builtin_amdgcn_fence(__ATOMIC_RELEASE, "agent");
            asm volatile("s_waitcnt vmcnt(0)" ::: "memory");
            const unsigned og = xb_add(&bar[XB_TOP], 1u);
            const unsigned tg = og / nx;
            if (og + 1u == (tg + 1u) * nx) xb_add(&bar[XB_TOPGEN], 1u);
            else XB_SPIN(xb_ld(&bar[XB_TOPGEN]) == tg, bar);
            __builtin_amdgcn_fence(__ATOMIC_ACQUIRE, "agent");
            xb_add(&bar[XB_XGEN(b.x)], 1u);
            asm volatile("s_waitcnt vmcnt(0)" ::: "memory");
        } else {
            XB_SPIN(xb_ld(&bar[XB_XGEN(b.x)]) == gen, bar);
            __builtin_amdgcn_fence(__ATOMIC_ACQUIRE, "agent");
            asm volatile("s_waitcnt vmcnt(0)" ::: "memory");
        }
    }
    __syncthreads();
}

struct Args { const float* in[19]; float* out; unsigned char* ws; int ph_lo, ph_hi; };

__device__ __forceinline__ void p0_transpose_item(const float* W, int K, int N, bf16* WT, int dst_row0, LAS float* scr, int k0, int n0, int lane) {
    const int r8 = lane >> 3, c4 = lane & 7;
    f32x4 v[8];
#pragma unroll
    for (int i = 0; i < 8; ++i) v[i] = *(const f32x4*)(W + (size_t)(k0 + 8 * i + r8) * N + n0 + 4 * c4);
#pragma unroll
    for (int i = 0; i < 8; ++i) { LAS float* d = scr + (8 * i + r8) * 33 + 4 * c4; d[0] = v[i][0]; d[1] = v[i][1]; d[2] = v[i][2]; d[3] = v[i][3]; }
    LDS_WAIT(); asm volatile("" ::: "memory");
    const int c = lane & 7;
#pragma unroll
    for (int j = 0; j < 4; ++j) { const int n = (lane >> 3) + 8 * j; const LAS float* s = scr + (8 * c) * 33 + n;
        u32x4 o; o.x = cvtpk(s[0 * 33], s[1 * 33]); o.y = cvtpk(s[2 * 33], s[3 * 33]); o.z = cvtpk(s[4 * 33], s[5 * 33]); o.w = cvtpk(s[6 * 33], s[7 * 33]);
        *(u32x4*)(WT + (size_t)(dst_row0 + n) * K + k0 + 8 * c) = o; }
    LDS_WAIT(); asm volatile("" ::: "memory");
}
__device__ __forceinline__ void prologue_work(const Args& a, LAS unsigned char* lds, int vb, int nvb, int ada_mask, int tr_mask, bool rope) {
    const int tid = tid_opaque(), lane = tid & 63, wave = tid >> 6;
    {
        const float* cp = a.in[6]; const float* cs = a.in[7]; const float* w_ada = a.in[8]; const float* b_ada = a.in[9];
        float* mod = (float*)(a.ws + WS_MOD);
        LAS float* sc = (LAS float*)lds;
        LAS float* red = (LAS float*)(lds + 40960);
        const int cgp = tid & 7, ksl = tid >> 3;
        const int it0 = (ada_mask & 1) ? 0 : 384, it1 = (ada_mask & 2) ? 768 : 384;
        for (int it = it0 + vb; it < it1 && ada_mask; it += nvb) {
            const int l = it / 384, col0 = (it % 384) * 32;
            f32x4 acc[20];
#pragma unroll
            for (int j = 0; j < 20; ++j) acc[j] = (f32x4){0.f, 0.f, 0.f, 0.f};
            for (int kt = 0; kt < 8; ++kt) {
                __syncthreads();
#pragma unroll
                for (int j = 0; j < 20; ++j) { const float cv = (j < 4) ? cp[j * 4096 + kt * 512 + tid] : cs[(j - 4) * 4096 + kt * 512 + tid]; sc[tid * 20 + j] = silu_f(cv); }
                __syncthreads();
                const float* wp = w_ada + ((size_t)l * 4096 + kt * 512 + ksl * 8) * 12288 + col0 + cgp * 4;
                f32x4 w[8];
#pragma unroll
                for (int kk = 0; kk < 8; ++kk) w[kk] = *(const f32x4*)(wp + (size_t)kk * 12288);
#pragma unroll
                for (int kk = 0; kk < 8; ++kk) {
                    const LAS f32x4* s4 = (const LAS f32x4*)(sc + (ksl * 8 + kk) * 20);
#pragma unroll
                    for (int j4 = 0; j4 < 5; ++j4) { const f32x4 s = s4[j4];
#pragma unroll
                        for (int jj = 0; jj < 4; ++jj) acc[j4 * 4 + jj] += s[jj] * w[kk]; }
                }
            }
#pragma unroll
            for (int j = 0; j < 20; ++j)
#pragma unroll
                for (int c = 0; c < 4; ++c) { float v = acc[j][c]; v += __shfl_xor(v, 8); v += __shfl_xor(v, 16); v += __shfl_xor(v, 32); acc[j][c] = v; }
            __syncthreads();
            if (lane < 8) {
#pragma unroll
                for (int j = 0; j < 20; ++j) *(LAS f32x4*)(red + (wave * 20 + j) * 32 + lane * 4) = acc[j];
            }
            __syncthreads();
            for (int o = tid; o < 640; o += 512) { const int j = o >> 5, c = o & 31; float s = 0.f;
#pragma unroll
                for (int w8 = 0; w8 < 8; ++w8) s += red[(w8 * 20 + j) * 32 + c];
                mod[((size_t)l * 20 + j) * 12288 + col0 + c] = s + b_ada[(size_t)l * 12288 + col0 + c]; }
        }
        __syncthreads();
    }
    {
        LAS float* scr = (LAS float*)(lds + wave * 8448);
        const int gw = vb * 8 + wave, NGW = nvb * 8;
        constexpr int I_IN = 64 * 401, I_OUT = 64 * 128;
#pragma unroll 1
        for (int mtx = 0; mtx < 4; ++mtx) {
            if (!((tr_mask >> mtx) & 1)) continue;
            const int l = mtx >> 1;
            if ((mtx & 1) == 0) {
                for (int r = gw; r < I_IN; r += NGW) { const int kb = r / 401, nb = r % 401, n0 = nb * 32; const int dst = (n0 < 8192) ? n0 : ((n0 < 8224) ? (C_B + (n0 - 8192)) : (n0 - 32));
                    p0_transpose_item(a.in[12] + (size_t)l * 4096 * IN_DIM, 4096, IN_DIM, (bf16*)(a.ws + WS_BIN + l * BIN_BYTES), dst, scr, kb * 64, n0, lane); }
                constexpr int ZU = (NP - IN_DIM) * 4096 * 2 / 16;
                for (int u = vb * 512 + tid; u < ZU; u += nvb * 512) *(u32x4*)(a.ws + WS_BIN + l * BIN_BYTES + (size_t)IN_DIM * 4096 * 2 + (size_t)u * 16) = (u32x4){0u, 0u, 0u, 0u};
            } else {
                for (int r = gw; r < I_OUT; r += NGW) { const int kb = r / 128, nb = r % 128;
                    p0_transpose_item(a.in[18] + (size_t)l * 4096 * 4096, 4096, 4096, (bf16*)(a.ws + WS_BOUT + l * BOUT_BYTES), nb * 32, scr, kb * 64, nb * 32, lane); }
            }
        }
        if (rope) { f32x2* rt = (f32x2*)(a.ws + WS_ROPE);
            for (int idx = vb * 512 + tid; idx < 4096 * 32; idx += nvb * 512) { const int pos = idx >> 5, i = idx & 31;
                const double inv = exp2(-(double)i * (13.287712379549449 / 32.0)); const double ang = (double)pos * inv;
                rt[idx] = (f32x2){(float)cos(ang), (float)sin(ang)}; } }
    }
}
#ifndef SPLIT_PROLOGUE
#define SPLIT_PROLOGUE 0
#endif
__device__ __forceinline__ void phase_prologue(const Args& a, LAS unsigned char* lds, int G) {
#if SPLIT_PROLOGUE
    prologue_work(a, lds, (int)blockIdx.x, G, 1, 0x7, true);
#else
    prologue_work(a, lds, (int)blockIdx.x, G, 3, 0xF, true);
#endif
}

__device__ __forceinline__ int row_j(int row) { return (row < MP) ? (row >> 12) : (4 + ((row - MP) >> 4)); }
__device__ __forceinline__ void stage_params(const Args& a, LAS float* pl, int tid, int mode  , int j) {
    const float* mod = (const float*)(a.ws + WS_MOD); const float* g_pre = a.in[10]; const float* g_post = a.in[11];
    for (int c = tid * 4; c < D; c += 2048) {
        if (mode == 0) { const float* mr = mod + (size_t)j * 12288;
            *(LAS f32x4*)(pl + 4096 + c) = *(const f32x4*)(g_pre + c) * (*(const f32x4*)(mr + 4096 + c) + 1.0f); *(LAS f32x4*)(pl + 8192 + c) = *(const f32x4*)(mr + c); }
        else { const int l = mode - 1; const float* mr = mod + ((size_t)l * 20 + j) * 12288;
            *(LAS f32x4*)(pl + c) = *(const f32x4*)(mr + 8192 + c) * *(const f32x4*)(g_post + (size_t)l * D + c);
            if (l == 0) { const float* m1 = mod + ((size_t)20 + j) * 12288;
                *(LAS f32x4*)(pl + 4096 + c) = *(const f32x4*)(g_pre + D + c) * (*(const f32x4*)(m1 + 4096 + c) + 1.0f); *(LAS f32x4*)(pl + 8192 + c) = *(const f32x4*)(m1 + c); } }
    }
}
template <int mode> __device__ __forceinline__ void phase_rows(const Args& a, LAS unsigned char* lds, int G) {
    const int tid = tid_opaque(), wave = tid >> 6;
    LAS float* pl = (LAS float*)lds;
    const bf16* Y = (const bf16*)(a.ws + WS_P); const float* ysq = (const float*)(a.ws + WS_YSQ);
    bf16* H = (bf16*)(a.ws + WS_HO);
    const int rpb = (M + G - 1) / G;
    const int r0 = blockIdx.x * rpb, r1 = (r0 + rpb < M) ? r0 + rpb : M;
    int cur_a = -1, cur_b = -1;
    f32x4 xn[16]; u32x2 yn[16]; float ysn = 0.f;
#define ROW_LOAD(row_) do { const int lane_ = tid_opaque() & 63; float* orow_ = ((row_) < MP) ? a.out + O_YP + (size_t)(row_) * D : a.out + O_YS + (size_t)((row_) - MP) * D; \
        const float* xr_ = (mode == 2) ? orow_ : (((row_) < MP) ? a.in[0] + (size_t)(row_) * D : a.in[1] + (size_t)((row_) - MP) * D); \
        if (mode == 2) { _Pragma("unroll") for (int q = 0; q < 16; ++q) { const u32x2 xb_ = *(const u32x2*)((const bf16*)orow_ + 4 * lane_ + 256 * q); xn[q] = (f32x4){bflo(xb_.x), bfhi(xb_.x), bflo(xb_.y), bfhi(xb_.y)}; } } \
        else { _Pragma("unroll") for (int q = 0; q < 16; ++q) xn[q] = *(const f32x4*)(xr_ + 4 * lane_ + 256 * q); } \
        if (mode != 0) { const bf16* yrow_ = ((row_) < MP) ? Y + (size_t)(row_) * D : (const bf16*)(a.ws + WS_YS) + (size_t)((row_) - MP) * D; \
            _Pragma("unroll") for (int q = 0; q < 16; ++q) yn[q] = *(const u32x2*)(yrow_ + 4 * lane_ + 256 * q); \
            ysn = ysq[(size_t)(row_) * 64 + lane_]; } } while (0)
    if (r0 + wave < r1) ROW_LOAD(r0 + wave);
    for (int rb = r0; rb < r1; rb += 8) {
        const int ja = row_j(rb), jb = row_j((rb + 7 < r1) ? rb + 7 : r1 - 1);
        if (ja != cur_a || jb != cur_b) { BAR_LDS(); stage_params(a, pl, tid, mode, ja); if (jb != ja) stage_params(a, pl + 12288, tid, mode, jb); cur_a = ja; cur_b = jb; BAR_LDS(); }
        const int row = rb + wave;
        if (row >= r1) continue;
        const int lane = tid_opaque() & 63;
        const LAS float* plw = pl + ((row_j(row) == ja) ? 0 : 12288);
        float* orow = (row < MP) ? a.out + O_YP + (size_t)row * D : a.out + O_YS + (size_t)(row - MP) * D;
        f32x4 v[16]; u32x2 yw[16]; float ysc = ysn;
#pragma unroll
        for (int q = 0; q < 16; ++q) { v[q] = xn[q]; yw[q] = yn[q]; }
        if (row + 8 < r1) ROW_LOAD(row + 8);
        float s = 0.f;
        if (mode == 0) {
#pragma unroll
            for (int q = 0; q < 16; ++q) s += (v[q][0] * v[q][0] + v[q][1] * v[q][1]) + (v[q][2] * v[q][2] + v[q][3] * v[q][3]);
        } else {
            const float rstd_y = rsqrtf(wave_sum(ysc) * (1.f / D) + EPS);
#pragma unroll
            for (int q = 0; q < 16; ++q) { const int c = 4 * lane + 256 * q; const f32x4 y = (f32x4){bflo(yw[q].x), bfhi(yw[q].x), bflo(yw[q].y), bfhi(yw[q].y)};
                const f32x4 pa = *(const LAS f32x4*)(plw + c);
                v[q] = v[q] + pa * (y * rstd_y);
                s += (v[q][0] * v[q][0] + v[q][1] * v[q][1]) + (v[q][2] * v[q][2] + v[q][3] * v[q][3]);
                if (mode == 2) *(f32x4*)(orow + c) = v[q];
                else { u32x2 xo; xo.x = cvtpk(v[q][0], v[q][1]); xo.y = cvtpk(v[q][2], v[q][3]); *(u32x2*)((bf16*)orow + c) = xo; } }
        }
        if (mode != 2) {
            const float rstd = rsqrtf(wave_sum(s) * (1.f / D) + EPS);
#pragma unroll
            for (int q = 0; q < 16; ++q) { const int c = 4 * lane + 256 * q;
                const f32x4 pb = *(const LAS f32x4*)(plw + 4096 + c), pc = *(const LAS f32x4*)(plw + 8192 + c);
                const f32x4 hv = v[q] * rstd * pb + pc; u32x2 w; w.x = cvtpk(hv[0], hv[1]); w.y = cvtpk(hv[2], hv[3]);
                *(u32x2*)(H + (size_t)row * D + c) = w; }
        }
    }
#undef ROW_LOAD
}


constexpr int L_KH = 0, L_QH = 18432, L_RT = 36864, L_XT = 77824, L_AI = 118784, L_DG = 129024, L_DI = 133120, L_GT = 135168;
constexpr int S128 = 144, S64 = 80;

__device__ __forceinline__ void phase_c1(const Args& a, int l, LAS unsigned char* lds, int G) {
    int tid, lane, wave, fr, fq;
#define RELANE() do { tid = tid_opaque(); lane = tid & 63; wave = __builtin_amdgcn_readfirstlane(tid >> 6); fr = lane & 15; fq = lane >> 4; } while (0)
    RELANE();
    const bf16* P = (const bf16*)(a.ws + WS_P);
    float* decbuf = (float*)(a.ws + WS_DEC);
    const float* conv_w = a.in[13] + (size_t)l * 4 * 6144;
    LAS bf16* KH = (LAS bf16*)(lds + L_KH); LAS bf16* QH = (LAS bf16*)(lds + L_QH); LAS bf16* RT = (LAS bf16*)(lds + L_RT); LAS bf16* XT = (LAS bf16*)(lds + L_XT);
    LAS bf16* AI = (LAS bf16*)(lds + L_AI); LAS float* DG = (LAS float*)(lds + L_DG); LAS bf16* DI = (LAS bf16*)(lds + L_DI);
    LAS unsigned char* STG = lds + L_XT;
    LAS float* g_beta = (LAS float*)(lds + L_GT); LAS float* g_gc = g_beta + 64; LAS float* g_egc = g_beta + 128; LAS float* g_misc = g_beta + 192;

    u32x4 raw[8]; unsigned gl = 0;
#define ITEM_PARAMS(it_, sample_, n_, c_, h_, ntok_, rowbase_) const bool sample_ = (it_) >= 4096; int n_, c_, h_, ntok_; size_t rowbase_; \
        if (!sample_) { h_ = (it_) & 15; c_ = ((it_) >> 4) & 63; n_ = (it_) >> 10; rowbase_ = (size_t)n_ * 4096 + c_ * 64; ntok_ = 64; } \
        else { const int s_ = (it_) - 4096; h_ = s_ & 15; n_ = s_ >> 4; c_ = 0; rowbase_ = (size_t)MP + n_ * 16; ntok_ = 16; }
#define PREFETCH(it_) do { ITEM_PARAMS(it_, ps_, pn_, pc_, ph_, pnt_, prb_); const int pt_ = tid_opaque(); \
        if (pt_ < 384) { const int pch0_ = (pt_ >> 7) * 2048 + ph_ * 128 + (pt_ & 15) * 8, pt0_ = ((pt_ >> 4) & 7) * 8; \
            _Pragma("unroll") for (int i = 0; i < 8; ++i) { const int tt = pt0_ + i; raw[i] = (u32x4){0u, 0u, 0u, 0u}; \
                if (tt < pnt_) raw[i] = *(const u32x4*)(P + (prb_ + tt) * NP + pch0_); } } \
        else { const int ptz_ = pt_ - 384; \
            if (ptz_ < 64 && ptz_ < pnt_) gl = (unsigned)P[(prb_ + ptz_) * NP + C_B + ph_] | ((unsigned)P[(prb_ + ptz_) * NP + C_A + ph_] << 16); } } while (0)

#ifdef DBG_MEASC
    unsigned long long dmacc_ = 0; const unsigned long long dmt0_ = __builtin_amdgcn_s_memtime(); unsigned long long dml_ = dmt0_;
#define DM(k) do { const unsigned long long n_ = __builtin_amdgcn_s_memtime(); if ((k) == DBG_MEASC) dmacc_ += n_ - dml_; dml_ = n_; } while (0)
#else
#define DM(k) do {} while (0)
#endif
    for (int item = blockIdx.x; item < NREC; item += G) {
        ITEM_PARAMS(item, sample, n, c, h, ntok, rowbase);
        const int reci = sample ? item : ((n * 16 + h) * 64 + c);
        unsigned char* rec = a.ws + WS_REC + (size_t)reci * REC_BYTES;
        const bool last = sample || (c == 63);
        DM(5); BAR_LDS(); DM(0);
        PREFETCH(item);
        RELANE();
        f32x2 val2[8][4];
        float ssq[8];
        int g = 3, cgl, seg;
        if (tid < 384) {
            cgl = tid & 15; g = __builtin_amdgcn_readfirstlane(tid >> 7); seg = (tid >> 4) & 7;
            const int ch0 = g * 2048 + h * 128 + cgl * 8;
            const int t0 = seg * 8;
            f32x4 wq[4][2];
#pragma unroll
            for (int j = 0; j < 4; ++j) { wq[j][0] = *(const f32x4*)(conv_w + (size_t)j * 6144 + ch0); wq[j][1] = *(const f32x4*)(conv_w + (size_t)j * 6144 + ch0 + 4); }
            u32x4 hist[3];
#pragma unroll
            for (int i = 0; i < 3; ++i) { const int tt = t0 - 3 + i; hist[i] = (u32x4){0u, 0u, 0u, 0u};
                if (tt < ntok && (tt >= 0 || (!sample && c > 0))) hist[i] = *(const u32x4*)(P + (rowbase + tt) * NP + ch0); }
            if (sample && seg == 0) {
                const float* sc = a.in[2] + (((size_t)l * 16 + n) * 3) * 6144 + ch0;
#pragma unroll
                for (int i = 0; i < 3; ++i) { const f32x4 s0 = *(const f32x4*)(sc + (size_t)i * 6144), s1 = *(const f32x4*)(sc + (size_t)i * 6144 + 4);
                    hist[i].x = cvtpk(s0[0], s0[1]); hist[i].y = cvtpk(s0[2], s0[3]); hist[i].z = cvtpk(s1[0], s1[1]); hist[i].w = cvtpk(s1[2], s1[3]); }
            }
            f32x2 sq2[8];
#pragma unroll
            for (int tok = 0; tok < 8; ++tok) sq2[tok] = (f32x2){0.f, 0.f};
#pragma unroll
            for (int cp = 0; cp < 4; ++cp) {
                f32x2 w2[4], x2[11];
#pragma unroll
                for (int j = 0; j < 4; ++j) w2[j] = (f32x2){wq[j][cp >> 1][2 * (cp & 1)], wq[j][cp >> 1][2 * (cp & 1) + 1]};
#pragma unroll
                for (int r = 0; r < 11; ++r) { const unsigned dw = (r < 3) ? hist[r < 3 ? r : 0][cp] : raw[r >= 3 ? r - 3 : 0][cp]; x2[r] = (f32x2){bflo(dw), bfhi(dw)}; }
#pragma unroll
                for (int tok = 0; tok < 8; ++tok) {
                    const f32x2 y = w2[0] * x2[tok] + w2[1] * x2[tok + 1] + w2[2] * x2[tok + 2] + w2[3] * x2[tok + 3];
                    const f32x2 t = y * -1.4426950408889634f; f32x2 e; e.x = __builtin_amdgcn_exp2f(t.x); e.y = __builtin_amdgcn_exp2f(t.y);
                    const f32x2 d = e + 1.0f; f32x2 r; r.x = __builtin_amdgcn_rcpf(d.x); r.y = __builtin_amdgcn_rcpf(d.y);
                    f32x2 v = y * r; if (!((t0 + tok) < ntok)) v = (f32x2){0.f, 0.f};
                    val2[tok][cp] = v; sq2[tok] += v * v; }
            }
#pragma unroll
            for (int tok = 0; tok < 8; ++tok) ssq[tok] = sq2[tok].x + sq2[tok].y;
            if (last && seg == (sample ? 1 : 7)) {
#pragma unroll
                for (int tok = 5; tok < 8; ++tok) { float rf[8]; unpack8(raw[tok], rf);
                    float* co = sample ? a.out + O_CONVS + (((size_t)l * 16 + n) * 3 + (tok - 5)) * 6144 + ch0 : a.out + O_CONVP + (((size_t)l * 4 + n) * 3 + (tok - 5)) * 6144 + ch0;
                    *(f32x4*)co = (f32x4){rf[0], rf[1], rf[2], rf[3]}; *(f32x4*)(co + 4) = (f32x4){rf[4], rf[5], rf[6], rf[7]}; }
            }
#pragma unroll
            for (int tok = 0; tok < 8; ++tok) ssq[tok] = sum16(ssq[tok]);
        } else {
            const int tz = tid - 384; cgl = tz & 15; seg = tz >> 4;
            if (wave == 6) {
                float beta = 0.f, gg = 0.f;
                if (lane < ntok) { const float b = bflo(gl), av = bfhi(gl);
                    beta = sigmoid_f(b); const float xx = av + a.in[15][l * 16 + h]; const float sp = fmaxf(xx, 0.f) + log1pf(__expf(-fabsf(xx)));
                    gg = -__expf(a.in[14][l * 16 + h]) * sp; }
                float gc = gg;
#pragma unroll
                for (int o = 1; o < 64; o <<= 1) { const float t = __shfl_up(gc, o); if (lane >= o) gc += t; }
                g_beta[lane] = beta; g_gc[lane] = gc; g_egc[lane] = __expf(gc);
                const float gcl = __shfl(gc, 63);
                if (lane == 0) { g_misc[0] = gcl; decbuf[reci] = __expf(gcl); }
            }
        }
        DM(1); BAR_LDS(); DM(2);
#ifndef DBG_C1_REP
#define DBG_C1_REP 0
#endif
        for (int rp1_ = 0; rp1_ < ((DBG_C1_REP) & 1) + 1; ++rp1_)
        {
            { const int t1 = tid_opaque(); cgl = t1 & 15; seg = (t1 >> 4) & 7; }
            const int t0 = seg * 8;
            float bt[8], gcv[8], eg[8];
            { const f32x4 b0 = *(const LAS f32x4*)(g_beta + t0), b1 = *(const LAS f32x4*)(g_beta + t0 + 4), c0 = *(const LAS f32x4*)(g_gc + t0), c1 = *(const LAS f32x4*)(g_gc + t0 + 4),
                  e0 = *(const LAS f32x4*)(g_egc + t0), e1 = *(const LAS f32x4*)(g_egc + t0 + 4);
#pragma unroll
              for (int i = 0; i < 4; ++i) { bt[i] = b0[i]; bt[4 + i] = b1[i]; gcv[i] = c0[i]; gcv[4 + i] = c1[i]; eg[i] = e0[i]; eg[4 + i] = e1[i]; } }
            const float gcl = g_misc[0];
            const int qs0 = ((cgl * 8) & 15) >> 2, half0 = ((cgl * 8) >> 4) & 1, ks0 = (cgl * 8) >> 5;
            const int tq0 = (t0 & 15) >> 2, thalf = (t0 >> 4) & 1, tks = t0 >> 5;
            if (g == 0) {
#pragma unroll
                for (int tok = 0; tok < 8; ++tok) { const int t = t0 + tok; const float r = rsqrtf(ssq[tok] + EPS) * 0.08838834764831845f; f32x2 qv[4];
#pragma unroll
                    for (int i = 0; i < 4; ++i) qv[i] = val2[tok][i] * r;
                    *(LAS u32x4*)(QH + t * S128 + cgl * 8) = pack8v(qv);
                    const float e = eg[tok];
                    const int fq_ = (t >> 4) * 4 + ks0; LAS unsigned char* fp = STG + fq_ * 1024 + ((((t & 15) + 16 * qs0) ^ (fq_ & 7)) * 16) + 8 * half0;
#pragma unroll
                    for (int i = 0; i < 4; ++i) qv[i] = qv[i] * e;
                    u32x2 w0, w1; w0.x = cvtpk(qv[0].x, qv[0].y); w0.y = cvtpk(qv[1].x, qv[1].y); w1.x = cvtpk(qv[2].x, qv[2].y); w1.y = cvtpk(qv[3].x, qv[3].y);
                    *(LAS u32x2*)fp = w0; *(LAS u32x2*)(fp + 256) = w1; }
            } else if (g == 1) {
#pragma unroll
                for (int tok = 0; tok < 8; ++tok) { const float r = rsqrtf(ssq[tok] + EPS);
#pragma unroll
                    for (int i = 0; i < 4; ++i) val2[tok][i] = val2[tok][i] * r;
                    *(LAS u32x4*)(KH + (t0 + tok) * S128 + cgl * 8) = pack8v(val2[tok]); }
                float f1[8], f2[8];
#pragma unroll
                for (int tok = 0; tok < 8; ++tok) { f1[tok] = bt[tok] * eg[tok]; f2[tok] = __expf(gcl - gcv[tok]); }
#pragma unroll
                for (int ip = 0; ip < 4; ++ip) {
                    f32x2 rr[8], kd[8];
#pragma unroll
                    for (int tok = 0; tok < 8; ++tok) { rr[tok] = val2[tok][ip] * f1[tok]; kd[tok] = val2[tok][ip] * f2[tok]; }
#pragma unroll
                    for (int hh = 0; hh < 2; ++hh) { const int i = 2 * ip + hh, d = cgl * 8 + i;
                        u32x4 rw; rw.x = cvtpk(rr[0][hh], rr[1][hh]); rw.y = cvtpk(rr[2][hh], rr[3][hh]); rw.z = cvtpk(rr[4][hh], rr[5][hh]); rw.w = cvtpk(rr[6][hh], rr[7][hh]);
                        *(LAS u32x4*)(RT + (128 + i * 16 + cgl) * S64 + t0) = rw;
                        const int fk_ = 16 + (d >> 4) * 2 + tks; LAS unsigned char* fp = STG + fk_ * 1024 + ((((d & 15) + 16 * tq0) ^ (fk_ & 7)) * 16) + 8 * thalf;
                        u32x2 w0, w1; w0.x = cvtpk(kd[0][hh], kd[1][hh]); w0.y = cvtpk(kd[2][hh], kd[3][hh]); w1.x = cvtpk(kd[4][hh], kd[5][hh]); w1.y = cvtpk(kd[6][hh], kd[7][hh]);
                        *(LAS u32x2*)fp = w0; *(LAS u32x2*)(fp + 256) = w1; } }
            } else if (g == 2) {
#pragma unroll
                for (int ip = 0; ip < 4; ++ip) { f32x2 rr[8];
#pragma unroll
                    for (int tok = 0; tok < 8; ++tok) rr[tok] = val2[tok][ip] * bt[tok];
#pragma unroll
                    for (int hh = 0; hh < 2; ++hh) { const int i = 2 * ip + hh;
                        u32x4 rw; rw.x = cvtpk(rr[0][hh], rr[1][hh]); rw.y = cvtpk(rr[2][hh], rr[3][hh]); rw.z = cvtpk(rr[4][hh], rr[5][hh]); rw.w = cvtpk(rr[6][hh], rr[7][hh]);
                        *(LAS u32x4*)(RT + (i * 16 + cgl) * S64 + t0) = rw; } }
            }
        }
        DM(3); BAR_LDS(); DM(4);
#if defined(DBG_C1_STOP) && DBG_C1_STOP <= 1
        continue;
#endif
        RELANE();
        for (int rp2_ = 0; rp2_ < (((DBG_C1_REP) >> 1) & 1) + 1; ++rp2_)
#pragma unroll
        for (int k2 = 0; k2 < 2; ++k2) {
            const int tile = wave * 2 + k2, ti = tile >> 2, tj = tile & 3;
            f32x4 acq = (f32x4){0.f, 0.f, 0.f, 0.f}, ack = (f32x4){0.f, 0.f, 0.f, 0.f};
#pragma unroll
            for (int ks = 0; ks < 4; ++ks) {
                const bf16x8 kj = *(const LAS bf16x8*)(KH + (16 * tj + fr) * S128 + 32 * ks + 8 * fq);
                const bf16x8 qi = *(const LAS bf16x8*)(QH + (16 * ti + fr) * S128 + 32 * ks + 8 * fq);
                acq = __builtin_amdgcn_mfma_f32_16x16x32_bf16(kj, qi, acq, 0, 0, 0);
                if (ti >= tj) { const bf16x8 ki = *(const LAS bf16x8*)(KH + (16 * ti + fr) * S128 + 32 * ks + 8 * fq);
                    ack = __builtin_amdgcn_mfma_f32_16x16x32_bf16(ki, kj, ack, 0, 0, 0); }
            }
            {
                const int i = 16 * ti + fr; const float gi = g_gc[i]; const f32x4 gj = *(const LAS f32x4*)(g_gc + 16 * tj + 4 * fq); float o[4];
#pragma unroll
                for (int r = 0; r < 4; ++r) { const int j = 16 * tj + 4 * fq + r; o[r] = (i >= j) ? acq[r] * __expf(fminf(gi - gj[r], 0.f)) : 0.f; }
                u32x2 w; w.x = cvtpk(o[0], o[1]); w.y = cvtpk(o[2], o[3]);
                { const int fk2_ = 32 + ti * 2 + (tj >> 1); *(LAS u32x2*)(STG + fk2_ * 1024 + ((lane ^ (fk2_ & 7)) * 16) + 8 * (tj & 1)) = w; }
            }
            if (ti >= tj) {
                const int j = 16 * tj + fr; const float gj = g_gc[j]; const f32x4 gi = *(const LAS f32x4*)(g_gc + 16 * ti + 4 * fq), bi = *(const LAS f32x4*)(g_beta + 16 * ti + 4 * fq);
#pragma unroll
                for (int r = 0; r < 4; ++r) { const int i = 16 * ti + 4 * fq + r; const float v = (i > j) ? bi[r] * ack[r] * __expf(fminf(gi[r] - gj, 0.f)) : 0.f;
                    AI[i * S64 + j] = (bf16)(cvtpk(v, 0.f) & 0xffffu);
                    if (ti == tj) DG[(ti * 16 + (i & 15)) * 16 + fr] = v; }
            }
        }
        BAR_LDS();
#if defined(DBG_C1_STOP) && DBG_C1_STOP <= 2
        continue;
#endif
        RELANE();
#pragma unroll
        for (int k5 = 0; k5 < 5; ++k5) { const int u = tid + 512 * k5, fu_ = u >> 6; *(u32x4*)(rec + REC_QD + (size_t)u * 16) = *(const LAS u32x4*)(STG + fu_ * 1024 + (((u & 63) ^ (fu_ & 7)) * 16)); }
        for (int rp3_ = 0; rp3_ < (((DBG_C1_REP) >> 2) & 1) + 1; ++rp3_)
        if (wave == 0) {
            const int b = fq, cc = fr; float x[16];
            {   f32x4 dg[10][3];
#pragma unroll
                for (int r = 1; r < 10; ++r)
#pragma unroll
                    for (int j4 = 0; j4 < (r + 3) / 4; ++j4) dg[r][j4] = *(const LAS f32x4*)(DG + (b * 16 + r) * 16 + 4 * j4);
                __builtin_amdgcn_sched_barrier(0);
#pragma unroll
                for (int r = 0; r < 10; ++r) { float s = (r == cc) ? 1.f : 0.f;
#pragma unroll
                    for (int j = 0; j < r; ++j) s -= dg[r][j >> 2][j & 3] * x[j];
                    x[r] = s; DI[(b * 16 + r) * 16 + cc] = (bf16)(cvtpk(s, 0.f) & 0xffffu); } }
            __builtin_amdgcn_sched_barrier(0);
            {   f32x4 dg[6][4];
#pragma unroll
                for (int r = 10; r < 16; ++r)
#pragma unroll
                    for (int j4 = 0; j4 < (r + 3) / 4; ++j4) dg[r - 10][j4] = *(const LAS f32x4*)(DG + (b * 16 + r) * 16 + 4 * j4);
                __builtin_amdgcn_sched_barrier(0);
#pragma unroll
                for (int r = 10; r < 16; ++r) { float s = (r == cc) ? 1.f : 0.f;
#pragma unroll
                    for (int j = 0; j < r; ++j) s -= dg[r - 10][j >> 2][j & 3] * x[j];
                    x[r] = s; DI[(b * 16 + r) * 16 + cc] = (bf16)(cvtpk(s, 0.f) & 0xffffu); } }
        }
        BAR_LDS();
#if defined(DBG_C1_STOP) && DBG_C1_STOP <= 3
        continue;
#endif
        for (int rp4_ = 0; rp4_ < (((DBG_C1_REP) >> 3) & 1) + 1; ++rp4_)
#pragma unroll
        for (int b = 0; b < 4; ++b) {
            RELANE();
#pragma unroll
            for (int k2 = 0; k2 < 2; ++k2) {
                const int nt = wave * 2 + k2;
                f32x4 y = (f32x4){0.f, 0.f, 0.f, 0.f};
#pragma unroll
                for (int ks = 0; ks < (b + 1) / 2; ++ks) {
                    const bool ok = (32 * ks + 8 * fq) < 16 * b;
                    u32x4 av = *(const LAS u32x4*)(AI + (16 * b + fr) * S64 + 32 * ks + 8 * fq), xv = *(const LAS u32x4*)(XT + (16 * nt + fr) * S64 + 32 * ks + 8 * fq);
                    if (!ok) { av = (u32x4){0u, 0u, 0u, 0u}; xv = (u32x4){0u, 0u, 0u, 0u}; }
                    y = __builtin_amdgcn_mfma_f32_16x16x32_bf16(as_bf16x8(av), as_bf16x8(xv), y, 0, 0, 0);
                }
                const int rn = 16 * nt + fr; const u32x2 rv = *(const LAS u32x2*)(RT + ((rn & 128) + (rn & 7) * 16 + ((rn & 127) >> 3)) * S64 + 16 * b + 4 * fq);
                const float z0 = bflo(rv.x) - y[0], z1 = bfhi(rv.x) - y[1], z2 = bflo(rv.y) - y[2], z3 = bfhi(rv.y) - y[3];
                u32x2 zb; zb.x = cvtpk(z0, z1); zb.y = cvtpk(z2, z3);
                const u32x2 dv = *(const LAS u32x2*)(DI + (b * 16 + fr) * 16 + 4 * fq);
                const f32x4 xo = __builtin_amdgcn_mfma_f32_16x16x16bf16_1k(as_bf16x4(dv), as_bf16x4(zb), (f32x4){0.f, 0.f, 0.f, 0.f}, 0, 0, 0);
                u32x2 xw; xw.x = cvtpk(xo[0], xo[1]); xw.y = cvtpk(xo[2], xo[3]);
                *(LAS u32x2*)(XT + (16 * nt + fr) * S64 + 16 * b + 4 * fq) = xw;
                if (nt < 8) *(u32x2*)(rec + REC_U + (size_t)(((nt * 4 + b) * 64 + lane) * 8)) = xw;
            }
            LDS_WAIT(); asm volatile("" ::: "memory");
        }
        BAR_LDS();
#if defined(DBG_C1_STOP) && DBG_C1_STOP <= 4
        continue;
#endif
        RELANE();
        for (int rp5_ = 0; rp5_ < (((DBG_C1_REP) >> 4) & 1) + 1; ++rp5_)
#pragma unroll
        for (int k2 = 0; k2 < 2; ++k2) {
            const int u = tid + 512 * k2, frag = u >> 6, tt = frag >> 2, ks = frag & 3;
            float wv[8];
#pragma unroll
            for (int j = 0; j < 8; ++j) wv[j] = -bf1(XT[(128 + 32 * ks + 16 * (j >> 2) + 4 * fq + (j & 3)) * S64 + 16 * tt + fr]);
            *(u32x4*)(rec + REC_W + (size_t)((frag * 64 + lane) * 16)) = pack8(wv);
        }
    }
#ifdef DBG_MEASC
    if (l == 1 && blockIdx.x == 0 && tid_opaque() == 0) { DM(5); const unsigned long long tot_ = __builtin_amdgcn_s_memtime() - dmt0_; const float fr_ = (float)dmacc_ / (float)tot_;
        ((unsigned*)(a.ws + WS_CTL))[2000] = 32u * (unsigned)(fr_ * 8.0f + 0.5f); }
#endif
#undef DM
#undef RELANE
#undef PREFETCH
#undef ITEM_PARAMS
}


constexpr int L_SS = 2 * REC_STAGE, L_RS = L_SS + 2048, L_DN = L_RS + 256, L_OB = L_DN + 512, OBS = 136;
__device__ __forceinline__ void scan_seq(const Args& a, int l, LAS unsigned char* lds, int seq) {
    int tid = tid_opaque(), lane = tid & 63, wave = __builtin_amdgcn_readfirstlane(tid >> 6);
    int fr = lane & 15, fq = lane >> 4;
    const bool sample = seq >= 64;
    const int s2 = sample ? seq - 64 : seq, n = s2 >> 4, h = s2 & 15;
    const int nsteps = sample ? 1 : 64, ntok = sample ? 16 : 64;
    const int rec0 = sample ? 4096 + s2 : s2 * 64;
    const size_t rowbase0 = sample ? (size_t)MP + n * 16 : (size_t)n * 4096;
    const unsigned char* recs = a.ws + WS_REC;
    const float* decbuf = (const float*)(a.ws + WS_DEC);
    bf16* Ob = (bf16*)(a.ws + WS_HO);
    LAS float* ss = (LAS float*)(lds + L_SS); LAS float* rs = (LAS float*)(lds + L_RS); LAS bf16* ob = (LAS bf16*)(lds + L_OB);
    f32x4 st[8];
    if (sample) { const float* s0 = a.in[3] + (((size_t)l * 16 + n) * 16 + h) * 16384;
#pragma unroll
        for (int t = 0; t < 8; ++t)
#pragma unroll
            for (int j = 0; j < 4; ++j) st[t][j] = s0[(16 * t + 4 * fq + j) * 128 + 16 * wave + fr];
    } else {
#pragma unroll
        for (int t = 0; t < 8; ++t) st[t] = (f32x4){0.f, 0.f, 0.f, 0.f};
    }
    __syncthreads();
    {   const unsigned char* src = recs + (size_t)rec0 * REC_BYTES;
#pragma unroll
        for (int k = 0; k < 7; ++k) { const int p = wave * 7 + k;
            __builtin_amdgcn_global_load_lds((const unsigned*)(src + p * 1024 + lane * 16), (LAS unsigned*)(lds + p * 1024), 16, 0, 0); } }
    u32x2 u_cur[4], u_nxt[4]; float dec_cur, dec_nxt = 0.f; f32x4 o_prev[4];
    u32x4 zq[2], zn[2]; LAS float* dnl = (LAS float*)(lds + L_DN);
    if (tid < 128) dnl[tid] = a.in[16][(size_t)l * 128 + tid];
    zq[0] = zq[1] = zn[0] = zn[1] = (u32x4){0u, 0u, 0u, 0u};
    {   const unsigned char* rec = recs + (size_t)rec0 * REC_BYTES;
#pragma unroll
        for (int t = 0; t < 4; ++t) { u_cur[t] = *(const u32x2*)(rec + REC_U + ((wave * 4 + t) * 64 + lane) * 8); u_nxt[t] = u_cur[t]; o_prev[t] = (f32x4){0.f, 0.f, 0.f, 0.f}; }
        dec_cur = decbuf[rec0]; }
#define SCAN_STORE(cc) do {   \
        _Pragma("unroll") for (int t = 0; t < 4; ++t) { const f32x4 r4 = *(const LAS f32x4*)(rs + 16 * t + 4 * fq); \
            _Pragma("unroll") for (int j = 0; j < 4; ++j) ob[(16 * t + 4 * fq + j) * OBS + 16 * wave + fr] = (bf16)(cvtpk(o_prev[t][j] * r4[j], 0.f) & 0xffffu); } } while (0)
#define SCAN_ZLOAD(cc, Z) do { const int tok_ = tid >> 3; if (tok_ < ntok) { const bf16* zp_ = (const bf16*)(a.ws + WS_P) + (rowbase0 + (size_t)(cc) * 64 + tok_) * NP + C_ZDN + h * 128 + (tid & 7) * 8; \
            Z[0] = *(const u32x4*)zp_; Z[1] = *(const u32x4*)(zp_ + 64); } } while (0)
#define SCAN_FLUSH(cc, Z) do {   \
        const int tok_ = tid >> 3, pc_ = tid & 7; \
        if (tok_ < ntok) { bf16* op_ = Ob + (rowbase0 + (size_t)(cc) * 64 + tok_) * D + h * 128 + pc_ * 8; \
            _Pragma("unroll") for (int hh = 0; hh < 2; ++hh) { float ov_[8], zv_[8]; unpack8(*(const LAS u32x4*)(ob + tok_ * OBS + 64 * hh + pc_ * 8), ov_); unpack8(Z[hh], zv_); \
                _Pragma("unroll") for (int i = 0; i < 8; ++i) ov_[i] = ov_[i] * zv_[i];     \
                *(u32x4*)(op_ + 64 * hh) = pack8(ov_); } } } while (0)
#define SCAN_RS() do { if (tid < 64) { float tsum = 0.f; \
            _Pragma("unroll") for (int w8 = 0; w8 < 8; ++w8) tsum += ss[w8 * 64 + tid]; \
            rs[tid] = rsqrtf(tsum * (1.f / 128.f) + EPS); } } while (0)
#ifdef DBG_MEAS
    unsigned long long dbg_w_ = 0, dbg_b_ = 0, dbg_b2_ = 0; const unsigned long long dbg_t0_ = __builtin_amdgcn_s_memtime(); const unsigned long long dbg_r0_ = __builtin_amdgcn_s_memrealtime();
#endif
    for (int c = 0; c < nsteps; ++c) {
        tid = tid_opaque(); lane = tid & 63; wave = __builtin_amdgcn_readfirstlane(tid >> 6); fr = lane & 15; fq = lane >> 4;
        const LAS unsigned char* buf = lds + (c & 1) * REC_STAGE;
        const unsigned char* rec = recs + (size_t)(rec0 + c) * REC_BYTES;
#ifdef DBG_MEAS
        const unsigned long long tm0_ = __builtin_amdgcn_s_memtime();
        VM_WAIT();
        const unsigned long long tm1_ = __builtin_amdgcn_s_memtime();
        __syncthreads();
        const unsigned long long tm2_ = __builtin_amdgcn_s_memtime();
        dbg_w_ += tm1_ - tm0_; dbg_b_ += tm2_ - tm1_;
#else
        VM_WAIT(); __syncthreads();
#endif; everybody is done with the other buffer; ss of step c-1 is complete
        if (c + 1 < nsteps) { const unsigned char* src = rec + REC_BYTES; LAS unsigned char* dst = lds + ((c + 1) & 1) * REC_STAGE;
#pragma unroll
            for (int k = 0; k < 7; ++k) { const int p = wave * 7 + k;
                __builtin_amdgcn_global_load_lds((const unsigned*)(src + p * 1024 + lane * 16), (LAS unsigned*)(dst + p * 1024), 16, 0, 0); }
#pragma unroll
            for (int t = 0; t < 4; ++t) u_nxt[t] = *(const u32x2*)(src + REC_U + ((wave * 4 + t) * 64 + lane) * 8);
            dec_nxt = decbuf[rec0 + c + 1]; }
        if (c > 0) SCAN_RS();
        if (c > 1) SCAN_FLUSH(c - 2, zn);
        if (c > 0) SCAN_ZLOAD(c - 1, zn);
        bf16x8 Bs[4];
#pragma unroll
        for (int ks = 0; ks < 4; ++ks) { u32x4 w; w.x = cvtpk(st[2 * ks][0], st[2 * ks][1]); w.y = cvtpk(st[2 * ks][2], st[2 * ks][3]); w.z = cvtpk(st[2 * ks + 1][0], st[2 * ks + 1][1]); w.w = cvtpk(st[2 * ks + 1][2], st[2 * ks + 1][3]); Bs[ks] = as_bf16x8(w); }
        f32x4 ws4[4], oacc[4];
#pragma unroll
        for (int t = 0; t < 4; ++t) ws4[t] = (f32x4){bflo(u_cur[t].x), bfhi(u_cur[t].x), bflo(u_cur[t].y), bfhi(u_cur[t].y)};
        bf16x8 FX[8], FY[8];
#define LDG(F, off) do { _Pragma("unroll") for (int i_ = 0; i_ < 8; ++i_) F[i_] = *(const LAS bf16x8*)(buf + (off) + (i_ * 64 + lane) * 16); } while (0)
#define SB() __builtin_amdgcn_sched_barrier(0)
        LDG(FX, REC_W); LDG(FY, REC_W + 8192); SB();
#pragma unroll
        for (int i = 0; i < 8; ++i) ws4[i >> 2] = __builtin_amdgcn_mfma_f32_16x16x32_bf16(FX[i], Bs[i & 3], ws4[i >> 2], 0, 0, 0);
        SB(); LDG(FX, REC_QD); SB();
#pragma unroll
        for (int i = 0; i < 8; ++i) ws4[2 + (i >> 2)] = __builtin_amdgcn_mfma_f32_16x16x32_bf16(FY[i], Bs[i & 3], ws4[2 + (i >> 2)], 0, 0, 0);
        SB(); LDG(FY, REC_QD + 8192); SB();
#pragma unroll
        for (int i = 0; i < 8; ++i) oacc[i >> 2] = __builtin_amdgcn_mfma_f32_16x16x32_bf16(FX[i], Bs[i & 3], (i & 3) ? oacc[i >> 2] : (f32x4){0.f, 0.f, 0.f, 0.f}, 0, 0, 0);
        SB(); LDG(FX, REC_QK); SB();
#pragma unroll
        for (int i = 0; i < 8; ++i) oacc[2 + (i >> 2)] = __builtin_amdgcn_mfma_f32_16x16x32_bf16(FY[i], Bs[i & 3], (i & 3) ? oacc[2 + (i >> 2)] : (f32x4){0.f, 0.f, 0.f, 0.f}, 0, 0, 0);
        SB(); LDG(FY, REC_KD); SB();
        bf16x8 Bv[2];
        {   f32x4 vn[4];
#pragma unroll
            for (int t = 0; t < 4; ++t) vn[t] = ws4[t];
#pragma unroll
            for (int k2 = 0; k2 < 2; ++k2) { u32x4 w; w.x = cvtpk(vn[2 * k2][0], vn[2 * k2][1]); w.y = cvtpk(vn[2 * k2][2], vn[2 * k2][3]); w.z = cvtpk(vn[2 * k2 + 1][0], vn[2 * k2 + 1][1]); w.w = cvtpk(vn[2 * k2 + 1][2], vn[2 * k2 + 1][3]); Bv[k2] = as_bf16x8(w); } }
#pragma unroll
        for (int t = 0; t < 8; ++t) st[t] = st[t] * dec_cur;
        SB();
#pragma unroll
        for (int i = 0; i < 8; ++i) oacc[i >> 1] = __builtin_amdgcn_mfma_f32_16x16x32_bf16(FX[i], Bv[i & 1], oacc[i >> 1], 0, 0, 0);
        SB(); LDG(FX, REC_KD + 8192); SB();
#pragma unroll
        for (int i = 0; i < 8; ++i) st[i >> 1] = __builtin_amdgcn_mfma_f32_16x16x32_bf16(FY[i], Bv[i & 1], st[i >> 1], 0, 0, 0);
        SB();
#pragma unroll
        for (int i = 0; i < 8; ++i) st[4 + (i >> 1)] = __builtin_amdgcn_mfma_f32_16x16x32_bf16(FX[i], Bv[i & 1], st[4 + (i >> 1)], 0, 0, 0);
#undef LDG
#undef SB
#ifdef DBG_MEAS
        const unsigned long long tm3_ = __builtin_amdgcn_s_memtime();
#endif
        BAR_LDS();
#ifdef DBG_MEAS
        dbg_b2_ += __builtin_amdgcn_s_memtime() - tm3_;
#endif
        if (c > 0) SCAN_STORE(c - 1);
#pragma unroll
        for (int t = 0; t < 4; ++t) { const float k = quadsum16(oacc[t] * oacc[t], fr);
            if (fr < 4) ss[wave * 64 + 16 * t + 4 * fq + fr] = k; }
#pragma unroll
        for (int t = 0; t < 4; ++t) { o_prev[t] = oacc[t]; u_cur[t] = u_nxt[t]; }
        dec_cur = dec_nxt;
    }
#ifdef DBG_MEAS
    if (l == 1 && seq == 0 && tid == 0) { const unsigned long long tot_ = __builtin_amdgcn_s_memtime() - dbg_t0_; const unsigned long long rt_ = __builtin_amdgcn_s_memrealtime() - dbg_r0_;
        float fr_ = 0.f;
        if (DBG_MEAS == 1) fr_ = (float)dbg_w_ / (float)tot_; else if (DBG_MEAS == 2) fr_ = (float)dbg_b_ / (float)tot_; else if (DBG_MEAS == 3) fr_ = (float)dbg_b2_ / (float)tot_;
        else if (DBG_MEAS == 4) fr_ = (float)rt_ * 0.01f / 500.0f;
        else if (DBG_MEAS == 5) fr_ = (float)tot_ / (float)rt_ / 100.0f * 0.25f;
        ((unsigned*)(a.ws + WS_CTL))[2000] = 8u * (unsigned)(fr_ * 32.0f + 0.5f); }
#endif
    __syncthreads();
    SCAN_RS();
    if (nsteps > 1) SCAN_FLUSH(nsteps - 2, zn);
    SCAN_ZLOAD(nsteps - 1, zq);
    __syncthreads();
    SCAN_STORE(nsteps - 1);
    __syncthreads();
    SCAN_FLUSH(nsteps - 1, zq);
#undef SCAN_FLUSH
#undef SCAN_ZLOAD
#undef SCAN_STORE
#undef SCAN_RS
    {   float* so = sample ? a.out + O_DNS + (((size_t)l * 16 + n) * 16 + h) * 16384 : a.out + O_DNP + (((size_t)l * 4 + n) * 16 + h) * 16384;
#pragma unroll
        for (int t = 0; t < 8; ++t)
#pragma unroll
            for (int j = 0; j < 4; ++j) so[(16 * t + 4 * fq + j) * 128 + 16 * wave + fr] = st[t][j]; }
}

constexpr int L_KI = 0, L_VT = 30720, SKI = 80, SVT = 200;
__device__ __forceinline__ void attn_item(const Args& a, int l, LAS unsigned char* lds, int it) {
    const int tid = tid_opaque(), lane = tid & 63, wave = __builtin_amdgcn_readfirstlane(tid >> 6);
    const int fr = lane & 15, fq = lane >> 4;
    const bool sample = it >= 1024;
    const int kv = it & 3, c = sample ? 0 : ((it >> 2) & 63), n = sample ? ((it - 1024) >> 2) : (it >> 8);
    const bf16* P = (const bf16*)(a.ws + WS_P); const f32x2* rope = (const f32x2*)(a.ws + WS_ROPE);
    bf16* Ob = (bf16*)(a.ws + WS_HO);
    LAS bf16* KI = (LAS bf16*)(lds + L_KI); LAS bf16* VT = (LAS bf16*)(lds + L_VT);
    const int kt0 = sample ? 0 : ((c >= 2) ? 0 : (8 - 4 * c));
    const int nkt = sample ? 9 : 12, nqt = sample ? 1 : 4;
    const size_t qrow0 = sample ? (size_t)MP + n * 16 : (size_t)n * 4096 + c * 64;
    const int pos0 = sample ? PAST : c * 64;
    __syncthreads();
    if (!sample) {
#pragma unroll
        for (int k2 = 0; k2 < 2; ++k2) { const int u = tid + 512 * k2; if (u < 768) { const int key = u >> 2, dg = u & 3, tok = (c - 2) * 64 + key;
            if (tok >= 0) { const bf16* kp = P + ((size_t)n * 4096 + tok) * NP + C_AK + kv * 64 + dg * 8; float x1[8], x2[8], o1[8], o2[8];
                unpack8(*(const u32x4*)kp, x1); unpack8(*(const u32x4*)(kp + 32), x2);
#pragma unroll
                for (int j = 0; j < 8; ++j) { const f32x2 cs = rope[tok * 32 + dg * 8 + j]; o1[j] = x1[j] * cs.x - x2[j] * cs.y; o2[j] = x2[j] * cs.x + x1[j] * cs.y; }
                *(LAS u32x4*)(KI + key * SKI + dg * 8) = pack8(o1); *(LAS u32x4*)(KI + key * SKI + 32 + dg * 8) = pack8(o2);
                if (c == 63 && key >= 64) { float* ko = a.out + O_KP + ((((size_t)l * 4 + n) * 128 + (key - 64)) * 4 + kv) * 64 + dg * 8;
                    *(f32x4*)ko = (f32x4){o1[0], o1[1], o1[2], o1[3]}; *(f32x4*)(ko + 4) = (f32x4){o1[4], o1[5], o1[6], o1[7]};
                    *(f32x4*)(ko + 32) = (f32x4){o2[0], o2[1], o2[2], o2[3]}; *(f32x4*)(ko + 36) = (f32x4){o2[4], o2[5], o2[6], o2[7]}; } } } }
#pragma unroll
        for (int k3 = 0; k3 < 3; ++k3) { const int u = tid + 512 * k3, key = u >> 3, dg = u & 7, tok = (c - 2) * 64 + key;
            if (tok >= 0) { const u32x4 vw = *(const u32x4*)(P + ((size_t)n * 4096 + tok) * NP + C_AV + kv * 64 + dg * 8);
                const unsigned ww[4] = {vw.x, vw.y, vw.z, vw.w};
#pragma unroll
                for (int j = 0; j < 8; ++j) VT[(dg * 8 + j) * SVT + key] = (bf16)((j & 1) ? (ww[j >> 1] >> 16) : (ww[j >> 1] & 0xffffu));
                if (c == 63 && key >= 64) { float vf[8]; unpack8(vw, vf); float* vo = a.out + O_VP + ((((size_t)l * 4 + n) * 128 + (key - 64)) * 4 + kv) * 64 + dg * 8;
                    *(f32x4*)vo = (f32x4){vf[0], vf[1], vf[2], vf[3]}; *(f32x4*)(vo + 4) = (f32x4){vf[4], vf[5], vf[6], vf[7]}; } } }
    } else {
        const float* ck = a.in[4] + ((size_t)l * 16 + n) * 128 * 256 + kv * 64; const float* cv = a.in[5] + ((size_t)l * 16 + n) * 128 * 256 + kv * 64;
        float* kso = a.out + O_KS + (((size_t)l * 16 + n) * 128 * 4 + kv) * 64; float* vso = a.out + O_VS + (((size_t)l * 16 + n) * 128 * 4 + kv) * 64;
#pragma unroll
        for (int k2 = 0; k2 < 3; ++k2) { const int u = tid + 512 * k2; if (u < 144 * 8) { const int key = u >> 3, dg = u & 7; float kf[8], vf[8];
            if (key < 128) { const f32x4 k0 = *(const f32x4*)(ck + (size_t)key * 256 + dg * 8), k1 = *(const f32x4*)(ck + (size_t)key * 256 + dg * 8 + 4), v0 = *(const f32x4*)(cv + (size_t)key * 256 + dg * 8), v1 = *(const f32x4*)(cv + (size_t)key * 256 + dg * 8 + 4);
#pragma unroll
                for (int j = 0; j < 4; ++j) { kf[j] = k0[j]; kf[4 + j] = k1[j]; vf[j] = v0[j]; vf[4 + j] = v1[j]; } }
            else { const int t = key - 128; const bf16* kp = P + ((size_t)MP + n * 16 + t) * NP + C_AK + kv * 64; float x1[8], x2[8];
                const int d1 = (dg & 3) * 8; unpack8(*(const u32x4*)(kp + d1), x1); unpack8(*(const u32x4*)(kp + 32 + d1), x2);
#pragma unroll
                for (int j = 0; j < 8; ++j) { const f32x2 cs = rope[(PAST + t) * 32 + d1 + j]; kf[j] = (dg < 4) ? (x1[j] * cs.x - x2[j] * cs.y) : (x2[j] * cs.x + x1[j] * cs.y); }
                unpack8(*(const u32x4*)(P + ((size_t)MP + n * 16 + t) * NP + C_AV + kv * 64 + dg * 8), vf); }
            *(LAS u32x4*)(KI + key * SKI + dg * 8) = pack8(kf);
            const u32x4 vw = pack8(vf); const unsigned ww[4] = {vw.x, vw.y, vw.z, vw.w};
#pragma unroll
            for (int j = 0; j < 8; ++j) VT[(dg * 8 + j) * SVT + key] = (bf16)((j & 1) ? (ww[j >> 1] >> 16) : (ww[j >> 1] & 0xffffu));
            if (key >= 16) { float* ko = kso + (size_t)(key - 16) * 256 + dg * 8; float* vo = vso + (size_t)(key - 16) * 256 + dg * 8;
                *(f32x4*)ko = (f32x4){kf[0], kf[1], kf[2], kf[3]}; *(f32x4*)(ko + 4) = (f32x4){kf[4], kf[5], kf[6], kf[7]};
                *(f32x4*)vo = (f32x4){vf[0], vf[1], vf[2], vf[3]}; *(f32x4*)(vo + 4) = (f32x4){vf[4], vf[5], vf[6], vf[7]}; } } }
    }
    __syncthreads();
    const int hq = kv * 8 + wave;
    const float sink = a.in[17][l * 32 + hq];
    for (int qt = 0; qt < nqt; ++qt) {
        const int tq = pos0 + 16 * qt + fr; const size_t row = qrow0 + 16 * qt + fr;
        bf16x8 Qf[2];
        {   const bf16* qp = P + row * NP + C_AQ + hq * 64 + 8 * fq; float x1[8], x2[8], o1[8], o2[8];
            unpack8(*(const u32x4*)qp, x1); unpack8(*(const u32x4*)(qp + 32), x2);
#pragma unroll
            for (int j = 0; j < 8; ++j) { const f32x2 cs = rope[tq * 32 + 8 * fq + j]; o1[j] = (x1[j] * cs.x - x2[j] * cs.y) * 0.125f; o2[j] = (x2[j] * cs.x + x1[j] * cs.y) * 0.125f; }
            Qf[0] = as_bf16x8(pack8(o1)); Qf[1] = as_bf16x8(pack8(o2)); }
        u32x2 zw[4];
#pragma unroll
        for (int dt = 0; dt < 4; ++dt) zw[dt] = *(const u32x2*)(P + row * NP + C_AZ + hq * 64 + 16 * dt + 4 * fq);
        f32x4 s[12]; float m = sink;
#pragma unroll
        for (int kt = 0; kt < 12; ++kt) { s[kt] = (f32x4){0.f, 0.f, 0.f, 0.f};
            if (kt >= kt0 && kt < nkt) {
#pragma unroll
                for (int ks = 0; ks < 2; ++ks) { const bf16x8 kf = *(const LAS bf16x8*)(KI + (16 * kt + fr) * SKI + 32 * ks + 8 * fq); s[kt] = __builtin_amdgcn_mfma_f32_16x16x32_bf16(kf, Qf[ks], s[kt], 0, 0, 0); }
                m = fmaxf(m, fmaxf(fmaxf(s[kt][0], s[kt][1]), fmaxf(s[kt][2], s[kt][3]))); } }
        m = fmaxf(m, __shfl_xor(m, 16)); m = fmaxf(m, __shfl_xor(m, 32));
        float sum = 0.f; f32x4 oc[4];
#pragma unroll
        for (int dt = 0; dt < 4; ++dt) oc[dt] = (f32x4){0.f, 0.f, 0.f, 0.f};
#pragma unroll
        for (int kt = 0; kt < 12; ++kt) { if (kt >= kt0 && kt < nkt) {
            const float p0 = __expf(s[kt][0] - m), p1 = __expf(s[kt][1] - m), p2 = __expf(s[kt][2] - m), p3 = __expf(s[kt][3] - m); sum += (p0 + p1) + (p2 + p3);
            u32x2 pw; pw.x = cvtpk(p0, p1); pw.y = cvtpk(p2, p3);
#pragma unroll
            for (int dt = 0; dt < 4; ++dt) { const u32x2 vf = *(const LAS u32x2*)(VT + (16 * dt + fr) * SVT + 16 * kt + 4 * fq);
                oc[dt] = __builtin_amdgcn_mfma_f32_16x16x16bf16_1k(as_bf16x4(vf), as_bf16x4(pw), oc[dt], 0, 0, 0); } } }
        sum += __shfl_xor(sum, 16); sum += __shfl_xor(sum, 32);
        const float inv = 1.0f / (sum + __expf(sink - m));
#pragma unroll
        for (int dt = 0; dt < 4; ++dt) { const int d0 = 16 * dt + 4 * fq;
            const float o0 = oc[dt][0] * inv * silu_f(bflo(zw[dt].x)), o1 = oc[dt][1] * inv * silu_f(bfhi(zw[dt].x)), o2 = oc[dt][2] * inv * silu_f(bflo(zw[dt].y)), o3 = oc[dt][3] * inv * silu_f(bfhi(zw[dt].y));
            u32x2 ow; ow.x = cvtpk(o0, o1); ow.y = cvtpk(o2, o3);
            *(u32x2*)(Ob + row * D + 2048 + hq * 64 + d0) = ow; }
    }
}

struct OneUnit { int pn; __device__ __forceinline__ bool next(int i, pg8::Unit& u) const { if (i) return false; u.pm = 0; u.pn = pn; return true; }
    __device__ __forceinline__ void a_ready(const pg8::Unit&) const {} __device__ __forceinline__ void done(const pg8::Unit&) const {} };
#ifndef DBG_REPEAT
#define DBG_REPEAT 0
#endif
__device__ __forceinline__ void phase_c2(const Args& a, int l, LAS unsigned char* lds, int G) {
    const int b = blockIdx.x;
    unsigned* cnt = (unsigned*)(a.ws + WS_CTL) + CW_C2DONE + 64 * l;
    if (b < 64) { for (int r_ = 0; r_ < ((((DBG_REPEAT) >> 7) & 1) ? 2 : 1); ++r_) scan_seq(a, l, lds, b); }
    else if (b < 80) {
        if (threadIdx.x == 0) { unsigned sp = 0; while (__hip_atomic_load(cnt, __ATOMIC_RELAXED, __HIP_MEMORY_SCOPE_AGENT) < (unsigned)(G - 80)) { __builtin_amdgcn_s_sleep(8); if (++sp > (1u << 22)) break; }
            __builtin_amdgcn_fence(__ATOMIC_ACQUIRE, "agent"); VM_WAIT(); }
        __syncthreads();
        pg8::Gemm g{(const pg8::bf16_t*)(a.ws + WS_HO) + (size_t)MP * D, (const pg8::bf16_t*)(a.ws + WS_BOUT + l * BOUT_BYTES), MS, D, D};
        OneUnit S; S.pn = b - 64;
        pg8::EpiY E{(pg8::bf16_t*)(a.ws + WS_YS), D, (float*)(a.ws + WS_YSQ) + (size_t)MP * 64};
        pg8::gemm_phase<pg8::EpiY, OneUnit, true, true>(lds, g, S, E);
    } else {
        const int vb = b - 80, nvb = G - 80;
        for (int it = vb; it < 320; it += nvb) { if (it < 256) scan_seq(a, l, lds, 64 + it); else attn_item(a, l, lds, 1024 + (it - 256)); }
        VM_WAIT(); __syncthreads();
        if (threadIdx.x == 0) { __builtin_amdgcn_fence(__ATOMIC_RELEASE, "agent"); VM_WAIT(); __hip_atomic_fetch_add(cnt, 1u, __ATOMIC_RELAXED, __HIP_MEMORY_SCOPE_AGENT); }
        for (int it = vb; it < 1024; it += nvb) { for (int r_ = 0; r_ < ((((DBG_REPEAT) >> 8) & 1) ? 2 : 1); ++r_) attn_item(a, l, lds, it); }
#if SPLIT_PROLOGUE
        if (l == 0) { __syncthreads(); prologue_work(a, lds, vb, nvb, 2, 0x8, false); }
#endif
    }
}

constexpr int N_PHASES = 12;
__device__ __forceinline__ Args load_args(const __attribute__((address_space(4))) Args* p) {
    Args a;
#pragma unroll
    for (int i = 0; i < 19; ++i) a.in[i] = (const float*)(const GAS float*)p->in[i];
    a.out = (float*)(GAS float*)p->out; a.ws = (unsigned char*)(GAS unsigned char*)p->ws; a.ph_lo = p->ph_lo; a.ph_hi = p->ph_hi; return a;
}
__global__ void __launch_bounds__(512, 2) fwd(Args args) {
    extern __shared__ __attribute__((aligned(16))) unsigned char lds_raw[];
    LAS unsigned char* lds = (LAS unsigned char*)lds_raw;
    const int G = gridDim.x;
    typedef const __attribute__((address_space(4))) Args* KArgs;
    const KArgs kp = (KArgs)__builtin_amdgcn_kernarg_segment_ptr();
#define ARGS(name) KArgs name##_p = kp; asm volatile("" : "+s"(name##_p)); const Args name = load_args(name##_p)
    const int lo = kp->ph_lo, hi = kp->ph_hi;
    volatile LAS unsigned* MISC = (volatile LAS unsigned*)(lds + MISC_OFF);
    for (int u = threadIdx.x; u < 64; u += 512) MISC[u] = 0u;
    __syncthreads();
    unsigned* barw = (unsigned*)(GAS unsigned*)((GAS unsigned char*)kp->ws + WS_CTL) + CW_BAR;
    XcdBarrier bar; bar.bar = barw; bar.x = 0; bar.st = nullptr;
    const bool multi = (hi - lo) > 1;
    if (multi) bar = xcd_barrier_post(barw, MISC + 8);
#define IN(k) (lo <= (k) && (k) < hi)
#ifndef DBG_REPEAT
#define DBG_REPEAT 0
#endif
#define REP(bit) for (int rep_ = 0; rep_ < (((DBG_REPEAT) >> (bit)) & 1) + 1; ++rep_)
#define SEAM(k) do { if (IN(k) && IN((k) + 1)) xcd_barrier(bar); } while (0)
    if (IN(0)) REP(0) { ARGS(a0); phase_prologue(a0, lds, G); }
    SEAM(0);
    if (IN(1)) REP(1) { ARGS(a1); phase_rows<0>(a1, lds, G); }
    SEAM(1);
    for (int l = 0; l < 2; ++l) {
        const int pb = 2 + 5 * l;
        if (IN(pb + 0)) REP(2) {
            ARGS(args);
            pg8::Gemm g{(const pg8::bf16_t*)(args.ws + WS_HO), (const pg8::bf16_t*)(args.ws + WS_BIN + l * BIN_BYTES), M, NP, D};
            pg8::StaticOrder S; S.init(M, NP, G, (int)blockIdx.x);
            pg8::EpiP E{(pg8::bf16_t*)(args.ws + WS_P), NP, args.in[16] + (size_t)l * 128, C_ZDN / 256, (C_ZDN + 2048) / 256};
#ifdef DBG_CLK
            const unsigned long long ck0_ = __builtin_amdgcn_s_memtime(), cr0_ = __builtin_amdgcn_s_memrealtime();
#endif
            pg8::gemm_phase<pg8::EpiP, pg8::StaticOrder, true, true>(lds, g, S, E);
#ifdef DBG_CLK
            if (l == 1 && blockIdx.x == 0 && threadIdx.x == 0) { const unsigned long long dc_ = __builtin_amdgcn_s_memtime() - ck0_, dr_ = __builtin_amdgcn_s_memrealtime() - cr0_;
                const float ghz_ = (float)dc_ / ((float)dr_ * 10.0f);
                float fr_ = (DBG_CLK == 1) ? (ghz_ - 1.0f) / 1.6f : (float)dr_ * 0.01f / 2000.0f;
                fr_ = fr_ < 0.f ? 0.f : (fr_ > 1.f ? 1.f : fr_);
                ((unsigned*)(args.ws + WS_CTL))[2000] = 16u * (unsigned)(fr_ * 16.0f + 0.5f); }
#endif
        }
        SEAM(pb + 0);
        if (IN(pb + 1)) REP(3) { ARGS(a2); phase_c1(a2, l, lds, G); }
        SEAM(pb + 1);
        if (IN(pb + 2)) REP(4) { ARGS(a3); phase_c2(a3, l, lds, G); }
        SEAM(pb + 2);
        if (IN(pb + 3)) REP(5) {
            ARGS(args);
            pg8::Gemm g{(const pg8::bf16_t*)(args.ws + WS_HO), (const pg8::bf16_t*)(args.ws + WS_BOUT + l * BOUT_BYTES), MP, D, D};
            pg8::StaticOrder S; S.init(MP, D, G, (int)blockIdx.x);
            pg8::EpiY E{(pg8::bf16_t*)(args.ws + WS_P), D, (float*)(args.ws + WS_YSQ)};
            pg8::gemm_phase<pg8::EpiY, pg8::StaticOrder, true, true>(lds, g, S, E);
        }
        SEAM(pb + 3);
        if (IN(pb + 4)) for (int rep_ = 0; rep_ < ((((DBG_REPEAT) >> 6) & 1) && l == 0 ? 2 : 1); ++rep_) { ARGS(a4); if (l == 0) phase_rows<1>(a4, lds, G); else phase_rows<2>(a4, lds, G); }
        SEAM(pb + 4);
    }
#undef IN
#undef SEAM
#undef ARGS
}


#ifdef DBG_STOP_AFTER
__global__ void dbg_dump(const unsigned char* ws, float* out) {
    const size_t regs[9][2] = {{WS_MOD, 1966080}, {WS_ROPE, 1048576}, {WS_DEC, 17408}, {WS_YSQ, (size_t)M * 64 * 4}, {WS_BIN, 2 * BIN_BYTES}, {WS_BOUT, 2 * BOUT_BYTES}, {WS_HO, (size_t)M * D * 2}, {WS_P, (size_t)M * NP * 2}, {WS_REC, (size_t)NREC * REC_BYTES}};
    size_t obase = 0;
    for (int r = 0; r < 9; ++r) { const size_t nchunk = regs[r][1] / 128; const unsigned short* p = (const unsigned short*)(ws + regs[r][0]);
        for (size_t i = (size_t)blockIdx.x * blockDim.x + threadIdx.x; i < nchunk; i += (size_t)gridDim.x * blockDim.x) { unsigned s = 0; for (int k = 0; k < 64; ++k) s += p[i * 64 + k]; out[obase + i] = (float)s; }
        obase += nchunk; }
}
#endif
#ifndef MK_PER_PHASE
#define MK_PER_PHASE 1
#endif
extern "C" void kernel_launch(void* const* d_in, const int* in_sizes, int n_in, void* d_out, int out_size, void* d_ws, size_t ws_size, hipStream_t stream) {
    static int grid = 0;
    if (grid == 0) {
        if (n_in != 19 || out_size != (int)O_END || ws_size < WS_END) { fprintf(stderr, "kernel_launch: unexpected shapes (n_in %d out %d ws %zu need %zu)\n", n_in, out_size, ws_size, (size_t)WS_END); grid = -1; return; }
        int dev = 0, cus = 0;
        if (hipGetDevice(&dev) != hipSuccess || hipDeviceGetAttribute(&cus, hipDeviceAttributeMultiprocessorCount, dev) != hipSuccess) { grid = -1; return; }
        if (hipFuncSetAttribute((const void*)fwd, hipFuncAttributeMaxDynamicSharedMemorySize, LDS_BYTES) != hipSuccess) { fprintf(stderr, "kernel_launch: hipFuncSetAttribute failed\n"); grid = -1; return; }
        int per_cu = 0;
        if (hipOccupancyMaxActiveBlocksPerMultiprocessor(&per_cu, (const void*)fwd, 512, LDS_BYTES) != hipSuccess || per_cu < 1) fprintf(stderr, "kernel_launch: occupancy query says %d\n", per_cu);
        (void)hipGetLastError();
        grid = cus;
        if (grid < 128) { fprintf(stderr, "kernel_launch: needs >= 128 CUs\n"); grid = -1; return; }
    }
    if (grid < 0) return;
    (void)in_sizes;
    if (hipMemsetAsync((char*)d_ws + WS_CTL, 0, CTL_ZERO_BYTES, stream) != hipSuccess) return;
    Args a{};
    for (int i = 0; i < 19; ++i) a.in[i] = (const float*)d_in[i];
    a.out = (float*)d_out; a.ws = (unsigned char*)d_ws;
#ifdef DBG_STOP_AFTER
    for (int p = 0; p <= DBG_STOP_AFTER; ++p) { a.ph_lo = p; a.ph_hi = p + 1; hipLaunchKernelGGL(fwd, dim3(grid), dim3(512), LDS_BYTES, stream, a); }
    hipLaunchKernelGGL(dbg_dump, dim3(2048), dim3(256), 0, stream, (const unsigned char*)d_ws, (float*)d_out);
#elif MK_PER_PHASE
    for (int p = 0; p < N_PHASES; ++p) { a.ph_lo = p; a.ph_hi = p + 1; hipLaunchKernelGGL(fwd, dim3(grid), dim3(512), LDS_BYTES, stream, a); }
#else
    a.ph_lo = 0; a.ph_hi = N_PHASES;
    hipLaunchKernelGGL(fwd, dim3(grid), dim3(512), LDS_BYTES, stream, a);
#endif
}
```

```cpp
#include <hip/hip_runtime.h>
#include <cstdio>
#include <cstdint>
#define MK_PER_PHASE 0
__device__ __forceinline__ int tid_opaque() { int t = threadIdx.x; asm volatile("" : "+v"(t)); return t; }
namespace pg8 {
#define PG8_LAS __attribute__((address_space(3)))
typedef unsigned short bf16_t;
typedef short bf16x8 __attribute__((ext_vector_type(8)));
typedef float f32x4 __attribute__((ext_vector_type(4)));
typedef unsigned u32x4 __attribute__((ext_vector_type(4)));
constexpr int BM = 256, BK = 64, HALF = 128, HTB = HALF * BK * 2  , STAGE_BYTES = 8 * HTB, NXCD = 8, WGM = 8;

__host__ __device__ __forceinline__ int lds_byte(int r, int c) { const int st = (r >> 4) * 2 + (c >> 5), rr = r & 15, cc = c & 31, ob = rr * 64 + cc * 2; return st * 1024 + (ob ^ (((ob >> 9) & 1) << 5)); }
__host__ __device__ __forceinline__ void stage_rc(int b, int& R, int& C) { const int st = b / 1024, sb = b % 1024, swz = sb ^ (((sb >> 9) & 1) << 5); R = (st >> 1) * 16 + swz / 64; C = (st & 1) * 32 + (swz % 64) / 2; }
__host__ __device__ __forceinline__ int perm32(int rho) { const int n = rho >> 4, i = rho & 15; return 8 * (i >> 2) + 4 * n + (i & 3); }

struct Unit { int pm, pn; };
struct Gemm { const bf16_t* A; const bf16_t* Bt; int M, N, K; };

struct StaticOrder {
    int nM, nN, nwg, G, c;
    __host__ __device__ void init(int M, int N, int G_, int c_) { nM = M / BM; nN = N / BM; nwg = nM * nN; G = G_; c = c_; }
    __host__ __device__ bool next(int i, Unit& u) const {
        const long L = (long)i * G + c; if (L >= nwg) return false;
        int wgid = (int)L; { const int q = nwg / NXCD, r = nwg % NXCD, xcd = wgid % NXCD, off = wgid / NXCD; wgid = (xcd < r ? xcd * (q + 1) : r * (q + 1) + (xcd - r) * q) + off; }
        const int nig = WGM * nN, gid = wgid / nig, fm = gid * WGM, gsz = (nM - fm) < WGM ? (nM - fm) : WGM;
        u.pm = fm + ((wgid % nig) % gsz); u.pn = (wgid % nig) / gsz; return true;
    }
    __device__ __forceinline__ void a_ready(const Unit&) const {}
    __device__ __forceinline__ void done(const Unit&) const {}
};

typedef __bf16 hwbf16x2_t __attribute__((ext_vector_type(2))); typedef float f32x2_t __attribute__((ext_vector_type(2)));
__device__ __forceinline__ unsigned cvt_pk_bf16(float lo, float hi) { const f32x2_t v = {lo, hi}; return __builtin_bit_cast(unsigned, __builtin_convertvector(v, hwbf16x2_t)); }
struct EpiP {
    static constexpr bool PERM = true, AFTER_DRAIN = false;
    bf16_t* O; int ldc; const float* dn; int gate_lo, gate_hi;
    __device__ __forceinline__ void operator()(const f32x4 (&acc)[2][2][4][2], const Unit& u, int wr, int wc, int fr, int fq) const {
        const int row0 = u.pm * BM + wr * 64 + fr, col0 = u.pn * BM + wc * 32 + 8 * fq;
        if (u.pn >= gate_lo && u.pn < gate_hi) {
            f32x4 dv[2][2];
#pragma unroll
            for (int bj = 0; bj < 2; ++bj) { const int e0 = (wc * 32 + 8 * fq) & 127; dv[bj][0] = *(const f32x4*)(dn + e0); dv[bj][1] = *(const f32x4*)(dn + e0 + 4); }
#pragma unroll
            for (int ai = 0; ai < 2; ++ai)
#pragma unroll
                for (int m = 0; m < 4; ++m) { bf16_t* rowp = O + (size_t)(row0 + ai * HALF + m * 16) * ldc + col0;
#pragma unroll
                    for (int bj = 0; bj < 2; ++bj) { f32x4 v[2] = {acc[ai][bj][m][0], acc[ai][bj][m][1]};
#pragma unroll
                        for (int n = 0; n < 2; ++n) { const f32x4 t = v[n] * -1.4426950408889634f; f32x4 s;
#pragma unroll
                            for (int j = 0; j < 4; ++j) s[j] = __builtin_amdgcn_rcpf(1.0f + __builtin_amdgcn_exp2f(t[j]));
                            v[n] = v[n] * s * dv[bj][n]; }
                        u32x4 w; w.x = cvt_pk_bf16(v[0][0], v[0][1]); w.y = cvt_pk_bf16(v[0][2], v[0][3]); w.z = cvt_pk_bf16(v[1][0], v[1][1]); w.w = cvt_pk_bf16(v[1][2], v[1][3]);
                        *(u32x4*)(rowp + bj * HALF) = w; } }
            return;
        }
#pragma unroll
        for (int ai = 0; ai < 2; ++ai)
#pragma unroll
            for (int m = 0; m < 4; ++m) { bf16_t* rowp = O + (size_t)(row0 + ai * HALF + m * 16) * ldc + col0;
#pragma unroll
                for (int bj = 0; bj < 2; ++bj) { const f32x4 v0 = acc[ai][bj][m][0], v1 = acc[ai][bj][m][1];
                    u32x4 w; w.x = cvt_pk_bf16(v0[0], v0[1]); w.y = cvt_pk_bf16(v0[2], v0[3]); w.z = cvt_pk_bf16(v1[0], v1[1]); w.w = cvt_pk_bf16(v1[2], v1[3]);
                    *(u32x4*)(rowp + bj * HALF) = w; } }
    }
};
struct EpiY {
    static constexpr bool PERM = true, AFTER_DRAIN = false;
    bf16_t* O; int ldc; float* part;
    __device__ __forceinline__ void operator()(const f32x4 (&acc)[2][2][4][2], const Unit& u, int wr, int wc, int fr, int fq) const {
        const int row0 = u.pm * BM + wr * 64 + fr, col0 = u.pn * BM + wc * 32 + 8 * fq;
#pragma unroll
        for (int ai = 0; ai < 2; ++ai)
#pragma unroll
            for (int m = 0; m < 4; ++m) { const int row = row0 + ai * HALF + m * 16; bf16_t* rowp = O + (size_t)row * ldc + col0; float s = 0.f;
#pragma unroll
                for (int bj = 0; bj < 2; ++bj) { const f32x4 v0 = acc[ai][bj][m][0], v1 = acc[ai][bj][m][1];
                    s += (v0[0] * v0[0] + v0[1] * v0[1]) + (v0[2] * v0[2] + v0[3] * v0[3]) + (v1[0] * v1[0] + v1[1] * v1[1]) + (v1[2] * v1[2] + v1[3] * v1[3]);
                    u32x4 w; w.x = cvt_pk_bf16(v0[0], v0[1]); w.y = cvt_pk_bf16(v0[2], v0[3]); w.z = cvt_pk_bf16(v1[0], v1[1]); w.w = cvt_pk_bf16(v1[2], v1[3]);
                    *(u32x4*)(rowp + bj * HALF) = w; }
                s += __shfl_xor(s, 16); s += __shfl_xor(s, 32);
                if (fq == 0) part[(size_t)row * 64 + u.pn * 4 + wc] = s; }
    }
};

template <class Epi, class Sched, bool ALIGN_EPI = false, bool SP2 = false>
__device__ __forceinline__ void gemm_phase(PG8_LAS unsigned char* lds, const Gemm g, const Sched& S, const Epi& E) {
    const int tid = tid_opaque(), wid = __builtin_amdgcn_readfirstlane(tid >> 6), lane = tid & 63, wr = wid >> 2, wc = wid & 3, fr = lane & 15, fq = lane >> 4;
    const int K = g.K, nt = K / BK;
    unsigned voffA[2], voffB[2];
#pragma unroll
    for (int i = 0; i < 2; ++i) { int R, C; stage_rc(tid * 16 + i * 8192, R, C); const int Rb = Epi::PERM ? ((R & ~31) + perm32(R & 31)) : R;
        voffA[i] = (unsigned)(R * K + C) * 2u; voffB[i] = (unsigned)(Rb * K + C) * 2u; }
    const size_t kstep = (size_t)(BK * 2);
    const size_t hstep = (size_t)HALF * K * 2;
    const size_t tstep = 2 * hstep;
    const unsigned ldsw = (unsigned)wid * 1024u;
    const int aoff = lds_byte(wr * 64 + fr, fq * 8), boff = lds_byte(wc * 32 + fr, fq * 8);
#define PG8_SA(b, h) (((b) * 2 + (h)) * HTB)
#define PG8_SB(b, h) ((4 + (b) * 2 + (h)) * HTB)
#define PG8_STAGE(bufoff, gbase, voff) do { _Pragma("unroll") for (int _i = 0; _i < 2; ++_i) \
        __builtin_amdgcn_global_load_lds((const unsigned*)((const char*)(gbase) + (voff)[_i]), (PG8_LAS unsigned*)(lds + (bufoff) + ldsw + _i * 8192), 16, 0, 0); } while (0)
#define PG8_LDA(dst, b, h) do { _Pragma("unroll") for (int m = 0; m < 4; ++m) _Pragma("unroll") for (int k = 0; k < 2; ++k) dst[m][k] = *(const PG8_LAS bf16x8*)(lds + PG8_SA(b, h) + aoff + m * 2048 + k * 1024); } while (0)
#define PG8_LDB(dst, b, h) do { _Pragma("unroll") for (int n = 0; n < 2; ++n) _Pragma("unroll") for (int k = 0; k < 2; ++k) dst[n][k] = *(const PG8_LAS bf16x8*)(lds + PG8_SB(b, h) + boff + n * 2048 + k * 1024); } while (0)
#define PG8_MMA(ai, bj, At, Bt) do { __builtin_amdgcn_s_setprio(1); _Pragma("unroll") for (int m = 0; m < 4; ++m) _Pragma("unroll") for (int n = 0; n < 2; ++n) _Pragma("unroll") for (int k = 0; k < 2; ++k) \
        acc[ai][bj][m][n] = __builtin_amdgcn_mfma_f32_16x16x32_bf16(Bt[n][k], At[m][k], acc[ai][bj][m][n], 0, 0, 0); __builtin_amdgcn_s_setprio(0); } while (0)
#define PG8_WAIT_V(n) asm volatile("s_waitcnt vmcnt(" #n ")" ::: "memory")
#define PG8_WAIT_L(n) asm volatile("s_waitcnt lgkmcnt(" #n ")" ::: "memory")
#define PG8_BAR __builtin_amdgcn_s_barrier()
#define PG8_SCHED __builtin_amdgcn_sched_barrier(0)
    Unit cur, nxt; int ui = 0;
    if (!S.next(0, cur)) return;
    f32x4 acc[2][2][4][2];
#pragma unroll
    for (int a = 0; a < 2; ++a)
#pragma unroll
        for (int b = 0; b < 2; ++b)
#pragma unroll
            for (int m = 0; m < 4; ++m)
#pragma unroll
                for (int n = 0; n < 2; ++n) acc[a][b][m][n] = (f32x4){0.f, 0.f, 0.f, 0.f};
    bf16x8 At[4][2], B0[2][2], B1[2][2];
    const char* cA = (const char*)g.A + (size_t)cur.pm * tstep; const char* cB = (const char*)g.Bt + (size_t)cur.pn * tstep;
    S.a_ready(cur);
    if constexpr (SP2) {
        PG8_STAGE(PG8_SB(0, 0), cB, voffB); PG8_STAGE(PG8_SB(0, 1), cB + hstep, voffB); PG8_STAGE(PG8_SA(0, 0), cA, voffA); PG8_STAGE(PG8_SA(0, 1), cA + hstep, voffA);
        if (wr == 1) PG8_BAR;
        PG8_WAIT_V(2); PG8_BAR;
        PG8_STAGE(PG8_SB(1, 0), cB + kstep, voffB); PG8_STAGE(PG8_SA(1, 0), cA + kstep, voffA); PG8_STAGE(PG8_SB(1, 1), cB + hstep + kstep, voffB);
        PG8_WAIT_V(6); PG8_BAR;
    } else {
        PG8_STAGE(PG8_SB(0, 0), cB, voffB); PG8_STAGE(PG8_SA(0, 0), cA, voffA); PG8_STAGE(PG8_SB(0, 1), cB + hstep, voffB); PG8_STAGE(PG8_SA(0, 1), cA + hstep, voffA);
        if (wr == 1) PG8_BAR;
        PG8_WAIT_V(4); PG8_BAR;
        PG8_STAGE(PG8_SB(1, 0), cB + kstep, voffB); PG8_STAGE(PG8_SA(1, 0), cA + kstep, voffA); PG8_STAGE(PG8_SB(1, 1), cB + hstep + kstep, voffB);
        PG8_WAIT_V(6); PG8_BAR;
    }
    for (;;) {
        const bool has_next = S.next(ui + 1, nxt);
        const char* nA = has_next ? (const char*)g.A + (size_t)nxt.pm * tstep : cA; const char* nB = has_next ? (const char*)g.Bt + (size_t)nxt.pn * tstep : cB;
        for (int t = 0; t < nt; t += 2) {
            const bool last = (t == nt - 2);
            const char* a1 = cA + (size_t)(t + 1) * kstep;
            const char* a2 = last ? nA : cA + (size_t)(t + 2) * kstep; const char* b2 = last ? nB : cB + (size_t)(t + 2) * kstep;
            const char* a3 = a2 + kstep; const char* b3 = b2 + kstep;
            if (last && has_next) S.a_ready(nxt);
            if constexpr (SP2) {
            PG8_LDB(B0, 0, 0); PG8_LDB(B1, 0, 1); PG8_SCHED; PG8_LDA(At, 0, 0); PG8_STAGE(PG8_SA(1, 1), a1 + hstep, voffA);
            PG8_WAIT_V(8); PG8_WAIT_L(0); PG8_BAR; PG8_MMA(0, 0, At, B0); PG8_MMA(0, 1, At, B1); PG8_BAR; PG8_SCHED;
            PG8_LDA(At, 0, 1); PG8_STAGE(PG8_SB(0, 0), b2, voffB); PG8_STAGE(PG8_SB(0, 1), b2 + hstep, voffB); PG8_STAGE(PG8_SA(0, 0), a2, voffA);
            PG8_WAIT_V(8); PG8_WAIT_L(0); PG8_BAR; PG8_MMA(1, 0, At, B0); PG8_MMA(1, 1, At, B1); PG8_BAR; PG8_SCHED;
            PG8_LDB(B0, 1, 0); PG8_LDB(B1, 1, 1); PG8_SCHED; PG8_LDA(At, 1, 0); PG8_STAGE(PG8_SA(0, 1), a2 + hstep, voffA);
            PG8_WAIT_V(8); PG8_WAIT_L(0); PG8_BAR; PG8_MMA(0, 0, At, B0); PG8_MMA(0, 1, At, B1); PG8_BAR; PG8_SCHED;
            PG8_LDA(At, 1, 1); PG8_STAGE(PG8_SB(1, 0), b3, voffB); PG8_STAGE(PG8_SB(1, 1), b3 + hstep, voffB); PG8_STAGE(PG8_SA(1, 0), a3, voffA);
            PG8_WAIT_V(8); PG8_WAIT_L(0); PG8_BAR; PG8_MMA(1, 0, At, B0); PG8_MMA(1, 1, At, B1); PG8_BAR; PG8_SCHED;
            } else {
            PG8_LDB(B0, 0, 0); PG8_SCHED; PG8_LDA(At, 0, 0); PG8_STAGE(PG8_SA(1, 1), a1 + hstep, voffA);
            PG8_WAIT_L(8); PG8_BAR; PG8_WAIT_L(0); PG8_MMA(0, 0, At, B0); PG8_BAR; PG8_SCHED;
            PG8_LDB(B1, 0, 1); PG8_STAGE(PG8_SB(0, 0), b2, voffB);
            PG8_BAR; PG8_WAIT_L(0); PG8_MMA(0, 1, At, B1); PG8_BAR;
            PG8_LDA(At, 0, 1); PG8_STAGE(PG8_SA(0, 0), a2, voffA);
            PG8_BAR; PG8_WAIT_L(0); PG8_MMA(1, 0, At, B0); PG8_BAR; PG8_SCHED;
            PG8_STAGE(PG8_SB(0, 1), b2 + hstep, voffB);
            PG8_WAIT_V(6); PG8_BAR; PG8_MMA(1, 1, At, B1); PG8_BAR;
            PG8_LDB(B0, 1, 0); PG8_SCHED; PG8_LDA(At, 1, 0); PG8_STAGE(PG8_SA(0, 1), a2 + hstep, voffA);
            PG8_WAIT_L(8); PG8_BAR; PG8_WAIT_L(0); PG8_MMA(0, 0, At, B0); PG8_BAR; PG8_SCHED;
            PG8_LDB(B1, 1, 1); PG8_STAGE(PG8_SB(1, 0), b3, voffB);
            PG8_BAR; PG8_WAIT_L(0); PG8_MMA(0, 1, At, B1); PG8_BAR;
            PG8_LDA(At, 1, 1); PG8_STAGE(PG8_SA(1, 0), a3, voffA);
            PG8_BAR; PG8_WAIT_L(0); PG8_MMA(1, 0, At, B0); PG8_BAR; PG8_SCHED;
            PG8_STAGE(PG8_SB(1, 1), b3 + hstep, voffB);
            PG8_WAIT_V(6); PG8_BAR; PG8_MMA(1, 1, At, B1); PG8_BAR;
            }
        }
        if constexpr (ALIGN_EPI) { if (wr == 0) PG8_BAR; }
        if constexpr (!Epi::AFTER_DRAIN) { E(acc, cur, wr, wc, fr, fq); S.done(cur); }
        if (!has_next) break;
#pragma unroll
        for (int a = 0; a < 2; ++a)
#pragma unroll
            for (int b = 0; b < 2; ++b)
#pragma unroll
                for (int m = 0; m < 4; ++m)
#pragma unroll
                    for (int n = 0; n < 2; ++n) acc[a][b][m][n] = (f32x4){0.f, 0.f, 0.f, 0.f};
        cur = nxt; cA = nA; cB = nB; ++ui;
        if constexpr (ALIGN_EPI) { if (wr == 1) PG8_BAR; }
    }
    PG8_WAIT_V(0);
    if constexpr (!ALIGN_EPI) { if (wr == 0) PG8_BAR; }
    PG8_BAR;
    if constexpr (Epi::AFTER_DRAIN) { E.fused(acc, cur, wr, wc, fr, fq, lds, wid, lane); S.done(cur); }
#undef PG8_SA
#undef PG8_SB
#undef PG8_STAGE
#undef PG8_LDA
#undef PG8_LDB
#undef PG8_MMA
#undef PG8_WAIT_V
#undef PG8_WAIT_L
#undef PG8_BAR
#undef PG8_SCHED
}
}

#define GAS __attribute__((address_space(1)))
#define LAS __attribute__((address_space(3)))
typedef unsigned short bf16;
typedef short bf16x8 __attribute__((ext_vector_type(8)));
typedef short bf16x4 __attribute__((ext_vector_type(4)));
typedef float f32x4 __attribute__((ext_vector_type(4)));
typedef float f32x2 __attribute__((ext_vector_type(2)));
typedef unsigned u32x4 __attribute__((ext_vector_type(4)));
typedef unsigned u32x2 __attribute__((ext_vector_type(2)));

constexpr int D = 4096, NB = 4, T = 4096, NSB = 16, TS = 16, PAST = 2048;
constexpr int MP = NB * T, MS = NSB * TS, M = MP + MS;
constexpr int NP = 13056, IN_DIM = 12832;
constexpr int C_Q = 0, C_K = 2048, C_V = 4096, C_ZDN = 6144, C_AQ = 8192, C_AK = 10240, C_AV = 10496, C_AZ = 10752, C_B = 12800, C_A = 12816;
constexpr float EPS = 1e-6f;
constexpr size_t O_YP = 0, O_YS = O_YP + (size_t)MP * D, O_CONVP = O_YS + (size_t)MS * D, O_DNP = O_CONVP + 2 * 4 * 3 * 6144, O_KP = O_DNP + 2 * 4 * 16 * 128 * 128,
                 O_VP = O_KP + 2 * 4 * 128 * 256, O_CONVS = O_VP + 2 * 4 * 128 * 256, O_DNS = O_CONVS + 2 * 16 * 3 * 6144, O_KS = O_DNS + (size_t)2 * 16 * 16 * 128 * 128,
                 O_VS = O_KS + 2 * 16 * 128 * 256, O_END = O_VS + 2 * 16 * 128 * 256;
static_assert(O_END == 82001920, "output size");
constexpr size_t MiB = 1u << 20;
constexpr size_t WS_CTL = 0, CTL_ZERO_BYTES = 1 * MiB;
constexpr size_t WS_MOD = 1 * MiB;
constexpr size_t WS_ROPE = 3 * MiB;
constexpr size_t WS_DEC = 4 * MiB;
constexpr size_t WS_YSQ = 5 * MiB;
constexpr size_t WS_BIN = 10 * MiB;
constexpr size_t BIN_BYTES = (size_t)NP * 4096 * 2;
constexpr size_t WS_BOUT = 214 * MiB;
constexpr size_t BOUT_BYTES = (size_t)4096 * 4096 * 2;
constexpr size_t WS_HO = 278 * MiB;
constexpr size_t WS_P = 408 * MiB;
constexpr size_t WS_REC = 823 * MiB;
constexpr int REC_W = 0, REC_QD = 16384, REC_KD = 32768, REC_QK = 49152, REC_U = 57344, REC_BYTES = 73728, REC_STAGE = 57344;
constexpr int NREC = 4096 + 256;
constexpr size_t WS_YS = WS_REC + (size_t)NREC * REC_BYTES;
constexpr size_t WS_END = WS_YS + (size_t)MS * D * 2;
constexpr int CW_C2DONE = 3072;
static_assert(WS_BIN + 2 * BIN_BYTES <= WS_BOUT && WS_HO + (size_t)M * D * 2 <= WS_P && WS_P + (size_t)M * NP * 2 <= WS_REC, "ws map");
constexpr int CW_BAR = 4096;
constexpr int LDS_BYTES = 147456;
constexpr int MISC_OFF = 147456 - 256;

#define RLX_AGENT __ATOMIC_RELAXED, __HIP_MEMORY_SCOPE_AGENT
#define LDS_WAIT() asm volatile("s_waitcnt lgkmcnt(0)" ::: "memory")
#define VM_WAIT() asm volatile("s_waitcnt vmcnt(0)" ::: "memory")
#define BAR_LDS() do { asm volatile("s_waitcnt lgkmcnt(0)" ::: "memory"); __builtin_amdgcn_s_barrier(); asm volatile("" ::: "memory"); } while (0)
typedef __bf16 hwbf16x2 __attribute__((ext_vector_type(2)));
__device__ __forceinline__ unsigned cvtpk(float lo, float hi) { const f32x2 v = {lo, hi}; return __builtin_bit_cast(unsigned, __builtin_convertvector(v, hwbf16x2)); }
__device__ __forceinline__ float bflo(unsigned w) { return __uint_as_float(w << 16); }
__device__ __forceinline__ float bfhi(unsigned w) { return __uint_as_float(w & 0xffff0000u); }
__device__ __forceinline__ float bf1(bf16 h) { return __uint_as_float(((unsigned)h) << 16); }
__device__ __forceinline__ float silu_f(float x) { return x * __builtin_amdgcn_rcpf(1.0f + __expf(-x)); }
__device__ __forceinline__ float sigmoid_f(float x) { return __builtin_amdgcn_rcpf(1.0f + __expf(-x)); }
__device__ __forceinline__ float sum16(float v) {
    v += __builtin_bit_cast(float, __builtin_amdgcn_update_dpp(0, __builtin_bit_cast(int, v), 0xB1, 0xf, 0xf, true));
    v += __builtin_bit_cast(float, __builtin_amdgcn_update_dpp(0, __builtin_bit_cast(int, v), 0x4E, 0xf, 0xf, true));
    v += __builtin_bit_cast(float, __builtin_amdgcn_update_dpp(0, __builtin_bit_cast(int, v), 0x141, 0xf, 0xf, true));
    v += __builtin_bit_cast(float, __builtin_amdgcn_update_dpp(0, __builtin_bit_cast(int, v), 0x140, 0xf, 0xf, true));
    return v;
}
__device__ __forceinline__ float quadsum16(const f32x4 q, int fr) {
    const bool o1 = fr & 1, o2 = fr & 2;
    float kA = o1 ? q[1] : q[0], sA = o1 ? q[0] : q[1], kB = o1 ? q[3] : q[2], sB = o1 ? q[2] : q[3];
    kA += __builtin_bit_cast(float, __builtin_amdgcn_update_dpp(0, __builtin_bit_cast(int, sA), 0xB1, 0xf, 0xf, true));
    kB += __builtin_bit_cast(float, __builtin_amdgcn_update_dpp(0, __builtin_bit_cast(int, sB), 0xB1, 0xf, 0xf, true));
    float k = o2 ? kB : kA; const float s = o2 ? kA : kB;
    k += __builtin_bit_cast(float, __builtin_amdgcn_update_dpp(0, __builtin_bit_cast(int, s), 0x4E, 0xf, 0xf, true));
    k += __builtin_bit_cast(float, __builtin_amdgcn_update_dpp(0, __builtin_bit_cast(int, k), 0x124, 0xf, 0xf, true));
    k += __builtin_bit_cast(float, __builtin_amdgcn_update_dpp(0, __builtin_bit_cast(int, k), 0x128, 0xf, 0xf, true));
    return k;
}
__device__ __forceinline__ float wave_sum(float v) { v = sum16(v); v += __shfl_xor(v, 16); v += __shfl_xor(v, 32); return v; }
__device__ __forceinline__ float wave_max(float v) {
#pragma unroll
    for (int o = 1; o < 64; o <<= 1) v = fmaxf(v, __shfl_xor(v, o));
    return v;
}
__device__ __forceinline__ void unpack8(const u32x4 w, float (&f)[8]) {
    f[0] = bflo(w.x); f[1] = bfhi(w.x); f[2] = bflo(w.y); f[3] = bfhi(w.y); f[4] = bflo(w.z); f[5] = bfhi(w.z); f[6] = bflo(w.w); f[7] = bfhi(w.w);
}
__device__ __forceinline__ u32x4 pack8(const float (&f)[8]) { u32x4 w; w.x = cvtpk(f[0], f[1]); w.y = cvtpk(f[2], f[3]); w.z = cvtpk(f[4], f[5]); w.w = cvtpk(f[6], f[7]); return w; }
__device__ __forceinline__ u32x4 pack8v(const f32x2 (&f)[4]) { u32x4 w; w.x = cvtpk(f[0].x, f[0].y); w.y = cvtpk(f[1].x, f[1].y); w.z = cvtpk(f[2].x, f[2].y); w.w = cvtpk(f[3].x, f[3].y); return w; }
__device__ __forceinline__ bf16x8 as_bf16x8(const u32x4 w) { return __builtin_bit_cast(bf16x8, w); }
__device__ __forceinline__ bf16x4 as_bf16x4(const u32x2 w) { return __builtin_bit_cast(bf16x4, w); }

#define XB_TMO      128
#define XB_XCNT(j)  (256  + 64 * (j))
#define XB_XSUB(j)  (1280 + 64 * (j))
#define XB_XGEN(j)  (2304 + 64 * (j))
#define XB_TOP      3328
#define XB_TOPGEN   3392
#define XCD_BAR_WORDS 3456
#define XB_SPIN_CAP (1u << 18)

__device__ __forceinline__ unsigned xb_ld(unsigned* p)              { return __hip_atomic_load(p, __ATOMIC_RELAXED, __HIP_MEMORY_SCOPE_AGENT); }
__device__ __forceinline__ unsigned xb_add(unsigned* p, unsigned v) { return __hip_atomic_fetch_add(p, v, __ATOMIC_RELAXED, __HIP_MEMORY_SCOPE_AGENT); }
__device__ __forceinline__ unsigned xb_xcc_id() { return (unsigned)__builtin_amdgcn_s_getreg((3 << 11) | 20) & 0xFu; }
#define XB_SPIN(cond, bar) do { unsigned _sp = 0; while (cond) { __builtin_amdgcn_s_sleep(1); \
    if ((++_sp & 255u) == 0u) { if (xb_ld(&(bar)[XB_TMO])) break; if (_sp > XB_SPIN_CAP) { atomicAdd(&(bar)[XB_TMO], 1u); break; } } } } while (0)

struct XcdBarrier {
    unsigned* bar; unsigned x;
    volatile LAS unsigned* st;
};

__device__ __forceinline__ XcdBarrier xcd_barrier_post(unsigned* bar, volatile LAS unsigned* st) {
    XcdBarrier b; b.bar = bar; b.x = xb_xcc_id(); b.st = st;
    if (threadIdx.x == 0) (void)xb_add(&bar[XB_XCNT(b.x)], 1u);
    return b;
}
__device__ __forceinline__ void xcd_barrier_complete(unsigned* bar, unsigned x, unsigned& nloc, unsigned& nx) {
    const unsigned G = gridDim.x * gridDim.y * gridDim.z;
    unsigned sum, cnt, mine, sp = 0u;
    for (;;) {
        sum = 0u; cnt = 0u; mine = 0u;
#pragma unroll
        for (unsigned j = 0; j < 16; ++j) { const unsigned c = xb_ld(&bar[XB_XCNT(j)]); sum += c; cnt += (c > 0u) ? 1u : 0u; mine = (j == x) ? c : mine; }
        if (sum == G) break;
        __builtin_amdgcn_s_sleep(1);
        if ((++sp & 255u) == 0u) { if (xb_ld(&bar[XB_TMO])) break; if (sp > XB_SPIN_CAP) { atomicAdd(&bar[XB_TMO], 1u); break; } }
    }
    nloc = mine > 0u ? mine : 1u; nx = cnt > 0u ? cnt : 1u;
}

__device__ __forceinline__ void xcd_barrier(const XcdBarrier& b) {
    asm volatile("s_waitcnt vmcnt(0)" ::: "memory");
    __syncthreads();
    if (threadIdx.x == 0) {
        unsigned* bar = b.bar;
        __builtin_amdgcn_s_waitcnt(0);
        unsigned nloc = b.st[0], nx = b.st[1];
        if (nloc == 0u) { xcd_barrier_complete(bar, b.x, nloc, nx); b.st[0] = nloc; b.st[1] = nx; }
        const unsigned old = xb_add(&bar[XB_XSUB(b.x)], 1u);
        const unsigned gen = old / nloc;
        if (old + 1u == (gen + 1u) * nloc) {
            __builtin_amdgcn_fence(__ATOMIC_RELEASE, "agent");
            asm volatile("s_waitcnt vmcnt(0)" ::: "memory");
            const unsigned og = xb_add(&bar[XB_TOP], 1u);
            const unsigned tg = og / nx;
            if (og + 1u == (tg + 1u) * nx) xb_add(&bar[XB_TOPGEN], 1u);
            else XB_SPIN(xb_ld(&bar[XB_TOPGEN]) == tg, bar);
            __builtin_amdgcn_fence(__ATOMIC_ACQUIRE, "agent");
            xb_add(&bar[XB_XGEN(b.x)], 1u);
            asm volatile("s_waitcnt vmcnt(0)" ::: "memory");
        } else {
            XB_SPIN(xb_ld(&bar[XB_XGEN(b.x)]) == gen, bar);
            __builtin_amdgcn_fence(__ATOMIC_ACQUIRE, "agent");
            asm volatile("s_waitcnt vmcnt(0)" ::: "memory");
        }
    }
    __syncthreads();
}

struct Args { const float* in[19]; float* out; unsigned char* ws; int ph_lo, ph_hi; };

__device__ __forceinline__ void p0_transpose_item(const float* W, int K, int N, bf16* WT, int dst_row0, LAS float* scr, int k0, int n0, int lane) {
    const int r8 = lane >> 3, c4 = lane & 7;
    f32x4 v[8];
#pragma unroll
    for (int i = 0; i < 8; ++i) v[i] = *(const f32x4*)(W + (size_t)(k0 + 8 * i + r8) * N + n0 + 4 * c4);
#pragma unroll
    for (int i = 0; i < 8; ++i) { LAS float* d = scr + (8 * i + r8) * 33 + 4 * c4; d[0] = v[i][0]; d[1] = v[i][1]; d[2] = v[i][2]; d[3] = v[i][3]; }
    LDS_WAIT(); asm volatile("" ::: "memory");
    const int c = lane & 7;
#pragma unroll
    for (int j = 0; j < 4; ++j) { const int n = (lane >> 3) + 8 * j; const LAS float* s = scr + (8 * c) * 33 + n;
        u32x4 o; o.x = cvtpk(s[0 * 33], s[1 * 33]); o.y = cvtpk(s[2 * 33], s[3 * 33]); o.z = cvtpk(s[4 * 33], s[5 * 33]); o.w = cvtpk(s[6 * 33], s[7 * 33]);
        *(u32x4*)(WT + (size_t)(dst_row0 + n) * K + k0 + 8 * c) = o; }
    LDS_WAIT(); asm volatile("" ::: "memory");
}
__device__ __forceinline__ void prologue_work(const Args& a, LAS unsigned char* lds, int vb, int nvb, int ada_mask, int tr_mask, bool rope) {
    const int tid = tid_opaque(), lane = tid & 63, wave = tid >> 6;
    {
        const float* cp = a.in[6]; const float* cs = a.in[7]; const float* w_ada = a.in[8]; const float* b_ada = a.in[9];
        float* mod = (float*)(a.ws + WS_MOD);
        LAS float* sc = (LAS float*)lds;
        LAS float* red = (LAS float*)(lds + 40960);
        const int cgp = tid & 7, ksl = tid >> 3;
        const int it0 = (ada_mask & 1) ? 0 : 384, it1 = (ada_mask & 2) ? 768 : 384;
        for (int it = it0 + vb; it < it1 && ada_mask; it += nvb) {
            const int l = it / 384, col0 = (it % 384) * 32;
            f32x4 acc[20];
#pragma unroll
            for (int j = 0; j < 20; ++j) acc[j] = (f32x4){0.f, 0.f, 0.f, 0.f};
            for (int kt = 0; kt < 8; ++kt) {
                __syncthreads();
#pragma unroll
                for (int j = 0; j < 20; ++j) { const float cv = (j < 4) ? cp[j * 4096 + kt * 512 + tid] : cs[(j - 4) * 4096 + kt * 512 + tid]; sc[tid * 20 + j] = silu_f(cv); }
                __syncthreads();
                const float* wp = w_ada + ((size_t)l * 4096 + kt * 512 + ksl * 8) * 12288 + col0 + cgp * 4;
                f32x4 w[8];
#pragma unroll
                for (int kk = 0; kk < 8; ++kk) w[kk] = *(const f32x4*)(wp + (size_t)kk * 12288);
#pragma unroll
                for (int kk = 0; kk < 8; ++kk) {
                    const LAS f32x4* s4 = (const LAS f32x4*)(sc + (ksl * 8 + kk) * 20);
#pragma unroll
                    for (int j4 = 0; j4 < 5; ++j4) { const f32x4 s = s4[j4];
#pragma unroll
                        for (int jj = 0; jj < 4; ++jj) acc[j4 * 4 + jj] += s[jj] * w[kk]; }
                }
            }
#pragma unroll
            for (int j = 0; j < 20; ++j)
#pragma unroll
                for (int c = 0; c < 4; ++c) { float v = acc[j][c]; v += __shfl_xor(v, 8); v += __shfl_xor(v, 16); v += __shfl_xor(v, 32); acc[j][c] = v; }
            __syncthreads();
            if (lane < 8) {
#pragma unroll
                for (int j = 0; j < 20; ++j) *(LAS f32x4*)(red + (wave * 20 + j) * 32 + lane * 4) = acc[j];
            }
            __syncthreads();
            for (int o = tid; o < 640; o += 512) { const int j = o >> 5, c = o & 31; float s = 0.f;
#pragma unroll
                for (int w8 = 0; w8 < 8; ++w8) s += red[(w8 * 20 + j) * 32 + c];
                mod[((size_t)l * 20 + j) * 12288 + col0 + c] = s + b_ada[(size_t)l * 12288 + col0 + c]; }
        }
        __syncthreads();
    }
    {
        LAS float* scr = (LAS float*)(lds + wave * 8448);
        const int gw = vb * 8 + wave, NGW = nvb * 8;
        constexpr int I_IN = 64 * 401, I_OUT = 64 * 128;
#pragma unroll 1
        for (int mtx = 0; mtx < 4; ++mtx) {
            if (!((tr_mask >> mtx) & 1)) continue;
            const int l = mtx >> 1;
            if ((mtx & 1) == 0) {
                for (int r = gw; r < I_IN; r += NGW) { const int kb = r / 401, nb = r % 401, n0 = nb * 32; const int dst = (n0 < 8192) ? n0 : ((n0 < 8224) ? (C_B + (n0 - 8192)) : (n0 - 32));
                    p0_transpose_item(a.in[12] + (size_t)l * 4096 * IN_DIM, 4096, IN_DIM, (bf16*)(a.ws + WS_BIN + l * BIN_BYTES), dst, scr, kb * 64, n0, lane); }
                constexpr int ZU = (NP - IN_DIM) * 4096 * 2 / 16;
                for (int u = vb * 512 + tid; u < ZU; u += nvb * 512) *(u32x4*)(a.ws + WS_BIN + l * BIN_BYTES + (size_t)IN_DIM * 4096 * 2 + (size_t)u * 16) = (u32x4){0u, 0u, 0u, 0u};
            } else {
                for (int r = gw; r < I_OUT; r += NGW) { const int kb = r / 128, nb = r % 128;
                    p0_transpose_item(a.in[18] + (size_t)l * 4096 * 4096, 4096, 4096, (bf16*)(a.ws + WS_BOUT + l * BOUT_BYTES), nb * 32, scr, kb * 64, nb * 32, lane); }
            }
        }
        if (rope) { f32x2* rt = (f32x2*)(a.ws + WS_ROPE);
            for (int idx = vb * 512 + tid; idx < 4096 * 32; idx += nvb * 512) { const int pos = idx >> 5, i = idx & 31;
                const double inv = exp2(-(double)i * (13.287712379549449 / 32.0)); const double ang = (double)pos * inv;
                rt[idx] = (f32x2){(float)cos(ang), (float)sin(ang)}; } }
    }
}
#ifndef SPLIT_PROLOGUE
#define SPLIT_PROLOGUE 0
#endif
__device__ __forceinline__ void phase_prologue(const Args& a, LAS unsigned char* lds, int G) {
#if SPLIT_PROLOGUE
    prologue_work(a, lds, (int)blockIdx.x, G, 1, 0x7, true);
#else
    prologue_work(a, lds, (int)blockIdx.x, G, 3, 0xF, true);
#endif
}

__device__ __forceinline__ int row_j(int row) { return (row < MP) ? (row >> 12) : (4 + ((row - MP) >> 4)); }
__device__ __forceinline__ void stage_params(const Args& a, LAS float* pl, int tid, int mode  , int j) {
    const float* mod = (const float*)(a.ws + WS_MOD); const float* g_pre = a.in[10]; const float* g_post = a.in[11];
    for (int c = tid * 4; c < D; c += 2048) {
        if (mode == 0) { const float* mr = mod + (size_t)j * 12288;
            *(LAS f32x4*)(pl + 4096 + c) = *(const f32x4*)(g_pre + c) * (*(const f32x4*)(mr + 4096 + c) + 1.0f); *(LAS f32x4*)(pl + 8192 + c) = *(const f32x4*)(mr + c); }
        else { const int l = mode - 1; const float* mr = mod + ((size_t)l * 20 + j) * 12288;
            *(LAS f32x4*)(pl + c) = *(const f32x4*)(mr + 8192 + c) * *(const f32x4*)(g_post + (size_t)l * D + c);
            if (l == 0) { const float* m1 = mod + ((size_t)20 + j) * 12288;
                *(LAS f32x4*)(pl + 4096 + c) = *(const f32x4*)(g_pre + D + c) * (*(const f32x4*)(m1 + 4096 + c) + 1.0f); *(LAS f32x4*)(pl + 8192 + c) = *(const f32x4*)(m1 + c); } }
    }
}
template <int mode> __device__ __forceinline__ void phase_rows(const Args& a, LAS unsigned char* lds, int G) {
    const int tid = tid_opaque(), wave = tid >> 6;
    LAS float* pl = (LAS float*)lds;
    const bf16* Y = (const bf16*)(a.ws + WS_P); const float* ysq = (const float*)(a.ws + WS_YSQ);
    bf16* H = (bf16*)(a.ws + WS_HO);
    const int rpb = (M + G - 1) / G;
    const int r0 = blockIdx.x * rpb, r1 = (r0 + rpb < M) ? r0 + rpb : M;
    int cur_a = -1, cur_b = -1;
    f32x4 xn[16]; u32x2 yn[16]; float ysn = 0.f;
#define ROW_LOAD(row_) do { const int lane_ = tid_opaque() & 63; float* orow_ = ((row_) < MP) ? a.out + O_YP + (size_t)(row_) * D : a.out + O_YS + (size_t)((row_) - MP) * D; \
        const float* xr_ = (mode == 2) ? orow_ : (((row_) < MP) ? a.in[0] + (size_t)(row_) * D : a.in[1] + (size_t)((row_) - MP) * D); \
        if (mode == 2) { _Pragma("unroll") for (int q = 0; q < 16; ++q) { const u32x2 xb_ = *(const u32x2*)((const bf16*)orow_ + 4 * lane_ + 256 * q); xn[q] = (f32x4){bflo(xb_.x), bfhi(xb_.x), bflo(xb_.y), bfhi(xb_.y)}; } } \
        else { _Pragma("unroll") for (int q = 0; q < 16; ++q) xn[q] = *(const f32x4*)(xr_ + 4 * lane_ + 256 * q); } \
        if (mode != 0) { const bf16* yrow_ = ((row_) < MP) ? Y + (size_t)(row_) * D : (const bf16*)(a.ws + WS_YS) + (size_t)((row_) - MP) * D; \
            _Pragma("unroll") for (int q = 0; q < 16; ++q) yn[q] = *(const u32x2*)(yrow_ + 4 * lane_ + 256 * q); \
            ysn = ysq[(size_t)(row_) * 64 + lane_]; } } while (0)
    if (r0 + wave < r1) ROW_LOAD(r0 + wave);
    for (int rb = r0; rb < r1; rb += 8) {
        const int ja = row_j(rb), jb = row_j((rb + 7 < r1) ? rb + 7 : r1 - 1);
        if (ja != cur_a || jb != cur_b) { BAR_LDS(); stage_params(a, pl, tid, mode, ja); if (jb != ja) stage_params(a, pl + 12288, tid, mode, jb); cur_a = ja; cur_b = jb; BAR_LDS(); }
        const int row = rb + wave;
        if (row >= r1) continue;
        const int lane = tid_opaque() & 63;
        const LAS float* plw = pl + ((row_j(row) == ja) ? 0 : 12288);
        float* orow = (row < MP) ? a.out + O_YP + (size_t)row * D : a.out + O_YS + (size_t)(row - MP) * D;
        f32x4 v[16]; u32x2 yw[16]; float ysc = ysn;
#pragma unroll
        for (int q = 0; q < 16; ++q) { v[q] = xn[q]; yw[q] = yn[q]; }
        if (row + 8 < r1) ROW_LOAD(row + 8);
        float s = 0.f;
        if (mode == 0) {
#pragma unroll
            for (int q = 0; q < 16; ++q) s += (v[q][0] * v[q][0] + v[q][1] * v[q][1]) + (v[q][2] * v[q][2] + v[q][3] * v[q][3]);
        } else {
            const float rstd_y = rsqrtf(wave_sum(ysc) * (1.f / D) + EPS);
#pragma unroll
            for (int q = 0; q < 16; ++q) { const int c = 4 * lane + 256 * q; const f32x4 y = (f32x4){bflo(yw[q].x), bfhi(yw[q].x), bflo(yw[q].y), bfhi(yw[q].y)};
                const f32x4 pa = *(const LAS f32x4*)(plw + c);
                v[q] = v[q] + pa * (y * rstd_y);
                s += (v[q][0] * v[q][0] + v[q][1] * v[q][1]) + (v[q][2] * v[q][2] + v[q][3] * v[q][3]);
                if (mode == 2) *(f32x4*)(orow + c) = v[q];
                else { u32x2 xo; xo.x = cvtpk(v[q][0], v[q][1]); xo.y = cvtpk(v[q][2], v[q][3]); *(u32x2*)((bf16*)orow + c) = xo; } }
        }
        if (mode != 2) {
            const float rstd = rsqrtf(wave_sum(s) * (1.f / D) + EPS);
#pragma unroll
            for (int q = 0; q < 16; ++q) { const int c = 4 * lane + 256 * q;
                const f32x4 pb = *(const LAS f32x4*)(plw + 4096 + c), pc = *(const LAS f32x4*)(plw + 8192 + c);
                const f32x4 hv = v[q] * rstd * pb + pc; u32x2 w; w.x = cvtpk(hv[0], hv[1]); w.y = cvtpk(hv[2], hv[3]);
                *(u32x2*)(H + (size_t)row * D + c) = w; }
        }
    }
#undef ROW_LOAD
}


constexpr int L_KH = 0, L_QH = 18432, L_RT = 36864, L_XT = 77824, L_AI = 118784, L_DG = 129024, L_DI = 133120, L_GT = 135168;
constexpr int S128 = 144, S64 = 80;

__device__ __forceinline__ void phase_c1(const Args& a, int l, LAS unsigned char* lds, int G) {
    int tid, lane, wave, fr, fq;
#define RELANE() do { tid = tid_opaque(); lane = tid & 63; wave = __builtin_amdgcn_readfirstlane(tid >> 6); fr = lane & 15; fq = lane >> 4; } while (0)
    RELANE();
    const bf16* P = (const bf16*)(a.ws + WS_P);
    float* decbuf = (float*)(a.ws + WS_DEC);
    const float* conv_w = a.in[13] + (size_t)l * 4 * 6144;
    LAS bf16* KH = (LAS bf16*)(lds + L_KH); LAS bf16* QH = (LAS bf16*)(lds + L_QH); LAS bf16* RT = (LAS bf16*)(lds + L_RT); LAS bf16* XT = (LAS bf16*)(lds + L_XT);
    LAS bf16* AI = (LAS bf16*)(lds + L_AI); LAS float* DG = (LAS float*)(lds + L_DG); LAS bf16* DI = (LAS bf16*)(lds + L_DI);
    LAS unsigned char* STG = lds + L_XT;
    LAS float* g_beta = (LAS float*)(lds + L_GT); LAS float* g_gc = g_beta + 64; LAS float* g_egc = g_beta + 128; LAS float* g_misc = g_beta + 192;

    u32x4 raw[8]; unsigned gl = 0;
#define ITEM_PARAMS(it_, sample_, n_, c_, h_, ntok_, rowbase_) const bool sample_ = (it_) >= 4096; int n_, c_, h_, ntok_; size_t rowbase_; \
        if (!sample_) { h_ = (it_) & 15; c_ = ((it_) >> 4) & 63; n_ = (it_) >> 10; rowbase_ = (size_t)n_ * 4096 + c_ * 64; ntok_ = 64; } \
        else { const int s_ = (it_) - 4096; h_ = s_ & 15; n_ = s_ >> 4; c_ = 0; rowbase_ = (size_t)MP + n_ * 16; ntok_ = 16; }
#define PREFETCH(it_) do { ITEM_PARAMS(it_, ps_, pn_, pc_, ph_, pnt_, prb_); const int pt_ = tid_opaque(); \
        if (pt_ < 384) { const int pch0_ = (pt_ >> 7) * 2048 + ph_ * 128 + (pt_ & 15) * 8, pt0_ = ((pt_ >> 4) & 7) * 8; \
            _Pragma("unroll") for (int i = 0; i < 8; ++i) { const int tt = pt0_ + i; raw[i] = (u32x4){0u, 0u, 0u, 0u}; \
                if (tt < pnt_) raw[i] = *(const u32x4*)(P + (prb_ + tt) * NP + pch0_); } } \
        else { const int ptz_ = pt_ - 384; \
            if (ptz_ < 64 && ptz_ < pnt_) gl = (unsigned)P[(prb_ + ptz_) * NP + C_B + ph_] | ((unsigned)P[(prb_ + ptz_) * NP + C_A + ph_] << 16); } } while (0)

#ifdef DBG_MEASC
    unsigned long long dmacc_ = 0; const unsigned long long dmt0_ = __builtin_amdgcn_s_memtime(); unsigned long long dml_ = dmt0_;
#define DM(k) do { const unsigned long long n_ = __builtin_amdgcn_s_memtime(); if ((k) == DBG_MEASC) dmacc_ += n_ - dml_; dml_ = n_; } while (0)
#else
#define DM(k) do {} while (0)
#endif
    if ((int)blockIdx.x < NREC) PREFETCH((int)blockIdx.x);
    for (int item = blockIdx.x; item < NREC; item += G) {
        ITEM_PARAMS(item, sample, n, c, h, ntok, rowbase);
        const int reci = sample ? item : ((n * 16 + h) * 64 + c);
        unsigned char* rec = a.ws + WS_REC + (size_t)reci * REC_BYTES;
        const bool last = sample || (c == 63);
        DM(5); BAR_LDS(); DM(0);
        RELANE();
        f32x2 val2[8][4];
        float ssq[8];
        int g = 3, cgl, seg;
        if (tid < 384) {
            cgl = tid & 15; g = __builtin_amdgcn_readfirstlane(tid >> 7); seg = (tid >> 4) & 7;
            const int ch0 = g * 2048 + h * 128 + cgl * 8;
            const int t0 = seg * 8;
            f32x4 wq[4][2];
#pragma unroll
            for (int j = 0; j < 4; ++j) { wq[j][0] = *(const f32x4*)(conv_w + (size_t)j * 6144 + ch0); wq[j][1] = *(const f32x4*)(conv_w + (size_t)j * 6144 + ch0 + 4); }
            u32x4 hist[3];
#pragma unroll
            for (int i = 0; i < 3; ++i) { const int tt = t0 - 3 + i; hist[i] = (u32x4){0u, 0u, 0u, 0u};
                if (tt < ntok && (tt >= 0 || (!sample && c > 0))) hist[i] = *(const u32x4*)(P + (rowbase + tt) * NP + ch0); }
            if (sample && seg == 0) {
                const float* sc = a.in[2] + (((size_t)l * 16 + n) * 3) * 6144 + ch0;
#pragma unroll
                for (int i = 0; i < 3; ++i) { const f32x4 s0 = *(const f32x4*)(sc + (size_t)i * 6144), s1 = *(const f32x4*)(sc + (size_t)i * 6144 + 4);
                    hist[i].x = cvtpk(s0[0], s0[1]); hist[i].y = cvtpk(s0[2], s0[3]); hist[i].z = cvtpk(s1[0], s1[1]); hist[i].w = cvtpk(s1[2], s1[3]); }
            }
            f32x2 sq2[8];
#pragma unroll
            for (int tok = 0; tok < 8; ++tok) sq2[tok] = (f32x2){0.f, 0.f};
#pragma unroll
            for (int cp = 0; cp < 4; ++cp) {
                f32x2 w2[4], x2[11];
#pragma unroll
                for (int j = 0; j < 4; ++j) w2[j] = (f32x2){wq[j][cp >> 1][2 * (cp & 1)], wq[j][cp >> 1][2 * (cp & 1) + 1]};
#pragma unroll
                for (int r = 0; r < 11; ++r) { const unsigned dw = (r < 3) ? hist[r < 3 ? r : 0][cp] : raw[r >= 3 ? r - 3 : 0][cp]; x2[r] = (f32x2){bflo(dw), bfhi(dw)}; }
#pragma unroll
                for (int tok = 0; tok < 8; ++tok) {
                    const f32x2 y = w2[0] * x2[tok] + w2[1] * x2[tok + 1] + w2[2] * x2[tok + 2] + w2[3] * x2[tok + 3];
                    const f32x2 t = y * -1.4426950408889634f; f32x2 e; e.x = __builtin_amdgcn_exp2f(t.x); e.y = __builtin_amdgcn_exp2f(t.y);
                    const f32x2 d = e + 1.0f; f32x2 r; r.x = __builtin_amdgcn_rcpf(d.x); r.y = __builtin_amdgcn_rcpf(d.y);
                    f32x2 v = y * r; if (!((t0 + tok) < ntok)) v = (f32x2){0.f, 0.f};
                    val2[tok][cp] = v; sq2[tok] += v * v; }
            }
#pragma unroll
            for (int tok = 0; tok < 8; ++tok) ssq[tok] = sq2[tok].x + sq2[tok].y;
            if (last && seg == (sample ? 1 : 7)) {
#pragma unroll
                for (int tok = 5; tok < 8; ++tok) { float rf[8]; unpack8(raw[tok], rf);
                    float* co = sample ? a.out + O_CONVS + (((size_t)l * 16 + n) * 3 + (tok - 5)) * 6144 + ch0 : a.out + O_CONVP + (((size_t)l * 4 + n) * 3 + (tok - 5)) * 6144 + ch0;
                    *(f32x4*)co = (f32x4){rf[0], rf[1], rf[2], rf[3]}; *(f32x4*)(co + 4) = (f32x4){rf[4], rf[5], rf[6], rf[7]}; }
            }
#pragma unroll
            for (int tok = 0; tok < 8; ++tok) ssq[tok] = sum16(ssq[tok]);
        } else {
            const int tz = tid - 384; cgl = tz & 15; seg = tz >> 4;
            if (wave == 6) {
                float beta = 0.f, gg = 0.f;
                if (lane < ntok) { const float b = bflo(gl), av = bfhi(gl);
                    beta = sigmoid_f(b); const float xx = av + a.in[15][l * 16 + h]; const float sp = fmaxf(xx, 0.f) + log1pf(__expf(-fabsf(xx)));
                    gg = -__expf(a.in[14][l * 16 + h]) * sp; }
                float gc = gg;
#pragma unroll
                for (int o = 1; o < 64; o <<= 1) { const float t = __shfl_up(gc, o); if (lane >= o) gc += t; }
                g_beta[lane] = beta; g_gc[lane] = gc; g_egc[lane] = __expf(gc);
                const float gcl = __shfl(gc, 63);
                if (lane == 0) { g_misc[0] = gcl; decbuf[reci] = __expf(gcl); }
            }
        }
        if (item + G < NREC) PREFETCH(item + G);
        DM(1); BAR_LDS(); DM(2);
#ifndef DBG_C1_REP
#define DBG_C1_REP 0
#endif
        for (int rp1_ = 0; rp1_ < ((DBG_C1_REP) & 1) + 1; ++rp1_)
        {
            { const int t1 = tid_opaque(); cgl = t1 & 15; seg = (t1 >> 4) & 7; }
            const int t0 = seg * 8;
            float bt[8], gcv[8], eg[8];
            { const f32x4 b0 = *(const LAS f32x4*)(g_beta + t0), b1 = *(const LAS f32x4*)(g_beta + t0 + 4), c0 = *(const LAS f32x4*)(g_gc + t0), c1 = *(const LAS f32x4*)(g_gc + t0 + 4),
                  e0 = *(const LAS f32x4*)(g_egc + t0), e1 = *(const LAS f32x4*)(g_egc + t0 + 4);
#pragma unroll
              for (int i = 0; i < 4; ++i) { bt[i] = b0[i]; bt[4 + i] = b1[i]; gcv[i] = c0[i]; gcv[4 + i] = c1[i]; eg[i] = e0[i]; eg[4 + i] = e1[i]; } }
            const float gcl = g_misc[0];
            const int qs0 = ((cgl * 8) & 15) >> 2, half0 = ((cgl * 8) >> 4) & 1, ks0 = (cgl * 8) >> 5;
            const int tq0 = (t0 & 15) >> 2, thalf = (t0 >> 4) & 1, tks = t0 >> 5;
            if (g == 0) {
#pragma unroll
                for (int tok = 0; tok < 8; ++tok) { const int t = t0 + tok; const float r = rsqrtf(ssq[tok] + EPS) * 0.08838834764831845f; f32x2 qv[4];
#pragma unroll
                    for (int i = 0; i < 4; ++i) qv[i] = val2[tok][i] * r;
                    *(LAS u32x4*)(QH + t * S128 + cgl * 8) = pack8v(qv);
                    const float e = eg[tok];
                    const int fq_ = (t >> 4) * 4 + ks0; LAS unsigned char* fp = STG + fq_ * 1024 + ((((t & 15) + 16 * qs0) ^ (fq_ & 7)) * 16) + 8 * half0;
#pragma unroll
                    for (int i = 0; i < 4; ++i) qv[i] = qv[i] * e;
                    u32x2 w0, w1; w0.x = cvtpk(qv[0].x, qv[0].y); w0.y = cvtpk(qv[1].x, qv[1].y); w1.x = cvtpk(qv[2].x, qv[2].y); w1.y = cvtpk(qv[3].x, qv[3].y);
                    *(LAS u32x2*)fp = w0; *(LAS u32x2*)(fp + 256) = w1; }
            } else if (g == 1) {
#pragma unroll
                for (int tok = 0; tok < 8; ++tok) { const float r = rsqrtf(ssq[tok] + EPS);
#pragma unroll
                    for (int i = 0; i < 4; ++i) val2[tok][i] = val2[tok][i] * r;
                    *(LAS u32x4*)(KH + (t0 + tok) * S128 + cgl * 8) = pack8v(val2[tok]); }
                float f1[8], f2[8];
#pragma unroll
                for (int tok = 0; tok < 8; ++tok) { f1[tok] = bt[tok] * eg[tok]; f2[tok] = __expf(gcl - gcv[tok]); }
#pragma unroll
                for (int ip = 0; ip < 4; ++ip) {
                    f32x2 rr[8], kd[8];
#pragma unroll
                    for (int tok = 0; tok < 8; ++tok) { rr[tok] = val2[tok][ip] * f1[tok]; kd[tok] = val2[tok][ip] * f2[tok]; }
#pragma unroll
                    for (int hh = 0; hh < 2; ++hh) { const int i = 2 * ip + hh, d = cgl * 8 + i;
                        u32x4 rw; rw.x = cvtpk(rr[0][hh], rr[1][hh]); rw.y = cvtpk(rr[2][hh], rr[3][hh]); rw.z = cvtpk(rr[4][hh], rr[5][hh]); rw.w = cvtpk(rr[6][hh], rr[7][hh]);
                        *(LAS u32x4*)(RT + (128 + i * 16 + cgl) * S64 + t0) = rw;
                        const int fk_ = 16 + (d >> 4) * 2 + tks; LAS unsigned char* fp = STG + fk_ * 1024 + ((((d & 15) + 16 * tq0) ^ (fk_ & 7)) * 16) + 8 * thalf;
                        u32x2 w0, w1; w0.x = cvtpk(kd[0][hh], kd[1][hh]); w0.y = cvtpk(kd[2][hh], kd[3][hh]); w1.x = cvtpk(kd[4][hh], kd[5][hh]); w1.y = cvtpk(kd[6][hh], kd[7][hh]);
                        *(LAS u32x2*)fp = w0; *(LAS u32x2*)(fp + 256) = w1; } }
            } else if (g == 2) {
#pragma unroll
                for (int ip = 0; ip < 4; ++ip) { f32x2 rr[8];
#pragma unroll
                    for (int tok = 0; tok < 8; ++tok) rr[tok] = val2[tok][ip] * bt[tok];
#pragma unroll
                    for (int hh = 0; hh < 2; ++hh) { const int i = 2 * ip + hh;
                        u32x4 rw; rw.x = cvtpk(rr[0][hh], rr[1][hh]); rw.y = cvtpk(rr[2][hh], rr[3][hh]); rw.z = cvtpk(rr[4][hh], rr[5][hh]); rw.w = cvtpk(rr[6][hh], rr[7][hh]);
                        *(LAS u32x4*)(RT + (i * 16 + cgl) * S64 + t0) = rw; } }
            }
        }
        DM(3); BAR_LDS(); DM(4);
#if defined(DBG_C1_STOP) && DBG_C1_STOP <= 1
        continue;
#endif
        RELANE();
        for (int rp2_ = 0; rp2_ < (((DBG_C1_REP) >> 1) & 1) + 1; ++rp2_)
#pragma unroll
        for (int k2 = 0; k2 < 2; ++k2) {
            const int tile = wave * 2 + k2, ti = tile >> 2, tj = tile & 3;
            f32x4 acq = (f32x4){0.f, 0.f, 0.f, 0.f}, ack = (f32x4){0.f, 0.f, 0.f, 0.f};
#pragma unroll
            for (int ks = 0; ks < 4; ++ks) {
                const bf16x8 kj = *(const LAS bf16x8*)(KH + (16 * tj + fr) * S128 + 32 * ks + 8 * fq);
                const bf16x8 qi = *(const LAS bf16x8*)(QH + (16 * ti + fr) * S128 + 32 * ks + 8 * fq);
                acq = __builtin_amdgcn_mfma_f32_16x16x32_bf16(kj, qi, acq, 0, 0, 0);
                if (ti >= tj) { const bf16x8 ki = *(const LAS bf16x8*)(KH + (16 * ti + fr) * S128 + 32 * ks + 8 * fq);
                    ack = __builtin_amdgcn_mfma_f32_16x16x32_bf16(ki, kj, ack, 0, 0, 0); }
            }
            {
                const int i = 16 * ti + fr; const float gi = g_gc[i]; const f32x4 gj = *(const LAS f32x4*)(g_gc + 16 * tj + 4 * fq); float o[4];
#pragma unroll
                for (int r = 0; r < 4; ++r) { const int j = 16 * tj + 4 * fq + r; o[r] = (i >= j) ? acq[r] * __expf(fminf(gi - gj[r], 0.f)) : 0.f; }
                u32x2 w; w.x = cvtpk(o[0], o[1]); w.y = cvtpk(o[2], o[3]);
                { const int fk2_ = 32 + ti * 2 + (tj >> 1); *(LAS u32x2*)(STG + fk2_ * 1024 + ((lane ^ (fk2_ & 7)) * 16) + 8 * (tj & 1)) = w; }
            }
            if (ti >= tj) {
                const int j = 16 * tj + fr; const float gj = g_gc[j]; const f32x4 gi = *(const LAS f32x4*)(g_gc + 16 * ti + 4 * fq), bi = *(const LAS f32x4*)(g_beta + 16 * ti + 4 * fq);
#pragma unroll
                for (int r = 0; r < 4; ++r) { const int i = 16 * ti + 4 * fq + r; const float v = (i > j) ? bi[r] * ack[r] * __expf(fminf(gi[r] - gj, 0.f)) : 0.f;
                    AI[i * S64 + j] = (bf16)(cvtpk(v, 0.f) & 0xffffu);
                    if (ti == tj) DG[(ti * 16 + (i & 15)) * 16 + fr] = v; }
            }
        }
        BAR_LDS();
#if defined(DBG_C1_STOP) && DBG_C1_STOP <= 2
        continue;
#endif
        RELANE();
#pragma unroll
        for (int k5 = 0; k5 < 5; ++k5) { const int u = tid + 512 * k5, fu_ = u >> 6; *(u32x4*)(rec + REC_QD + (size_t)u * 16) = *(const LAS u32x4*)(STG + fu_ * 1024 + (((u & 63) ^ (fu_ & 7)) * 16)); }
        for (int rp3_ = 0; rp3_ < (((DBG_C1_REP) >> 2) & 1) + 1; ++rp3_)
        if (wave == 0) {
            const int b = fq, cc = fr; float x[16];
            {   f32x4 dg[10][3];
#pragma unroll
                for (int r = 1; r < 10; ++r)
#pragma unroll
                    for (int j4 = 0; j4 < (r + 3) / 4; ++j4) dg[r][j4] = *(const LAS f32x4*)(DG + (b * 16 + r) * 16 + 4 * j4);
                __builtin_amdgcn_sched_barrier(0);
#pragma unroll
                for (int r = 0; r < 10; ++r) { float s = (r == cc) ? 1.f : 0.f;
#pragma unroll
                    for (int j = 0; j < r; ++j) s -= dg[r][j >> 2][j & 3] * x[j];
                    x[r] = s; DI[(b * 16 + r) * 16 + cc] = (bf16)(cvtpk(s, 0.f) & 0xffffu); } }
            __builtin_amdgcn_sched_barrier(0);
            {   f32x4 dg[6][4];
#pragma unroll
                for (int r = 10; r < 16; ++r)
#pragma unroll
                    for (int j4 = 0; j4 < (r + 3) / 4; ++j4) dg[r - 10][j4] = *(const LAS f32x4*)(DG + (b * 16 + r) * 16 + 4 * j4);
                __builtin_amdgcn_sched_barrier(0);
#pragma unroll
                for (int r = 10; r < 16; ++r) { float s = (r == cc) ? 1.f : 0.f;
#pragma unroll
                    for (int j = 0; j < r; ++j) s -= dg[r - 10][j >> 2][j & 3] * x[j];
                    x[r] = s; DI[(b * 16 + r) * 16 + cc] = (bf16)(cvtpk(s, 0.f) & 0xffffu); } }
        }
        BAR_LDS();
#if defined(DBG_C1_STOP) && DBG_C1_STOP <= 3
        continue;
#endif
        for (int rp4_ = 0; rp4_ < (((DBG_C1_REP) >> 3) & 1) + 1; ++rp4_)
#pragma unroll
        for (int b = 0; b < 4; ++b) {
            RELANE();
#pragma unroll
            for (int k2 = 0; k2 < 2; ++k2) {
                const int nt = wave * 2 + k2;
                f32x4 y = (f32x4){0.f, 0.f, 0.f, 0.f};
#pragma unroll
                for (int ks = 0; ks < (b + 1) / 2; ++ks) {
                    const bool ok = (32 * ks + 8 * fq) < 16 * b;
                    u32x4 av = *(const LAS u32x4*)(AI + (16 * b + fr) * S64 + 32 * ks + 8 * fq), xv = *(const LAS u32x4*)(XT + (16 * nt + fr) * S64 + 32 * ks + 8 * fq);
                    if (!ok) { av = (u32x4){0u, 0u, 0u, 0u}; xv = (u32x4){0u, 0u, 0u, 0u}; }
                    y = __builtin_amdgcn_mfma_f32_16x16x32_bf16(as_bf16x8(av), as_bf16x8(xv), y, 0, 0, 0);
                }
                const int rn = 16 * nt + fr; const u32x2 rv = *(const LAS u32x2*)(RT + ((rn & 128) + (rn & 7) * 16 + ((rn & 127) >> 3)) * S64 + 16 * b + 4 * fq);
                const float z0 = bflo(rv.x) - y[0], z1 = bfhi(rv.x) - y[1], z2 = bflo(rv.y) - y[2], z3 = bfhi(rv.y) - y[3];
                u32x2 zb; zb.x = cvtpk(z0, z1); zb.y = cvtpk(z2, z3);
                const u32x2 dv = *(const LAS u32x2*)(DI + (b * 16 + fr) * 16 + 4 * fq);
                const f32x4 xo = __builtin_amdgcn_mfma_f32_16x16x16bf16_1k(as_bf16x4(dv), as_bf16x4(zb), (f32x4){0.f, 0.f, 0.f, 0.f}, 0, 0, 0);
                u32x2 xw; xw.x = cvtpk(xo[0], xo[1]); xw.y = cvtpk(xo[2], xo[3]);
                *(LAS u32x2*)(XT + (16 * nt + fr) * S64 + 16 * b + 4 * fq) = xw;
                if (nt < 8) *(u32x2*)(rec + REC_U + (size_t)(((nt * 4 + b) * 64 + lane) * 8)) = xw;
            }
            LDS_WAIT(); asm volatile("" ::: "memory");
        }
        BAR_LDS();
#if defined(DBG_C1_STOP) && DBG_C1_STOP <= 4
        continue;
#endif
        RELANE();
        for (int rp5_ = 0; rp5_ < (((DBG_C1_REP) >> 4) & 1) + 1; ++rp5_)
#pragma unroll
        for (int k2 = 0; k2 < 2; ++k2) {
            const int u = tid + 512 * k2, frag = u >> 6, tt = frag >> 2, ks = frag & 3;
            float wv[8];
#pragma unroll
            for (int j = 0; j < 8; ++j) wv[j] = -bf1(XT[(128 + 32 * ks + 16 * (j >> 2) + 4 * fq + (j & 3)) * S64 + 16 * tt + fr]);
            *(u32x4*)(rec + REC_W + (size_t)((frag * 64 + lane) * 16)) = pack8(wv);
        }
    }
#ifdef DBG_MEASC
    if (l == 1 && blockIdx.x == 0 && tid_opaque() == 0) { DM(5); const unsigned long long tot_ = __builtin_amdgcn_s_memtime() - dmt0_; const float fr_ = (float)dmacc_ / (float)tot_;
        ((unsigned*)(a.ws + WS_CTL))[2000] = 32u * (unsigned)(fr_ * 8.0f + 0.5f); }
#endif
#undef DM
#undef RELANE
#undef PREFETCH
#undef ITEM_PARAMS
}


constexpr int L_SS = 2 * REC_STAGE, L_RS = L_SS + 2048, L_DN = L_RS + 256, L_OB = L_DN + 512, OBS = 136;
__device__ __forceinline__ void scan_seq(const Args& a, int l, LAS unsigned char* lds, int seq) {
    int tid = tid_opaque(), lane = tid & 63, wave = __builtin_amdgcn_readfirstlane(tid >> 6);
    int fr = lane & 15, fq = lane >> 4;
    const bool sample = seq >= 64;
    const int s2 = sample ? seq - 64 : seq, n = s2 >> 4, h = s2 & 15;
    const int nsteps = sample ? 1 : 64, ntok = sample ? 16 : 64;
    const int rec0 = sample ? 4096 + s2 : s2 * 64;
    const size_t rowbase0 = sample ? (size_t)MP + n * 16 : (size_t)n * 4096;
    const unsigned char* recs = a.ws + WS_REC;
    const float* decbuf = (const float*)(a.ws + WS_DEC);
    bf16* Ob = (bf16*)(a.ws + WS_HO);
    LAS float* ss = (LAS float*)(lds + L_SS); LAS float* rs = (LAS float*)(lds + L_RS); LAS bf16* ob = (LAS bf16*)(lds + L_OB);
    f32x4 st[8];
    if (sample) { const float* s0 = a.in[3] + (((size_t)l * 16 + n) * 16 + h) * 16384;
#pragma unroll
        for (int t = 0; t < 8; ++t)
#pragma unroll
            for (int j = 0; j < 4; ++j) st[t][j] = s0[(16 * t + 4 * fq + j) * 128 + 16 * wave + fr];
    } else {
#pragma unroll
        for (int t = 0; t < 8; ++t) st[t] = (f32x4){0.f, 0.f, 0.f, 0.f};
    }
    __syncthreads();
    {   const unsigned char* src = recs + (size_t)rec0 * REC_BYTES;
#pragma unroll
        for (int k = 0; k < 7; ++k) { const int p = wave * 7 + k;
            __builtin_amdgcn_global_load_lds((const unsigned*)(src + p * 1024 + lane * 16), (LAS unsigned*)(lds + p * 1024), 16, 0, 0); } }
    u32x2 u_cur[4], u_nxt[4]; float dec_cur, dec_nxt = 0.f; f32x4 o_prev[4];
    u32x4 zq[2], zn[2]; LAS float* dnl = (LAS float*)(lds + L_DN);
    if (tid < 128) dnl[tid] = a.in[16][(size_t)l * 128 + tid];
    zq[0] = zq[1] = zn[0] = zn[1] = (u32x4){0u, 0u, 0u, 0u};
    {   const unsigned char* rec = recs + (size_t)rec0 * REC_BYTES;
#pragma unroll
        for (int t = 0; t < 4; ++t) { u_cur[t] = *(const u32x2*)(rec + REC_U + ((wave * 4 + t) * 64 + lane) * 8); u_nxt[t] = u_cur[t]; o_prev[t] = (f32x4){0.f, 0.f, 0.f, 0.f}; }
        dec_cur = decbuf[rec0]; }
#define SCAN_STORE(cc) do {   \
        _Pragma("unroll") for (int t = 0; t < 4; ++t) { const f32x4 r4 = *(const LAS f32x4*)(rs + 16 * t + 4 * fq); \
            _Pragma("unroll") for (int j = 0; j < 4; ++j) ob[(16 * t + 4 * fq + j) * OBS + 16 * wave + fr] = (bf16)(cvtpk(o_prev[t][j] * r4[j], 0.f) & 0xffffu); } } while (0)
#define SCAN_ZLOAD(cc, Z) do { const int tok_ = tid >> 3; if (tok_ < ntok) { const bf16* zp_ = (const bf16*)(a.ws + WS_P) + (rowbase0 + (size_t)(cc) * 64 + tok_) * NP + C_ZDN + h * 128 + (tid & 7) * 8; \
            Z[0] = *(const u32x4*)zp_; Z[1] = *(const u32x4*)(zp_ + 64); } } while (0)
#define SCAN_FLUSH(cc, Z) do {   \
        const int tok_ = tid >> 3, pc_ = tid & 7; \
        if (tok_ < ntok) { bf16* op_ = Ob + (rowbase0 + (size_t)(cc) * 64 + tok_) * D + h * 128 + pc_ * 8; \
            _Pragma("unroll") for (int hh = 0; hh < 2; ++hh) { float ov_[8], zv_[8]; unpack8(*(const LAS u32x4*)(ob + tok_ * OBS + 64 * hh + pc_ * 8), ov_); unpack8(Z[hh], zv_); \
                _Pragma("unroll") for (int i = 0; i < 8; ++i) ov_[i] = ov_[i] * zv_[i];     \
                *(u32x4*)(op_ + 64 * hh) = pack8(ov_); } } } while (0)
#define SCAN_RS() do { if (tid < 64) { float tsum = 0.f; \
            _Pragma("unroll") for (int w8 = 0; w8 < 8; ++w8) tsum += ss[w8 * 64 + tid]; \
            rs[tid] = rsqrtf(tsum * (1.f / 128.f) + EPS); } } while (0)
#ifdef DBG_MEAS
    unsigned long long dbg_w_ = 0, dbg_b_ = 0, dbg_b2_ = 0; const unsigned long long dbg_t0_ = __builtin_amdgcn_s_memtime(); const unsigned long long dbg_r0_ = __builtin_amdgcn_s_memrealtime();
#endif
    for (int c = 0; c < nsteps; ++c) {
        tid = tid_opaque(); lane = tid & 63; wave = __builtin_amdgcn_readfirstlane(tid >> 6); fr = lane & 15; fq = lane >> 4;
        const LAS unsigned char* buf = lds + (c & 1) * REC_STAGE;
        const unsigned char* rec = recs + (size_t)(rec0 + c) * REC_BYTES;
#ifdef DBG_MEAS
        const unsigned long long tm0_ = __builtin_amdgcn_s_memtime();
        VM_WAIT();
        const unsigned long long tm1_ = __builtin_amdgcn_s_memtime();
        __syncthreads();
        const unsigned long long tm2_ = __builtin_amdgcn_s_memtime();
        dbg_w_ += tm1_ - tm0_; dbg_b_ += tm2_ - tm1_;
#else
        VM_WAIT(); __syncthreads();
#endif; everybody is done with the other buffer; ss of step c-1 is complete
        if (c + 1 < nsteps) { const unsigned char* src = rec + REC_BYTES; LAS unsigned char* dst = lds + ((c + 1) & 1) * REC_STAGE;
#pragma unroll
            for (int k = 0; k < 7; ++k) { const int p = wave * 7 + k;
                __builtin_amdgcn_global_load_lds((const unsigned*)(src + p * 1024 + lane * 16), (LAS unsigned*)(dst + p * 1024), 16, 0, 0); }
#pragma unroll
            for (int t = 0; t < 4; ++t) u_nxt[t] = *(const u32x2*)(src + REC_U + ((wave * 4 + t) * 64 + lane) * 8);
            dec_nxt = decbuf[rec0 + c + 1]; }
        if (c > 0) SCAN_RS();
        if (c > 1) SCAN_FLUSH(c - 2, zn);
        if (c > 0) SCAN_ZLOAD(c - 1, zn);
        bf16x8 Bs[4];
#pragma unroll
        for (int ks = 0; ks < 4; ++ks) { u32x4 w; w.x = cvtpk(st[2 * ks][0], st[2 * ks][1]); w.y = cvtpk(st[2 * ks][2], st[2 * ks][3]); w.z = cvtpk(st[2 * ks + 1][0], st[2 * ks + 1][1]); w.w = cvtpk(st[2 * ks + 1][2], st[2 * ks + 1][3]); Bs[ks] = as_bf16x8(w); }
        f32x4 ws4[4], oacc[4];
#pragma unroll
        for (int t = 0; t < 4; ++t) ws4[t] = (f32x4){bflo(u_cur[t].x), bfhi(u_cur[t].x), bflo(u_cur[t].y), bfhi(u_cur[t].y)};
        bf16x8 FX[8], FY[8];
#define LDG(F, off) do { _Pragma("unroll") for (int i_ = 0; i_ < 8; ++i_) F[i_] = *(const LAS bf16x8*)(buf + (off) + (i_ * 64 + lane) * 16); } while (0)
#define SB() __builtin_amdgcn_sched_barrier(0)
        LDG(FX, REC_W); LDG(FY, REC_W + 8192); SB();
#pragma unroll
        for (int i = 0; i < 8; ++i) ws4[i >> 2] = __builtin_amdgcn_mfma_f32_16x16x32_bf16(FX[i], Bs[i & 3], ws4[i >> 2], 0, 0, 0);
        SB(); LDG(FX, REC_QD); SB();
#pragma unroll
        for (int i = 0; i < 8; ++i) ws4[2 + (i >> 2)] = __builtin_amdgcn_mfma_f32_16x16x32_bf16(FY[i], Bs[i & 3], ws4[2 + (i >> 2)], 0, 0, 0);
        SB(); LDG(FY, REC_QD + 8192); SB();
#pragma unroll
        for (int i = 0; i < 8; ++i) oacc[i >> 2] = __builtin_amdgcn_mfma_f32_16x16x32_bf16(FX[i], Bs[i & 3], (i & 3) ? oacc[i >> 2] : (f32x4){0.f, 0.f, 0.f, 0.f}, 0, 0, 0);
        SB(); LDG(FX, REC_QK); SB();
#pragma unroll
        for (int i = 0; i < 8; ++i) oacc[2 + (i >> 2)] = __builtin_amdgcn_mfma_f32_16x16x32_bf16(FY[i], Bs[i & 3], (i & 3) ? oacc[2 + (i >> 2)] : (f32x4){0.f, 0.f, 0.f, 0.f}, 0, 0, 0);
        SB(); LDG(FY, REC_KD); SB();
        bf16x8 Bv[2];
        {   f32x4 vn[4];
#pragma unroll
            for (int t = 0; t < 4; ++t) vn[t] = ws4[t];
#pragma unroll
            for (int k2 = 0; k2 < 2; ++k2) { u32x4 w; w.x = cvtpk(vn[2 * k2][0], vn[2 * k2][1]); w.y = cvtpk(vn[2 * k2][2], vn[2 * k2][3]); w.z = cvtpk(vn[2 * k2 + 1][0], vn[2 * k2 + 1][1]); w.w = cvtpk(vn[2 * k2 + 1][2], vn[2 * k2 + 1][3]); Bv[k2] = as_bf16x8(w); } }
#pragma unroll
        for (int t = 0; t < 8; ++t) st[t] = st[t] * dec_cur;
        SB();
#pragma unroll
        for (int i = 0; i < 8; ++i) oacc[i >> 1] = __builtin_amdgcn_mfma_f32_16x16x32_bf16(FX[i], Bv[i & 1], oacc[i >> 1], 0, 0, 0);
        SB(); LDG(FX, REC_KD + 8192); SB();
#pragma unroll
        for (int i = 0; i < 8; ++i) st[i >> 1] = __builtin_amdgcn_mfma_f32_16x16x32_bf16(FY[i], Bv[i & 1], st[i >> 1], 0, 0, 0);
        SB();
#pragma unroll
        for (int i = 0; i < 8; ++i) st[4 + (i >> 1)] = __builtin_amdgcn_mfma_f32_16x16x32_bf16(FX[i], Bv[i & 1], st[4 + (i >> 1)], 0, 0, 0);
#undef LDG
#undef SB
#ifdef DBG_MEAS
        const unsigned long long tm3_ = __builtin_amdgcn_s_memtime();
#endif
        BAR_LDS();
#ifdef DBG_MEAS
        dbg_b2_ += __builtin_amdgcn_s_memtime() - tm3_;
#endif
        if (c > 0) SCAN_STORE(c - 1);
#pragma unroll
        for (int t = 0; t < 4; ++t) { const float k = quadsum16(oacc[t] * oacc[t], fr);
            if (fr < 4) ss[wave * 64 + 16 * t + 4 * fq + fr] = k; }
#pragma unroll
        for (int t = 0; t < 4; ++t) { o_prev[t] = oacc[t]; u_cur[t] = u_nxt[t]; }
        dec_cur = dec_nxt;
    }
#ifdef DBG_MEAS
    if (l == 1 && seq == 0 && tid == 0) { const unsigned long long tot_ = __builtin_amdgcn_s_memtime() - dbg_t0_; const unsigned long long rt_ = __builtin_amdgcn_s_memrealtime() - dbg_r0_;
        float fr_ = 0.f;
        if (DBG_MEAS == 1) fr_ = (float)dbg_w_ / (float)tot_; else if (DBG_MEAS == 2) fr_ = (float)dbg_b_ / (float)tot_; else if (DBG_MEAS == 3) fr_ = (float)dbg_b2_ / (float)tot_;
        else if (DBG_MEAS == 4) fr_ = (float)rt_ * 0.01f / 500.0f;
        else if (DBG_MEAS == 5) fr_ = (float)tot_ / (float)rt_ / 100.0f * 0.25f;
        ((unsigned*)(a.ws + WS_CTL))[2000] = 8u * (unsigned)(fr_ * 32.0f + 0.5f); }
#endif
    __syncthreads();
    SCAN_RS();
    if (nsteps > 1) SCAN_FLUSH(nsteps - 2, zn);
    SCAN_ZLOAD(nsteps - 1, zq);
    __syncthreads();
    SCAN_STORE(nsteps - 1);
    __syncthreads();
    SCAN_FLUSH(nsteps - 1, zq);
#undef SCAN_FLUSH
#undef SCAN_ZLOAD
#undef SCAN_STORE
#undef SCAN_RS
    {   float* so = sample ? a.out + O_DNS + (((size_t)l * 16 + n) * 16 + h) * 16384 : a.out + O_DNP + (((size_t)l * 4 + n) * 16 + h) * 16384;
#pragma unroll
        for (int t = 0; t < 8; ++t)
#pragma unroll
            for (int j = 0; j < 4; ++j) so[(16 * t + 4 * fq + j) * 128 + 16 * wave + fr] = st[t][j]; }
}

constexpr int L_KI = 0, L_VT = 30720, SKI = 80, SVT = 200;
__device__ __forceinline__ void attn_item(const Args& a, int l, LAS unsigned char* lds, int it) {
    const int tid = tid_opaque(), lane = tid & 63, wave = __builtin_amdgcn_readfirstlane(tid >> 6);
    const int fr = lane & 15, fq = lane >> 4;
    const bool sample = it >= 1024;
    const int kv = it & 3, c = sample ? 0 : ((it >> 2) & 63), n = sample ? ((it - 1024) >> 2) : (it >> 8);
    const bf16* P = (const bf16*)(a.ws + WS_P); const f32x2* rope = (const f32x2*)(a.ws + WS_ROPE);
    bf16* Ob = (bf16*)(a.ws + WS_HO);
    LAS bf16* KI = (LAS bf16*)(lds + L_KI); LAS bf16* VT = (LAS bf16*)(lds + L_VT);
    const int kt0 = sample ? 0 : ((c >= 2) ? 0 : (8 - 4 * c));
    const int nkt = sample ? 9 : 12, nqt = sample ? 1 : 4;
    const size_t qrow0 = sample ? (size_t)MP + n * 16 : (size_t)n * 4096 + c * 64;
    const int pos0 = sample ? PAST : c * 64;
    __syncthreads();
    if (!sample) {
#pragma unroll
        for (int k2 = 0; k2 < 2; ++k2) { const int u = tid + 512 * k2; if (u < 768) { const int key = u >> 2, dg = u & 3, tok = (c - 2) * 64 + key;
            if (tok >= 0) { const bf16* kp = P + ((size_t)n * 4096 + tok) * NP + C_AK + kv * 64 + dg * 8; float x1[8], x2[8], o1[8], o2[8];
                unpack8(*(const u32x4*)kp, x1); unpack8(*(const u32x4*)(kp + 32), x2);
#pragma unroll
                for (int j = 0; j < 8; ++j) { const f32x2 cs = rope[tok * 32 + dg * 8 + j]; o1[j] = x1[j] * cs.x - x2[j] * cs.y; o2[j] = x2[j] * cs.x + x1[j] * cs.y; }
                *(LAS u32x4*)(KI + key * SKI + dg * 8) = pack8(o1); *(LAS u32x4*)(KI + key * SKI + 32 + dg * 8) = pack8(o2);
                if (c == 63 && key >= 64) { float* ko = a.out + O_KP + ((((size_t)l * 4 + n) * 128 + (key - 64)) * 4 + kv) * 64 + dg * 8;
                    *(f32x4*)ko = (f32x4){o1[0], o1[1], o1[2], o1[3]}; *(f32x4*)(ko + 4) = (f32x4){o1[4], o1[5], o1[6], o1[7]};
                    *(f32x4*)(ko + 32) = (f32x4){o2[0], o2[1], o2[2], o2[3]}; *(f32x4*)(ko + 36) = (f32x4){o2[4], o2[5], o2[6], o2[7]}; } } } }
#pragma unroll
        for (int k3 = 0; k3 < 3; ++k3) { const int u = tid + 512 * k3, key = u >> 3, dg = u & 7, tok = (c - 2) * 64 + key;
            if (tok >= 0) { const u32x4 vw = *(const u32x4*)(P + ((size_t)n * 4096 + tok) * NP + C_AV + kv * 64 + dg * 8);
                const unsigned ww[4] = {vw.x, vw.y, vw.z, vw.w};
#pragma unroll
                for (int j = 0; j < 8; ++j) VT[(dg * 8 + j) * SVT + key] = (bf16)((j & 1) ? (ww[j >> 1] >> 16) : (ww[j >> 1] & 0xffffu));
                if (c == 63 && key >= 64) { float vf[8]; unpack8(vw, vf); float* vo = a.out + O_VP + ((((size_t)l * 4 + n) * 128 + (key - 64)) * 4 + kv) * 64 + dg * 8;
                    *(f32x4*)vo = (f32x4){vf[0], vf[1], vf[2], vf[3]}; *(f32x4*)(vo + 4) = (f32x4){vf[4], vf[5], vf[6], vf[7]}; } } }
    } else {
        const float* ck = a.in[4] + ((size_t)l * 16 + n) * 128 * 256 + kv * 64; const float* cv = a.in[5] + ((size_t)l * 16 + n) * 128 * 256 + kv * 64;
        float* kso = a.out + O_KS + (((size_t)l * 16 + n) * 128 * 4 + kv) * 64; float* vso = a.out + O_VS + (((size_t)l * 16 + n) * 128 * 4 + kv) * 64;
#pragma unroll
        for (int k2 = 0; k2 < 3; ++k2) { const int u = tid + 512 * k2; if (u < 144 * 8) { const int key = u >> 3, dg = u & 7; float kf[8], vf[8];
            if (key < 128) { const f32x4 k0 = *(const f32x4*)(ck + (size_t)key * 256 + dg * 8), k1 = *(const f32x4*)(ck + (size_t)key * 256 + dg * 8 + 4), v0 = *(const f32x4*)(cv + (size_t)key * 256 + dg * 8), v1 = *(const f32x4*)(cv + (size_t)key * 256 + dg * 8 + 4);
#pragma unroll
                for (int j = 0; j < 4; ++j) { kf[j] = k0[j]; kf[4 + j] = k1[j]; vf[j] = v0[j]; vf[4 + j] = v1[j]; } }
            else { const int t = key - 128; const bf16* kp = P + ((size_t)MP + n * 16 + t) * NP + C_AK + kv * 64; float x1[8], x2[8];
                const int d1 = (dg & 3) * 8; unpack8(*(const u32x4*)(kp + d1), x1); unpack8(*(const u32x4*)(kp + 32 + d1), x2);
#pragma unroll
                for (int j = 0; j < 8; ++j) { const f32x2 cs = rope[(PAST + t) * 32 + d1 + j]; kf[j] = (dg < 4) ? (x1[j] * cs.x - x2[j] * cs.y) : (x2[j] * cs.x + x1[j] * cs.y); }
                unpack8(*(const u32x4*)(P + ((size_t)MP + n * 16 + t) * NP + C_AV + kv * 64 + dg * 8), vf); }
            *(LAS u32x4*)(KI + key * SKI + dg * 8) = pack8(kf);
            const u32x4 vw = pack8(vf); const unsigned ww[4] = {vw.x, vw.y, vw.z, vw.w};
#pragma unroll
            for (int j = 0; j < 8; ++j) VT[(dg * 8 + j) * SVT + key] = (bf16)((j & 1) ? (ww[j >> 1] >> 16) : (ww[j >> 1] & 0xffffu));
            if (key >= 16) { float* ko = kso + (size_t)(key - 16) * 256 + dg * 8; float* vo = vso + (size_t)(key - 16) * 256 + dg * 8;
                *(f32x4*)ko = (f32x4){kf[0], kf[1], kf[2], kf[3]}; *(f32x4*)(ko + 4) = (f32x4){kf[4], kf[5], kf[6], kf[7]};
                *(f32x4*)vo = (f32x4){vf[0], vf[1], vf[2], vf[3]}; *(f32x4*)(vo + 4) = (f32x4){vf[4], vf[5], vf[6], vf[7]}; } } }
    }
    __syncthreads();
    const int hq = kv * 8 + wave;
    const float sink = a.in[17][l * 32 + hq];
    for (int qt = 0; qt < nqt; ++qt) {
        const int tq = pos0 + 16 * qt + fr; const size_t row = qrow0 + 16 * qt + fr;
        bf16x8 Qf[2];
        {   const bf16* qp = P + row * NP + C_AQ + hq * 64 + 8 * fq; float x1[8], x2[8], o1[8], o2[8];
            unpack8(*(const u32x4*)qp, x1); unpack8(*(const u32x4*)(qp + 32), x2);
#pragma unroll
            for (int j = 0; j < 8; ++j) { const f32x2 cs = rope[tq * 32 + 8 * fq + j]; o1[j] = (x1[j] * cs.x - x2[j] * cs.y) * 0.125f; o2[j] = (x2[j] * cs.x + x1[j] * cs.y) * 0.125f; }
            Qf[0] = as_bf16x8(pack8(o1)); Qf[1] = as_bf16x8(pack8(o2)); }
        u32x2 zw[4];
#pragma unroll
        for (int dt = 0; dt < 4; ++dt) zw[dt] = *(const u32x2*)(P + row * NP + C_AZ + hq * 64 + 16 * dt + 4 * fq);
        f32x4 s[12]; float m = sink;
#pragma unroll
        for (int kt = 0; kt < 12; ++kt) { s[kt] = (f32x4){0.f, 0.f, 0.f, 0.f};
            if (kt >= kt0 && kt < nkt) {
#pragma unroll
                for (int ks = 0; ks < 2; ++ks) { const bf16x8 kf = *(const LAS bf16x8*)(KI + (16 * kt + fr) * SKI + 32 * ks + 8 * fq); s[kt] = __builtin_amdgcn_mfma_f32_16x16x32_bf16(kf, Qf[ks], s[kt], 0, 0, 0); }
                m = fmaxf(m, fmaxf(fmaxf(s[kt][0], s[kt][1]), fmaxf(s[kt][2], s[kt][3]))); } }
        m = fmaxf(m, __shfl_xor(m, 16)); m = fmaxf(m, __shfl_xor(m, 32));
        float sum = 0.f; f32x4 oc[4];
#pragma unroll
        for (int dt = 0; dt < 4; ++dt) oc[dt] = (f32x4){0.f, 0.f, 0.f, 0.f};
#pragma unroll
        for (int kt = 0; kt < 12; ++kt) { if (kt >= kt0 && kt < nkt) {
            const float p0 = __expf(s[kt][0] - m), p1 = __expf(s[kt][1] - m), p2 = __expf(s[kt][2] - m), p3 = __expf(s[kt][3] - m); sum += (p0 + p1) + (p2 + p3);
            u32x2 pw; pw.x = cvtpk(p0, p1); pw.y = cvtpk(p2, p3);
#pragma unroll
            for (int dt = 0; dt < 4; ++dt) { const u32x2 vf = *(const LAS u32x2*)(VT + (16 * dt + fr) * SVT + 16 * kt + 4 * fq);
                oc[dt] = __builtin_amdgcn_mfma_f32_16x16x16bf16_1k(as_bf16x4(vf), as_bf16x4(pw), oc[dt], 0, 0, 0); } } }
        sum += __shfl_xor(sum, 16); sum += __shfl_xor(sum, 32);
        const float inv = 1.0f / (sum + __expf(sink - m));
#pragma unroll
        for (int dt = 0; dt < 4; ++dt) { const int d0 = 16 * dt + 4 * fq;
            const float o0 = oc[dt][0] * inv * silu_f(bflo(zw[dt].x)), o1 = oc[dt][1] * inv * silu_f(bfhi(zw[dt].x)), o2 = oc[dt][2] * inv * silu_f(bflo(zw[dt].y)), o3 = oc[dt][3] * inv * silu_f(bfhi(zw[dt].y));
            u32x2 ow; ow.x = cvtpk(o0, o1); ow.y = cvtpk(o2, o3);
            *(u32x2*)(Ob + row * D + 2048 + hq * 64 + d0) = ow; }
    }
}

struct OneUnit { int pn; __device__ __forceinline__ bool next(int i, pg8::Unit& u) const { if (i) return false; u.pm = 0; u.pn = pn; return true; }
    __device__ __forceinline__ void a_ready(const pg8::Unit&) const {} __device__ __forceinline__ void done(const pg8::Unit&) const {} };
#ifndef DBG_REPEAT
#define DBG_REPEAT 0
#endif
__device__ __forceinline__ void phase_c2(const Args& a, int l, LAS unsigned char* lds, int G) {
    const int b = blockIdx.x;
    unsigned* cnt = (unsigned*)(a.ws + WS_CTL) + CW_C2DONE + 64 * l;
    if (b < 64) { for (int r_ = 0; r_ < ((((DBG_REPEAT) >> 7) & 1) ? 2 : 1); ++r_) scan_seq(a, l, lds, b); }
    else if (b < 80) {
        if (threadIdx.x == 0) { unsigned sp = 0; while (__hip_atomic_load(cnt, __ATOMIC_RELAXED, __HIP_MEMORY_SCOPE_AGENT) < (unsigned)(G - 80)) { __builtin_amdgcn_s_sleep(8); if (++sp > (1u << 22)) break; }
            __builtin_amdgcn_fence(__ATOMIC_ACQUIRE, "agent"); VM_WAIT(); }
        __syncthreads();
        pg8::Gemm g{(const pg8::bf16_t*)(a.ws + WS_HO) + (size_t)MP * D, (const pg8::bf16_t*)(a.ws + WS_BOUT + l * BOUT_BYTES), MS, D, D};
        OneUnit S; S.pn = b - 64;
        pg8::EpiY E{(pg8::bf16_t*)(a.ws + WS_YS), D, (float*)(a.ws + WS_YSQ) + (size_t)MP * 64};
        pg8::gemm_phase<pg8::EpiY, OneUnit, true, true>(lds, g, S, E);
    } else {
        const int vb = b - 80, nvb = G - 80;
        for (int it = vb; it < 320; it += nvb) { if (it < 256) scan_seq(a, l, lds, 64 + it); else attn_item(a, l, lds, 1024 + (it - 256)); }
        VM_WAIT(); __syncthreads();
        if (threadIdx.x == 0) { __builtin_amdgcn_fence(__ATOMIC_RELEASE, "agent"); VM_WAIT(); __hip_atomic_fetch_add(cnt, 1u, __ATOMIC_RELAXED, __HIP_MEMORY_SCOPE_AGENT); }
        for (int it = vb; it < 1024; it += nvb) { for (int r_ = 0; r_ < ((((DBG_REPEAT) >> 8) & 1) ? 2 : 1); ++r_) attn_item(a, l, lds, it); }
#if SPLIT_PROLOGUE
        if (l == 0) { __syncthreads(); prologue_work(a, lds, vb, nvb, 2, 0x8, false); }
#endif
    }
}

constexpr int N_PHASES = 12;
__device__ __forceinline__ Args load_args(const __attribute__((address_space(4))) Args* p) {
    Args a;
#pragma unroll
    for (int i = 0; i < 19; ++i) a.in[i] = (const float*)(const GAS float*)p->in[i];
    a.out = (float*)(GAS float*)p->out; a.ws = (unsigned char*)(GAS unsigned char*)p->ws; a.ph_lo = p->ph_lo; a.ph_hi = p->ph_hi; return a;
}
__global__ void __launch_bounds__(512, 2) fwd(Args args) {
    extern __shared__ __attribute__((aligned(16))) unsigned char lds_raw[];
    LAS unsigned char* lds = (LAS unsigned char*)lds_raw;
    const int G = gridDim.x;
    typedef const __attribute__((address_space(4))) Args* KArgs;
    const KArgs kp = (KArgs)__builtin_amdgcn_kernarg_segment_ptr();
#define ARGS(name) KArgs name##_p = kp; asm volatile("" : "+s"(name##_p)); const Args name = load_args(name##_p)
    const int lo = kp->ph_lo, hi = kp->ph_hi;
    volatile LAS unsigned* MISC = (volatile LAS unsigned*)(lds + MISC_OFF);
    for (int u = threadIdx.x; u < 64; u += 512) MISC[u] = 0u;
    __syncthreads();
    unsigned* barw = (unsigned*)(GAS unsigned*)((GAS unsigned char*)kp->ws + WS_CTL) + CW_BAR;
    XcdBarrier bar; bar.bar = barw; bar.x = 0; bar.st = nullptr;
    const bool multi = (hi - lo) > 1;
    if (multi) bar = xcd_barrier_post(barw, MISC + 8);
#define IN(k) (lo <= (k) && (k) < hi)
#ifndef DBG_REPEAT
#define DBG_REPEAT 0
#endif
#define REP(bit) for (int rep_ = 0; rep_ < (((DBG_REPEAT) >> (bit)) & 1) + 1; ++rep_)
#define SEAM(k) do { if (IN(k) && IN((k) + 1)) xcd_barrier(bar); } while (0)
    if (IN(0)) REP(0) { ARGS(a0); phase_prologue(a0, lds, G); }
    SEAM(0);
    if (IN(1)) REP(1) { ARGS(a1); phase_rows<0>(a1, lds, G); }
    SEAM(1);
    for (int l = 0; l < 2; ++l) {
        const int pb = 2 + 5 * l;
        if (IN(pb + 0)) REP(2) {
            ARGS(args);
            pg8::Gemm g{(const pg8::bf16_t*)(args.ws + WS_HO), (const pg8::bf16_t*)(args.ws + WS_BIN + l * BIN_BYTES), M, NP, D};
            pg8::StaticOrder S; S.init(M, NP, G, (int)blockIdx.x);
            pg8::EpiP E{(pg8::bf16_t*)(args.ws + WS_P), NP, args.in[16] + (size_t)l * 128, C_ZDN / 256, (C_ZDN + 2048) / 256};
#ifdef DBG_CLK
            const unsigned long long ck0_ = __builtin_amdgcn_s_memtime(), cr0_ = __builtin_amdgcn_s_memrealtime();
#endif
            pg8::gemm_phase<pg8::EpiP, pg8::StaticOrder, true, true>(lds, g, S, E);
#ifdef DBG_CLK
            if (l == 1 && blockIdx.x == 0 && threadIdx.x == 0) { const unsigned long long dc_ = __builtin_amdgcn_s_memtime() - ck0_, dr_ = __builtin_amdgcn_s_memrealtime() - cr0_;
                const float ghz_ = (float)dc_ / ((float)dr_ * 10.0f);
                float fr_ = (DBG_CLK == 1) ? (ghz_ - 1.0f) / 1.6f : (float)dr_ * 0.01f / 2000.0f;
                fr_ = fr_ < 0.f ? 0.f : (fr_ > 1.f ? 1.f : fr_);
                ((unsigned*)(args.ws + WS_CTL))[2000] = 16u * (unsigned)(fr_ * 16.0f + 0.5f); }
#endif
        }
        SEAM(pb + 0);
        if (IN(pb + 1)) REP(3) { ARGS(a2); phase_c1(a2, l, lds, G); }
        SEAM(pb + 1);
        if (IN(pb + 2)) REP(4) { ARGS(a3); phase_c2(a3, l, lds, G); }
        SEAM(pb + 2);
        if (IN(pb + 3)) REP(5) {
            ARGS(args);
            pg8::Gemm g{(const pg8::bf16_t*)(args.ws + WS_HO), (const pg8::bf16_t*)(args.ws + WS_BOUT + l * BOUT_BYTES), MP, D, D};
            pg8::StaticOrder S; S.init(MP, D, G, (int)blockIdx.x);
            pg8::EpiY E{(pg8::bf16_t*)(args.ws + WS_P), D, (float*)(args.ws + WS_YSQ)};
            pg8::gemm_phase<pg8::EpiY, pg8::StaticOrder, true, true>(lds, g, S, E);
        }
        SEAM(pb + 3);
        if (IN(pb + 4)) for (int rep_ = 0; rep_ < ((((DBG_REPEAT) >> 6) & 1) && l == 0 ? 2 : 1); ++rep_) { ARGS(a4); if (l == 0) phase_rows<1>(a4, lds, G); else phase_rows<2>(a4, lds, G); }
        SEAM(pb + 4);
    }
#undef IN
#undef SEAM
#undef ARGS
}


#ifdef DBG_STOP_AFTER
__global__ void dbg_dump(const unsigned char* ws, float* out) {
    const size_t regs[9][2] = {{WS_MOD, 1966080}, {WS_ROPE, 1048576}, {WS_DEC, 17408}, {WS_YSQ, (size_t)M * 64 * 4}, {WS_BIN, 2 * BIN_BYTES}, {WS_BOUT, 2 * BOUT_BYTES}, {WS_HO, (size_t)M * D * 2}, {WS_P, (size_t)M * NP * 2}, {WS_REC, (size_t)NREC * REC_BYTES}};
    size_t obase = 0;
    for (int r = 0; r < 9; ++r) { const size_t nchunk = regs[r][1] / 128; const unsigned short* p = (const unsigned short*)(ws + regs[r][0]);
        for (size_t i = (size_t)blockIdx.x * blockDim.x + threadIdx.x; i < nchunk; i += (size_t)gridDim.x * blockDim.x) { unsigned s = 0; for (int k = 0; k < 64; ++k) s += p[i * 64 + k]; out[obase + i] = (float)s; }
        obase += nchunk; }
}
#endif
#ifndef MK_PER_PHASE
#define MK_PER_PHASE 1
#endif
extern "C" void kernel_launch(void* const* d_in, const int* in_sizes, int n_in, void* d_out, int out_size, void* d_ws, size_t ws_size, hipStream_t stream) {
    static int grid = 0;
    if (grid == 0) {
        if (n_in != 19 || out_size != (int)O_END || ws_size < WS_END) { fprintf(stderr, "kernel_launch: unexpected shapes (n_in %d out %d ws %zu need %zu)\n", n_in, out_size, ws_size, (size_t)WS_END); grid = -1; return; }
        int dev = 0, cus = 0;
        if (hipGetDevice(&dev) != hipSuccess || hipDeviceGetAttribute(&cus, hipDeviceAttributeMultiprocessorCount, dev) != hipSuccess) { grid = -1; return; }
        if (hipFuncSetAttribute((const void*)fwd, hipFuncAttributeMaxDynamicSharedMemorySize, LDS_BYTES) != hipSuccess) { fprintf(stderr, "kernel_launch: hipFuncSetAttribute failed\n"); grid = -1; return; }
        int per_cu = 0;
        if (hipOccupancyMaxActiveBlocksPerMultiprocessor(&per_cu, (const void*)fwd, 512, LDS_BYTES) != hipSuccess || per_cu < 1) fprintf(stderr, "kernel_launch: occupancy query says %d\n", per_cu);
        (void)hipGetLastError();
        grid = cus;
        if (grid < 128) { fprintf(stderr, "kernel_launch: needs >= 128 CUs\n"); grid = -1; return; }
    }
    if (grid < 0) return;
    (void)in_sizes;
    if (hipMemsetAsync((char*)d_ws + WS_CTL, 0, CTL_ZERO_BYTES, stream) != hipSuccess) return;
    Args a{};
    for (int i = 0; i < 19; ++i) a.in[i] = (const float*)d_in[i];
    a.out = (float*)d_out; a.ws = (unsigned char*)d_ws;
#ifdef DBG_STOP_AFTER
    for (int p = 0; p <= DBG_STOP_AFTER; ++p) { a.ph_lo = p; a.ph_hi = p + 1; hipLaunchKernelGGL(fwd, dim3(grid), dim3(512), LDS_BYTES, stream, a); }
    hipLaunchKernelGGL(dbg_dump, dim3(2048), dim3(256), 0, stream, (const unsigned char*)d_ws, (float*)d_out);
#elif MK_PER_PHASE
    for (int p = 0; p < N_PHASES; ++p) { a.ph_lo = p; a.ph_hi = p + 1; hipLaunchKernelGGL(fwd, dim3(grid), dim3(512), LDS_BYTES, stream, a); }
#else
    a.ph_lo = 0; a.ph_hi = N_PHASES;
    hipLaunchKernelGGL(fwd, dim3(grid), dim3(512), LDS_BYTES, stream, a);
#endif
}
```

```cpp
#include <hip/hip_runtime.h>
#include <cstdio>
#include <cstdint>
#define MK_PER_PHASE 0
__device__ __forceinline__ int tid_opaque() { int t = threadIdx.x; asm volatile("" : "+v"(t)); return t; }
namespace pg8 {
#define PG8_LAS __attribute__((address_space(3)))
typedef unsigned short bf16_t;
typedef short bf16x8 __attribute__((ext_vector_type(8)));
typedef float f32x4 __attribute__((ext_vector_type(4)));
typedef unsigned u32x4 __attribute__((ext_vector_type(4)));
constexpr int BM = 256, BK = 64, HALF = 128, HTB = HALF * BK * 2  , STAGE_BYTES = 8 * HTB, NXCD = 8, WGM = 8;

__host__ __device__ __forceinline__ int lds_byte(int r, int c) { const int st = (r >> 4) * 2 + (c >> 5), rr = r & 15, cc = c & 31, ob = rr * 64 + cc * 2; return st * 1024 + (ob ^ (((ob >> 9) & 1) << 5)); }
__host__ __device__ __forceinline__ void stage_rc(int b, int& R, int& C) { const int st = b / 1024, sb = b % 1024, swz = sb ^ (((sb >> 9) & 1) << 5); R = (st >> 1) * 16 + swz / 64; C = (st & 1) * 32 + (swz % 64) / 2; }
__host__ __device__ __forceinline__ int perm32(int rho) { const int n = rho >> 4, i = rho & 15; return 8 * (i >> 2) + 4 * n + (i & 3); }

struct Unit { int pm, pn; };
struct Gemm { const bf16_t* A; const bf16_t* Bt; int M, N, K; };

struct StaticOrder {
    int nM, nN, nwg, G, c;
    __host__ __device__ void init(int M, int N, int G_, int c_) { nM = M / BM; nN = N / BM; nwg = nM * nN; G = G_; c = c_; }
    __host__ __device__ bool next(int i, Unit& u) const {
        const long L = (long)i * G + c; if (L >= nwg) return false;
        int wgid = (int)L; { const int q = nwg / NXCD, r = nwg % NXCD, xcd = wgid % NXCD, off = wgid / NXCD; wgid = (xcd < r ? xcd * (q + 1) : r * (q + 1) + (xcd - r) * q) + off; }
        const int nig = WGM * nN, gid = wgid / nig, fm = gid * WGM, gsz = (nM - fm) < WGM ? (nM - fm) : WGM;
        u.pm = fm + ((wgid % nig) % gsz); u.pn = (wgid % nig) / gsz; return true;
    }
    __device__ __forceinline__ void a_ready(const Unit&) const {}
    __device__ __forceinline__ void done(const Unit&) const {}
};

typedef __bf16 hwbf16x2_t __attribute__((ext_vector_type(2))); typedef float f32x2_t __attribute__((ext_vector_type(2)));
__device__ __forceinline__ unsigned cvt_pk_bf16(float lo, float hi) { const f32x2_t v = {lo, hi}; return __builtin_bit_cast(unsigned, __builtin_convertvector(v, hwbf16x2_t)); }
struct EpiP {
    static constexpr bool PERM = true, AFTER_DRAIN = false;
    bf16_t* O; int ldc; const float* dn; int gate_lo, gate_hi;
    __device__ __forceinline__ void operator()(const f32x4 (&acc)[2][2][4][2], const Unit& u, int wr, int wc, int fr, int fq) const {
        const int row0 = u.pm * BM + wr * 64 + fr, col0 = u.pn * BM + wc * 32 + 8 * fq;
        if (u.pn >= gate_lo && u.pn < gate_hi) {
            f32x4 dv[2][2];
#pragma unroll
            for (int bj = 0; bj < 2; ++bj) { const int e0 = (wc * 32 + 8 * fq) & 127; dv[bj][0] = *(const f32x4*)(dn + e0); dv[bj][1] = *(const f32x4*)(dn + e0 + 4); }
#pragma unroll
            for (int ai = 0; ai < 2; ++ai)
#pragma unroll
                for (int m = 0; m < 4; ++m) { bf16_t* rowp = O + (size_t)(row0 + ai * HALF + m * 16) * ldc + col0;
#pragma unroll
                    for (int bj = 0; bj < 2; ++bj) { f32x4 v[2] = {acc[ai][bj][m][0], acc[ai][bj][m][1]};
#pragma unroll
                        for (int n = 0; n < 2; ++n) { const f32x4 t = v[n] * -1.4426950408889634f; f32x4 s;
#pragma unroll
                            for (int j = 0; j < 4; ++j) s[j] = __builtin_amdgcn_rcpf(1.0f + __builtin_amdgcn_exp2f(t[j]));
                            v[n] = v[n] * s * dv[bj][n]; }
                        u32x4 w; w.x = cvt_pk_bf16(v[0][0], v[0][1]); w.y = cvt_pk_bf16(v[0][2], v[0][3]); w.z = cvt_pk_bf16(v[1][0], v[1][1]); w.w = cvt_pk_bf16(v[1][2], v[1][3]);
                        *(u32x4*)(rowp + bj * HALF) = w; } }
            return;
        }
#pragma unroll
        for (int ai = 0; ai < 2; ++ai)
#pragma unroll
            for (int m = 0; m < 4; ++m) { bf16_t* rowp = O + (size_t)(row0 + ai * HALF + m * 16) * ldc + col0;
#pragma unroll
                for (int bj = 0; bj < 2; ++bj) { const f32x4 v0 = acc[ai][bj][m][0], v1 = acc[ai][bj][m][1];
                    u32x4 w; w.x = cvt_pk_bf16(v0[0], v0[1]); w.y = cvt_pk_bf16(v0[2], v0[3]); w.z = cvt_pk_bf16(v1[0], v1[1]); w.w = cvt_pk_bf16(v1[2], v1[3]);
                    *(u32x4*)(rowp + bj * HALF) = w; } }
    }
};
struct EpiY {
    static constexpr bool PERM = true, AFTER_DRAIN = false;
    bf16_t* O; int ldc; float* part;
    __device__ __forceinline__ void operator()(const f32x4 (&acc)[2][2][4][2], const Unit& u, int wr, int wc, int fr, int fq) const {
        const int row0 = u.pm * BM + wr * 64 + fr, col0 = u.pn * BM + wc * 32 + 8 * fq;
#pragma unroll
        for (int ai = 0; ai < 2; ++ai)
#pragma unroll
            for (int m = 0; m < 4; ++m) { const int row = row0 + ai * HALF + m * 16; bf16_t* rowp = O + (size_t)row * ldc + col0; float s = 0.f;
#pragma unroll
                for (int bj = 0; bj < 2; ++bj) { const f32x4 v0 = acc[ai][bj][m][0], v1 = acc[ai][bj][m][1];
                    s += (v0[0] * v0[0] + v0[1] * v0[1]) + (v0[2] * v0[2] + v0[3] * v0[3]) + (v1[0] * v1[0] + v1[1] * v1[1]) + (v1[2] * v1[2] + v1[3] * v1[3]);
                    u32x4 w; w.x = cvt_pk_bf16(v0[0], v0[1]); w.y = cvt_pk_bf16(v0[2], v0[3]); w.z = cvt_pk_bf16(v1[0], v1[1]); w.w = cvt_pk_bf16(v1[2], v1[3]);
                    *(u32x4*)(rowp + bj * HALF) = w; }
                s += __shfl_xor(s, 16); s += __shfl_xor(s, 32);
                if (fq == 0) part[(size_t)row * 64 + u.pn * 4 + wc] = s; }
    }
};

template <class Epi, class Sched, bool ALIGN_EPI = false, bool SP2 = false>
__device__ __forceinline__ void gemm_phase(PG8_LAS unsigned char* lds, const Gemm g, const Sched& S, const Epi& E) {
    const int tid = tid_opaque(), wid = __builtin_amdgcn_readfirstlane(tid >> 6), lane = tid & 63, wr = wid >> 2, wc = wid & 3, fr = lane & 15, fq = lane >> 4;
    const int K = g.K, nt = K / BK;
    unsigned voffA[2], voffB[2];
#pragma unroll
    for (int i = 0; i < 2; ++i) { int R, C; stage_rc(tid * 16 + i * 8192, R, C); const int Rb = Epi::PERM ? ((R & ~31) + perm32(R & 31)) : R;
        voffA[i] = (unsigned)(R * K + C) * 2u; voffB[i] = (unsigned)(Rb * K + C) * 2u; }
    const size_t kstep = (size_t)(BK * 2);
    const size_t hstep = (size_t)HALF * K * 2;
    const size_t tstep = 2 * hstep;
    const unsigned ldsw = (unsigned)wid * 1024u;
    const int aoff = lds_byte(wr * 64 + fr, fq * 8), boff = lds_byte(wc * 32 + fr, fq * 8);
#define PG8_SA(b, h) (((b) * 2 + (h)) * HTB)
#define PG8_SB(b, h) ((4 + (b) * 2 + (h)) * HTB)
#define PG8_STAGE(bufoff, gbase, voff) do { _Pragma("unroll") for (int _i = 0; _i < 2; ++_i) \
        __builtin_amdgcn_global_load_lds((const unsigned*)((const char*)(gbase) + (voff)[_i]), (PG8_LAS unsigned*)(lds + (bufoff) + ldsw + _i * 8192), 16, 0, 0); } while (0)
#define PG8_LDA(dst, b, h) do { _Pragma("unroll") for (int m = 0; m < 4; ++m) _Pragma("unroll") for (int k = 0; k < 2; ++k) dst[m][k] = *(const PG8_LAS bf16x8*)(lds + PG8_SA(b, h) + aoff + m * 2048 + k * 1024); } while (0)
#define PG8_LDB(dst, b, h) do { _Pragma("unroll") for (int n = 0; n < 2; ++n) _Pragma("unroll") for (int k = 0; k < 2; ++k) dst[n][k] = *(const PG8_LAS bf16x8*)(lds + PG8_SB(b, h) + boff + n * 2048 + k * 1024); } while (0)
#define PG8_MMA(ai, bj, At, Bt) do { __builtin_amdgcn_s_setprio(1); _Pragma("unroll") for (int m = 0; m < 4; ++m) _Pragma("unroll") for (int n = 0; n < 2; ++n) _Pragma("unroll") for (int k = 0; k < 2; ++k) \
        acc[ai][bj][m][n] = __builtin_amdgcn_mfma_f32_16x16x32_bf16(Bt[n][k], At[m][k], acc[ai][bj][m][n], 0, 0, 0); __builtin_amdgcn_s_setprio(0); } while (0)
#define PG8_WAIT_V(n) asm volatile("s_waitcnt vmcnt(" #n ")" ::: "memory")
#define PG8_WAIT_L(n) asm volatile("s_waitcnt lgkmcnt(" #n ")" ::: "memory")
#define PG8_BAR __builtin_amdgcn_s_barrier()
#define PG8_SCHED __builtin_amdgcn_sched_barrier(0)
    Unit cur, nxt; int ui = 0;
    if (!S.next(0, cur)) return;
    f32x4 acc[2][2][4][2];
#pragma unroll
    for (int a = 0; a < 2; ++a)
#pragma unroll
        for (int b = 0; b < 2; ++b)
#pragma unroll
            for (int m = 0; m < 4; ++m)
#pragma unroll
                for (int n = 0; n < 2; ++n) acc[a][b][m][n] = (f32x4){0.f, 0.f, 0.f, 0.f};
    bf16x8 At[4][2], B0[2][2], B1[2][2];
    const char* cA = (const char*)g.A + (size_t)cur.pm * tstep; const char* cB = (const char*)g.Bt + (size_t)cur.pn * tstep;
    S.a_ready(cur);
    if constexpr (SP2) {
        PG8_STAGE(PG8_SB(0, 0), cB, voffB); PG8_STAGE(PG8_SB(0, 1), cB + hstep, voffB); PG8_STAGE(PG8_SA(0, 0), cA, voffA); PG8_STAGE(PG8_SA(0, 1), cA + hstep, voffA);
        if (wr == 1) PG8_BAR;
        PG8_WAIT_V(2); PG8_BAR;
        PG8_STAGE(PG8_SB(1, 0), cB + kstep, voffB); PG8_STAGE(PG8_SA(1, 0), cA + kstep, voffA); PG8_STAGE(PG8_SB(1, 1), cB + hstep + kstep, voffB);
        PG8_WAIT_V(6); PG8_BAR;
    } else {
        PG8_STAGE(PG8_SB(0, 0), cB, voffB); PG8_STAGE(PG8_SA(0, 0), cA, voffA); PG8_STAGE(PG8_SB(0, 1), cB + hstep, voffB); PG8_STAGE(PG8_SA(0, 1), cA + hstep, voffA);
        if (wr == 1) PG8_BAR;
        PG8_WAIT_V(4); PG8_BAR;
        PG8_STAGE(PG8_SB(1, 0), cB + kstep, voffB); PG8_STAGE(PG8_SA(1, 0), cA + kstep, voffA); PG8_STAGE(PG8_SB(1, 1), cB + hstep + kstep, voffB);
        PG8_WAIT_V(6); PG8_BAR;
    }
    for (;;) {
        const bool has_next = S.next(ui + 1, nxt);
        const char* nA = has_next ? (const char*)g.A + (size_t)nxt.pm * tstep : cA; const char* nB = has_next ? (const char*)g.Bt + (size_t)nxt.pn * tstep : cB;
        for (int t = 0; t < nt; t += 2) {
            const bool last = (t == nt - 2);
            const char* a1 = cA + (size_t)(t + 1) * kstep;
            const char* a2 = last ? nA : cA + (size_t)(t + 2) * kstep; const char* b2 = last ? nB : cB + (size_t)(t + 2) * kstep;
            const char* a3 = a2 + kstep; const char* b3 = b2 + kstep;
            if (last && has_next) S.a_ready(nxt);
            if constexpr (SP2) {
            PG8_LDB(B0, 0, 0); PG8_LDB(B1, 0, 1); PG8_SCHED; PG8_LDA(At, 0, 0); PG8_STAGE(PG8_SA(1, 1), a1 + hstep, voffA);
            PG8_WAIT_V(8); PG8_WAIT_L(0); PG8_BAR; PG8_MMA(0, 0, At, B0); PG8_MMA(0, 1, At, B1); PG8_BAR; PG8_SCHED;
            PG8_LDA(At, 0, 1); PG8_STAGE(PG8_SB(0, 0), b2, voffB); PG8_STAGE(PG8_SB(0, 1), b2 + hstep, voffB); PG8_STAGE(PG8_SA(0, 0), a2, voffA);
            PG8_WAIT_V(8); PG8_WAIT_L(0); PG8_BAR; PG8_MMA(1, 0, At, B0); PG8_MMA(1, 1, At, B1); PG8_BAR; PG8_SCHED;
            PG8_LDB(B0, 1, 0); PG8_LDB(B1, 1, 1); PG8_SCHED; PG8_LDA(At, 1, 0); PG8_STAGE(PG8_SA(0, 1), a2 + hstep, voffA);
            PG8_WAIT_V(8); PG8_WAIT_L(0); PG8_BAR; PG8_MMA(0, 0, At, B0); PG8_MMA(0, 1, At, B1); PG8_BAR; PG8_SCHED;
            PG8_LDA(At, 1, 1); PG8_STAGE(PG8_SB(1, 0), b3, voffB); PG8_STAGE(PG8_SB(1, 1), b3 + hstep, voffB); PG8_STAGE(PG8_SA(1, 0), a3, voffA);
            PG8_WAIT_V(8); PG8_WAIT_L(0); PG8_BAR; PG8_MMA(1, 0, At, B0); PG8_MMA(1, 1, At, B1); PG8_BAR; PG8_SCHED;
            } else {
            PG8_LDB(B0, 0, 0); PG8_SCHED; PG8_LDA(At, 0, 0); PG8_STAGE(PG8_SA(1, 1), a1 + hstep, voffA);
            PG8_WAIT_L(8); PG8_BAR; PG8_WAIT_L(0); PG8_MMA(0, 0, At, B0); PG8_BAR; PG8_SCHED;
            PG8_LDB(B1, 0, 1); PG8_STAGE(PG8_SB(0, 0), b2, voffB);
            PG8_BAR; PG8_WAIT_L(0); PG8_MMA(0, 1, At, B1); PG8_BAR;
            PG8_LDA(At, 0, 1); PG8_STAGE(PG8_SA(0, 0), a2, voffA);
            PG8_BAR; PG8_WAIT_L(0); PG8_MMA(1, 0, At, B0); PG8_BAR; PG8_SCHED;
            PG8_STAGE(PG8_SB(0, 1), b2 + hstep, voffB);
            PG8_WAIT_V(6); PG8_BAR; PG8_MMA(1, 1, At, B1); PG8_BAR;
            PG8_LDB(B0, 1, 0); PG8_SCHED; PG8_LDA(At, 1, 0); PG8_STAGE(PG8_SA(0, 1), a2 + hstep, voffA);
            PG8_WAIT_L(8); PG8_BAR; PG8_WAIT_L(0); PG8_MMA(0, 0, At, B0); PG8_BAR; PG8_SCHED;
            PG8_LDB(B1, 1, 1); PG8_STAGE(PG8_SB(1, 0), b3, voffB);
            PG8_BAR; PG8_WAIT_L(0); PG8_MMA(0, 1, At, B1); PG8_BAR;
            PG8_LDA(At, 1, 1); PG8_STAGE(PG8_SA(1, 0), a3, voffA);
            PG8_BAR; PG8_WAIT_L(0); PG8_MMA(1, 0, At, B0); PG8_BAR; PG8_SCHED;
            PG8_STAGE(PG8_SB(1, 1), b3 + hstep, voffB);
            PG8_WAIT_V(6); PG8_BAR; PG8_MMA(1, 1, At, B1); PG8_BAR;
            }
        }
        if constexpr (ALIGN_EPI) { if (wr == 0) PG8_BAR; }
        if constexpr (!Epi::AFTER_DRAIN) { E(acc, cur, wr, wc, fr, fq); S.done(cur); }
        if (!has_next) break;
#pragma unroll
        for (int a = 0; a < 2; ++a)
#pragma unroll
            for (int b = 0; b < 2; ++b)
#pragma unroll
                for (int m = 0; m < 4; ++m)
#pragma unroll
                    for (int n = 0; n < 2; ++n) acc[a][b][m][n] = (f32x4){0.f, 0.f, 0.f, 0.f};
        cur = nxt; cA = nA; cB = nB; ++ui;
        if constexpr (ALIGN_EPI) { if (wr == 1) PG8_BAR; }
    }
    PG8_WAIT_V(0);
    if constexpr (!ALIGN_EPI) { if (wr == 0) PG8_BAR; }
    PG8_BAR;
    if constexpr (Epi::AFTER_DRAIN) { E.fused(acc, cur, wr, wc, fr, fq, lds, wid, lane); S.done(cur); }
#undef PG8_SA
#undef PG8_SB
#undef PG8_STAGE
#undef PG8_LDA
#undef PG8_LDB
#undef PG8_MMA
#undef PG8_WAIT_V
#undef PG8_WAIT_L
#undef PG8_BAR
#undef PG8_SCHED
}
}

#define GAS __attribute__((address_space(1)))
#define LAS __attribute__((address_space(3)))
typedef unsigned short bf16;
typedef short bf16x8 __attribute__((ext_vector_type(8)));
typedef short bf16x4 __attribute__((ext_vector_type(4)));
typedef float f32x4 __attribute__((ext_vector_type(4)));
typedef float f32x2 __attribute__((ext_vector_type(2)));
typedef unsigned u32x4 __attribute__((ext_vector_type(4)));
typedef unsigned u32x2 __attribute__((ext_vector_type(2)));

constexpr int D = 4096, NB = 4, T = 4096, NSB = 16, TS = 16, PAST = 2048;
constexpr int MP = NB * T, MS = NSB * TS, M = MP + MS;
constexpr int NP = 13056, IN_DIM = 12832;
constexpr int C_Q = 0, C_K = 2048, C_V = 4096, C_ZDN = 6144, C_AQ = 8192, C_AK = 10240, C_AV = 10496, C_AZ = 10752, C_B = 12800, C_A = 12816;
constexpr float EPS = 1e-6f;
constexpr size_t O_YP = 0, O_YS = O_YP + (size_t)MP * D, O_CONVP = O_YS + (size_t)MS * D, O_DNP = O_CONVP + 2 * 4 * 3 * 6144, O_KP = O_DNP + 2 * 4 * 16 * 128 * 128,
                 O_VP = O_KP + 2 * 4 * 128 * 256, O_CONVS = O_VP + 2 * 4 * 128 * 256, O_DNS = O_CONVS + 2 * 16 * 3 * 6144, O_KS = O_DNS + (size_t)2 * 16 * 16 * 128 * 128,
                 O_VS = O_KS + 2 * 16 * 128 * 256, O_END = O_VS + 2 * 16 * 128 * 256;
static_assert(O_END == 82001920, "output size");
constexpr size_t MiB = 1u << 20;
constexpr size_t WS_CTL = 0, CTL_ZERO_BYTES = 1 * MiB;
constexpr size_t WS_MOD = 1 * MiB;
constexpr size_t WS_ROPE = 3 * MiB;
constexpr size_t WS_DEC = 4 * MiB;
constexpr size_t WS_YSQ = 5 * MiB;
constexpr size_t WS_BIN = 10 * MiB;
constexpr size_t BIN_BYTES = (size_t)NP * 4096 * 2;
constexpr size_t WS_BOUT = 214 * MiB;
constexpr size_t BOUT_BYTES = (size_t)4096 * 4096 * 2;
constexpr size_t WS_HO = 278 * MiB;
constexpr size_t WS_P = 408 * MiB;
constexpr size_t WS_REC = 823 * MiB;
constexpr int REC_W = 0, REC_QD = 16384, REC_KD = 32768, REC_QK = 49152, REC_U = 57344, REC_BYTES = 73728, REC_STAGE = 57344;
constexpr int NREC = 4096 + 256;
constexpr size_t WS_YS = WS_REC + (size_t)NREC * REC_BYTES;
constexpr size_t WS_END = WS_YS + (size_t)MS * D * 2;
constexpr int CW_C2DONE = 3072;
static_assert(WS_BIN + 2 * BIN_BYTES <= WS_BOUT && WS_HO + (size_t)M * D * 2 <= WS_P && WS_P + (size_t)M * NP * 2 <= WS_REC, "ws map");
constexpr int CW_BAR = 4096;
constexpr int LDS_BYTES = 147456;
constexpr int MISC_OFF = 147456 - 256;

#define RLX_AGENT __ATOMIC_RELAXED, __HIP_MEMORY_SCOPE_AGENT
#define LDS_WAIT() asm volatile("s_waitcnt lgkmcnt(0)" ::: "memory")
#define VM_WAIT() asm volatile("s_waitcnt vmcnt(0)" ::: "memory")
#define BAR_LDS() do { asm volatile("s_waitcnt lgkmcnt(0)" ::: "memory"); __builtin_amdgcn_s_barrier(); asm volatile("" ::: "memory"); } while (0)
typedef __bf16 hwbf16x2 __attribute__((ext_vector_type(2)));
__device__ __forceinline__ unsigned cvtpk(float lo, float hi) { const f32x2 v = {lo, hi}; return __builtin_bit_cast(unsigned, __builtin_convertvector(v, hwbf16x2)); }
__device__ __forceinline__ float bflo(unsigned w) { return __uint_as_float(w << 16); }
__device__ __forceinline__ float bfhi(unsigned w) { return __uint_as_float(w & 0xffff0000u); }
__device__ __forceinline__ float bf1(bf16 h) { return __uint_as_float(((unsigned)h) << 16); }
__device__ __forceinline__ float silu_f(float x) { return x * __builtin_amdgcn_rcpf(1.0f + __expf(-x)); }
__device__ __forceinline__ float sigmoid_f(float x) { return __builtin_amdgcn_rcpf(1.0f + __expf(-x)); }
__device__ __forceinline__ float sum16(float v) {
    v += __builtin_bit_cast(float, __builtin_amdgcn_update_dpp(0, __builtin_bit_cast(int, v), 0xB1, 0xf, 0xf, true));
    v += __builtin_bit_cast(float, __builtin_amdgcn_update_dpp(0, __builtin_bit_cast(int, v), 0x4E, 0xf, 0xf, true));
    v += __builtin_bit_cast(float, __builtin_amdgcn_update_dpp(0, __builtin_bit_cast(int, v), 0x141, 0xf, 0xf, true));
    v += __builtin_bit_cast(float, __builtin_amdgcn_update_dpp(0, __builtin_bit_cast(int, v), 0x140, 0xf, 0xf, true));
    return v;
}
__device__ __forceinline__ float quadsum16(const f32x4 q, int fr) {
    const bool o1 = fr & 1, o2 = fr & 2;
    float kA = o1 ? q[1] : q[0], sA = o1 ? q[0] : q[1], kB = o1 ? q[3] : q[2], sB = o1 ? q[2] : q[3];
    kA += __builtin_bit_cast(float, __builtin_amdgcn_update_dpp(0, __builtin_bit_cast(int, sA), 0xB1, 0xf, 0xf, true));
    kB += __builtin_bit_cast(float, __builtin_amdgcn_update_dpp(0, __builtin_bit_cast(int, sB), 0xB1, 0xf, 0xf, true));
    float k = o2 ? kB : kA; const float s = o2 ? kA : kB;
    k += __builtin_bit_cast(float, __builtin_amdgcn_update_dpp(0, __builtin_bit_cast(int, s), 0x4E, 0xf, 0xf, true));
    k += __builtin_bit_cast(float, __builtin_amdgcn_update_dpp(0, __builtin_bit_cast(int, k), 0x124, 0xf, 0xf, true));
    k += __builtin_bit_cast(float, __builtin_amdgcn_update_dpp(0, __builtin_bit_cast(int, k), 0x128, 0xf, 0xf, true));
    return k;
}
__device__ __forceinline__ float wave_sum(float v) { v = sum16(v); v += __shfl_xor(v, 16); v += __shfl_xor(v, 32); return v; }
__device__ __forceinline__ float wave_max(float v) {
#pragma unroll
    for (int o = 1; o < 64; o <<= 1) v = fmaxf(v, __shfl_xor(v, o));
    return v;
}
__device__ __forceinline__ void unpack8(const u32x4 w, float (&f)[8]) {
    f[0] = bflo(w.x); f[1] = bfhi(w.x); f[2] = bflo(w.y); f[3] = bfhi(w.y); f[4] = bflo(w.z); f[5] = bfhi(w.z); f[6] = bflo(w.w); f[7] = bfhi(w.w);
}
__device__ __forceinline__ u32x4 pack8(const float (&f)[8]) { u32x4 w; w.x = cvtpk(f[0], f[1]); w.y = cvtpk(f[2], f[3]); w.z = cvtpk(f[4], f[5]); w.w = cvtpk(f[6], f[7]); return w; }
__device__ __forceinline__ u32x4 pack8v(const f32x2 (&f)[4]) { u32x4 w; w.x = cvtpk(f[0].x, f[0].y); w.y = cvtpk(f[1].x, f[1].y); w.z = cvtpk(f[2].x, f[2].y); w.w = cvtpk(f[3].x, f[3].y); return w; }
__device__ __forceinline__ bf16x8 as_bf16x8(const u32x4 w) { return __builtin_bit_cast(bf16x8, w); }
__device__ __forceinline__ bf16x4 as_bf16x4(const u32x2 w) { return __builtin_bit_cast(bf16x4, w); }

#define XB_TMO      128
#define XB_XCNT(j)  (256  + 64 * (j))
#define XB_XSUB(j)  (1280 + 64 * (j))
#define XB_XGEN(j)  (2304 + 64 * (j))
#define XB_TOP      3328
#define XB_TOPGEN   3392
#define XCD_BAR_WORDS 3456
#define XB_SPIN_CAP (1u << 18)

__device__ __forceinline__ unsigned xb_ld(unsigned* p)              { return __hip_atomic_load(p, __ATOMIC_RELAXED, __HIP_MEMORY_SCOPE_AGENT); }
__device__ __forceinline__ unsigned xb_add(unsigned* p, unsigned v) { return __hip_atomic_fetch_add(p, v, __ATOMIC_RELAXED, __HIP_MEMORY_SCOPE_AGENT); }
__device__ __forceinline__ unsigned xb_xcc_id() { return (unsigned)__builtin_amdgcn_s_getreg((3 << 11) | 20) & 0xFu; }
#define XB_SPIN(cond, bar) do { unsigned _sp = 0; while (cond) { __builtin_amdgcn_s_sleep(1); \
    if ((++_sp & 255u) == 0u) { if (xb_ld(&(bar)[XB_TMO])) break; if (_sp > XB_SPIN_CAP) { atomicAdd(&(bar)[XB_TMO], 1u); break; } } } } while (0)

struct XcdBarrier {
    unsigned* bar; unsigned x;
    volatile LAS unsigned* st;
};

__device__ __forceinline__ XcdBarrier xcd_barrier_post(unsigned* bar, volatile LAS unsigned* st) {
    XcdBarrier b; b.bar = bar; b.x = xb_xcc_id(); b.st = st;
    if (threadIdx.x == 0) (void)xb_add(&bar[XB_XCNT(b.x)], 1u);
    return b;
}
__device__ __forceinline__ void xcd_barrier_complete(unsigned* bar, unsigned x, unsigned& nloc, unsigned& nx) {
    const unsigned G = gridDim.x * gridDim.y * gridDim.z;
    unsigned sum, cnt, mine, sp = 0u;
    for (;;) {
        sum = 0u; cnt = 0u; mine = 0u;
#pragma unroll
        for (unsigned j = 0; j < 16; ++j) { const unsigned c = xb_ld(&bar[XB_XCNT(j)]); sum += c; cnt += (c > 0u) ? 1u : 0u; mine = (j == x) ? c : mine; }
        if (sum == G) break;
        __builtin_amdgcn_s_sleep(1);
        if ((++sp & 255u) == 0u) { if (xb_ld(&bar[XB_TMO])) break; if (sp > XB_SPIN_CAP) { atomicAdd(&bar[XB_TMO], 1u); break; } }
    }
    nloc = mine > 0u ? mine : 1u; nx = cnt > 0u ? cnt : 1u;
}

__device__ __forceinline__ void xcd_barrier(const XcdBarrier& b) {
    asm volatile("s_waitcnt vmcnt(0)" ::: "memory");
    __syncthreads();
    if (threadIdx.x == 0) {
        unsigned* bar = b.bar;
        __builtin_amdgcn_s_waitcnt(0);
        unsigned nloc = b.st[0], nx = b.st[1];
        if (nloc == 0u) { xcd_barrier_complete(bar, b.x, nloc, nx); b.st[0] = nloc; b.st[1] = nx; }
        const unsigned old = xb_add(&bar[XB_XSUB(b.x)], 1u);
        const unsigned gen = old / nloc;
        if (old + 1u == (gen + 1u) * nloc) {
            __builtin_amdgcn_fence(__ATOMIC_RELEASE, "agent");
            asm volatile("s_waitcnt vmcnt(0)" ::: "memory");
            const unsigned og = xb_add(&bar[XB_TOP], 1u);
            const unsigned tg = og / nx;
            if (og + 1u == (tg + 1u) * nx) xb_add(&bar[XB_TOPGEN], 1u);
            else XB_SPIN(xb_ld(&bar[XB_TOPGEN]) == tg, bar);
            __builtin_amdgcn_fence(__ATOMIC_ACQUIRE, "agent");
            xb_add(&bar[XB_XGEN(b.x)], 1u);
            asm volatile("s_waitcnt vmcnt(0)" ::: "memory");
        } else {
            XB_SPIN(xb_ld(&bar[XB_XGEN(b.x)]) == gen, bar);
            __builtin_amdgcn_fence(__ATOMIC_ACQUIRE, "agent");
            asm volatile("s_waitcnt vmcnt(0)" ::: "memory");
        }
    }
    __syncthreads();
}

struct Args { const float* in[19]; float* out; unsigned char* ws; int ph_lo, ph_hi; };

__device__ __forceinline__ void p0_transpose_item(const float* W, int K, int N, bf16* WT, int dst_row0, LAS float* scr, int k0, int n0, int lane) {
    const int r8 = lane >> 3, c4 = lane & 7;
    f32x4 v[8];
#pragma unroll
    for (int i = 0; i < 8; ++i) v[i] = *(const f32x4*)(W + (size_t)(k0 + 8 * i + r8) * N + n0 + 4 * c4);
#pragma unroll
    for (int i = 0; i < 8; ++i) { LAS float* d = scr + (8 * i + r8) * 33 + 4 * c4; d[0] = v[i][0]; d[1] = v[i][1]; d[2] = v[i][2]; d[3] = v[i][3]; }
    LDS_WAIT(); asm volatile("" ::: "memory");
    const int c = lane & 7;
#pragma unroll
    for (int j = 0; j < 4; ++j) { const int n = (lane >> 3) + 8 * j; const LAS float* s = scr + (8 * c) * 33 + n;
        u32x4 o; o.x = cvtpk(s[0 * 33], s[1 * 33]); o.y = cvtpk(s[2 * 33], s[3 * 33]); o.z = cvtpk(s[4 * 33], s[5 * 33]); o.w = cvtpk(s[6 * 33], s[7 * 33]);
        *(u32x4*)(WT + (size_t)(dst_row0 + n) * K + k0 + 8 * c) = o; }
    LDS_WAIT(); asm volatile("" ::: "memory");
}
__device__ __forceinline__ void prologue_work(const Args& a, LAS unsigned char* lds, int vb, int nvb, int ada_mask, int tr_mask, bool rope) {
    const int tid = tid_opaque(), lane = tid & 63, wave = tid >> 6;
    {
        const float* cp = a.in[6]; const float* cs = a.in[7]; const float* w_ada = a.in[8]; const float* b_ada = a.in[9];
        float* mod = (float*)(a.ws + WS_MOD);
        LAS float* sc = (LAS float*)lds;
        LAS float* red = (LAS float*)(lds + 40960);
        const int cgp = tid & 7, ksl = tid >> 3;
        const int it0 = (ada_mask & 1) ? 0 : 384, it1 = (ada_mask & 2) ? 768 : 384;
        for (int it = it0 + vb; it < it1 && ada_mask; it += nvb) {
            const int l = it / 384, col0 = (it % 384) * 32;
            f32x4 acc[20];
#pragma unroll
            for (int j = 0; j < 20; ++j) acc[j] = (f32x4){0.f, 0.f, 0.f, 0.f};
            for (int kt = 0; kt < 8; ++kt) {
                __syncthreads();
#pragma unroll
                for (int j = 0; j < 20; ++j) { const float cv = (j < 4) ? cp[j * 4096 + kt * 512 + tid] : cs[(j - 4) * 4096 + kt * 512 + tid]; sc[tid * 20 + j] = silu_f(cv); }
                __syncthreads();
                const float* wp = w_ada + ((size_t)l * 4096 + kt * 512 + ksl * 8) * 12288 + col0 + cgp * 4;
                f32x4 w[8];
#pragma unroll
                for (int kk = 0; kk < 8; ++kk) w[kk] = *(const f32x4*)(wp + (size_t)kk * 12288);
#pragma unroll
                for (int kk = 0; kk < 8; ++kk) {
                    const LAS f32x4* s4 = (const LAS f32x4*)(sc + (ksl * 8 + kk) * 20);
#pragma unroll
                    for (int j4 = 0; j4 < 5; ++j4) { const f32x4 s = s4[j4];
#pragma unroll
                        for (int jj = 0; jj < 4; ++jj) acc[j4 * 4 + jj] += s[jj] * w[kk]; }
                }
            }
#pragma unroll
            for (int j = 0; j < 20; ++j)
#pragma unroll
                for (int c = 0; c < 4; ++c) { float v = acc[j][c]; v += __shfl_xor(v, 8); v += __shfl_xor(v, 16); v += __shfl_xor(v, 32); acc[j][c] = v; }
            __syncthreads();
            if (lane < 8) {
#pragma unroll
                for (int j = 0; j < 20; ++j) *(LAS f32x4*)(red + (wave * 20 + j) * 32 + lane * 4) = acc[j];
            }
            __syncthreads();
            for (int o = tid; o < 640; o += 512) { const int j = o >> 5, c = o & 31; float s = 0.f;
#pragma unroll
                for (int w8 = 0; w8 < 8; ++w8) s += red[(w8 * 20 + j) * 32 + c];
                mod[((size_t)l * 20 + j) * 12288 + col0 + c] = s + b_ada[(size_t)l * 12288 + col0 + c]; }
        }
        __syncthreads();
    }
    {
        LAS float* scr = (LAS float*)(lds + wave * 8448);
        const int gw = vb * 8 + wave, NGW = nvb * 8;
        constexpr int I_IN = 64 * 401, I_OUT = 64 * 128;
#pragma unroll 1
        for (int mtx = 0; mtx < 4; ++mtx) {
            if (!((tr_mask >> mtx) & 1)) continue;
            const int l = mtx >> 1;
            if ((mtx & 1) == 0) {
                for (int r = gw; r < I_IN; r += NGW) { const int kb = r / 401, nb = r % 401, n0 = nb * 32; const int dst = (n0 < 8192) ? n0 : ((n0 < 8224) ? (C_B + (n0 - 8192)) : (n0 - 32));
                    p0_transpose_item(a.in[12] + (size_t)l * 4096 * IN_DIM, 4096, IN_DIM, (bf16*)(a.ws + WS_BIN + l * BIN_BYTES), dst, scr, kb * 64, n0, lane); }
                constexpr int ZU = (NP - IN_DIM) * 4096 * 2 / 16;
                for (int u = vb * 512 + tid; u < ZU; u += nvb * 512) *(u32x4*)(a.ws + WS_BIN + l * BIN_BYTES + (size_t)IN_DIM * 4096 * 2 + (size_t)u * 16) = (u32x4){0u, 0u, 0u, 0u};
            } else {
                for (int r = gw; r < I_OUT; r += NGW) { const int kb = r / 128, nb = r % 128;
                    p0_transpose_item(a.in[18] + (size_t)l * 4096 * 4096, 4096, 4096, (bf16*)(a.ws + WS_BOUT + l * BOUT_BYTES), nb * 32, scr, kb * 64, nb * 32, lane); }
            }
        }
        if (rope) { f32x2* rt = (f32x2*)(a.ws + WS_ROPE);
            for (int idx = vb * 512 + tid; idx < 4096 * 32; idx += nvb * 512) { const int pos = idx >> 5, i = idx & 31;
                const double inv = exp2(-(double)i * (13.287712379549449 / 32.0)); const double ang = (double)pos * inv;
                rt[idx] = (f32x2){(float)cos(ang), (float)sin(ang)}; } }
    }
}
#ifndef SPLIT_PROLOGUE
#define SPLIT_PROLOGUE 0
#endif
__device__ __forceinline__ void phase_prologue(const Args& a, LAS unsigned char* lds, int G) {
#if SPLIT_PROLOGUE
    prologue_work(a, lds, (int)blockIdx.x, G, 1, 0x7, true);
#else
    prologue_work(a, lds, (int)blockIdx.x, G, 3, 0xF, true);
#endif
}

__device__ __forceinline__ int row_j(int row) { return (row < MP) ? (row >> 12) : (4 + ((row - MP) >> 4)); }
__device__ __forceinline__ void stage_params(const Args& a, LAS float* pl, int tid, int mode  , int j) {
    const float* mod = (const float*)(a.ws + WS_MOD); const float* g_pre = a.in[10]; const float* g_post = a.in[11];
    for (int c = tid * 4; c < D; c += 2048) {
        if (mode == 0) { const float* mr = mod + (size_t)j * 12288;
            *(LAS f32x4*)(pl + 4096 + c) = *(const f32x4*)(g_pre + c) * (*(const f32x4*)(mr + 4096 + c) + 1.0f); *(LAS f32x4*)(pl + 8192 + c) = *(const f32x4*)(mr + c); }
        else { const int l = mode - 1; const float* mr = mod + ((size_t)l * 20 + j) * 12288;
            *(LAS f32x4*)(pl + c) = *(const f32x4*)(mr + 8192 + c) * *(const f32x4*)(g_post + (size_t)l * D + c);
            if (l == 0) { const float* m1 = mod + ((size_t)20 + j) * 12288;
                *(LAS f32x4*)(pl + 4096 + c) = *(const f32x4*)(g_pre + D + c) * (*(const f32x4*)(m1 + 4096 + c) + 1.0f); *(LAS f32x4*)(pl + 8192 + c) = *(const f32x4*)(m1 + c); } }
    }
}
template <int mode> __device__ __forceinline__ void phase_rows(const Args& a, LAS unsigned char* lds, int G) {
    const int tid = tid_opaque(), wave = tid >> 6;
    LAS float* pl = (LAS float*)lds;
    const bf16* Y = (const bf16*)(a.ws + WS_P); const float* ysq = (const float*)(a.ws + WS_YSQ);
    bf16* H = (bf16*)(a.ws + WS_HO);
    const int rpb = (M + G - 1) / G;
    const int r0 = blockIdx.x * rpb, r1 = (r0 + rpb < M) ? r0 + rpb : M;
#ifdef DBG_SIDE
    const unsigned dbg_nz_ = (mode == 2) ? __hip_atomic_load((const unsigned*)(a.ws + WS_CTL) + 2000, __ATOMIC_RELAXED, __HIP_MEMORY_SCOPE_AGENT) : 0u;
#endif
    int cur_a = -1, cur_b = -1;
    f32x4 xn[16]; u32x2 yn[16]; float ysn = 0.f;
#define ROW_LOAD(row_) do { const int lane_ = tid_opaque() & 63; float* orow_ = ((row_) < MP) ? a.out + O_YP + (size_t)(row_) * D : a.out + O_YS + (size_t)((row_) - MP) * D; \
        const float* xr_ = (mode == 2) ? orow_ : (((row_) < MP) ? a.in[0] + (size_t)(row_) * D : a.in[1] + (size_t)((row_) - MP) * D); \
        if (mode == 2) { _Pragma("unroll") for (int q = 0; q < 16; ++q) { const u32x2 xb_ = *(const u32x2*)((const bf16*)orow_ + 4 * lane_ + 256 * q); xn[q] = (f32x4){bflo(xb_.x), bfhi(xb_.x), bflo(xb_.y), bfhi(xb_.y)}; } } \
        else { _Pragma("unroll") for (int q = 0; q < 16; ++q) xn[q] = *(const f32x4*)(xr_ + 4 * lane_ + 256 * q); } \
        if (mode != 0) { const bf16* yrow_ = ((row_) < MP) ? Y + (size_t)(row_) * D : (const bf16*)(a.ws + WS_YS) + (size_t)((row_) - MP) * D; \
            _Pragma("unroll") for (int q = 0; q < 16; ++q) yn[q] = *(const u32x2*)(yrow_ + 4 * lane_ + 256 * q); \
            ysn = ysq[(size_t)(row_) * 64 + lane_]; } } while (0)
    if (r0 + wave < r1) ROW_LOAD(r0 + wave);
    for (int rb = r0; rb < r1; rb += 8) {
        const int ja = row_j(rb), jb = row_j((rb + 7 < r1) ? rb + 7 : r1 - 1);
        if (ja != cur_a || jb != cur_b) { BAR_LDS(); stage_params(a, pl, tid, mode, ja); if (jb != ja) stage_params(a, pl + 12288, tid, mode, jb); cur_a = ja; cur_b = jb; BAR_LDS(); }
        const int row = rb + wave;
        if (row >= r1) continue;
        const int lane = tid_opaque() & 63;
        const LAS float* plw = pl + ((row_j(row) == ja) ? 0 : 12288);
        float* orow = (row < MP) ? a.out + O_YP + (size_t)row * D : a.out + O_YS + (size_t)(row - MP) * D;
        f32x4 v[16]; u32x2 yw[16]; float ysc = ysn;
#pragma unroll
        for (int q = 0; q < 16; ++q) { v[q] = xn[q]; yw[q] = yn[q]; }
        if (row + 8 < r1) ROW_LOAD(row + 8);
        float s = 0.f;
        if (mode == 0) {
#pragma unroll
            for (int q = 0; q < 16; ++q) s += (v[q][0] * v[q][0] + v[q][1] * v[q][1]) + (v[q][2] * v[q][2] + v[q][3] * v[q][3]);
        } else {
            const float rstd_y = rsqrtf(wave_sum(ysc) * (1.f / D) + EPS);
#pragma unroll
            for (int q = 0; q < 16; ++q) { const int c = 4 * lane + 256 * q; const f32x4 y = (f32x4){bflo(yw[q].x), bfhi(yw[q].x), bflo(yw[q].y), bfhi(yw[q].y)};
                const f32x4 pa = *(const LAS f32x4*)(plw + c);
                v[q] = v[q] + pa * (y * rstd_y);
                s += (v[q][0] * v[q][0] + v[q][1] * v[q][1]) + (v[q][2] * v[q][2] + v[q][3] * v[q][3]);
#ifdef DBG_SIDE
                if (mode == 2) { f32x4 vo_ = v[q]; if (row >= MP && (unsigned)(row - MP) < dbg_nz_) vo_ = (f32x4){0.f, 0.f, 0.f, 0.f}; *(f32x4*)(orow + c) = vo_; }
#else
                if (mode == 2) *(f32x4*)(orow + c) = v[q];
#endif
                else { u32x2 xo; xo.x = cvtpk(v[q][0], v[q][1]); xo.y = cvtpk(v[q][2], v[q][3]); *(u32x2*)((bf16*)orow + c) = xo; } }
        }
        if (mode != 2) {
            const float rstd = rsqrtf(wave_sum(s) * (1.f / D) + EPS);
#pragma unroll
            for (int q = 0; q < 16; ++q) { const int c = 4 * lane + 256 * q;
                const f32x4 pb = *(const LAS f32x4*)(plw + 4096 + c), pc = *(const LAS f32x4*)(plw + 8192 + c);
                const f32x4 hv = v[q] * rstd * pb + pc; u32x2 w; w.x = cvtpk(hv[0], hv[1]); w.y = cvtpk(hv[2], hv[3]);
                *(u32x2*)(H + (size_t)row * D + c) = w; }
        }
    }
#undef ROW_LOAD
}


constexpr int L_KH = 0, L_QH = 18432, L_RT = 36864, L_XT = 77824, L_AI = 118784, L_DG = 129024, L_DI = 133120, L_GT = 135168;
constexpr int S128 = 144, S64 = 80;

__device__ __forceinline__ void phase_c1(const Args& a, int l, LAS unsigned char* lds, int G) {
    int tid, lane, wave, fr, fq;
#define RELANE() do { tid = tid_opaque(); lane = tid & 63; wave = __builtin_amdgcn_readfirstlane(tid >> 6); fr = lane & 15; fq = lane >> 4; } while (0)
    RELANE();
    const bf16* P = (const bf16*)(a.ws + WS_P);
    float* decbuf = (float*)(a.ws + WS_DEC);
    const float* conv_w = a.in[13] + (size_t)l * 4 * 6144;
    LAS bf16* KH = (LAS bf16*)(lds + L_KH); LAS bf16* QH = (LAS bf16*)(lds + L_QH); LAS bf16* RT = (LAS bf16*)(lds + L_RT); LAS bf16* XT = (LAS bf16*)(lds + L_XT);
    LAS bf16* AI = (LAS bf16*)(lds + L_AI); LAS float* DG = (LAS float*)(lds + L_DG); LAS bf16* DI = (LAS bf16*)(lds + L_DI);
    LAS unsigned char* STG = lds + L_XT;
    LAS float* g_beta = (LAS float*)(lds + L_GT); LAS float* g_gc = g_beta + 64; LAS float* g_egc = g_beta + 128; LAS float* g_misc = g_beta + 192;

    u32x4 raw[8]; unsigned gl = 0;
#define ITEM_PARAMS(it_, sample_, n_, c_, h_, ntok_, rowbase_) const bool sample_ = (it_) >= 4096; int n_, c_, h_, ntok_; size_t rowbase_; \
        if (!sample_) { h_ = (it_) & 15; c_ = ((it_) >> 4) & 63; n_ = (it_) >> 10; rowbase_ = (size_t)n_ * 4096 + c_ * 64; ntok_ = 64; } \
        else { const int s_ = (it_) - 4096; h_ = s_ & 15; n_ = s_ >> 4; c_ = 0; rowbase_ = (size_t)MP + n_ * 16; ntok_ = 16; }
#define PREFETCH(it_) do { ITEM_PARAMS(it_, ps_, pn_, pc_, ph_, pnt_, prb_); const int pt_ = tid_opaque(); \
        if (pt_ < 384) { const int pch0_ = (pt_ >> 7) * 2048 + ph_ * 128 + (pt_ & 15) * 8, pt0_ = ((pt_ >> 4) & 7) * 8; \
            _Pragma("unroll") for (int i = 0; i < 8; ++i) { const int tt = pt0_ + i; raw[i] = (u32x4){0u, 0u, 0u, 0u}; \
                if (tt < pnt_) raw[i] = *(const u32x4*)(P + (prb_ + tt) * NP + pch0_); } } \
        else { const int ptz_ = pt_ - 384; \
            if (ptz_ < 64 && ptz_ < pnt_) gl = (unsigned)P[(prb_ + ptz_) * NP + C_B + ph_] | ((unsigned)P[(prb_ + ptz_) * NP + C_A + ph_] << 16); } } while (0)

#ifdef DBG_MEASC
    unsigned long long dmacc_ = 0; const unsigned long long dmt0_ = __builtin_amdgcn_s_memtime(); unsigned long long dml_ = dmt0_;
#define DM(k) do { const unsigned long long n_ = __builtin_amdgcn_s_memtime(); if ((k) == DBG_MEASC) dmacc_ += n_ - dml_; dml_ = n_; } while (0)
#else
#define DM(k) do {} while (0)
#endif
    if ((int)blockIdx.x < NREC) PREFETCH((int)blockIdx.x);
    for (int item = blockIdx.x; item < NREC; item += G) {
        ITEM_PARAMS(item, sample, n, c, h, ntok, rowbase);
        const int reci = sample ? item : ((n * 16 + h) * 64 + c);
        unsigned char* rec = a.ws + WS_REC + (size_t)reci * REC_BYTES;
        const bool last = sample || (c == 63);
        DM(5); DM(0);
        RELANE();
        f32x2 val2[8][4];
        float ssq[8];
        int g = 3, cgl, seg;
        if (tid < 384) {
            cgl = tid & 15; g = __builtin_amdgcn_readfirstlane(tid >> 7); seg = (tid >> 4) & 7;
            const int ch0 = g * 2048 + h * 128 + cgl * 8;
            const int t0 = seg * 8;
            f32x4 wq[4][2];
#pragma unroll
            for (int j = 0; j < 4; ++j) { wq[j][0] = *(const f32x4*)(conv_w + (size_t)j * 6144 + ch0); wq[j][1] = *(const f32x4*)(conv_w + (size_t)j * 6144 + ch0 + 4); }
            u32x4 hist[3];
#pragma unroll
            for (int i = 0; i < 3; ++i) { const int tt = t0 - 3 + i; hist[i] = (u32x4){0u, 0u, 0u, 0u};
                if (tt < ntok && (tt >= 0 || (!sample && c > 0))) hist[i] = *(const u32x4*)(P + (rowbase + tt) * NP + ch0); }
            if (sample && seg == 0) {
                const float* sc = a.in[2] + (((size_t)l * 16 + n) * 3) * 6144 + ch0;
#pragma unroll
                for (int i = 0; i < 3; ++i) { const f32x4 s0 = *(const f32x4*)(sc + (size_t)i * 6144), s1 = *(const f32x4*)(sc + (size_t)i * 6144 + 4);
                    hist[i].x = cvtpk(s0[0], s0[1]); hist[i].y = cvtpk(s0[2], s0[3]); hist[i].z = cvtpk(s1[0], s1[1]); hist[i].w = cvtpk(s1[2], s1[3]); }
            }
            f32x2 sq2[8];
#pragma unroll
            for (int tok = 0; tok < 8; ++tok) sq2[tok] = (f32x2){0.f, 0.f};
#pragma unroll
            for (int cp = 0; cp < 4; ++cp) {
                f32x2 w2[4], x2[11];
#pragma unroll
                for (int j = 0; j < 4; ++j) w2[j] = (f32x2){wq[j][cp >> 1][2 * (cp & 1)], wq[j][cp >> 1][2 * (cp & 1) + 1]};
#pragma unroll
                for (int r = 0; r < 11; ++r) { const unsigned dw = (r < 3) ? hist[r < 3 ? r : 0][cp] : raw[r >= 3 ? r - 3 : 0][cp]; x2[r] = (f32x2){bflo(dw), bfhi(dw)}; }
#pragma unroll
                for (int tok = 0; tok < 8; ++tok) {
                    const f32x2 y = w2[0] * x2[tok] + w2[1] * x2[tok + 1] + w2[2] * x2[tok + 2] + w2[3] * x2[tok + 3];
                    const f32x2 t = y * -1.4426950408889634f; f32x2 e; e.x = __builtin_amdgcn_exp2f(t.x); e.y = __builtin_amdgcn_exp2f(t.y);
                    const f32x2 d = e + 1.0f; f32x2 r; r.x = __builtin_amdgcn_rcpf(d.x); r.y = __builtin_amdgcn_rcpf(d.y);
                    f32x2 v = y * r; if (!((t0 + tok) < ntok)) v = (f32x2){0.f, 0.f};
                    val2[tok][cp] = v; sq2[tok] += v * v; }
            }
#pragma unroll
            for (int tok = 0; tok < 8; ++tok) ssq[tok] = sq2[tok].x + sq2[tok].y;
            if (last && seg == (sample ? 1 : 7)) {
#pragma unroll
                for (int tok = 5; tok < 8; ++tok) { float rf[8]; unpack8(raw[tok], rf);
                    float* co = sample ? a.out + O_CONVS + (((size_t)l * 16 + n) * 3 + (tok - 5)) * 6144 + ch0 : a.out + O_CONVP + (((size_t)l * 4 + n) * 3 + (tok - 5)) * 6144 + ch0;
                    *(f32x4*)co = (f32x4){rf[0], rf[1], rf[2], rf[3]}; *(f32x4*)(co + 4) = (f32x4){rf[4], rf[5], rf[6], rf[7]}; }
            }
#pragma unroll
            for (int tok = 0; tok < 8; ++tok) ssq[tok] = sum16(ssq[tok]);
        } else {
            const int tz = tid - 384; cgl = tz & 15; seg = tz >> 4;
            if (wave == 6) {
                float beta = 0.f, gg = 0.f;
                if (lane < ntok) { const float b = bflo(gl), av = bfhi(gl);
                    beta = sigmoid_f(b); const float xx = av + a.in[15][l * 16 + h]; const float sp = fmaxf(xx, 0.f) + log1pf(__expf(-fabsf(xx)));
                    gg = -__expf(a.in[14][l * 16 + h]) * sp; }
                float gc = gg;
#pragma unroll
                for (int o = 1; o < 64; o <<= 1) { const float t = __shfl_up(gc, o); if (lane >= o) gc += t; }
                g_beta[lane] = beta; g_gc[lane] = gc; g_egc[lane] = __expf(gc);
                const float gcl = __shfl(gc, 63);
                if (lane == 0) { g_misc[0] = gcl; decbuf[reci] = __expf(gcl); }
            }
        }
        if (item + G < NREC) PREFETCH(item + G);
        DM(1); BAR_LDS(); DM(2);
#ifndef DBG_C1_REP
#define DBG_C1_REP 0
#endif
        for (int rp1_ = 0; rp1_ < ((DBG_C1_REP) & 1) + 1; ++rp1_)
        {
            { const int t1 = tid_opaque(); cgl = t1 & 15; seg = (t1 >> 4) & 7; }
            const int t0 = seg * 8;
            float bt[8], gcv[8], eg[8];
            { const f32x4 b0 = *(const LAS f32x4*)(g_beta + t0), b1 = *(const LAS f32x4*)(g_beta + t0 + 4), c0 = *(const LAS f32x4*)(g_gc + t0), c1 = *(const LAS f32x4*)(g_gc + t0 + 4),
                  e0 = *(const LAS f32x4*)(g_egc + t0), e1 = *(const LAS f32x4*)(g_egc + t0 + 4);
#pragma unroll
              for (int i = 0; i < 4; ++i) { bt[i] = b0[i]; bt[4 + i] = b1[i]; gcv[i] = c0[i]; gcv[4 + i] = c1[i]; eg[i] = e0[i]; eg[4 + i] = e1[i]; } }
            const float gcl = g_misc[0];
            const int qs0 = ((cgl * 8) & 15) >> 2, half0 = ((cgl * 8) >> 4) & 1, ks0 = (cgl * 8) >> 5;
            const int tq0 = (t0 & 15) >> 2, thalf = (t0 >> 4) & 1, tks = t0 >> 5;
            if (g == 0) {
#pragma unroll
                for (int tok = 0; tok < 8; ++tok) { const int t = t0 + tok; const float r = rsqrtf(ssq[tok] + EPS) * 0.08838834764831845f; f32x2 qv[4];
#pragma unroll
                    for (int i = 0; i < 4; ++i) qv[i] = val2[tok][i] * r;
                    *(LAS u32x4*)(QH + t * S128 + cgl * 8) = pack8v(qv);
                    const float e = eg[tok];
                    const int fq_ = (t >> 4) * 4 + ks0; LAS unsigned char* fp = STG + fq_ * 1024 + ((((t & 15) + 16 * qs0) ^ (fq_ & 7)) * 16) + 8 * half0;
#pragma unroll
                    for (int i = 0; i < 4; ++i) qv[i] = qv[i] * e;
                    u32x2 w0, w1; w0.x = cvtpk(qv[0].x, qv[0].y); w0.y = cvtpk(qv[1].x, qv[1].y); w1.x = cvtpk(qv[2].x, qv[2].y); w1.y = cvtpk(qv[3].x, qv[3].y);
                    *(LAS u32x2*)fp = w0; *(LAS u32x2*)(fp + 256) = w1; }
            } else if (g == 1) {
#pragma unroll
                for (int tok = 0; tok < 8; ++tok) { const float r = rsqrtf(ssq[tok] + EPS);
#pragma unroll
                    for (int i = 0; i < 4; ++i) val2[tok][i] = val2[tok][i] * r;
                    *(LAS u32x4*)(KH + (t0 + tok) * S128 + cgl * 8) = pack8v(val2[tok]); }
                float f1[8], f2[8];
#pragma unroll
                for (int tok = 0; tok < 8; ++tok) { f1[tok] = bt[tok] * eg[tok]; f2[tok] = __expf(gcl - gcv[tok]); }
#pragma unroll
                for (int ip = 0; ip < 4; ++ip) {
                    f32x2 rr[8], kd[8];
#pragma unroll
                    for (int tok = 0; tok < 8; ++tok) { rr[tok] = val2[tok][ip] * f1[tok]; kd[tok] = val2[tok][ip] * f2[tok]; }
#pragma unroll
                    for (int hh = 0; hh < 2; ++hh) { const int i = 2 * ip + hh, d = cgl * 8 + i;
                        u32x4 rw; rw.x = cvtpk(rr[0][hh], rr[1][hh]); rw.y = cvtpk(rr[2][hh], rr[3][hh]); rw.z = cvtpk(rr[4][hh], rr[5][hh]); rw.w = cvtpk(rr[6][hh], rr[7][hh]);
                        *(LAS u32x4*)(RT + (128 + i * 16 + cgl) * S64 + t0) = rw;
                        const int fk_ = 16 + (d >> 4) * 2 + tks; LAS unsigned char* fp = STG + fk_ * 1024 + ((((d & 15) + 16 * tq0) ^ (fk_ & 7)) * 16) + 8 * thalf;
                        u32x2 w0, w1; w0.x = cvtpk(kd[0][hh], kd[1][hh]); w0.y = cvtpk(kd[2][hh], kd[3][hh]); w1.x = cvtpk(kd[4][hh], kd[5][hh]); w1.y = cvtpk(kd[6][hh], kd[7][hh]);
                        *(LAS u32x2*)fp = w0; *(LAS u32x2*)(fp + 256) = w1; } }
            } else if (g == 2) {
#pragma unroll
                for (int ip = 0; ip < 4; ++ip) { f32x2 rr[8];
#pragma unroll
                    for (int tok = 0; tok < 8; ++tok) rr[tok] = val2[tok][ip] * bt[tok];
#pragma unroll
                    for (int hh = 0; hh < 2; ++hh) { const int i = 2 * ip + hh;
                        u32x4 rw; rw.x = cvtpk(rr[0][hh], rr[1][hh]); rw.y = cvtpk(rr[2][hh], rr[3][hh]); rw.z = cvtpk(rr[4][hh], rr[5][hh]); rw.w = cvtpk(rr[6][hh], rr[7][hh]);
                        *(LAS u32x4*)(RT + (i * 16 + cgl) * S64 + t0) = rw; } }
            }
        }
        DM(3); BAR_LDS(); DM(4);
#if defined(DBG_C1_STOP) && DBG_C1_STOP <= 1
        continue;
#endif
        RELANE();
        for (int rp2_ = 0; rp2_ < (((DBG_C1_REP) >> 1) & 1) + 1; ++rp2_)
#pragma unroll
        for (int k2 = 0; k2 < 2; ++k2) {
            const int tile = wave * 2 + k2, ti = tile >> 2, tj = tile & 3;
            f32x4 acq = (f32x4){0.f, 0.f, 0.f, 0.f}, ack = (f32x4){0.f, 0.f, 0.f, 0.f};
#pragma unroll
            for (int ks = 0; ks < 4; ++ks) {
                const bf16x8 kj = *(const LAS bf16x8*)(KH + (16 * tj + fr) * S128 + 32 * ks + 8 * fq);
                const bf16x8 qi = *(const LAS bf16x8*)(QH + (16 * ti + fr) * S128 + 32 * ks + 8 * fq);
                acq = __builtin_amdgcn_mfma_f32_16x16x32_bf16(kj, qi, acq, 0, 0, 0);
                if (ti >= tj) { const bf16x8 ki = *(const LAS bf16x8*)(KH + (16 * ti + fr) * S128 + 32 * ks + 8 * fq);
                    ack = __builtin_amdgcn_mfma_f32_16x16x32_bf16(ki, kj, ack, 0, 0, 0); }
            }
            {
                const int i = 16 * ti + fr; const float gi = g_gc[i]; const f32x4 gj = *(const LAS f32x4*)(g_gc + 16 * tj + 4 * fq); float o[4];
#pragma unroll
                for (int r = 0; r < 4; ++r) { const int j = 16 * tj + 4 * fq + r; o[r] = (i >= j) ? acq[r] * __expf(fminf(gi - gj[r], 0.f)) : 0.f; }
                u32x2 w; w.x = cvtpk(o[0], o[1]); w.y = cvtpk(o[2], o[3]);
                { const int fk2_ = 32 + ti * 2 + (tj >> 1); *(LAS u32x2*)(STG + fk2_ * 1024 + ((lane ^ (fk2_ & 7)) * 16) + 8 * (tj & 1)) = w; }
            }
            if (ti >= tj) {
                const int j = 16 * tj + fr; const float gj = g_gc[j]; const f32x4 gi = *(const LAS f32x4*)(g_gc + 16 * ti + 4 * fq), bi = *(const LAS f32x4*)(g_beta + 16 * ti + 4 * fq);
#pragma unroll
                for (int r = 0; r < 4; ++r) { const int i = 16 * ti + 4 * fq + r; const float v = (i > j) ? bi[r] * ack[r] * __expf(fminf(gi[r] - gj, 0.f)) : 0.f;
                    AI[i * S64 + j] = (bf16)(cvtpk(v, 0.f) & 0xffffu);
                    if (ti == tj) DG[(ti * 16 + (i & 15)) * 16 + fr] = v; }
            }
        }
        BAR_LDS(); DM(6);
#if defined(DBG_C1_STOP) && DBG_C1_STOP <= 2
        continue;
#endif
        RELANE();
        if (wave != 0) {
#pragma unroll
            for (int k5 = 0; k5 < 6; ++k5) { const int u = (tid - 64) + 448 * k5, fu_ = u >> 6; if (u < 2560) *(u32x4*)(rec + REC_QD + (size_t)u * 16) = *(const LAS u32x4*)(STG + fu_ * 1024 + (((u & 63) ^ (fu_ & 7)) * 16)); } }
        for (int rp3_ = 0; rp3_ < (((DBG_C1_REP) >> 2) & 1) + 1; ++rp3_)
        if (wave == 0) {
            const int b = fq, cc = fr; float x[16];
            {   f32x4 dg[10][3];
#pragma unroll
                for (int r = 1; r < 10; ++r)
#pragma unroll
                    for (int j4 = 0; j4 < (r + 3) / 4; ++j4) dg[r][j4] = *(const LAS f32x4*)(DG + (b * 16 + r) * 16 + 4 * j4);
                __builtin_amdgcn_sched_barrier(0);
#pragma unroll
                for (int r = 0; r < 10; ++r) { float s = (r == cc) ? 1.f : 0.f;
#pragma unroll
                    for (int j = 0; j < r; ++j) s -= dg[r][j >> 2][j & 3] * x[j];
                    x[r] = s; DI[(b * 16 + r) * 16 + cc] = (bf16)(cvtpk(s, 0.f) & 0xffffu); } }
            __builtin_amdgcn_sched_barrier(0);
            {   f32x4 dg[6][4];
#pragma unroll
                for (int r = 10; r < 16; ++r)
#pragma unroll
                    for (int j4 = 0; j4 < (r + 3) / 4; ++j4) dg[r - 10][j4] = *(const LAS f32x4*)(DG + (b * 16 + r) * 16 + 4 * j4);
                __builtin_amdgcn_sched_barrier(0);
#pragma unroll
                for (int r = 10; r < 16; ++r) { float s = (r == cc) ? 1.f : 0.f;
#pragma unroll
                    for (int j = 0; j < r; ++j) s -= dg[r - 10][j >> 2][j & 3] * x[j];
                    x[r] = s; DI[(b * 16 + r) * 16 + cc] = (bf16)(cvtpk(s, 0.f) & 0xffffu); } }
        }
        BAR_LDS(); DM(7);
#if defined(DBG_C1_STOP) && DBG_C1_STOP <= 3
        continue;
#endif
        for (int rp4_ = 0; rp4_ < (((DBG_C1_REP) >> 3) & 1) + 1; ++rp4_)
#pragma unroll
        for (int b = 0; b < 4; ++b) {
            RELANE();
#pragma unroll
            for (int k2 = 0; k2 < 2; ++k2) {
                const int nt = wave * 2 + k2;
                f32x4 y = (f32x4){0.f, 0.f, 0.f, 0.f};
#pragma unroll
                for (int ks = 0; ks < (b + 1) / 2; ++ks) {
                    const bool ok = (32 * ks + 8 * fq) < 16 * b;
                    u32x4 av = *(const LAS u32x4*)(AI + (16 * b + fr) * S64 + 32 * ks + 8 * fq), xv = *(const LAS u32x4*)(XT + (16 * nt + fr) * S64 + 32 * ks + 8 * fq);
                    if (!ok) { av = (u32x4){0u, 0u, 0u, 0u}; xv = (u32x4){0u, 0u, 0u, 0u}; }
                    y = __builtin_amdgcn_mfma_f32_16x16x32_bf16(as_bf16x8(av), as_bf16x8(xv), y, 0, 0, 0);
                }
                const int rn = 16 * nt + fr; const u32x2 rv = *(const LAS u32x2*)(RT + ((rn & 128) + (rn & 7) * 16 + ((rn & 127) >> 3)) * S64 + 16 * b + 4 * fq);
                const float z0 = bflo(rv.x) - y[0], z1 = bfhi(rv.x) - y[1], z2 = bflo(rv.y) - y[2], z3 = bfhi(rv.y) - y[3];
                u32x2 zb; zb.x = cvtpk(z0, z1); zb.y = cvtpk(z2, z3);
                const u32x2 dv = *(const LAS u32x2*)(DI + (b * 16 + fr) * 16 + 4 * fq);
                const f32x4 xo = __builtin_amdgcn_mfma_f32_16x16x16bf16_1k(as_bf16x4(dv), as_bf16x4(zb), (f32x4){0.f, 0.f, 0.f, 0.f}, 0, 0, 0);
                u32x2 xw; xw.x = cvtpk(xo[0], xo[1]); xw.y = cvtpk(xo[2], xo[3]);
                *(LAS u32x2*)(XT + (16 * nt + fr) * S64 + 16 * b + 4 * fq) = xw;
                if (nt < 8) *(u32x2*)(rec + REC_U + (size_t)(((nt * 4 + b) * 64 + lane) * 8)) = xw;
                else {
                    const f32x4 xt = __builtin_amdgcn_mfma_f32_16x16x16bf16_1k(as_bf16x4(zb), as_bf16x4(dv), (f32x4){0.f, 0.f, 0.f, 0.f}, 0, 0, 0);
                    u32x2 ww; ww.x = cvtpk(-xt[0], -xt[1]); ww.y = cvtpk(-xt[2], -xt[3]);
                    const int wt = nt - 8;
                    *(u32x2*)(rec + REC_W + (size_t)((((b * 4 + (wt >> 1)) * 64 + lane) * 16) + 8 * (wt & 1))) = ww; }
            }
            LDS_WAIT(); asm volatile("" ::: "memory");
        }
        BAR_LDS(); DM(8);
    }
#ifdef DBG_MEASC
    if (l == 1 && blockIdx.x == 0 && tid_opaque() == 0) { DM(5); const unsigned long long tot_ = __builtin_amdgcn_s_memtime() - dmt0_; const float fr_ = (float)dmacc_ / (float)tot_;
        ((unsigned*)(a.ws + WS_CTL))[2000] = 8u * (unsigned)(fr_ * 32.0f + 0.5f); }
#endif
#undef DM
#undef RELANE
#undef PREFETCH
#undef ITEM_PARAMS
}


constexpr int L_SS = 2 * REC_STAGE, L_RS = L_SS + 2048, L_DN = L_RS + 256, L_OB = L_DN + 512, OBS = 136;
__device__ __forceinline__ void scan_seq(const Args& a, int l, LAS unsigned char* lds, int seq) {
    int tid = tid_opaque(), lane = tid & 63, wave = __builtin_amdgcn_readfirstlane(tid >> 6);
    int fr = lane & 15, fq = lane >> 4;
    const bool sample = seq >= 64;
    const int s2 = sample ? seq - 64 : seq, n = s2 >> 4, h = s2 & 15;
    const int nsteps = sample ? 1 : 64, ntok = sample ? 16 : 64;
    const int rec0 = sample ? 4096 + s2 : s2 * 64;
    const size_t rowbase0 = sample ? (size_t)MP + n * 16 : (size_t)n * 4096;
    const unsigned char* recs = a.ws + WS_REC;
    const float* decbuf = (const float*)(a.ws + WS_DEC);
    bf16* Ob = (bf16*)(a.ws + WS_HO);
    LAS float* ss = (LAS float*)(lds + L_SS); LAS float* rs = (LAS float*)(lds + L_RS); LAS bf16* ob = (LAS bf16*)(lds + L_OB);
    f32x4 st[8];
    if (sample) { const float* s0 = a.in[3] + (((size_t)l * 16 + n) * 16 + h) * 16384;
#pragma unroll
        for (int t = 0; t < 8; ++t)
#pragma unroll
            for (int j = 0; j < 4; ++j) st[t][j] = s0[(16 * t + 4 * fq + j) * 128 + 16 * wave + fr];
    } else {
#pragma unroll
        for (int t = 0; t < 8; ++t) st[t] = (f32x4){0.f, 0.f, 0.f, 0.f};
    }
    __syncthreads();
    {   const unsigned char* src = recs + (size_t)rec0 * REC_BYTES;
#pragma unroll
        for (int k = 0; k < 7; ++k) { const int p = wave * 7 + k;
            __builtin_amdgcn_global_load_lds((const unsigned*)(src + p * 1024 + lane * 16), (LAS unsigned*)(lds + p * 1024), 16, 0, 0); } }
    u32x2 u_cur[4], u_nxt[4]; float dec_cur, dec_nxt = 0.f; f32x4 o_prev[4];
    u32x4 zq[2], zn[2]; LAS float* dnl = (LAS float*)(lds + L_DN);
    if (tid < 128) dnl[tid] = a.in[16][(size_t)l * 128 + tid];
    zq[0] = zq[1] = zn[0] = zn[1] = (u32x4){0u, 0u, 0u, 0u};
    {   const unsigned char* rec = recs + (size_t)rec0 * REC_BYTES;
#pragma unroll
        for (int t = 0; t < 4; ++t) { u_cur[t] = *(const u32x2*)(rec + REC_U + ((wave * 4 + t) * 64 + lane) * 8); u_nxt[t] = u_cur[t]; o_prev[t] = (f32x4){0.f, 0.f, 0.f, 0.f}; }
        dec_cur = decbuf[rec0]; }
#define SCAN_STORE(cc) do {   \
        _Pragma("unroll") for (int t = 0; t < 4; ++t) { const f32x4 r4 = *(const LAS f32x4*)(rs + 16 * t + 4 * fq); \
            _Pragma("unroll") for (int j = 0; j < 4; ++j) ob[(16 * t + 4 * fq + j) * OBS + 16 * wave + fr] = (bf16)(cvtpk(o_prev[t][j] * r4[j], 0.f) & 0xffffu); } } while (0)
#define SCAN_ZLOAD(cc, Z) do { const int tok_ = tid >> 3; if (tok_ < ntok) { const bf16* zp_ = (const bf16*)(a.ws + WS_P) + (rowbase0 + (size_t)(cc) * 64 + tok_) * NP + C_ZDN + h * 128 + (tid & 7) * 8; \
            Z[0] = *(const u32x4*)zp_; Z[1] = *(const u32x4*)(zp_ + 64); } } while (0)
#define SCAN_FLUSH(cc, Z) do {   \
        const int tok_ = tid >> 3, pc_ = tid & 7; \
        if (tok_ < ntok) { bf16* op_ = Ob + (rowbase0 + (size_t)(cc) * 64 + tok_) * D + h * 128 + pc_ * 8; \
            _Pragma("unroll") for (int hh = 0; hh < 2; ++hh) { float ov_[8], zv_[8]; unpack8(*(const LAS u32x4*)(ob + tok_ * OBS + 64 * hh + pc_ * 8), ov_); unpack8(Z[hh], zv_); \
                _Pragma("unroll") for (int i = 0; i < 8; ++i) ov_[i] = ov_[i] * zv_[i];     \
                *(u32x4*)(op_ + 64 * hh) = pack8(ov_); } } } while (0)
#define SCAN_RS() do { if (tid < 64) { float tsum = 0.f; \
            _Pragma("unroll") for (int w8 = 0; w8 < 8; ++w8) tsum += ss[w8 * 64 + tid]; \
            rs[tid] = rsqrtf(tsum * (1.f / 128.f) + EPS); } } while (0)
#ifdef DBG_MEAS
    unsigned long long dbg_w_ = 0, dbg_b_ = 0, dbg_b2_ = 0; const unsigned long long dbg_t0_ = __builtin_amdgcn_s_memtime(); const unsigned long long dbg_r0_ = __builtin_amdgcn_s_memrealtime();
#endif
    for (int c = 0; c < nsteps; ++c) {
        tid = tid_opaque(); lane = tid & 63; wave = __builtin_amdgcn_readfirstlane(tid >> 6); fr = lane & 15; fq = lane >> 4;
        const LAS unsigned char* buf = lds + (c & 1) * REC_STAGE;
        const unsigned char* rec = recs + (size_t)(rec0 + c) * REC_BYTES;
#ifdef DBG_MEAS
        const unsigned long long tm0_ = __builtin_amdgcn_s_memtime();
        VM_WAIT();
        const unsigned long long tm1_ = __builtin_amdgcn_s_memtime();
        __syncthreads();
        const unsigned long long tm2_ = __builtin_amdgcn_s_memtime();
        dbg_w_ += tm1_ - tm0_; dbg_b_ += tm2_ - tm1_;
#else
        VM_WAIT(); __syncthreads();
#endif; everybody is done with the other buffer; ss of step c-1 is complete
        if (c + 1 < nsteps) { const unsigned char* src = rec + REC_BYTES; LAS unsigned char* dst = lds + ((c + 1) & 1) * REC_STAGE;
#pragma unroll
            for (int k = 0; k < 7; ++k) { const int p = wave * 7 + k;
                __builtin_amdgcn_global_load_lds((const unsigned*)(src + p * 1024 + lane * 16), (LAS unsigned*)(dst + p * 1024), 16, 0, 0); }
#pragma unroll
            for (int t = 0; t < 4; ++t) u_nxt[t] = *(const u32x2*)(src + REC_U + ((wave * 4 + t) * 64 + lane) * 8);
            dec_nxt = decbuf[rec0 + c + 1]; }
        if (c > 0) SCAN_RS();
        if (c > 1) SCAN_FLUSH(c - 2, zn);
        if (c > 0) SCAN_ZLOAD(c - 1, zn);
        bf16x8 Bs[4];
#pragma unroll
        for (int ks = 0; ks < 4; ++ks) { u32x4 w; w.x = cvtpk(st[2 * ks][0], st[2 * ks][1]); w.y = cvtpk(st[2 * ks][2], st[2 * ks][3]); w.z = cvtpk(st[2 * ks + 1][0], st[2 * ks + 1][1]); w.w = cvtpk(st[2 * ks + 1][2], st[2 * ks + 1][3]); Bs[ks] = as_bf16x8(w); }
        f32x4 ws4[4], oacc[4];
#pragma unroll
        for (int t = 0; t < 4; ++t) ws4[t] = (f32x4){bflo(u_cur[t].x), bfhi(u_cur[t].x), bflo(u_cur[t].y), bfhi(u_cur[t].y)};
        bf16x8 FX[8], FY[8];
#define LDG(F, off) do { _Pragma("unroll") for (int i_ = 0; i_ < 8; ++i_) F[i_] = *(const LAS bf16x8*)(buf + (off) + (i_ * 64 + lane) * 16); } while (0)
#define SB() __builtin_amdgcn_sched_barrier(0)
        LDG(FX, REC_W); LDG(FY, REC_W + 8192); SB();
#pragma unroll
        for (int i = 0; i < 8; ++i) ws4[i >> 2] = __builtin_amdgcn_mfma_f32_16x16x32_bf16(FX[i], Bs[i & 3], ws4[i >> 2], 0, 0, 0);
        SB(); LDG(FX, REC_QD); SB();
#pragma unroll
        for (int i = 0; i < 8; ++i) ws4[2 + (i >> 2)] = __builtin_amdgcn_mfma_f32_16x16x32_bf16(FY[i], Bs[i & 3], ws4[2 + (i >> 2)], 0, 0, 0);
        SB(); LDG(FY, REC_QD + 8192); SB();
#pragma unroll
        for (int i = 0; i < 8; ++i) oacc[i >> 2] = __builtin_amdgcn_mfma_f32_16x16x32_bf16(FX[i], Bs[i & 3], (i & 3) ? oacc[i >> 2] : (f32x4){0.f, 0.f, 0.f, 0.f}, 0, 0, 0);
        SB(); LDG(FX, REC_QK); SB();
#pragma unroll
        for (int i = 0; i < 8; ++i) oacc[2 + (i >> 2)] = __builtin_amdgcn_mfma_f32_16x16x32_bf16(FY[i], Bs[i & 3], (i & 3) ? oacc[2 + (i >> 2)] : (f32x4){0.f, 0.f, 0.f, 0.f}, 0, 0, 0);
        SB(); LDG(FY, REC_KD); SB();
        bf16x8 Bv[2];
        {   f32x4 vn[4];
#pragma unroll
            for (int t = 0; t < 4; ++t) vn[t] = ws4[t];
#pragma unroll
            for (int k2 = 0; k2 < 2; ++k2) { u32x4 w; w.x = cvtpk(vn[2 * k2][0], vn[2 * k2][1]); w.y = cvtpk(vn[2 * k2][2], vn[2 * k2][3]); w.z = cvtpk(vn[2 * k2 + 1][0], vn[2 * k2 + 1][1]); w.w = cvtpk(vn[2 * k2 + 1][2], vn[2 * k2 + 1][3]); Bv[k2] = as_bf16x8(w); } }
#pragma unroll
        for (int t = 0; t < 8; ++t) st[t] = st[t] * dec_cur;
        SB();
#pragma unroll
        for (int i = 0; i < 8; ++i) oacc[i >> 1] = __builtin_amdgcn_mfma_f32_16x16x32_bf16(FX[i], Bv[i & 1], oacc[i >> 1], 0, 0, 0);
        SB(); LDG(FX, REC_KD + 8192); SB();
#pragma unroll
        for (int i = 0; i < 8; ++i) st[i >> 1] = __builtin_amdgcn_mfma_f32_16x16x32_bf16(FY[i], Bv[i & 1], st[i >> 1], 0, 0, 0);
        SB();
#pragma unroll
        for (int i = 0; i < 8; ++i) st[4 + (i >> 1)] = __builtin_amdgcn_mfma_f32_16x16x32_bf16(FX[i], Bv[i & 1], st[4 + (i >> 1)], 0, 0, 0);
#undef LDG
#undef SB
#ifdef DBG_MEAS
        const unsigned long long tm3_ = __builtin_amdgcn_s_memtime();
#endif
        BAR_LDS();
#ifdef DBG_MEAS
        dbg_b2_ += __builtin_amdgcn_s_memtime() - tm3_;
#endif
        if (c > 0) SCAN_STORE(c - 1);
#pragma unroll
        for (int t = 0; t < 4; ++t) { const float k = quadsum16(oacc[t] * oacc[t], fr);
            if (fr < 4) ss[wave * 64 + 16 * t + 4 * fq + fr] = k; }
#pragma unroll
        for (int t = 0; t < 4; ++t) { o_prev[t] = oacc[t]; u_cur[t] = u_nxt[t]; }
        dec_cur = dec_nxt;
    }
#ifdef DBG_MEAS
    if (l == 1 && seq == 0 && tid == 0) { const unsigned long long tot_ = __builtin_amdgcn_s_memtime() - dbg_t0_; const unsigned long long rt_ = __builtin_amdgcn_s_memrealtime() - dbg_r0_;
        float fr_ = 0.f;
        if (DBG_MEAS == 1) fr_ = (float)dbg_w_ / (float)tot_; else if (DBG_MEAS == 2) fr_ = (float)dbg_b_ / (float)tot_; else if (DBG_MEAS == 3) fr_ = (float)dbg_b2_ / (float)tot_;
        else if (DBG_MEAS == 4) fr_ = (float)rt_ * 0.01f / 500.0f;
        else if (DBG_MEAS == 5) fr_ = (float)tot_ / (float)rt_ / 100.0f * 0.25f;
        ((unsigned*)(a.ws + WS_CTL))[2000] = 8u * (unsigned)(fr_ * 32.0f + 0.5f); }
#endif
    __syncthreads();
    SCAN_RS();
    if (nsteps > 1) SCAN_FLUSH(nsteps - 2, zn);
    SCAN_ZLOAD(nsteps - 1, zq);
    __syncthreads();
    SCAN_STORE(nsteps - 1);
    __syncthreads();
    SCAN_FLUSH(nsteps - 1, zq);
#undef SCAN_FLUSH
#undef SCAN_ZLOAD
#undef SCAN_STORE
#undef SCAN_RS
    {   float* so = sample ? a.out + O_DNS + (((size_t)l * 16 + n) * 16 + h) * 16384 : a.out + O_DNP + (((size_t)l * 4 + n) * 16 + h) * 16384;
#pragma unroll
        for (int t = 0; t < 8; ++t)
#pragma unroll
            for (int j = 0; j < 4; ++j) so[(16 * t + 4 * fq + j) * 128 + 16 * wave + fr] = st[t][j]; }
}

constexpr int L_KI = 0, L_VT = 30720, SKI = 80, SVT = 200;
__device__ __forceinline__ void attn_item(const Args& a, int l, LAS unsigned char* lds, int it) {
    const int tid = tid_opaque(), lane = tid & 63, wave = __builtin_amdgcn_readfirstlane(tid >> 6);
    const int fr = lane & 15, fq = lane >> 4;
    const bool sample = it >= 1024;
    const int kv = it & 3, c = sample ? 0 : ((it >> 2) & 63), n = sample ? ((it - 1024) >> 2) : (it >> 8);
    const bf16* P = (const bf16*)(a.ws + WS_P); const f32x2* rope = (const f32x2*)(a.ws + WS_ROPE);
    bf16* Ob = (bf16*)(a.ws + WS_HO);
    LAS bf16* KI = (LAS bf16*)(lds + L_KI); LAS bf16* VT = (LAS bf16*)(lds + L_VT);
    const int kt0 = sample ? 0 : ((c >= 2) ? 0 : (8 - 4 * c));
    const int nkt = sample ? 9 : 12, nqt = sample ? 1 : 4;
    const size_t qrow0 = sample ? (size_t)MP + n * 16 : (size_t)n * 4096 + c * 64;
    const int pos0 = sample ? PAST : c * 64;
    __syncthreads();
    if (!sample) {
#pragma unroll
        for (int k2 = 0; k2 < 2; ++k2) { const int u = tid + 512 * k2; if (u < 768) { const int key = u >> 2, dg = u & 3, tok = (c - 2) * 64 + key;
            if (tok >= 0) { const bf16* kp = P + ((size_t)n * 4096 + tok) * NP + C_AK + kv * 64 + dg * 8; float x1[8], x2[8], o1[8], o2[8];
                unpack8(*(const u32x4*)kp, x1); unpack8(*(const u32x4*)(kp + 32), x2);
#pragma unroll
                for (int j = 0; j < 8; ++j) { const f32x2 cs = rope[tok * 32 + dg * 8 + j]; o1[j] = x1[j] * cs.x - x2[j] * cs.y; o2[j] = x2[j] * cs.x + x1[j] * cs.y; }
                *(LAS u32x4*)(KI + key * SKI + dg * 8) = pack8(o1); *(LAS u32x4*)(KI + key * SKI + 32 + dg * 8) = pack8(o2);
                if (c == 63 && key >= 64) { float* ko = a.out + O_KP + ((((size_t)l * 4 + n) * 128 + (key - 64)) * 4 + kv) * 64 + dg * 8;
                    *(f32x4*)ko = (f32x4){o1[0], o1[1], o1[2], o1[3]}; *(f32x4*)(ko + 4) = (f32x4){o1[4], o1[5], o1[6], o1[7]};
                    *(f32x4*)(ko + 32) = (f32x4){o2[0], o2[1], o2[2], o2[3]}; *(f32x4*)(ko + 36) = (f32x4){o2[4], o2[5], o2[6], o2[7]}; } } } }
#pragma unroll
        for (int k3 = 0; k3 < 3; ++k3) { const int u = tid + 512 * k3, key = u >> 3, dg = u & 7, tok = (c - 2) * 64 + key;
            if (tok >= 0) { const u32x4 vw = *(const u32x4*)(P + ((size_t)n * 4096 + tok) * NP + C_AV + kv * 64 + dg * 8);
                const unsigned ww[4] = {vw.x, vw.y, vw.z, vw.w};
#pragma unroll
                for (int j = 0; j < 8; ++j) VT[(dg * 8 + j) * SVT + key] = (bf16)((j & 1) ? (ww[j >> 1] >> 16) : (ww[j >> 1] & 0xffffu));
                if (c == 63 && key >= 64) { float vf[8]; unpack8(vw, vf); float* vo = a.out + O_VP + ((((size_t)l * 4 + n) * 128 + (key - 64)) * 4 + kv) * 64 + dg * 8;
                    *(f32x4*)vo = (f32x4){vf[0], vf[1], vf[2], vf[3]}; *(f32x4*)(vo + 4) = (f32x4){vf[4], vf[5], vf[6], vf[7]}; } } }
    } else {
        const float* ck = a.in[4] + ((size_t)l * 16 + n) * 128 * 256 + kv * 64; const float* cv = a.in[5] + ((size_t)l * 16 + n) * 128 * 256 + kv * 64;
        float* kso = a.out + O_KS + (((size_t)l * 16 + n) * 128 * 4 + kv) * 64; float* vso = a.out + O_VS + (((size_t)l * 16 + n) * 128 * 4 + kv) * 64;
#pragma unroll
        for (int k2 = 0; k2 < 3; ++k2) { const int u = tid + 512 * k2; if (u < 144 * 8) { const int key = u >> 3, dg = u & 7; float kf[8], vf[8];
            if (key < 128) { const f32x4 k0 = *(const f32x4*)(ck + (size_t)key * 256 + dg * 8), k1 = *(const f32x4*)(ck + (size_t)key * 256 + dg * 8 + 4), v0 = *(const f32x4*)(cv + (size_t)key * 256 + dg * 8), v1 = *(const f32x4*)(cv + (size_t)key * 256 + dg * 8 + 4);
#pragma unroll
                for (int j = 0; j < 4; ++j) { kf[j] = k0[j]; kf[4 + j] = k1[j]; vf[j] = v0[j]; vf[4 + j] = v1[j]; } }
            else { const int t = key - 128; const bf16* kp = P + ((size_t)MP + n * 16 + t) * NP + C_AK + kv * 64; float x1[8], x2[8];
                const int d1 = (dg & 3) * 8; unpack8(*(const u32x4*)(kp + d1), x1); unpack8(*(const u32x4*)(kp + 32 + d1), x2);
#pragma unroll
                for (int j = 0; j < 8; ++j) { const f32x2 cs = rope[(PAST + t) * 32 + d1 + j]; kf[j] = (dg < 4) ? (x1[j] * cs.x - x2[j] * cs.y) : (x2[j] * cs.x + x1[j] * cs.y); }
                unpack8(*(const u32x4*)(P + ((size_t)MP + n * 16 + t) * NP + C_AV + kv * 64 + dg * 8), vf); }
            *(LAS u32x4*)(KI + key * SKI + dg * 8) = pack8(kf);
            const u32x4 vw = pack8(vf); const unsigned ww[4] = {vw.x, vw.y, vw.z, vw.w};
#pragma unroll
            for (int j = 0; j < 8; ++j) VT[(dg * 8 + j) * SVT + key] = (bf16)((j & 1) ? (ww[j >> 1] >> 16) : (ww[j >> 1] & 0xffffu));
            if (key >= 16) { float* ko = kso + (size_t)(key - 16) * 256 + dg * 8; float* vo = vso + (size_t)(key - 16) * 256 + dg * 8;
                *(f32x4*)ko = (f32x4){kf[0], kf[1], kf[2], kf[3]}; *(f32x4*)(ko + 4) = (f32x4){kf[4], kf[5], kf[6], kf[7]};
                *(f32x4*)vo = (f32x4){vf[0], vf[1], vf[2], vf[3]}; *(f32x4*)(vo + 4) = (f32x4){vf[4], vf[5], vf[6], vf[7]}; } } }
    }
    __syncthreads();
    const int hq = kv * 8 + wave;
    const float sink = a.in[17][l * 32 + hq];
    for (int qt = 0; qt < nqt; ++qt) {
        const int tq = pos0 + 16 * qt + fr; const size_t row = qrow0 + 16 * qt + fr;
        bf16x8 Qf[2];
        {   const bf16* qp = P + row * NP + C_AQ + hq * 64 + 8 * fq; float x1[8], x2[8], o1[8], o2[8];
            unpack8(*(const u32x4*)qp, x1); unpack8(*(const u32x4*)(qp + 32), x2);
#pragma unroll
            for (int j = 0; j < 8; ++j) { const f32x2 cs = rope[tq * 32 + 8 * fq + j]; o1[j] = (x1[j] * cs.x - x2[j] * cs.y) * 0.125f; o2[j] = (x2[j] * cs.x + x1[j] * cs.y) * 0.125f; }
            Qf[0] = as_bf16x8(pack8(o1)); Qf[1] = as_bf16x8(pack8(o2)); }
        u32x2 zw[4];
#pragma unroll
        for (int dt = 0; dt < 4; ++dt) zw[dt] = *(const u32x2*)(P + row * NP + C_AZ + hq * 64 + 16 * dt + 4 * fq);
        f32x4 s[12]; float m = sink;
#pragma unroll
        for (int kt = 0; kt < 12; ++kt) { s[kt] = (f32x4){0.f, 0.f, 0.f, 0.f};
            if (kt >= kt0 && kt < nkt) {
#pragma unroll
                for (int ks = 0; ks < 2; ++ks) { const bf16x8 kf = *(const LAS bf16x8*)(KI + (16 * kt + fr) * SKI + 32 * ks + 8 * fq); s[kt] = __builtin_amdgcn_mfma_f32_16x16x32_bf16(kf, Qf[ks], s[kt], 0, 0, 0); }
                m = fmaxf(m, fmaxf(fmaxf(s[kt][0], s[kt][1]), fmaxf(s[kt][2], s[kt][3]))); } }
        m = fmaxf(m, __shfl_xor(m, 16)); m = fmaxf(m, __shfl_xor(m, 32));
        float sum = 0.f; f32x4 oc[4];
#pragma unroll
        for (int dt = 0; dt < 4; ++dt) oc[dt] = (f32x4){0.f, 0.f, 0.f, 0.f};
#pragma unroll
        for (int kt = 0; kt < 12; ++kt) { if (kt >= kt0 && kt < nkt) {
            const float p0 = __expf(s[kt][0] - m), p1 = __expf(s[kt][1] - m), p2 = __expf(s[kt][2] - m), p3 = __expf(s[kt][3] - m); sum += (p0 + p1) + (p2 + p3);
            u32x2 pw; pw.x = cvtpk(p0, p1); pw.y = cvtpk(p2, p3);
#pragma unroll
            for (int dt = 0; dt < 4; ++dt) { const u32x2 vf = *(const LAS u32x2*)(VT + (16 * dt + fr) * SVT + 16 * kt + 4 * fq);
                oc[dt] = __builtin_amdgcn_mfma_f32_16x16x16bf16_1k(as_bf16x4(vf), as_bf16x4(pw), oc[dt], 0, 0, 0); } } }
        sum += __shfl_xor(sum, 16); sum += __shfl_xor(sum, 32);
        const float inv = 1.0f / (sum + __expf(sink - m));
#pragma unroll
        for (int dt = 0; dt < 4; ++dt) { const int d0 = 16 * dt + 4 * fq;
            const float o0 = oc[dt][0] * inv * silu_f(bflo(zw[dt].x)), o1 = oc[dt][1] * inv * silu_f(bfhi(zw[dt].x)), o2 = oc[dt][2] * inv * silu_f(bflo(zw[dt].y)), o3 = oc[dt][3] * inv * silu_f(bfhi(zw[dt].y));
            u32x2 ow; ow.x = cvtpk(o0, o1); ow.y = cvtpk(o2, o3);
            *(u32x2*)(Ob + row * D + 2048 + hq * 64 + d0) = ow; }
    }
}

struct OneUnit { int pn; __device__ __forceinline__ bool next(int i, pg8::Unit& u) const { if (i) return false; u.pm = 0; u.pn = pn; return true; }
    __device__ __forceinline__ void a_ready(const pg8::Unit&) const {} __device__ __forceinline__ void done(const pg8::Unit&) const {} };
#ifndef DBG_REPEAT
#define DBG_REPEAT 0
#endif
__device__ __forceinline__ void phase_c2(const Args& a, int l, LAS unsigned char* lds, int G) {
    const int b = blockIdx.x;
    unsigned* cnt = (unsigned*)(a.ws + WS_CTL) + CW_C2DONE + 64 * l;
    if (b < 64) { for (int r_ = 0; r_ < ((((DBG_REPEAT) >> 7) & 1) ? 2 : 1); ++r_) scan_seq(a, l, lds, b); }
    else if (b < 80) {
        if (threadIdx.x == 0) { unsigned sp = 0; while (__hip_atomic_load(cnt, __ATOMIC_RELAXED, __HIP_MEMORY_SCOPE_AGENT) < (unsigned)(G - 80)) { __builtin_amdgcn_s_sleep(8); if (++sp > (1u << 22)) break; }
            __builtin_amdgcn_fence(__ATOMIC_ACQUIRE, "agent"); VM_WAIT(); }
        __syncthreads();
        pg8::Gemm g{(const pg8::bf16_t*)(a.ws + WS_HO) + (size_t)MP * D, (const pg8::bf16_t*)(a.ws + WS_BOUT + l * BOUT_BYTES), MS, D, D};
        OneUnit S; S.pn = b - 64;
        pg8::EpiY E{(pg8::bf16_t*)(a.ws + WS_YS), D, (float*)(a.ws + WS_YSQ) + (size_t)MP * 64};
        pg8::gemm_phase<pg8::EpiY, OneUnit, true, true>(lds, g, S, E);
    } else {
        const int vb = b - 80, nvb = G - 80;
        for (int it = vb; it < 320; it += nvb) { if (it < 256) scan_seq(a, l, lds, 64 + it); else attn_item(a, l, lds, 1024 + (it - 256)); }
        VM_WAIT(); __syncthreads();
        if (threadIdx.x == 0) { __builtin_amdgcn_fence(__ATOMIC_RELEASE, "agent"); VM_WAIT(); __hip_atomic_fetch_add(cnt, 1u, __ATOMIC_RELAXED, __HIP_MEMORY_SCOPE_AGENT); }
        for (int it = vb; it < 1024; it += nvb) { for (int r_ = 0; r_ < ((((DBG_REPEAT) >> 8) & 1) ? 2 : 1); ++r_) attn_item(a, l, lds, it); }
#if SPLIT_PROLOGUE
        if (l == 0) { __syncthreads(); prologue_work(a, lds, vb, nvb, 2, 0x8, false); }
#endif
    }
}

constexpr int N_PHASES = 12;
__device__ __forceinline__ Args load_args(const __attribute__((address_space(4))) Args* p) {
    Args a;
#pragma unroll
    for (int i = 0; i < 19; ++i) a.in[i] = (const float*)(const GAS float*)p->in[i];
    a.out = (float*)(GAS float*)p->out; a.ws = (unsigned char*)(GAS unsigned char*)p->ws; a.ph_lo = p->ph_lo; a.ph_hi = p->ph_hi; return a;
}
__global__ void __launch_bounds__(512, 2) fwd(Args args) {
    extern __shared__ __attribute__((aligned(16))) unsigned char lds_raw[];
    LAS unsigned char* lds = (LAS unsigned char*)lds_raw;
    const int G = gridDim.x;
    typedef const __attribute__((address_space(4))) Args* KArgs;
    const KArgs kp = (KArgs)__builtin_amdgcn_kernarg_segment_ptr();
#define ARGS(name) KArgs name##_p = kp; asm volatile("" : "+s"(name##_p)); const Args name = load_args(name##_p)
    const int lo = kp->ph_lo, hi = kp->ph_hi;
    volatile LAS unsigned* MISC = (volatile LAS unsigned*)(lds + MISC_OFF);
    for (int u = threadIdx.x; u < 64; u += 512) MISC[u] = 0u;
    __syncthreads();
    unsigned* barw = (unsigned*)(GAS unsigned*)((GAS unsigned char*)kp->ws + WS_CTL) + CW_BAR;
    XcdBarrier bar; bar.bar = barw; bar.x = 0; bar.st = nullptr;
    const bool multi = (hi - lo) > 1;
    if (multi) bar = xcd_barrier_post(barw, MISC + 8);
#define IN(k) (lo <= (k) && (k) < hi)
#ifndef DBG_REPEAT
#define DBG_REPEAT 0
#endif
#define REP(bit) for (int rep_ = 0; rep_ < (((DBG_REPEAT) >> (bit)) & 1) + 1; ++rep_)
#define SEAM(k) do { if (IN(k) && IN((k) + 1)) xcd_barrier(bar); } while (0)
    if (IN(0)) REP(0) { ARGS(a0); phase_prologue(a0, lds, G); }
    SEAM(0);
    if (IN(1)) REP(1) { ARGS(a1); phase_rows<0>(a1, lds, G); }
    SEAM(1);
    for (int l = 0; l < 2; ++l) {
        const int pb = 2 + 5 * l;
        if (IN(pb + 0)) REP(2) {
            ARGS(args);
            pg8::Gemm g{(const pg8::bf16_t*)(args.ws + WS_HO), (const pg8::bf16_t*)(args.ws + WS_BIN + l * BIN_BYTES), M, NP, D};
            pg8::StaticOrder S; S.init(M, NP, G, (int)blockIdx.x);
            pg8::EpiP E{(pg8::bf16_t*)(args.ws + WS_P), NP, args.in[16] + (size_t)l * 128, C_ZDN / 256, (C_ZDN + 2048) / 256};
#ifdef DBG_CLK
            const unsigned long long ck0_ = __builtin_amdgcn_s_memtime(), cr0_ = __builtin_amdgcn_s_memrealtime();
#endif
            pg8::gemm_phase<pg8::EpiP, pg8::StaticOrder, true, true>(lds, g, S, E);
#ifdef DBG_CLK
            if (l == 1 && blockIdx.x == 0 && threadIdx.x == 0) { const unsigned long long dc_ = __builtin_amdgcn_s_memtime() - ck0_, dr_ = __builtin_amdgcn_s_memrealtime() - cr0_;
                const float ghz_ = (float)dc_ / ((float)dr_ * 10.0f);
                float fr_ = (DBG_CLK == 1) ? (ghz_ - 1.0f) / 1.6f : (float)dr_ * 0.01f / 2000.0f;
                fr_ = fr_ < 0.f ? 0.f : (fr_ > 1.f ? 1.f : fr_);
                ((unsigned*)(args.ws + WS_CTL))[2000] = 16u * (unsigned)(fr_ * 16.0f + 0.5f); }
#endif
        }
        SEAM(pb + 0);
        if (IN(pb + 1)) REP(3) { ARGS(a2); phase_c1(a2, l, lds, G); }
        SEAM(pb + 1);
        if (IN(pb + 2)) REP(4) { ARGS(a3); phase_c2(a3, l, lds, G); }
        SEAM(pb + 2);
        if (IN(pb + 3)) REP(5) {
            ARGS(args);
            pg8::Gemm g{(const pg8::bf16_t*)(args.ws + WS_HO), (const pg8::bf16_t*)(args.ws + WS_BOUT + l * BOUT_BYTES), MP, D, D};
            pg8::StaticOrder S; S.init(MP, D, G, (int)blockIdx.x);
            pg8::EpiY E{(pg8::bf16_t*)(args.ws + WS_P), D, (float*)(args.ws + WS_YSQ)};
            pg8::gemm_phase<pg8::EpiY, pg8::StaticOrder, true, true>(lds, g, S, E);
        }
        SEAM(pb + 3);
        if (IN(pb + 4)) for (int rep_ = 0; rep_ < ((((DBG_REPEAT) >> 6) & 1) && l == 0 ? 2 : 1); ++rep_) { ARGS(a4); if (l == 0) phase_rows<1>(a4, lds, G); else phase_rows<2>(a4, lds, G); }
        SEAM(pb + 4);
    }
#undef IN
#undef SEAM
#undef ARGS
}


#ifdef DBG_STOP_AFTER
__global__ void dbg_dump(const unsigned char* ws, float* out) {
    const size_t regs[9][2] = {{WS_MOD, 1966080}, {WS_ROPE, 1048576}, {WS_DEC, 17408}, {WS_YSQ, (size_t)M * 64 * 4}, {WS_BIN, 2 * BIN_BYTES}, {WS_BOUT, 2 * BOUT_BYTES}, {WS_HO, (size_t)M * D * 2}, {WS_P, (size_t)M * NP * 2}, {WS_REC, (size_t)NREC * REC_BYTES}};
    size_t obase = 0;
    for (int r = 0; r < 9; ++r) { const size_t nchunk = regs[r][1] / 128; const unsigned short* p = (const unsigned short*)(ws + regs[r][0]);
        for (size_t i = (size_t)blockIdx.x * blockDim.x + threadIdx.x; i < nchunk; i += (size_t)gridDim.x * blockDim.x) { unsigned s = 0; for (int k = 0; k < 64; ++k) s += p[i * 64 + k]; out[obase + i] = (float)s; }
        obase += nchunk; }
}
#endif
#ifndef MK_PER_PHASE
#define MK_PER_PHASE 1
#endif
extern "C" void kernel_launch(void* const* d_in, const int* in_sizes, int n_in, void* d_out, int out_size, void* d_ws, size_t ws_size, hipStream_t stream) {
    static int grid = 0;
    if (grid == 0) {
        if (n_in != 19 || out_size != (int)O_END || ws_size < WS_END) { fprintf(stderr, "kernel_launch: unexpected shapes (n_in %d out %d ws %zu need %zu)\n", n_in, out_size, ws_size, (size_t)WS_END); grid = -1; return; }
        int dev = 0, cus = 0;
        if (hipGetDevice(&dev) != hipSuccess || hipDeviceGetAttribute(&cus, hipDeviceAttributeMultiprocessorCount, dev) != hipSuccess) { grid = -1; return; }
        if (hipFuncSetAttribute((const void*)fwd, hipFuncAttributeMaxDynamicSharedMemorySize, LDS_BYTES) != hipSuccess) { fprintf(stderr, "kernel_launch: hipFuncSetAttribute failed\n"); grid = -1; return; }
        int per_cu = 0;
        if (hipOccupancyMaxActiveBlocksPerMultiprocessor(&per_cu, (const void*)fwd, 512, LDS_BYTES) != hipSuccess || per_cu < 1) fprintf(stderr, "kernel_launch: occupancy query says %d\n", per_cu);
        (void)hipGetLastError();
        grid = cus;
        if (grid < 128) { fprintf(stderr, "kernel_launch: needs >= 128 CUs\n"); grid = -1; return; }
    }
    if (grid < 0) return;
    (void)in_sizes;
    if (hipMemsetAsync((char*)d_ws + WS_CTL, 0, CTL_ZERO_BYTES, stream) != hipSuccess) return;
    Args a{};
    for (int i = 0; i < 19; ++i) a.in[i] = (const float*)d_in[i];
    a.out = (float*)d_out; a.ws = (unsigned char*)d_ws;
#ifdef DBG_STOP_AFTER
    for (int p = 0; p <= DBG_STOP_AFTER; ++p) { a.ph_lo = p; a.ph_hi = p + 1; hipLaunchKernelGGL(fwd, dim3(grid), dim3(512), LDS_BYTES, stream, a); }
    hipLaunchKernelGGL(dbg_dump, dim3(2048), dim3(256), 0, stream, (const unsigned char*)d_ws, (float*)d_out);
#elif MK_PER_PHASE
    for (int p = 0; p < N_PHASES; ++p) { a.ph_lo = p; a.ph_hi = p + 1; hipLaunchKernelGGL(fwd, dim3(grid), dim3(512), LDS_BYTES, stream, a); }
#else
    a.ph_lo = 0; a.ph_hi = N_PHASES;
    hipLaunchKernelGGL(fwd, dim3(grid), dim3(512), LDS_BYTES, stream, a);
#endif
}
```
